# Optimizing an MI355X kernel written in HIP

```python
import math
import jax, jax.numpy as jnp
from jax import lax
import numpy as np

D_MODEL = 1024
BATCH = 2
SEQ = 16384
DEPTH = 4

N_META = 16
N_A_LAYERS = DEPTH // 2
N_B_LAYERS = DEPTH - N_A_LAYERS
RWKV_HEAD = 64
RWKV_HEADS = D_MODEL // RWKV_HEAD
DECAY_LORA = 64
AAA_LORA = 64
MV_LORA = 32
GATE_LORA = 160
RWKV_GN_EPS = 64e-5
DIFF_HEADS = 8
DIFF_HD = D_MODEL // (2 * DIFF_HEADS)
Q_BLOCK = 128
N_EXPERTS = 64
TOP_K = 8
N_GROUPS = 8
TOPK_GROUPS = 4
EXPERT_FF = D_MODEL // 4
SHARED_FF = EXPERT_FF
ROUTED_SCALE = 2.5
MOE_BLOCK = 128
DN_ALPHA = (2 * DEPTH) ** 0.25
DN_BETA = (8 * DEPTH) ** -0.25
LN_EPS = 1e-5

kernel_name = "yoco_rwkv7_diffattn_moe_trunk"


def layer_norm(x, g, b):
    xf = x.astype(jnp.float32)
    mu = xf.mean(-1, keepdims=True)
    var = jnp.mean(jnp.square(xf - mu), -1, keepdims=True)
    return ((xf - mu) * lax.rsqrt(var + LN_EPS) * g + b).astype(x.dtype)


def wkv7_scan(r, w, k, v, a, b):
    B, T, H, N = r.shape
    tm = lambda z: jnp.moveaxis(z.astype(jnp.float32), 1, 0)

    def step(S, inp):
        r_t, w_t, k_t, v_t, a_t, b_t = inp
        Sa = jnp.einsum('bhvk,bhk->bhv', S, a_t)
        S = S * w_t[:, :, None, :] + Sa[..., None] * b_t[:, :, None, :] + v_t[..., None] * k_t[:, :, None, :]
        return S, jnp.einsum('bhvk,bhk->bhv', S, r_t)

    S0 = jnp.zeros((B, H, N, N), jnp.float32)
    _, y = lax.scan(step, S0, (tm(r), tm(w), tm(k), tm(v), tm(a), tm(b)))
    return jnp.moveaxis(y, 0, 1)


def rwkv7_time_mix(x, v_first, mu, w_rkv, w0, w_l1, w_l2, a0, a_l1, a_l2, g_l1, g_l2,
                   k_k, k_a, r_k, lnx_g, lnx_b, w_out, v_res):
    B, T, D = x.shape
    H, N = RWKV_HEADS, RWKV_HEAD
    x_prev = jnp.pad(x, ((0, 0), (1, 0), (0, 0)))[:, :-1]
    xm = x[None] + (x_prev - x)[None] * mu[:, None, None, :]
    r, k, v = jnp.einsum('sbtd,sde->sbte', xm[:3], w_rkv)
    xw, xa, xg = xm[3], xm[4], xm[5]
    w_log = -jax.nn.softplus(-(w0 + jnp.tanh(xw @ w_l1) @ w_l2)) - 0.5
    decay = jnp.exp(-jnp.exp(w_log.astype(jnp.float32)))
    if v_res is not None:
        v0, v_l1, v_l2 = v_res
        v = v + (v_first - v) * jax.nn.sigmoid(v0 + (xm[2] @ v_l1) @ v_l2)
    a = jax.nn.sigmoid(a0 + (xa @ a_l1) @ a_l2)
    g = jax.nn.sigmoid(xg @ g_l1) @ g_l2
    heads = lambda z: z.reshape(B, T, H, N)
    kk = heads(k * k_k).astype(jnp.float32)
    kk = kk / jnp.maximum(jnp.linalg.norm(kk, axis=-1, keepdims=True), 1e-12)
    k = k * (1 + (a - 1) * k_a)
    rh, kh, vh, ah = heads(r), heads(k), heads(v), heads(a)
    y = wkv7_scan(rh, heads(decay), kh, vh, -kk, kk * ah)
    m = y.mean(-1, keepdims=True)
    var = jnp.mean(jnp.square(y - m), -1, keepdims=True)
    yn = ((y - m) * lax.rsqrt(var + RWKV_GN_EPS)).reshape(B, T, D) * lnx_g + lnx_b
    bonus = (jnp.sum((rh * kh * r_k).astype(jnp.float32), -1, keepdims=True) * vh).reshape(B, T, D)
    out = ((yn + bonus) * g).astype(x.dtype) @ w_out
    return out, v


def shared_kv(h, kv_w):
    B, L, D = h.shape
    H, d = DIFF_HEADS, DIFF_HD
    kv = h @ kv_w
    k = jnp.transpose(kv[..., :2 * H * d].reshape(B, L, H, 2, d), (3, 0, 2, 1, 4))
    v = jnp.transpose(kv[..., 2 * H * d:].reshape(B, L, H, 2 * d), (0, 2, 1, 3))
    return k, v


def diff_attention(h, k_sh, v_sh, w_q, lam_q1, lam_k1, lam_q2, lam_k2, subln_g, w_out, layer_idx):
    B, L, D = h.shape
    H, d = DIFF_HEADS, DIFF_HD
    Lp = -(-L // Q_BLOCK) * Q_BLOCK
    q = (h @ w_q).reshape(B, L, H, 2, d)
    q = jnp.pad(q, ((0, 0), (0, Lp - L), (0, 0), (0, 0), (0, 0)))
    q = jnp.transpose(q, (3, 0, 2, 1, 4))
    lam_init = 0.8 - 0.6 * math.exp(-0.3 * layer_idx)
    f32 = jnp.float32
    lam = (jnp.exp(jnp.sum(lam_q1.astype(f32) * lam_k1.astype(f32)))
           - jnp.exp(jnp.sum(lam_q2.astype(f32) * lam_k2.astype(f32))) + lam_init)
    kpos = jnp.arange(L)
    scale = d ** -0.5

    def block(i):
        s = i * Q_BLOCK
        qb = lax.dynamic_slice_in_dim(q, s, Q_BLOCK, axis=3)
        sc = jnp.einsum('cbhqd,cbhkd->cbhqk', qb, k_sh).astype(f32) * scale
        qpos = s + jnp.arange(Q_BLOCK)
        sc = jnp.where(kpos[None, :] <= qpos[:, None], sc, -jnp.inf)
        p = jax.nn.softmax(sc, axis=-1)
        attn = p[0] - lam * p[1]
        return jnp.einsum('bhqk,bhkv->bhqv', attn.astype(v_sh.dtype), v_sh)

    o = lax.map(block, jnp.arange(Lp // Q_BLOCK))
    o = jnp.transpose(o, (1, 0, 3, 2, 4)).reshape(B, Lp, H, 2 * d)[:, :L].astype(f32)
    o = o * lax.rsqrt(jnp.mean(jnp.square(o), -1, keepdims=True) + 1e-5) * subln_g * (1.0 - lam_init)
    return o.reshape(B, L, H * 2 * d).astype(h.dtype) @ w_out


def route(x, router_w, router_b):
    N = x.shape[0]
    s = jax.nn.sigmoid((x @ router_w).astype(jnp.float32))
    sel = s + router_b.astype(jnp.float32)
    gscore = lax.top_k(sel.reshape(N, N_GROUPS, -1), 2)[0].sum(-1)
    _, gidx = lax.top_k(gscore, TOPK_GROUPS)
    gmask = jnp.any(gidx[:, :, None] == jnp.arange(N_GROUPS), axis=1)
    sel = jnp.where(jnp.repeat(gmask, N_EXPERTS // N_GROUPS, axis=1), sel, -jnp.inf)
    _, idx = lax.top_k(sel, TOP_K)
    wts = jnp.take_along_axis(s, idx, axis=1)
    wts = wts / jnp.sum(wts, -1, keepdims=True) * ROUTED_SCALE
    return idx, wts.astype(x.dtype)


def routed_experts(x, idx, gates, w_gate, w_up, w_down):
    N, D = x.shape
    E = w_gate.shape[0]
    NK = N * TOP_K
    n_blocks = -(-NK // MOE_BLOCK) + E
    P = n_blocks * MOE_BLOCK
    flat_e = idx.reshape(-1)
    order = jnp.argsort(flat_e)
    e_sorted = flat_e[order]
    tok_sorted = (order // TOP_K).astype(jnp.int32)
    gate_sorted = gates.reshape(-1)[order]
    counts = jnp.bincount(flat_e, length=E)
    padded = (counts + MOE_BLOCK - 1) // MOE_BLOCK * MOE_BLOCK
    pad_end = jnp.cumsum(padded)
    pad_start = pad_end - padded
    start = jnp.cumsum(counts) - counts
    dest = pad_start[e_sorted] + jnp.arange(NK) - start[e_sorted]
    slot_tok = jnp.full((P,), N, jnp.int32).at[dest].set(tok_sorted)
    slot_gate = jnp.zeros((P,), x.dtype).at[dest].set(gate_sorted)
    block_e = jnp.minimum(jnp.searchsorted(pad_end, jnp.arange(n_blocks) * MOE_BLOCK, side='right'), E - 1)
    x_pad = jnp.concatenate([x, jnp.zeros((1, D), x.dtype)], axis=0)

    def block(args):
        tok, gt, e = args
        xb = x_pad[tok]
        hb = jax.nn.silu(xb @ w_gate[e]) * (xb @ w_up[e])
        return (hb @ w_down[e]) * gt[:, None]

    yb = lax.map(block, (slot_tok.reshape(n_blocks, MOE_BLOCK), slot_gate.reshape(n_blocks, MOE_BLOCK), block_e))
    return jax.ops.segment_sum(yb.reshape(P, D), slot_tok, num_segments=N + 1)[:N]


def moe_ffn(h, router_w, router_b, w_gate, w_up, w_down, sh_gate, sh_up, sh_down):
    B, L, D = h.shape
    xf = h.reshape(-1, D)
    idx, gates = route(xf, router_w, router_b)
    routed = routed_experts(xf, idx, gates, w_gate, w_up, w_down)
    shared = (jax.nn.silu(xf @ sh_gate) * (xf @ sh_up)) @ sh_down
    return (routed + shared).reshape(B, L, D)


def setup_inputs(seed: int = 0) -> dict:
    key = jax.random.key(seed)
    ks = iter(jax.random.split(key, 64))
    f32 = jnp.float32
    D, A, Bn, H, N = D_MODEL, N_A_LAYERS, N_B_LAYERS, RWKV_HEADS, RWKV_HEAD
    d, E, F, Fs = DIFF_HD, N_EXPERTS, EXPERT_FF, SHARED_FF

    def nrm(shape, scale):
        return jax.random.normal(next(ks), shape, f32) * scale

    def unif(shape, lo, hi):
        return jax.random.uniform(next(ks), shape, f32, lo, hi)

    return {
        "x": nrm((BATCH, SEQ, D), 1.0),
        "meta_tokens": nrm((N_META, D), 1.0),
        "ln_mix_g": 1.0 + nrm((DEPTH, D), 0.02),
        "ln_mix_b": nrm((DEPTH, D), 0.02),
        "ln_ffn_g": 1.0 + nrm((DEPTH, D), 0.02),
        "ln_ffn_b": nrm((DEPTH, D), 0.02),
        "rw_mu": unif((A, 6, D), 0.0, 1.0),
        "rw_w_rkv": nrm((A, 3, D, D), D ** -0.5),
        "rw_w0": nrm((A, D), 0.5),
        "rw_w_l1": nrm((A, D, DECAY_LORA), D ** -0.5),
        "rw_w_l2": nrm((A, DECAY_LORA, D), 0.3 * DECAY_LORA ** -0.5),
        "rw_a0": nrm((A, D), 0.5),
        "rw_a_l1": nrm((A, D, AAA_LORA), D ** -0.5),
        "rw_a_l2": nrm((A, AAA_LORA, D), 0.3 * AAA_LORA ** -0.5),
        "rw_g_l1": nrm((A, D, GATE_LORA), D ** -0.5),
        "rw_g_l2": nrm((A, GATE_LORA, D), GATE_LORA ** -0.5),
        "rw_k_k": 0.85 + nrm((A, D), 0.05),
        "rw_k_a": 1.0 + nrm((A, D), 0.05),
        "rw_r_k": nrm((A, H, N), 0.1),
        "rw_lnx_g": 1.0 + nrm((A, D), 0.02),
        "rw_lnx_b": nrm((A, D), 0.02),
        "rw_w_out": nrm((A, D, D), D ** -0.5 * DN_BETA),
        "rw_v0": nrm((A - 1, D), 0.5),
        "rw_v_l1": nrm((A - 1, D, MV_LORA), D ** -0.5),
        "rw_v_l2": nrm((A - 1, MV_LORA, D), 0.3 * MV_LORA ** -0.5),
        "kv_w": nrm((D, 4 * DIFF_HEADS * d), D ** -0.5),
        "da_w_q": nrm((Bn, D, 2 * DIFF_HEADS * d), D ** -0.5),
        "da_lam_q1": nrm((Bn, d), 0.1),
        "da_lam_k1": nrm((Bn, d), 0.1),
        "da_lam_q2": nrm((Bn, d), 0.1),
        "da_lam_k2": nrm((Bn, d), 0.1),
        "da_subln_g": 1.0 + nrm((Bn, 2 * d), 0.02),
        "da_w_out": nrm((Bn, 2 * DIFF_HEADS * d, D), (2 * DIFF_HEADS * d) ** -0.5 * DN_BETA),
        "moe_router_w": nrm((DEPTH, D, E), D ** -0.5),
        "moe_router_b": nrm((DEPTH, E), 0.01),
        "moe_w_gate": nrm((DEPTH, E, D, F), D ** -0.5),
        "moe_w_up": nrm((DEPTH, E, D, F), D ** -0.5),
        "moe_w_down": nrm((DEPTH, E, F, D), F ** -0.5 * DN_BETA),
        "moe_sh_gate": nrm((DEPTH, D, Fs), D ** -0.5),
        "moe_sh_up": nrm((DEPTH, D, Fs), D ** -0.5),
        "moe_sh_down": nrm((DEPTH, Fs, D), Fs ** -0.5 * DN_BETA),
    }


def reference(x, meta_tokens, ln_mix_g, ln_mix_b, ln_ffn_g, ln_ffn_b,
              rw_mu, rw_w_rkv, rw_w0, rw_w_l1, rw_w_l2, rw_a0, rw_a_l1, rw_a_l2,
              rw_g_l1, rw_g_l2, rw_k_k, rw_k_a, rw_r_k, rw_lnx_g, rw_lnx_b, rw_w_out,
              rw_v0, rw_v_l1, rw_v_l2, kv_w,
              da_w_q, da_lam_q1, da_lam_k1, da_lam_q2, da_lam_k2, da_subln_g, da_w_out,
              moe_router_w, moe_router_b, moe_w_gate, moe_w_up, moe_w_down,
              moe_sh_gate, moe_sh_up, moe_sh_down):
    B, _, D = x.shape
    meta = jnp.broadcast_to(meta_tokens[None].astype(x.dtype), (B, N_META, D))
    h = jnp.concatenate([meta, x], axis=1)
    v_first = None
    k_sh = v_sh = None
    for l in range(DEPTH):
        if l < N_A_LAYERS:
            v_res = None if l == 0 else (rw_v0[l - 1], rw_v_l1[l - 1], rw_v_l2[l - 1])
            mix, v = rwkv7_time_mix(h, v_first, rw_mu[l], rw_w_rkv[l], rw_w0[l], rw_w_l1[l], rw_w_l2[l],
                                    rw_a0[l], rw_a_l1[l], rw_a_l2[l], rw_g_l1[l], rw_g_l2[l],
                                    rw_k_k[l], rw_k_a[l], rw_r_k[l], rw_lnx_g[l], rw_lnx_b[l],
                                    rw_w_out[l], v_res)
            if l == 0:
                v_first = v
        else:
            if l == N_A_LAYERS:
                k_sh, v_sh = shared_kv(h, kv_w)
            j = l - N_A_LAYERS
            mix = diff_attention(h, k_sh, v_sh, da_w_q[j], da_lam_q1[j], da_lam_k1[j], da_lam_q2[j],
                                 da_lam_k2[j], da_subln_g[j], da_w_out[j], l)
        h = layer_norm(DN_ALPHA * h + mix, ln_mix_g[l], ln_mix_b[l])
        ffn = moe_ffn(h, moe_router_w[l], moe_router_b[l], moe_w_gate[l], moe_w_up[l], moe_w_down[l],
                      moe_sh_gate[l], moe_sh_up[l], moe_sh_down[l])
        h = layer_norm(DN_ALPHA * h + ffn, ln_ffn_g[l], ln_ffn_b[l])
    return h[:, N_META:]
```

```cpp
#include <hip/hip_runtime.h>
#include <stdint.h>
#include <stdio.h>
#include <string.h>

#define DI __device__ __forceinline__
typedef unsigned short bf16_t;
typedef short bf16x8 __attribute__((ext_vector_type(8)));
typedef short s16x4 __attribute__((ext_vector_type(4)));
typedef float f32x2 __attribute__((ext_vector_type(2)));
typedef float f32x4 __attribute__((ext_vector_type(4)));
typedef float f32x16 __attribute__((ext_vector_type(16)));
typedef unsigned u32x4 __attribute__((ext_vector_type(4)));
typedef unsigned u32x2 __attribute__((ext_vector_type(2)));

constexpr int D_ = 1024, NB = 2, SEQ = 16384, NMETA = 16, LSEQ = SEQ + NMETA, LP = 16512, NP = NB * LP, NTOK = NB * LSEQ;
constexpr int NE = 64, TOPK = 8, FF = 256, NSLOT = NTOK * TOPK;
constexpr int NTHR = 512;
constexpr int MT = NP / 128;
constexpr float DN_ALPHA = 1.6817928305074290f;
constexpr float LN_EPS = 1e-5f;
constexpr int WBIG_ROWS = 3584, LO1_W = 384;

constexpr size_t AL(size_t x) { return (x + 255) & ~(size_t)255; }
constexpr size_t OFF_CTRL = 0;
constexpr size_t OFF_META32 = 65536;
constexpr size_t OFF_H16 = OFF_META32 + (size_t)NB * NMETA * D_ * 4;
constexpr size_t SZ_ACT16 = (size_t)NP * D_ * 2;
constexpr size_t OFF_KV = AL(OFF_H16 + SZ_ACT16 + 2048);
constexpr size_t OFF_WL = AL(OFF_KV + 2 * SZ_ACT16);
constexpr size_t SZ_WL = (size_t)WBIG_ROWS * 2048 * 2 + (size_t)1024 * LO1_W * 2 + (size_t)1024 * 1024 * 2;
constexpr size_t OFF_WSH = AL(OFF_WL + SZ_WL);
constexpr size_t SZ_WSH = (size_t)512 * 1024 * 2 + (size_t)1024 * 256 * 2 + (size_t)64 * 1024 * 2;
constexpr size_t OFF_WMOE = AL(OFF_WSH + SZ_WSH);
constexpr size_t SZ_WMOE = (size_t)NE * (512 * 1024 + 1024 * 256) * 2;
constexpr size_t OFF_TAB = AL(OFF_WMOE + SZ_WMOE);
constexpr size_t SZ_TAB = (size_t)NSLOT * 4 * 5 + 65536;
constexpr size_t OFF_SCR = AL(OFF_TAB + SZ_TAB);
constexpr size_t SCR_R = 0, SCR_K = SZ_ACT16, SCR_V = 2 * SZ_ACT16, SCR_G = 3 * SZ_ACT16, SCR_A = 4 * SZ_ACT16, SCR_Z = 5 * SZ_ACT16;
constexpr size_t SCR_W = 6 * SZ_ACT16;
constexpr size_t SCR_LO1 = SCR_W + 2 * SZ_ACT16;
constexpr size_t SZ_SCR_RW = SCR_LO1 + (size_t)NP * LO1_W * 2;
constexpr size_t SCR_H = 0;
constexpr size_t SCR_HS = AL((size_t)NSLOT * 256 * 2);
constexpr size_t SCR_Y = AL(SCR_HS + (size_t)NP * 256 * 2);
constexpr size_t SZ_SCR_MOE = SCR_Y + (size_t)NSLOT * 1024 * 2;
constexpr size_t SZ_SCR = SZ_SCR_MOE > SZ_SCR_RW ? SZ_SCR_MOE : SZ_SCR_RW;
constexpr size_t WS_NEED = OFF_SCR + SZ_SCR + 4096;

constexpr int CT_ATTNQ = 4096;
constexpr int CT_CNT = 4352;
constexpr int CT_CUR = 4608;
constexpr int CT_NT = 4864;

struct Params {
    const float* in[41];
    float* out;
    unsigned char* ws;
};
enum { I_X = 0, I_META, I_LNMG, I_LNMB, I_LNFG, I_LNFB, I_MU, I_WRKV, I_W0, I_WL1, I_WL2, I_A0, I_AL1, I_AL2, I_GL1, I_GL2, I_KK, I_KA, I_RK, I_LNXG, I_LNXB, I_WOUT,
       I_V0, I_VL1, I_VL2, I_KVW, I_WQ, I_LQ1, I_LK1, I_LQ2, I_LK2, I_SUBG, I_DAWO, I_RTW, I_RTB, I_MG, I_MU_, I_MD, I_SG, I_SU, I_SD };

#define XB_TMO      128
#define XB_XCNT(j)  (256  + 64 * (j))
#define XB_XSUB(j)  (1280 + 64 * (j))
#define XB_XGEN(j)  (2304 + 64 * (j))
#define XB_TOP      3328
#define XB_TOPGEN   3392
#define XCD_BAR_WORDS 3456
#define XB_SPIN_CAP (1u << 22)
#define LAS __attribute__((address_space(3)))

__device__ __forceinline__ unsigned xb_ld(unsigned* p)              { return __hip_atomic_load(p, __ATOMIC_RELAXED, __HIP_MEMORY_SCOPE_AGENT); }
__device__ __forceinline__ unsigned xb_add(unsigned* p, unsigned v) { return __hip_atomic_fetch_add(p, v, __ATOMIC_RELAXED, __HIP_MEMORY_SCOPE_AGENT); }
__device__ __forceinline__ unsigned xb_xcc_id() { return (unsigned)__builtin_amdgcn_s_getreg((3 << 11) | 20) & 0xFu; }
#define XB_SPIN(cond, bar) do { unsigned _sp = 0; while (cond) { __builtin_amdgcn_s_sleep(1); \
    if ((++_sp & 255u) == 0u) { if (xb_ld(&(bar)[XB_TMO])) break; if (_sp > XB_SPIN_CAP) { atomicAdd(&(bar)[XB_TMO], 1u); break; } } } } while (0)

struct XcdBarrier { unsigned* bar; unsigned x; volatile LAS unsigned* st; };

__device__ __forceinline__ XcdBarrier xcd_barrier_post(unsigned* bar, volatile LAS unsigned* st) {
    XcdBarrier b; b.bar = bar; b.x = xb_xcc_id(); b.st = st;
    if (threadIdx.x == 0) (void)xb_add(&bar[XB_XCNT(b.x)], 1u);
    return b;
}
__device__ __forceinline__ void xcd_barrier_complete(unsigned* bar, unsigned x, unsigned& nloc, unsigned& nx) {
    const unsigned G = gridDim.x * gridDim.y * gridDim.z;
    unsigned sum, cnt, mine, sp = 0u;
    for (;;) {
        sum = 0u; cnt = 0u; mine = 0u;
#pragma unroll
        for (unsigned j = 0; j < 16; ++j) { const unsigned c = xb_ld(&bar[XB_XCNT(j)]); sum += c; cnt += (c > 0u) ? 1u : 0u; mine = (j == x) ? c : mine; }
        if (sum == G) break;
        __builtin_amdgcn_s_sleep(1);
        if ((++sp & 255u) == 0u) { if (xb_ld(&bar[XB_TMO])) break; if (sp > XB_SPIN_CAP) { atomicAdd(&bar[XB_TMO], 1u); break; } }
    }
    nloc = mine > 0u ? mine : 1u; nx = cnt > 0u ? cnt : 1u;
}
__device__ __forceinline__ void xcd_barrier(const XcdBarrier& b) {
    asm volatile("s_waitcnt vmcnt(0)" ::: "memory");
    __syncthreads();
    if (threadIdx.x == 0) {
        unsigned* bar = b.bar;
        __builtin_amdgcn_s_waitcnt(0);
        unsigned nloc = b.st[0], nx = b.st[1];
        if (nloc == 0u) { xcd_barrier_complete(bar, b.x, nloc, nx); b.st[0] = nloc; b.st[1] = nx; }
        const unsigned old = xb_add(&bar[XB_XSUB(b.x)], 1u);
        const unsigned gen = old / nloc;
        if (old + 1u == (gen + 1u) * nloc) {
            __builtin_amdgcn_fence(__ATOMIC_RELEASE, "agent");
            asm volatile("s_waitcnt vmcnt(0)" ::: "memory");
            const unsigned og = xb_add(&bar[XB_TOP], 1u);
            const unsigned tg = og / nx;
            if (og + 1u == (tg + 1u) * nx) xb_add(&bar[XB_TOPGEN], 1u);
            else XB_SPIN(xb_ld(&bar[XB_TOPGEN]) == tg, bar);
            __builtin_amdgcn_fence(__ATOMIC_ACQUIRE, "agent");
            xb_add(&bar[XB_XGEN(b.x)], 1u);
            asm volatile("s_waitcnt vmcnt(0)" ::: "memory");
        } else {
            XB_SPIN(xb_ld(&bar[XB_XGEN(b.x)]) == gen, bar);
            __builtin_amdgcn_fence(__ATOMIC_ACQUIRE, "agent");
            asm volatile("s_waitcnt vmcnt(0)" ::: "memory");
        }
    }
    __syncthreads();
}

DI int tid_() { int t = threadIdx.x; asm volatile("" : "+v"(t)); return t; }
typedef __bf16 bf16v2 __attribute__((ext_vector_type(2)));
DI unsigned cvt_pk_bf16(float lo, float hi) { f32x2 v = {lo, hi}; bf16v2 b = __builtin_convertvector(v, bf16v2); return __builtin_bit_cast(unsigned, b); }
DI float bf2f(bf16_t x) { return __uint_as_float((unsigned)x << 16); }
DI float bflo(unsigned w) { return __uint_as_float(w << 16); }
DI float bfhi(unsigned w) { return __uint_as_float(w & 0xffff0000u); }
DI bf16_t f2bf(float x) { return (bf16_t)(cvt_pk_bf16(x, 0.f) & 0xffffu); }
DI float sigmoidf_(float x) { return 1.0f / (1.0f + __expf(-x)); }
DI float tanhf_(float x) { const float t = __expf(-2.0f * fabsf(x)); const float r = (1.0f - t) / (1.0f + t); return x < 0.f ? -r : r; }
template <int CTRL> DI float dpp_f(float v) { return __builtin_bit_cast(float, __builtin_amdgcn_update_dpp(0, __builtin_bit_cast(int, v), CTRL, 0xF, 0xF, true)); }
DI float rdlane(float v, int l) { return __builtin_bit_cast(float, __builtin_amdgcn_readlane(__builtin_bit_cast(int, v), l)); }
DI float red8_sum(float v) { v += dpp_f<0xB1>(v); v += dpp_f<0x4E>(v); v += dpp_f<0x141>(v); return v; }
DI float red16_sum(float v) { v = red8_sum(v); v += dpp_f<0x140>(v); return v; }
DI float wave_sum(float v) { v = red16_sum(v); return (rdlane(v, 0) + rdlane(v, 16)) + (rdlane(v, 32) + rdlane(v, 48)); }
DI float red8_max(float v) { v = fmaxf(v, dpp_f<0xB1>(v)); v = fmaxf(v, dpp_f<0x4E>(v)); v = fmaxf(v, dpp_f<0x141>(v)); return v; }
DI float wave_max(float v) { v = red8_max(v); v = fmaxf(v, dpp_f<0x140>(v)); return fmaxf(fmaxf(rdlane(v, 0), rdlane(v, 16)), fmaxf(rdlane(v, 32), rdlane(v, 48))); }

DI bf16_t* H16(const Params& p) { return (bf16_t*)(p.ws + OFF_H16 + 2048); }
DI float* h32row_(float* out, unsigned char* ws, int prow) {
    const int b = prow >= LP ? 1 : 0, t = prow - b * LP;
    return t < NMETA ? (float*)(ws + OFF_META32) + (size_t)(b * NMETA + t) * D_ : out + ((size_t)b * SEQ + (t - NMETA)) * D_;
}
DI float* h32row(const Params& p, int prow) { return h32row_(p.out, p.ws, prow); }
DI unsigned* CTRL(const Params& p) { return (unsigned*)(p.ws + OFF_CTRL); }

DI void phase_init(const Params& p) {
    bf16_t* h16 = H16(p);
    const float* x = p.in[I_X]; const float* meta = p.in[I_META];
    const int tid0 = tid_(); const int half = tid0 >> 8, t4 = (tid0 & 255) * 4;
    for (int rp = blockIdx.x; rp < NTOK / 2; rp += gridDim.x) {
        const int n = rp * 2 + half; const int b = n >= LSEQ ? 1 : 0, t = n - b * LSEQ; const int prow = b * LP + t;
        const float* src = t < NMETA ? meta + t * D_ + t4 : x + ((size_t)b * SEQ + (t - NMETA)) * D_ + t4;
        const f32x4 v = *(const f32x4*)src;
        *(f32x4*)(h32row(p, prow) + t4) = v;
        u32x2 w; w.x = cvt_pk_bf16(v[0], v[1]); w.y = cvt_pk_bf16(v[2], v[3]);
        *(u32x2*)(h16 + (size_t)prow * D_ + t4) = w;
    }
    for (int zr = blockIdx.x; zr < 225; zr += gridDim.x) {
        const long prow = zr == 224 ? -1 : (long)(zr / 112) * LP + LSEQ + (zr % 112);
        *(unsigned*)(h16 + prow * D_ + tid0 * 2) = 0u;
    }
}

struct Job { const float* src; int Kvalid, Kpad, N, ldsrc; bf16_t* dst; int ld_dst, kofs, rowmode, rowbase; const float* scale; int scalemode; };

DI void cvt_mat(float* T, int& tctr, const Job& jb) {
    if (jb.N == 0) return;
    const int tk = jb.Kpad >> 6, tn = (jb.N + 63) >> 6, nt = tk * tn;
    const int G = gridDim.x;
    int first = ((int)blockIdx.x - (tctr % G) + G) % G;
    const int tid = tid_();
    for (int i = first; i < nt; i += G) {
        const int k0 = (i / tn) << 6, n0 = (i % tn) << 6;
        {
            const int kk = tid >> 4, n4 = (tid & 15) * 4;
#pragma unroll
            for (int ps = 0; ps < 2; ++ps) {
                const int k = k0 + kk + 32 * ps, n = n0 + n4;
                f32x4 v = (f32x4){0.f, 0.f, 0.f, 0.f};
                if (k < jb.Kvalid && n < jb.N) {
                    v = *(const f32x4*)(jb.src + (size_t)k * jb.ldsrc + n);
                    float s = 1.0f;
                    if (jb.scalemode == 1) s = jb.scale[k]; else if (jb.scalemode == 2) s = 1.0f - jb.scale[k];
                    v = v * s;
                }
                float* tp = T + (kk + 32 * ps) * 65 + n4;
                tp[0] = v[0]; tp[1] = v[1]; tp[2] = v[2]; tp[3] = v[3];
            }
        }
        __syncthreads();
        {
            const int n = tid >> 3, k8 = (tid & 7) * 8;
            if (n0 + n < jb.N) {
                const int ng = n0 + n;
                const int row = jb.rowmode == 0 ? jb.rowbase + ng : jb.rowbase + 32 * (ng >> 4) + (ng & 15);
                const float* tp = T + k8 * 65 + n;
                u32x4 w;
                w.x = cvt_pk_bf16(tp[0], tp[65]); w.y = cvt_pk_bf16(tp[130], tp[195]); w.z = cvt_pk_bf16(tp[260], tp[325]); w.w = cvt_pk_bf16(tp[390], tp[455]);
                *(u32x4*)(jb.dst + (size_t)row * jb.ld_dst + jb.kofs + k0 + k8) = w;
            }
        }
        __syncthreads();
    }
    tctr += nt;
}

DI bf16_t* WL_BIG(const Params& p) { return (bf16_t*)(p.ws + OFF_WL); }
DI bf16_t* WL_LORA2(const Params& p) { return (bf16_t*)(p.ws + OFF_WL + (size_t)WBIG_ROWS * 2048 * 2); }
DI bf16_t* WL_OUT(const Params& p) { return (bf16_t*)(p.ws + OFF_WL + (size_t)WBIG_ROWS * 2048 * 2 + (size_t)1024 * LO1_W * 2); }
DI bf16_t* WL_WQ(const Params& p) { return (bf16_t*)(p.ws + OFF_WL + (size_t)2048 * 1024 * 2); }
DI bf16_t* WS_GU(const Params& p) { return (bf16_t*)(p.ws + OFF_WSH); }
DI bf16_t* WS_DN(const Params& p) { return (bf16_t*)(p.ws + OFF_WSH + (size_t)512 * 1024 * 2); }
DI bf16_t* WS_RT(const Params& p) { return (bf16_t*)(p.ws + OFF_WSH + (size_t)512 * 1024 * 2 + (size_t)1024 * 256 * 2); }
DI bf16_t* WM_GU(const Params& p) { return (bf16_t*)(p.ws + OFF_WMOE); }
DI bf16_t* WM_DN(const Params& p) { return (bf16_t*)(p.ws + OFF_WMOE + (size_t)NE * 512 * 1024 * 2); }

DI Job mkjob(const float* src, int Kv, int Kp, int N, int ldsrc, bf16_t* dst, int ld_dst, int kofs, int rowmode, int rowbase, const float* scale, int scalemode) {
    Job j; j.src = src; j.Kvalid = Kv; j.Kpad = Kp; j.N = N; j.ldsrc = ldsrc; j.dst = dst; j.ld_dst = ld_dst; j.kofs = kofs; j.rowmode = rowmode; j.rowbase = rowbase; j.scale = scale; j.scalemode = scalemode; return j;
}

DI Job get_job(const Params& p, int l, int j) {
    Job z = mkjob(nullptr, 0, 0, 0, 0, nullptr, 0, 0, 0, 0, nullptr, 0);
    if (j < 19) {
        if (l < 2) {
            const float* mu = p.in[I_MU] + (size_t)l * 6 * D_;
            bf16_t* big = WL_BIG(p); bf16_t* lo2 = WL_LORA2(p);
            if (j < 6) { const int s = j >> 1, part = j & 1; return mkjob(p.in[I_WRKV] + (size_t)(l * 3 + s) * D_ * D_, 1024, 1024, 1024, 1024, big, 2048, part * 1024, 0, s * 1024, mu + s * D_, 1 + part); }
            if (j < 8) { const int part = j & 1; return mkjob(p.in[I_WL1] + (size_t)l * D_ * 64, 1024, 1024, 64, 64, big, 2048, part * 1024, 0, 3072, mu + 3 * D_, 1 + part); }
            if (j < 10) { const int part = j & 1; return mkjob(p.in[I_AL1] + (size_t)l * D_ * 64, 1024, 1024, 64, 64, big, 2048, part * 1024, 0, 3136, mu + 4 * D_, 1 + part); }
            if (j < 12) { const int part = j & 1; return mkjob(p.in[I_GL1] + (size_t)l * D_ * 160, 1024, 1024, 160, 160, big, 2048, part * 1024, 0, 3200, mu + 5 * D_, 1 + part); }
            if (j < 14) { if (l != 1) return z; const int part = j & 1; return mkjob(p.in[I_VL1], 1024, 1024, 32, 32, big, 2048, part * 1024, 0, 3392, mu + 2 * D_, 1 + part); }
            if (j == 14) return mkjob(p.in[I_WL2] + (size_t)l * 64 * D_, 64, 64, 1024, 1024, lo2, 64, 0, 0, 0, nullptr, 0);
            if (j == 15) return mkjob(p.in[I_AL2] + (size_t)l * 64 * D_, 64, 64, 1024, 1024, lo2 + 1024 * 64, 64, 0, 0, 0, nullptr, 0);
            if (j == 16) return mkjob(p.in[I_GL2] + (size_t)l * 160 * D_, 160, 192, 1024, 1024, lo2 + 2 * 1024 * 64, 192, 0, 0, 0, nullptr, 0);
            if (j == 17) { if (l != 1) return z; return mkjob(p.in[I_VL2], 32, 64, 1024, 1024, lo2 + 2 * 1024 * 64 + 1024 * 192, 64, 0, 0, 0, nullptr, 0); }
            return mkjob(p.in[I_WOUT] + (size_t)l * D_ * D_, 1024, 1024, 1024, 1024, WL_OUT(p), 1024, 0, 0, 0, nullptr, 0);
        } else {
            const int a = l - 2;
            if (j == 0) { if (l != 2) return z; return mkjob(p.in[I_KVW], 1024, 1024, 2048, 2048, WL_BIG(p), 1024, 0, 0, 0, nullptr, 0); }
            if (j == 1) return mkjob(p.in[I_WQ] + (size_t)a * D_ * D_, 1024, 1024, 1024, 1024, WL_WQ(p), 1024, 0, 0, 0, nullptr, 0);
            if (j == 2) return mkjob(p.in[I_DAWO] + (size_t)a * D_ * D_, 1024, 1024, 1024, 1024, WL_OUT(p), 1024, 0, 0, 0, nullptr, 0);
            return z;
        }
    }
    j -= 19;
    if (j == 0) return mkjob(p.in[I_SG] + (size_t)l * D_ * FF, 1024, 1024, 256, 256, WS_GU(p), 1024, 0, 1, 0, nullptr, 0);
    if (j == 1) return mkjob(p.in[I_SU] + (size_t)l * D_ * FF, 1024, 1024, 256, 256, WS_GU(p), 1024, 0, 1, 16, nullptr, 0);
    if (j == 2) return mkjob(p.in[I_SD] + (size_t)l * FF * D_, 256, 256, 1024, 1024, WS_DN(p), 256, 0, 0, 0, nullptr, 0);
    if (j == 3) return mkjob(p.in[I_RTW] + (size_t)l * D_ * NE, 1024, 1024, 64, 64, WS_RT(p), 1024, 0, 0, 0, nullptr, 0);
    j -= 4;
    const int e = j / 3, w = j - e * 3;
    if (w == 0) return mkjob(p.in[I_MG] + ((size_t)l * NE + e) * D_ * FF, 1024, 1024, 256, 256, WM_GU(p) + (size_t)e * 512 * 1024, 1024, 0, 1, 0, nullptr, 0);
    if (w == 1) return mkjob(p.in[I_MU_] + ((size_t)l * NE + e) * D_ * FF, 1024, 1024, 256, 256, WM_GU(p) + (size_t)e * 512 * 1024, 1024, 0, 1, 16, nullptr, 0);
    return mkjob(p.in[I_MD] + ((size_t)l * NE + e) * FF * D_, 256, 256, 1024, 1024, WM_DN(p) + (size_t)e * 1024 * 256, 256, 0, 0, 0, nullptr, 0);
}

DI void phase_weights(const Params& p, unsigned char* lds, int l) {
    float* T = (float*)lds;
    int tctr = 0;
    for (int j = 0; j < 19 + 4 + NE * 3; ++j) { const Job jb = get_job(p, l, j); cvt_mat(T, tctr, jb); }
}

template <int BM, int BN, int WTM, int WTN, bool TRANS, class AP, class EPI>
DI void gemm_tile(unsigned char* lds, const AP& aptr, const bf16_t* __restrict__ Bt, size_t ldb, int K, const EPI& epi) {
    constexpr int WN_ = BN / WTN, MI = WTM / 16, NI = WTN / 16;
    static_assert((BM / WTM) * WN_ == 8, "8 waves");
    constexpr int CA = BM * 8 / NTHR, CB = BN * 8 / NTHR;
    static_assert(CA >= 1 && CB >= 1, "tile too small");
    constexpr int ABYTES = BM * 128, STAGE = (BM + BN) * 128;
    const int tid = tid_(), lane = tid & 63, wid = tid >> 6, wm = wid / WN_, wn = wid % WN_;
    const bf16_t* ap[CA]; const bf16_t* bp[CB]; unsigned aoff[CA], boff[CB];
#pragma unroll
    for (int i = 0; i < CA; ++i) { const int id = tid + NTHR * i, row = id >> 3, c = id & 7; ap[i] = aptr(row) + c * 8; aoff[i] = row * 128 + ((c ^ ((row >> 1) & 7)) << 4); }
#pragma unroll
    for (int i = 0; i < CB; ++i) { const int id = tid + NTHR * i, row = id >> 3, c = id & 7; bp[i] = Bt + (size_t)row * ldb + c * 8; boff[i] = ABYTES + row * 128 + ((c ^ ((row >> 1) & 7)) << 4); }
    u32x4 ra[CA], rb[CB];
    f32x4 acc[MI][NI];
#pragma unroll
    for (int mi = 0; mi < MI; ++mi)
#pragma unroll
        for (int ni = 0; ni < NI; ++ni) acc[mi][ni] = (f32x4){0.f, 0.f, 0.f, 0.f};
    const int nk = K >> 6;
#pragma unroll
    for (int i = 0; i < CA; ++i) ra[i] = *(const u32x4*)(ap[i]);
#pragma unroll
    for (int i = 0; i < CB; ++i) rb[i] = *(const u32x4*)(bp[i]);
#pragma unroll
    for (int i = 0; i < CA; ++i) *(u32x4*)(lds + aoff[i]) = ra[i];
#pragma unroll
    for (int i = 0; i < CB; ++i) *(u32x4*)(lds + boff[i]) = rb[i];
    __syncthreads();
    const int fr = lane & 15, fq = lane >> 4, sw = (fr >> 1) & 7;
    for (int kt = 0; kt < nk; ++kt) {
        const unsigned char* cur = lds + (kt & 1) * STAGE;
        unsigned char* nxt = lds + ((kt + 1) & 1) * STAGE;
        const bool more = kt + 1 < nk;
        if (more) {
#pragma unroll
            for (int i = 0; i < CA; ++i) ra[i] = *(const u32x4*)(ap[i] + (kt + 1) * 64);
#pragma unroll
            for (int i = 0; i < CB; ++i) rb[i] = *(const u32x4*)(bp[i] + (kt + 1) * 64);
        }
#pragma unroll
        for (int ks = 0; ks < 2; ++ks) {
            bf16x8 af[MI], bfr[NI];
            const int ch = ((ks * 4 + fq) ^ sw) << 4;
#pragma unroll
            for (int mi = 0; mi < MI; ++mi) af[mi] = *(const bf16x8*)(cur + (wm * WTM + mi * 16 + fr) * 128 + ch);
#pragma unroll
            for (int ni = 0; ni < NI; ++ni) bfr[ni] = *(const bf16x8*)(cur + ABYTES + (wn * WTN + ni * 16 + fr) * 128 + ch);
#pragma unroll
            for (int mi = 0; mi < MI; ++mi)
#pragma unroll
                for (int ni = 0; ni < NI; ++ni)
                    acc[mi][ni] = TRANS ? __builtin_amdgcn_mfma_f32_16x16x32_bf16(bfr[ni], af[mi], acc[mi][ni], 0, 0, 0)
                                        : __builtin_amdgcn_mfma_f32_16x16x32_bf16(af[mi], bfr[ni], acc[mi][ni], 0, 0, 0);
        }
        if (more) {
#pragma unroll
            for (int i = 0; i < CA; ++i) *(u32x4*)(nxt + aoff[i]) = ra[i];
#pragma unroll
            for (int i = 0; i < CB; ++i) *(u32x4*)(nxt + boff[i]) = rb[i];
        }
        __syncthreads();
    }
    epi.template run<MI, NI>(acc, wm * WTM, wn * WTN, fr, fq);
}

struct APlain { const bf16_t* base; size_t ld; DI const bf16_t* operator()(int r) const { return base + (size_t)r * ld; } };
struct AClamp { const bf16_t* base; int last; DI const bf16_t* operator()(int r) const { return base + (size_t)(r < last ? r : last) * FF; } };
struct AGather { const bf16_t* base; const int* rows; int nrows; DI const bf16_t* operator()(int r) const { const int rr = r < nrows ? r : nrows - 1; return base + (size_t)rows[rr] * D_; } };

DI void st_bf4(bf16_t* dst, f32x4 v) { u32x2 w; w.x = cvt_pk_bf16(v[0], v[1]); w.y = cvt_pk_bf16(v[2], v[3]); *(u32x2*)dst = w; }

struct EpiR1 {
    bf16_t* dst; int kind; int m0, n0;
    template <int MI, int NI> DI void run(const f32x4 (&acc)[MI][NI], int rb, int cb, int fr, int fq) const {
#pragma unroll
        for (int ni = 0; ni < NI; ++ni) {
            const int col = n0 + cb + ni * 16 + 4 * fq;
            if (col >= 3456) continue;
#pragma unroll
            for (int mi = 0; mi < MI; ++mi) {
                const size_t row = (size_t)(m0 + rb + mi * 16 + fr);
                f32x4 a = acc[mi][ni];
                if (kind == 0) {
                    st_bf4(dst + row * D_ + (col & 1023), a);
                } else {
                    const int c = col - 3072;
                    if (c < 64) { a[0] = tanhf_(a[0]); a[1] = tanhf_(a[1]); a[2] = tanhf_(a[2]); a[3] = tanhf_(a[3]); }
                    else if (c >= 128 && c < 288) { a[0] = sigmoidf_(a[0]); a[1] = sigmoidf_(a[1]); a[2] = sigmoidf_(a[2]); a[3] = sigmoidf_(a[3]); }
                    else if ((c >= 288 && c < 320) || c >= 352) a = (f32x4){0.f, 0.f, 0.f, 0.f};
                    st_bf4(dst + row * LO1_W + c, a);
                }
            }
        }
    }
};
struct EpiLora2 {
    int mode; float* wdec; bf16_t* dst; const bf16_t* vfirst; const float* bias; int m0, n0;
    template <int MI, int NI> DI void run(const f32x4 (&acc)[MI][NI], int rb, int cb, int fr, int fq) const {
#pragma unroll
        for (int ni = 0; ni < NI; ++ni) {
            const int col = n0 + cb + ni * 16 + 4 * fq;
            f32x4 bv = (f32x4){0.f, 0.f, 0.f, 0.f};
            if (mode != 2) bv = *(const f32x4*)(bias + col);
#pragma unroll
            for (int mi = 0; mi < MI; ++mi) {
                const size_t off = (size_t)(m0 + rb + mi * 16 + fr) * D_ + col;
                f32x4 a = acc[mi][ni] + bv;
                if (mode == 0) {
#pragma unroll
                    for (int i = 0; i < 4; ++i) a[i] = __expf(-0.6065306597126334f * sigmoidf_(a[i]));
                    *(f32x4*)(wdec + off) = a;
                } else if (mode == 1) {
#pragma unroll
                    for (int i = 0; i < 4; ++i) a[i] = sigmoidf_(a[i]);
                    st_bf4(dst + off, a);
                } else if (mode == 2) {
                    st_bf4(dst + off, a);
                } else {
                    const u32x2 vv = *(const u32x2*)(dst + off), vf = *(const u32x2*)(vfirst + off);
                    const float v0 = bflo(vv.x), v1 = bfhi(vv.x), v2 = bflo(vv.y), v3 = bfhi(vv.y);
                    const float f0 = bflo(vf.x), f1 = bfhi(vf.x), f2 = bflo(vf.y), f3 = bfhi(vf.y);
                    f32x4 o;
                    o[0] = v0 + (f0 - v0) * sigmoidf_(a[0]); o[1] = v1 + (f1 - v1) * sigmoidf_(a[1]); o[2] = v2 + (f2 - v2) * sigmoidf_(a[2]); o[3] = v3 + (f3 - v3) * sigmoidf_(a[3]);
                    st_bf4(dst + off, o);
                }
            }
        }
    }
};
struct EpiResid {
    float* out; unsigned char* ws; int m0, n0;
    template <int MI, int NI> DI void run(const f32x4 (&acc)[MI][NI], int rb, int cb, int fr, int fq) const {
#pragma unroll
        for (int mi = 0; mi < MI; ++mi) {
            const int prow = m0 + rb + mi * 16 + fr;
            const int t = prow >= LP ? prow - LP : prow;
            if (t >= LSEQ) continue;
            float* hr = h32row_(out, ws, prow);
#pragma unroll
            for (int ni = 0; ni < NI; ++ni) {
                const int col = n0 + cb + ni * 16 + 4 * fq;
                f32x4 h = *(const f32x4*)(hr + col);
                *(f32x4*)(hr + col) = h * DN_ALPHA + acc[mi][ni];
            }
        }
    }
};
struct EpiQK {
    bf16_t* dst; float scale; int m0, n0;
    template <int MI, int NI> DI void run(const f32x4 (&acc)[MI][NI], int rb, int cb, int fr, int fq) const {
#pragma unroll
        for (int mi = 0; mi < MI; ++mi) {
            const int prow = m0 + rb + mi * 16 + fr;
            const int b = prow >= LP ? 1 : 0, t = prow - b * LP;
#pragma unroll
            for (int ni = 0; ni < NI; ++ni) {
                const int col = n0 + cb + ni * 16 + 4 * fq;
                const int hc = col >> 6, dd = col & 63;
                st_bf4(dst + (((size_t)(b * 16 + hc)) * LP + t) * 64 + dd, acc[mi][ni] * scale);
            }
        }
    }
};
struct EpiVt {
    bf16_t* dst; int m0, n0;
    template <int MI, int NI> DI void run(const f32x4 (&acc)[MI][NI], int rb, int cb, int fr, int fq) const {
#pragma unroll
        for (int mi = 0; mi < MI; ++mi) {
            const int prow = m0 + rb + mi * 16 + 4 * fq;
            const int b = prow >= LP ? 1 : 0, t = prow - b * LP;
#pragma unroll
            for (int ni = 0; ni < NI; ++ni) {
                const int col = n0 + cb + ni * 16 + fr;
                st_bf4(dst + ((size_t)(b * 1024 + col)) * LP + t, acc[mi][ni]);
            }
        }
    }
};
struct EpiM1 {
    bf16_t* dst; const float* gate; int row0, nrows, n0;
    template <int MI, int NI> DI void run(const f32x4 (&acc)[MI][NI], int rb, int cb, int fr, int fq) const {
#pragma unroll
        for (int mi = 0; mi < MI; ++mi) {
            const int r = rb + mi * 16 + fr;
            if (r >= nrows) continue;
            const float gw = gate ? gate[row0 + r] : 1.0f;
#pragma unroll
            for (int ni = 0; ni < NI; ni += 2) {
                const int hc = ((n0 + cb + ni * 16) >> 1) + 4 * fq;
                const f32x4 g = acc[mi][ni], u = acc[mi][ni + 1];
                f32x4 o;
#pragma unroll
                for (int i = 0; i < 4; ++i) o[i] = g[i] * sigmoidf_(g[i]) * u[i] * gw;
                st_bf4(dst + (size_t)(row0 + r) * FF + hc, o);
            }
        }
    }
};
struct EpiM2 {
    bf16_t* dst; int row0, nrows, n0;
    template <int MI, int NI> DI void run(const f32x4 (&acc)[MI][NI], int rb, int cb, int fr, int fq) const {
#pragma unroll
        for (int mi = 0; mi < MI; ++mi) {
            const int r = rb + mi * 16 + fr;
            if (r >= nrows) continue;
#pragma unroll
            for (int ni = 0; ni < NI; ++ni) st_bf4(dst + (size_t)(row0 + r) * D_ + n0 + cb + ni * 16 + 4 * fq, acc[mi][ni]);
        }
    }
};
struct EpiLds {
    float* dst;
    template <int MI, int NI> DI void run(const f32x4 (&acc)[MI][NI], int rb, int cb, int fr, int fq) const {
#pragma unroll
        for (int mi = 0; mi < MI; ++mi)
#pragma unroll
            for (int ni = 0; ni < NI; ++ni) {
                float* d = dst + (rb + mi * 16 + fr) * 65 + cb + ni * 16 + 4 * fq;
                d[0] = acc[mi][ni][0]; d[1] = acc[mi][ni][1]; d[2] = acc[mi][ni][2]; d[3] = acc[mi][ni][3];
            }
    }
};

DI bf16_t* SCR16(const Params& p, size_t off) { return (bf16_t*)(p.ws + OFF_SCR + off); }
DI bf16_t* VFIRST(const Params& p) { return (bf16_t*)(p.ws + OFF_KV); }
DI bf16_t* KBUF(const Params& p) { return (bf16_t*)(p.ws + OFF_KV); }
DI bf16_t* VTBUF(const Params& p) { return (bf16_t*)(p.ws + OFF_KV + SZ_ACT16); }

DI void phase_r1(const Params& p, unsigned char* lds, int l) {
    constexpr int NT = WBIG_ROWS / 256;
    EpiR1 e;
    for (int u = blockIdx.x; u < MT * NT; u += gridDim.x) {
        const int mt = u / NT, nt = u - mt * NT;
        e.m0 = mt * 128; e.n0 = nt * 256;
        if (nt < 4) { e.kind = 0; e.dst = SCR16(p, SCR_R); } else if (nt < 8) { e.kind = 0; e.dst = SCR16(p, SCR_K); }
        else if (nt < 12) { e.kind = 0; e.dst = l == 0 ? VFIRST(p) : SCR16(p, SCR_V); } else { e.kind = 1; e.dst = SCR16(p, SCR_LO1); }
        APlain a; a.base = H16(p) + (size_t)(mt * 128) * D_ - D_; a.ld = D_;
        gemm_tile<128, 256, 64, 64, true>(lds, a, WL_BIG(p) + (size_t)(nt * 256) * 2048, 2048, 2048, e);
    }
}
DI void phase_r2(const Params& p, unsigned char* lds, int l) {
    const int ng = l == 1 ? 4 : 3;
    for (int u = blockIdx.x; u < ng * MT * 4; u += gridDim.x) {
        const int g = u / (MT * 4), r = u - g * (MT * 4), mt = r >> 2, nt = r & 3;
        EpiLora2 e; e.mode = g; e.m0 = mt * 128; e.n0 = nt * 256; e.wdec = (float*)(p.ws + OFF_SCR + SCR_W); e.vfirst = VFIRST(p); e.bias = nullptr; e.dst = nullptr;
        APlain a; a.ld = LO1_W; const bf16_t* lo1 = SCR16(p, SCR_LO1) + (size_t)(mt * 128) * LO1_W;
        const bf16_t* lo2 = WL_LORA2(p);
        if (g == 0) { e.bias = p.in[I_W0] + l * D_; a.base = lo1; gemm_tile<128, 256, 64, 64, true>(lds, a, lo2 + (size_t)(nt * 256) * 64, 64, 64, e); }
        else if (g == 1) { e.bias = p.in[I_A0] + l * D_; e.dst = SCR16(p, SCR_A); a.base = lo1 + 64; gemm_tile<128, 256, 64, 64, true>(lds, a, lo2 + 1024 * 64 + (size_t)(nt * 256) * 64, 64, 64, e); }
        else if (g == 2) { e.dst = SCR16(p, SCR_G); a.base = lo1 + 128; gemm_tile<128, 256, 64, 64, true>(lds, a, lo2 + 2 * 1024 * 64 + (size_t)(nt * 256) * 192, 192, 192, e); }
        else { e.bias = p.in[I_V0]; e.dst = SCR16(p, SCR_V); a.base = lo1 + 320; gemm_tile<128, 256, 64, 64, true>(lds, a, lo2 + 2 * 1024 * 64 + 1024 * 192 + (size_t)(nt * 256) * 64, 64, 64, e); }
    }
}

DI void phase_scan(const Params& p, unsigned char* lds, int l) {
    float* sR = (float*)lds; float* sW = sR + 2048; float* sK = sW + 2048; float* sA = sK + 2048; float* sB = sA + 2048; float* sV = sB + 2048; float* sY = sV + 2048; float* sBon = sY + 2048;
    const int tid = tid_(), lane = tid & 63, wid = tid >> 6, vi = tid >> 3, q = tid & 7;
    const bf16_t* R = SCR16(p, SCR_R); const bf16_t* Kp = SCR16(p, SCR_K); const bf16_t* V = l == 0 ? VFIRST(p) : SCR16(p, SCR_V);
    const bf16_t* A = SCR16(p, SCR_A); const bf16_t* G = SCR16(p, SCR_G); const float* Wd = (const float*)(p.ws + OFF_SCR + SCR_W); bf16_t* Z = SCR16(p, SCR_Z);
    for (int unit = blockIdx.x; unit < NB * 16; unit += gridDim.x) {
        const int b = unit >> 4, h = unit & 15, hc = h * 64 + lane;
        const float c_kk = p.in[I_KK][l * D_ + hc], c_ka = p.in[I_KA][l * D_ + hc], c_rk = p.in[I_RK][l * D_ + hc], c_lg = p.in[I_LNXG][l * D_ + hc], c_lb = p.in[I_LNXB][l * D_ + hc];
        f32x2 S[4];
#pragma unroll
        for (int j = 0; j < 4; ++j) S[j] = (f32x2){0.f, 0.f};
        float pr[4], pk[4], pv[4], pa[4], pw[4];
        const size_t base0 = ((size_t)b * LP) * D_ + hc;
#pragma unroll
        for (int j = 0; j < 4; ++j) { const size_t e = base0 + (size_t)(wid * 4 + j) * D_; pr[j] = bf2f(R[e]); pk[j] = bf2f(Kp[e]); pv[j] = bf2f(V[e]); pa[j] = bf2f(A[e]); pw[j] = Wd[e]; }
        constexpr int NCH = (LSEQ + 31) / 32;
        for (int ch = 0; ch < NCH; ++ch) {
#pragma unroll
            for (int j = 0; j < 4; ++j) {
                const int tt = wid * 4 + j;
                const float kkr = pk[j] * c_kk;
                const float n2 = wave_sum(kkr * kkr);
                const float kk = kkr / fmaxf(sqrtf(n2), 1e-12f);
                const float k2 = pk[j] * (1.0f + (pa[j] - 1.0f) * c_ka);
                const float bon = wave_sum(pr[j] * k2 * c_rk);
                sR[tt * 64 + lane] = pr[j]; sW[tt * 64 + lane] = pw[j]; sK[tt * 64 + lane] = k2; sA[tt * 64 + lane] = -kk; sB[tt * 64 + lane] = kk * pa[j]; sV[tt * 64 + lane] = pv[j];
                if (lane == 0) sBon[tt] = bon;
            }
            __syncthreads();
            if (ch + 1 < NCH) {
#pragma unroll
                for (int j = 0; j < 4; ++j) { const size_t e = base0 + (size_t)((ch + 1) * 32 + wid * 4 + j) * D_; pr[j] = bf2f(R[e]); pk[j] = bf2f(Kp[e]); pv[j] = bf2f(V[e]); pa[j] = bf2f(A[e]); pw[j] = Wd[e]; }
            }
#pragma unroll 4
            for (int tt = 0; tt < 32; ++tt) {
                const f32x4 a0 = *(const f32x4*)(sA + tt * 64 + q * 8), a1 = *(const f32x4*)(sA + tt * 64 + q * 8 + 4);
                const f32x4 w0 = *(const f32x4*)(sW + tt * 64 + q * 8), w1 = *(const f32x4*)(sW + tt * 64 + q * 8 + 4);
                const f32x4 b0 = *(const f32x4*)(sB + tt * 64 + q * 8), b1 = *(const f32x4*)(sB + tt * 64 + q * 8 + 4);
                const f32x4 k0 = *(const f32x4*)(sK + tt * 64 + q * 8), k1 = *(const f32x4*)(sK + tt * 64 + q * 8 + 4);
                const f32x4 r0 = *(const f32x4*)(sR + tt * 64 + q * 8), r1 = *(const f32x4*)(sR + tt * 64 + q * 8 + 4);
                const float vv = sV[tt * 64 + vi];
                f32x2 d2 = S[0] * (f32x2){a0[0], a0[1]};
                d2 = S[1] * (f32x2){a0[2], a0[3]} + d2; d2 = S[2] * (f32x2){a1[0], a1[1]} + d2; d2 = S[3] * (f32x2){a1[2], a1[3]} + d2;
                const float sa = red8_sum(d2.x + d2.y);
                const f32x2 sa2 = (f32x2){sa, sa}, v2 = (f32x2){vv, vv};
                S[0] = S[0] * (f32x2){w0[0], w0[1]} + (sa2 * (f32x2){b0[0], b0[1]} + v2 * (f32x2){k0[0], k0[1]});
                S[1] = S[1] * (f32x2){w0[2], w0[3]} + (sa2 * (f32x2){b0[2], b0[3]} + v2 * (f32x2){k0[2], k0[3]});
                S[2] = S[2] * (f32x2){w1[0], w1[1]} + (sa2 * (f32x2){b1[0], b1[1]} + v2 * (f32x2){k1[0], k1[1]});
                S[3] = S[3] * (f32x2){w1[2], w1[3]} + (sa2 * (f32x2){b1[2], b1[3]} + v2 * (f32x2){k1[2], k1[3]});
                f32x2 y2 = S[0] * (f32x2){r0[0], r0[1]};
                y2 = S[1] * (f32x2){r0[2], r0[3]} + y2; y2 = S[2] * (f32x2){r1[0], r1[1]} + y2; y2 = S[3] * (f32x2){r1[2], r1[3]} + y2;
                const float y = red8_sum(y2.x + y2.y);
                if (q == 0) sY[tt * 64 + vi] = y;
            }
            __syncthreads();
#pragma unroll
            for (int j = 0; j < 4; ++j) {
                const int tt = wid * 4 + j;
                const float y = sY[tt * 64 + lane];
                const float mean = wave_sum(y) * (1.0f / 64.0f);
                const float dlt = y - mean;
                const float var = wave_sum(dlt * dlt) * (1.0f / 64.0f);
                const float yn = dlt * rsqrtf(var + 64e-5f) * c_lg + c_lb;
                const size_t e = base0 + (size_t)(ch * 32 + tt) * D_;
                const float g = bf2f(G[e]);
                Z[e] = f2bf((yn + sBon[tt] * sV[tt * 64 + lane]) * g);
            }
            __syncthreads();
        }
    }
}

DI void phase_outproj(const Params& p, unsigned char* lds) {
    EpiResid e; e.out = p.out; e.ws = p.ws;
    for (int u = blockIdx.x; u < MT * 4; u += gridDim.x) {
        const int mt = u >> 2, nt = u & 3;
        e.m0 = mt * 128; e.n0 = nt * 256;
        APlain a; a.base = SCR16(p, SCR_Z) + (size_t)(mt * 128) * D_; a.ld = D_;
        gemm_tile<128, 256, 64, 64, true>(lds, a, WL_OUT(p) + (size_t)(nt * 256) * D_, D_, D_, e);
    }
}

template <bool COMBINE>
DI void phase_ln(const Params& p, const float* gam, const float* bet) {
    const int tid0 = tid_(); const int lane = tid0 & 63, wid = tid0 >> 6;
    bf16_t* h16 = H16(p);
    const int* tok_slot = (const int*)(p.ws + OFF_TAB) + 2 * NSLOT;
    const bf16_t* Y = SCR16(p, SCR_Y);
    const int c0 = lane * 16;
    f32x4 g4[4], b4[4];
#pragma unroll
    for (int i = 0; i < 4; ++i) { g4[i] = *(const f32x4*)(gam + c0 + 4 * i); b4[i] = *(const f32x4*)(bet + c0 + 4 * i); }
    for (int n = blockIdx.x * 8 + wid; n < NTOK; n += gridDim.x * 8) {
        const int b = n >= LSEQ ? 1 : 0, t = n - b * LSEQ, prow = b * LP + t;
        float* hr = h32row(p, prow);
        f32x4 x[4];
#pragma unroll
        for (int i = 0; i < 4; ++i) x[i] = *(const f32x4*)(hr + c0 + 4 * i);
        if (COMBINE) {
#pragma unroll
            for (int i = 0; i < 4; ++i) x[i] = x[i] * DN_ALPHA;
#pragma unroll
            for (int k = 0; k < 9; ++k) {
                const bf16_t* src = k == 8 ? h16 + (size_t)prow * D_ : Y + (size_t)tok_slot[n * 8 + k] * D_;
                const u32x4 w0 = *(const u32x4*)(src + c0), w1 = *(const u32x4*)(src + c0 + 8);
                x[0][0] += bflo(w0.x); x[0][1] += bfhi(w0.x); x[0][2] += bflo(w0.y); x[0][3] += bfhi(w0.y);
                x[1][0] += bflo(w0.z); x[1][1] += bfhi(w0.z); x[1][2] += bflo(w0.w); x[1][3] += bfhi(w0.w);
                x[2][0] += bflo(w1.x); x[2][1] += bfhi(w1.x); x[2][2] += bflo(w1.y); x[2][3] += bfhi(w1.y);
                x[3][0] += bflo(w1.z); x[3][1] += bfhi(w1.z); x[3][2] += bflo(w1.w); x[3][3] += bfhi(w1.w);
            }
        }
        float s = 0.f;
#pragma unroll
        for (int i = 0; i < 4; ++i) s += (x[i][0] + x[i][1]) + (x[i][2] + x[i][3]);
        const float mean = wave_sum(s) * (1.0f / 1024.0f);
        float qv = 0.f;
#pragma unroll
        for (int i = 0; i < 4; ++i) { const f32x4 d = x[i] - mean; qv += (d[0] * d[0] + d[1] * d[1]) + (d[2] * d[2] + d[3] * d[3]); }
        const float rstd = rsqrtf(wave_sum(qv) * (1.0f / 1024.0f) + LN_EPS);
        u32x4 o0, o1;
#pragma unroll
        for (int i = 0; i < 4; ++i) { x[i] = (x[i] - mean) * rstd * g4[i] + b4[i]; *(f32x4*)(hr + c0 + 4 * i) = x[i]; }
        o0.x = cvt_pk_bf16(x[0][0], x[0][1]); o0.y = cvt_pk_bf16(x[0][2], x[0][3]); o0.z = cvt_pk_bf16(x[1][0], x[1][1]); o0.w = cvt_pk_bf16(x[1][2], x[1][3]);
        o1.x = cvt_pk_bf16(x[2][0], x[2][1]); o1.y = cvt_pk_bf16(x[2][2], x[2][3]); o1.z = cvt_pk_bf16(x[3][0], x[3][1]); o1.w = cvt_pk_bf16(x[3][2], x[3][3]);
        *(u32x4*)(h16 + (size_t)prow * D_ + c0) = o0; *(u32x4*)(h16 + (size_t)prow * D_ + c0 + 8) = o1;
    }
}

DI void phase_qkv(const Params& p, unsigned char* lds, int l) {
    const int nq = MT * 4, nk = l == 2 ? MT * 4 : 0, nv = nk;
    for (int u = blockIdx.x; u < nq + nk + nv; u += gridDim.x) {
        if (u < nq + nk) {
            const bool isq = u < nq; const int r = isq ? u : u - nq, mt = r >> 2, nt = r & 3;
            EpiQK e; e.m0 = mt * 128; e.n0 = nt * 256; e.dst = isq ? SCR16(p, 0) : KBUF(p); e.scale = isq ? 0.125f * 1.4426950408889634f : 1.0f;
            APlain a; a.base = H16(p) + (size_t)(mt * 128) * D_; a.ld = D_;
            const bf16_t* B = isq ? WL_WQ(p) + (size_t)(nt * 256) * D_ : WL_BIG(p) + (size_t)(nt * 256) * D_;
            gemm_tile<128, 256, 64, 64, true>(lds, a, B, D_, D_, e);
        } else {
            const int r = u - nq - nk, mt = r >> 2, nt = r & 3;
            EpiVt e; e.m0 = mt * 128; e.n0 = nt * 256; e.dst = VTBUF(p);
            APlain a; a.base = H16(p) + (size_t)(mt * 128) * D_; a.ld = D_;
            gemm_tile<128, 256, 64, 64, false>(lds, a, WL_BIG(p) + (size_t)(1024 + nt * 256) * D_, D_, D_, e);
        }
    }
}

DI int crow32(int i, int h) { return (i & 3) + 8 * (i >> 2) + 4 * h; }

DI void phase_attn(const Params& p, unsigned char* lds, int j) {
    const int tid = tid_(), lane = tid & 63, wid = tid >> 6, cmap = wid >> 2, rg = wid & 3, ql = lane & 31, hh = lane >> 5;
    const float lam_init = j == 0 ? (float)(0.8 - 0.6 * 0.5488116360940264) : (float)(0.8 - 0.6 * 0.4065696597405991);
    float d1 = 0.f, d2 = 0.f;
    for (int i = 0; i < 64; ++i) { d1 += p.in[I_LQ1][j * 64 + i] * p.in[I_LK1][j * 64 + i]; d2 += p.in[I_LQ2][j * 64 + i] * p.in[I_LK2][j * 64 + i]; }
    const float lam = __expf(d1) - __expf(d2) + lam_init;
    const float post = 1.0f - lam_init;
    const bf16_t* Q = SCR16(p, 0); const bf16_t* Kb = KBUF(p); const bf16_t* Vt = VTBUF(p); bf16_t* Z = SCR16(p, SCR_Z);
    const float* subg = p.in[I_SUBG] + j * 128;
    unsigned* ctr = CTRL(p) + CT_ATTNQ + 64 * j;
    constexpr int STG = 32768;
    unsigned* s_u = (unsigned*)(lds + 2 * STG);
    constexpr int NQB = LP / 128;
    const int total = NB * 8 * NQB;
    const int krow = tid >> 3, kc8 = tid & 7;
    const unsigned koff = krow * 128 + ((kc8 ^ ((krow >> 1) & 7)) << 4);
    for (;;) {
        if (tid == 0) *s_u = atomicAdd(ctr, 1u);
        __syncthreads();
        const int u = (int)*s_u;
        __syncthreads();
        if (u >= total) break;
        const int qb = NQB - 1 - u / 16, bh = u & 15, b = bh >> 3, head = bh & 7;
        const int q0 = qb * 128 + rg * 32;
        bf16x8 qf[4];
        {
            const bf16_t* qp = Q + (((size_t)(b * 16 + head * 2 + cmap)) * LP + q0 + ql) * 64 + 8 * hh;
#pragma unroll
            for (int s = 0; s < 4; ++s) qf[s] = *(const bf16x8*)(qp + 16 * s);
        }
        const bf16_t* k0p = Kb + (((size_t)(b * 16 + head * 2 + 0)) * LP) * 64 + krow * 64 + kc8 * 8;
        const bf16_t* k1p = Kb + (((size_t)(b * 16 + head * 2 + 1)) * LP) * 64 + krow * 64 + kc8 * 8;
        const bf16_t* vp0 = Vt + ((size_t)(b * 1024 + head * 128 + krow)) * LP + kc8 * 8;
        const bf16_t* vp1 = vp0 + (size_t)64 * LP;
        const int ntile = 2 * qb + 2;
        f32x16 O[4];
#pragma unroll
        for (int i = 0; i < 4; ++i)
#pragma unroll
            for (int r = 0; r < 16; ++r) O[i][r] = 0.f;
        float m_run = -1e30f, l_run = 0.f;
        u32x4 rk0, rk1, rv0, rv1;
        rk0 = *(const u32x4*)(k0p); rk1 = *(const u32x4*)(k1p); rv0 = *(const u32x4*)(vp0); rv1 = *(const u32x4*)(vp1);
        auto stage_write = [&](unsigned char* st) {
            *(u32x4*)(st + koff) = rk0; *(u32x4*)(st + 8192 + koff) = rk1;
            {
                const int r0 = krow, r1 = krow + 64;
                const int s0 = (r0 >> 1) & 15, s1 = (r1 >> 1) & 15;
                unsigned char* vb = st + 16384;
                *(u32x2*)(vb + r0 * 128 + (((2 * kc8) ^ s0) << 3)) = (u32x2){rv0.x, rv0.y};
                *(u32x2*)(vb + r0 * 128 + (((2 * kc8 + 1) ^ s0) << 3)) = (u32x2){rv0.z, rv0.w};
                *(u32x2*)(vb + r1 * 128 + (((2 * kc8) ^ s1) << 3)) = (u32x2){rv1.x, rv1.y};
                *(u32x2*)(vb + r1 * 128 + (((2 * kc8 + 1) ^ s1) << 3)) = (u32x2){rv1.z, rv1.w};
            }
        };
        stage_write(lds);
        __syncthreads();
        for (int kt = 0; kt < ntile; ++kt) {
            const unsigned char* cur = lds + (kt & 1) * STG;
            const bool more = kt + 1 < ntile;
            if (more) {
                const size_t ko = (size_t)(kt + 1) * 64 * 64, vo = (size_t)(kt + 1) * 64;
                rk0 = *(const u32x4*)(k0p + ko); rk1 = *(const u32x4*)(k1p + ko); rv0 = *(const u32x4*)(vp0 + vo); rv1 = *(const u32x4*)(vp1 + vo);
            }
            const int key0 = kt * 64;
            if (key0 <= q0 + 31) {
                const unsigned char* kst = cur + cmap * 8192;
                f32x16 sc[2];
#pragma unroll
                for (int kb = 0; kb < 2; ++kb) {
#pragma unroll
                    for (int r = 0; r < 16; ++r) sc[kb][r] = 0.f;
                    const int row = kb * 32 + ql;
#pragma unroll
                    for (int s = 0; s < 4; ++s) {
                        const bf16x8 kf = *(const bf16x8*)(kst + row * 128 + (((2 * s + hh) ^ ((row >> 1) & 7)) << 4));
                        sc[kb] = __builtin_amdgcn_mfma_f32_32x32x16_bf16(kf, qf[s], sc[kb], 0, 0, 0);
                    }
                }
                if (key0 + 63 > q0) {
                    const int qq = q0 + ql;
#pragma unroll
                    for (int kb = 0; kb < 2; ++kb)
#pragma unroll
                        for (int r = 0; r < 16; ++r) { const int key = key0 + kb * 32 + crow32(r, hh); if (key > qq) sc[kb][r] = -INFINITY; }
                }
                float mx = sc[0][0];
#pragma unroll
                for (int kb = 0; kb < 2; ++kb)
#pragma unroll
                    for (int r = 0; r < 16; ++r) mx = fmaxf(mx, sc[kb][r]);
                mx = fmaxf(mx, __shfl_xor(mx, 32));
                const float m_new = fmaxf(m_run, mx);
                const float alpha = __builtin_amdgcn_exp2f(m_run - m_new);
                m_run = m_new;
                float ps = 0.f;
#pragma unroll
                for (int kb = 0; kb < 2; ++kb)
#pragma unroll
                    for (int r = 0; r < 16; ++r) { const float e = __builtin_amdgcn_exp2f(sc[kb][r] - m_new); sc[kb][r] = e; ps += e; }
                l_run = l_run * alpha + ps;
#pragma unroll
                for (int i = 0; i < 4; ++i)
#pragma unroll
                    for (int r = 0; r < 16; ++r) O[i][r] *= alpha;
                const unsigned char* vst = cur + 16384;
#pragma unroll
                for (int s = 0; s < 4; ++s) {
                    const int kb = s >> 1, r0 = 8 * (s & 1);
                    u32x4 pw;
                    pw.x = cvt_pk_bf16(sc[kb][r0 + 0], sc[kb][r0 + 1]); pw.y = cvt_pk_bf16(sc[kb][r0 + 2], sc[kb][r0 + 3]);
                    pw.z = cvt_pk_bf16(sc[kb][r0 + 4], sc[kb][r0 + 5]); pw.w = cvt_pk_bf16(sc[kb][r0 + 6], sc[kb][r0 + 7]);
                    const bf16x8 pf = __builtin_bit_cast(bf16x8, pw);
#pragma unroll
                    for (int dvb = 0; dvb < 4; ++dvb) {
                        const int row = dvb * 32 + ql, sw = (row >> 1) & 15;
                        const u32x2 lo = *(const u32x2*)(vst + row * 128 + (((4 * s + hh) ^ sw) << 3));
                        const u32x2 hi = *(const u32x2*)(vst + row * 128 + (((4 * s + 2 + hh) ^ sw) << 3));
                        const bf16x8 vf = __builtin_bit_cast(bf16x8, (u32x4){lo.x, lo.y, hi.x, hi.y});
                        O[dvb] = __builtin_amdgcn_mfma_f32_32x32x16_bf16(vf, pf, O[dvb], 0, 0, 0);
                    }
                }
            }
            if (more) stage_write(lds + ((kt + 1) & 1) * STG);
            __syncthreads();
        }
        const float l_tot = l_run + __shfl_xor(l_run, 32);
        const float inv = 1.0f / l_tot;
        float* xb = (float*)lds + rg * 4096;
        if (cmap == 1) {
            const float sc1 = lam * inv;
#pragma unroll
            for (int i = 0; i < 4; ++i)
#pragma unroll
                for (int r = 0; r < 16; ++r) xb[(i * 16 + r) * 64 + lane] = O[i][r] * sc1;
        }
        __syncthreads();
        if (cmap == 0) {
            float ss = 0.f;
#pragma unroll
            for (int i = 0; i < 4; ++i)
#pragma unroll
                for (int r = 0; r < 16; ++r) { const float o = O[i][r] * inv - xb[(i * 16 + r) * 64 + lane]; O[i][r] = o; ss += o * o; }
            ss += __shfl_xor(ss, 32);
            const float rn = rsqrtf(ss * (1.0f / 128.0f) + 1e-5f) * post;
            bf16_t* zp = Z + ((size_t)(b * LP + q0 + ql)) * D_ + head * 128;
#pragma unroll
            for (int i = 0; i < 4; ++i)
#pragma unroll
                for (int g = 0; g < 4; ++g) {
                    const int dv = i * 32 + 8 * g + 4 * hh;
                    const f32x4 sg = *(const f32x4*)(subg + dv);
                    f32x4 o; o[0] = O[i][4 * g + 0] * rn * sg[0]; o[1] = O[i][4 * g + 1] * rn * sg[1]; o[2] = O[i][4 * g + 2] * rn * sg[2]; o[3] = O[i][4 * g + 3] * rn * sg[3];
                    st_bf4(zp + dv, o);
                }
        }
        __syncthreads();
    }
}

DI int* TAB_IDX(const Params& p) { return (int*)(p.ws + OFF_TAB); }
DI float* TAB_GATE(const Params& p) { return (float*)(p.ws + OFF_TAB) + NSLOT; }
DI int* TAB_TOKSLOT(const Params& p) { return (int*)(p.ws + OFF_TAB) + 2 * NSLOT; }
DI int* TAB_SLOTTOK(const Params& p) { return (int*)(p.ws + OFF_TAB) + 3 * NSLOT; }
DI float* TAB_SLOTGATE(const Params& p) { return (float*)(p.ws + OFF_TAB) + 4 * NSLOT; }
DI int* TAB_TILES(const Params& p) { return (int*)(p.ws + OFF_TAB) + 5 * NSLOT; }

DI void phase_router(const Params& p, unsigned char* lds, int l) {
    float* lg = (float*)(lds + 2 * (128 + 64) * 128);
    unsigned* hist = (unsigned*)(lds + 2 * (128 + 64) * 128 + 128 * 65 * 4);
    const int tid = tid_(), lane = tid & 63, wid = tid >> 6;
    if (tid < 64) hist[tid] = 0u;
    __syncthreads();
    const float bias = p.in[I_RTB][l * NE + lane];
    int* idx = TAB_IDX(p); float* gt = TAB_GATE(p);
    for (int mt = blockIdx.x; mt < MT; mt += gridDim.x) {
        EpiLds e; e.dst = lg;
        APlain a; a.base = H16(p) + (size_t)(mt * 128) * D_; a.ld = D_;
        gemm_tile<128, 64, 16, 64, true>(lds, a, WS_RT(p), D_, D_, e);
        __syncthreads();
        for (int rr = 0; rr < 16; ++rr) {
            const int prow = mt * 128 + wid * 16 + rr;
            const int b = prow >= LP ? 1 : 0, t = prow - b * LP;
            if (t >= LSEQ) continue;
            const int n = b * LSEQ + t;
            const float s = sigmoidf_(lg[(wid * 16 + rr) * 65 + lane]);
            const float sel = s + bias;
            const float m1 = red8_max(sel);
            const unsigned long long eq = __ballot(sel == m1);
            const unsigned gb = (unsigned)(eq >> ((lane >> 3) * 8)) & 0xffu;
            const int first = __builtin_ctz(gb | 0x100u);
            const float sel2 = (lane & 7) == first ? -INFINITY : sel;
            const float gs = m1 + red8_max(sel2);
            int rank = 0;
#pragma unroll
            for (int g = 0; g < 8; ++g) { const float o = rdlane(gs, g * 8); rank += (o > gs || (o == gs && g < (lane >> 3))) ? 1 : 0; }
            float cur = rank < 4 ? sel : -INFINITY;
            float wsum = 0.f, my_s = 0.f; int my_i = 0;
#pragma unroll
            for (int k = 0; k < 8; ++k) {
                const float m = wave_max(cur);
                const unsigned long long bal = __ballot(cur == m);
                const int win = __builtin_ctzll(bal | (1ull << 63));
                const float swv = rdlane(s, win);
                wsum += swv;
                if (lane == k) { my_i = win; my_s = swv; }
                if (lane == win) cur = -INFINITY;
            }
            if (lane < 8) {
                idx[n * 8 + lane] = my_i; gt[n * 8 + lane] = my_s / wsum * 2.5f;
                atomicAdd(hist + my_i, 1u);
            }
        }
        __syncthreads();
    }
    __syncthreads();
    if (tid < 64 && hist[tid]) atomicAdd(CTRL(p) + CT_CNT + 64 * l + tid, (unsigned)hist[tid]);
}

DI void phase_scatter(const Params& p, unsigned char* lds, int l) {
    unsigned* cnt = (unsigned*)lds; unsigned* lh = cnt + 64; unsigned* lbase = lh + 64; unsigned* lcur = lbase + 64; unsigned* start = lcur + 64;
    const int tid = tid_();
    unsigned* gc = CTRL(p) + CT_CNT + 64 * l; unsigned* gcur = CTRL(p) + CT_CUR + 64 * l;
    if (tid < 64) { cnt[tid] = __hip_atomic_load(gc + tid, __ATOMIC_RELAXED, __HIP_MEMORY_SCOPE_AGENT); lh[tid] = 0u; lcur[tid] = 0u; }
    __syncthreads();
    if (tid < 64) { unsigned s = 0; for (int e = 0; e < tid; ++e) s += cnt[e]; start[tid] = s; }
    const int per = (NTOK + gridDim.x - 1) / gridDim.x;
    const int n0 = blockIdx.x * per, n1 = n0 + per < NTOK ? n0 + per : NTOK;
    const int* idx = TAB_IDX(p); const float* gt = TAB_GATE(p);
    int* tok_slot = TAB_TOKSLOT(p); int* slot_tok = TAB_SLOTTOK(p); float* slot_gate = TAB_SLOTGATE(p);
    __syncthreads();
    for (int i = n0 * 8 + tid; i < n1 * 8; i += NTHR) atomicAdd(lh + idx[i], 1u);
    __syncthreads();
    if (tid < 64) lbase[tid] = start[tid] + (lh[tid] ? atomicAdd(gcur + tid, (unsigned)lh[tid]) : 0u);
    __syncthreads();
    for (int i = n0 * 8 + tid; i < n1 * 8; i += NTHR) {
        const int e = idx[i], n = i >> 3;
        const unsigned pos = lbase[e] + atomicAdd(lcur + e, 1u);
        const int b = n >= LSEQ ? 1 : 0, t = n - b * LSEQ;
        slot_tok[pos] = b * LP + t; slot_gate[pos] = gt[i]; tok_slot[i] = (int)pos;
    }
    if (blockIdx.x == 0 && tid < 64) {
        unsigned tb = 0; for (int e = 0; e < tid; ++e) tb += (cnt[e] + 127) >> 7;
        const unsigned nt = (cnt[tid] + 127) >> 7;
        int* tiles = TAB_TILES(p);
        for (unsigned i = 0; i < nt; ++i) { int* tp = tiles + (tb + i) * 4; tp[0] = tid; tp[1] = (int)(start[tid] + 128 * i); const int rem = (int)cnt[tid] - 128 * (int)i; tp[2] = rem < 128 ? rem : 128; tp[3] = 0; }
        if (tid == 63) CTRL(p)[CT_NT + l] = tb + nt;
    }
}

DI void phase_m1(const Params& p, unsigned char* lds, int l) {
    const int T = (int)CTRL(p)[CT_NT + l];
    const int* tiles = TAB_TILES(p);
    for (int u = blockIdx.x; u < (T + MT) * 2; u += gridDim.x) {
        const int tile = u >> 1, half = u & 1;
        EpiM1 e; e.n0 = half * 256;
        if (tile < T) {
            const int ex = tiles[tile * 4], s0 = tiles[tile * 4 + 1], nr = tiles[tile * 4 + 2];
            e.dst = SCR16(p, SCR_H); e.gate = TAB_SLOTGATE(p); e.row0 = s0; e.nrows = nr;
            AGather a; a.base = H16(p); a.rows = TAB_SLOTTOK(p) + s0; a.nrows = nr;
            gemm_tile<128, 256, 64, 64, true>(lds, a, WM_GU(p) + ((size_t)ex * 512 + half * 256) * D_, D_, D_, e);
        } else {
            const int mt = tile - T;
            e.dst = SCR16(p, SCR_HS); e.gate = nullptr; e.row0 = mt * 128; e.nrows = 128;
            APlain a; a.base = H16(p) + (size_t)(mt * 128) * D_; a.ld = D_;
            gemm_tile<128, 256, 64, 64, true>(lds, a, WS_GU(p) + (size_t)(half * 256) * D_, D_, D_, e);
        }
    }
}
DI void phase_m2(const Params& p, unsigned char* lds, int l) {
    const int T = (int)CTRL(p)[CT_NT + l];
    const int* tiles = TAB_TILES(p);
    for (int u = blockIdx.x; u < (T + MT) * 4; u += gridDim.x) {
        const int tile = u >> 2, nq = u & 3;
        EpiM2 e; e.n0 = nq * 256;
        if (tile < T) {
            const int ex = tiles[tile * 4], s0 = tiles[tile * 4 + 1], nr = tiles[tile * 4 + 2];
            e.dst = SCR16(p, SCR_Y); e.row0 = s0; e.nrows = nr;
            int last = NSLOT - 1 - s0; if (last > 127) last = 127;
            AClamp a;
            a.base = SCR16(p, SCR_H) + (size_t)s0 * FF; a.last = last;
            gemm_tile<128, 256, 64, 64, true>(lds, a, WM_DN(p) + ((size_t)ex * 1024 + nq * 256) * FF, FF, FF, e);
        } else {
            const int mt = tile - T;
            e.dst = H16(p); e.row0 = mt * 128; e.nrows = 128;
            APlain a; a.base = SCR16(p, SCR_HS) + (size_t)(mt * 128) * FF; a.ld = FF;
            gemm_tile<128, 256, 64, 64, true>(lds, a, WS_DN(p) + (size_t)(nq * 256) * FF, FF, FF, e);
        }
    }
}

__global__ void __launch_bounds__(NTHR, 2) mega(Params p) {
    extern __shared__ __attribute__((aligned(16))) unsigned char lds[];
    LAS unsigned* xbw = (LAS unsigned*)(lds + 131072);
    if (threadIdx.x == 0) { xbw[0] = 0u; xbw[1] = 0u; xbw[2] = 0u; xbw[3] = 0u; }
    __syncthreads();
    XcdBarrier bar = xcd_barrier_post(CTRL(p), (volatile LAS unsigned*)xbw);
    phase_init(p);
    phase_weights(p, lds, 0);
    xcd_barrier(bar);
    for (int l = 0; l < 4; ++l) {
        if (l < 2) {
            phase_r1(p, lds, l); xcd_barrier(bar);
            phase_r2(p, lds, l); xcd_barrier(bar);
            phase_scan(p, lds, l); xcd_barrier(bar);
        } else {
            phase_qkv(p, lds, l); xcd_barrier(bar);
            phase_attn(p, lds, l - 2); xcd_barrier(bar);
        }
        phase_outproj(p, lds); xcd_barrier(bar);
        phase_ln<false>(p, p.in[I_LNMG] + l * D_, p.in[I_LNMB] + l * D_); xcd_barrier(bar);
        phase_router(p, lds, l); xcd_barrier(bar);
        phase_scatter(p, lds, l); xcd_barrier(bar);
        phase_m1(p, lds, l); xcd_barrier(bar);
        phase_m2(p, lds, l); xcd_barrier(bar);
        phase_ln<true>(p, p.in[I_LNFG] + l * D_, p.in[I_LNFB] + l * D_);
        if (l < 3) phase_weights(p, lds, l + 1);
        xcd_barrier(bar);
    }
}

extern "C" void kernel_launch(void* const* d_in, const int* in_sizes, int n_in, void* d_out, int out_size, void* d_ws, size_t ws_size, hipStream_t stream) {
    constexpr size_t kDynLds = 131072 + 256;
    static int grid = 0;
    if (!grid) {
        int dev = 0, cus = 0, per_cu = 0;
        hipGetDevice(&dev);
        hipDeviceGetAttribute(&cus, hipDeviceAttributeMultiprocessorCount, dev);
        hipFuncSetAttribute((const void*)mega, hipFuncAttributeMaxDynamicSharedMemorySize, (int)kDynLds);
        hipOccupancyMaxActiveBlocksPerMultiprocessor(&per_cu, mega, NTHR, kDynLds);
        grid = cus * (per_cu < 1 ? per_cu : 1);
        if (grid <= 0) grid = 0;
    }
    if (n_in < 41 || ws_size < WS_NEED || grid <= 0) { fprintf(stderr, "kernel_launch: bad config (n_in %d ws %zu need %zu grid %d)\n", n_in, ws_size, (size_t)WS_NEED, grid); return; }
    hipMemsetAsync(d_ws, 0, 65536, stream);
    Params p; memset(&p, 0, sizeof(p));
    for (int i = 0; i < 41; ++i) p.in[i] = (const float*)d_in[i];
    p.out = (float*)d_out; p.ws = (unsigned char*)d_ws;
    hipLaunchKernelGGL(mega, dim3(grid), dim3(NTHR), kDynLds, stream, p);
}
#ifdef PHASE_TEST
#define PK(name, body) __global__ void __launch_bounds__(NTHR, 2) name(Params p, int l) { extern __shared__ __attribute__((aligned(16))) unsigned char lds[]; body; }
PK(t_init, phase_init(p))
PK(t_weights, phase_weights(p, lds, l))
PK(t_r1, phase_r1(p, lds, l))
PK(t_r2, phase_r2(p, lds, l))
PK(t_scan, phase_scan(p, lds, l))
PK(t_outproj, phase_outproj(p, lds))
PK(t_ln0, phase_ln<false>(p, p.in[I_LNMG], p.in[I_LNMB]))
PK(t_ln1, phase_ln<true>(p, p.in[I_LNMG], p.in[I_LNMB]))
PK(t_qkv, phase_qkv(p, lds, l))
PK(t_attn, phase_attn(p, lds, l))
PK(t_router, phase_router(p, lds, l))
PK(t_scatter, phase_scatter(p, lds, l))
PK(t_m1, phase_m1(p, lds, l))
PK(t_m2, phase_m2(p, lds, l))
#endif
```

```cpp
#include <hip/hip_runtime.h>
#include <stdint.h>
#include <stdio.h>
#include <string.h>

#define DI __device__ __forceinline__
typedef unsigned short bf16_t;
typedef short bf16x8 __attribute__((ext_vector_type(8)));
typedef short s16x4 __attribute__((ext_vector_type(4)));
typedef float f32x2 __attribute__((ext_vector_type(2)));
typedef float f32x4 __attribute__((ext_vector_type(4)));
typedef float f32x16 __attribute__((ext_vector_type(16)));
typedef unsigned u32x4 __attribute__((ext_vector_type(4)));
typedef unsigned u32x2 __attribute__((ext_vector_type(2)));

constexpr int D_ = 1024, NB = 2, SEQ = 16384, NMETA = 16, LSEQ = SEQ + NMETA, LP = 16512, NP = NB * LP, NTOK = NB * LSEQ;
constexpr int NE = 64, TOPK = 8, FF = 256, NSLOT = NTOK * TOPK;
constexpr int NTHR = 512;
constexpr int LDS_BAR = 145408;
constexpr int NCHR = 257;
constexpr int MT = NP / 128;
constexpr float DN_ALPHA = 1.6817928305074290f;
constexpr float LN_EPS = 1e-5f;
constexpr int WBIG_ROWS = 3584, LO1_W = 384;

constexpr size_t AL(size_t x) { return (x + 255) & ~(size_t)255; }
constexpr size_t OFF_CTRL = 0;
constexpr size_t OFF_META32 = 65536;
constexpr size_t OFF_H16 = OFF_META32 + (size_t)NB * NMETA * D_ * 4;
constexpr size_t SZ_ACT16 = (size_t)NP * D_ * 2;
constexpr size_t OFF_KV = AL(OFF_H16 + SZ_ACT16 + 2048);
constexpr size_t OFF_WL = AL(OFF_KV + 2 * SZ_ACT16);
constexpr size_t SZ_WL = (size_t)WBIG_ROWS * 2048 * 2 + (size_t)1024 * LO1_W * 2 + (size_t)1024 * 1024 * 2;
constexpr size_t OFF_WSH = AL(OFF_WL + SZ_WL);
constexpr size_t SZ_WSH = (size_t)512 * 1024 * 2 + (size_t)1024 * 256 * 2 + (size_t)64 * 1024 * 2;
constexpr size_t OFF_WMOE = AL(OFF_WSH + SZ_WSH);
constexpr size_t SZ_WMOE = (size_t)NE * (512 * 1024 + 1024 * 256) * 2;
constexpr size_t OFF_TAB = AL(OFF_WMOE + SZ_WMOE);
constexpr size_t SZ_TAB = (size_t)NSLOT * 4 * 5 + 65536;
constexpr size_t OFF_SCR = AL(OFF_TAB + SZ_TAB);
constexpr size_t SCR_R = 0, SCR_K = SZ_ACT16, SCR_V = 2 * SZ_ACT16, SCR_G = 3 * SZ_ACT16, SCR_A = 4 * SZ_ACT16, SCR_Z = 5 * SZ_ACT16;
constexpr size_t SCR_W = 6 * SZ_ACT16;
constexpr size_t SCR_LO1 = SCR_W + 2 * SZ_ACT16;
constexpr size_t SCR_QS = SCR_LO1 + (size_t)NP * LO1_W * 2;
constexpr size_t SZ_SCR_RW = SCR_QS + SZ_ACT16;
constexpr size_t SCR_H = 0;
constexpr size_t SCR_HS = AL((size_t)NSLOT * 256 * 2);
constexpr size_t SCR_Y = AL(SCR_HS + (size_t)NP * 256 * 2);
constexpr size_t SZ_SCR_MOE = SCR_Y + (size_t)NSLOT * 1024 * 2;
constexpr size_t SZ_SCR = SZ_SCR_MOE > SZ_SCR_RW ? SZ_SCR_MOE : SZ_SCR_RW;
constexpr size_t WS_NEED = OFF_SCR + SZ_SCR + 4096;

constexpr int CT_ATTNQ = 4096;
constexpr int CT_CNT = 4352;
constexpr int CT_CUR = 4608;
constexpr int CT_NT = 4864;

struct Params {
    const float* in[41];
    float* out;
    unsigned char* ws;
};
enum { I_X = 0, I_META, I_LNMG, I_LNMB, I_LNFG, I_LNFB, I_MU, I_WRKV, I_W0, I_WL1, I_WL2, I_A0, I_AL1, I_AL2, I_GL1, I_GL2, I_KK, I_KA, I_RK, I_LNXG, I_LNXB, I_WOUT,
       I_V0, I_VL1, I_VL2, I_KVW, I_WQ, I_LQ1, I_LK1, I_LQ2, I_LK2, I_SUBG, I_DAWO, I_RTW, I_RTB, I_MG, I_MU_, I_MD, I_SG, I_SU, I_SD };

#define XB_TMO      128
#define XB_XCNT(j)  (256  + 64 * (j))
#define XB_XSUB(j)  (1280 + 64 * (j))
#define XB_XGEN(j)  (2304 + 64 * (j))
#define XB_TOP      3328
#define XB_TOPGEN   3392
#define XCD_BAR_WORDS 3456
#define XB_SPIN_CAP (1u << 22)
#define LAS __attribute__((address_space(3)))

__device__ __forceinline__ unsigned xb_ld(unsigned* p)              { return __hip_atomic_load(p, __ATOMIC_RELAXED, __HIP_MEMORY_SCOPE_AGENT); }
__device__ __forceinline__ unsigned xb_add(unsigned* p, unsigned v) { return __hip_atomic_fetch_add(p, v, __ATOMIC_RELAXED, __HIP_MEMORY_SCOPE_AGENT); }
__device__ __forceinline__ unsigned xb_xcc_id() { return (unsigned)__builtin_amdgcn_s_getreg((3 << 11) | 20) & 0xFu; }
#define XB_SPIN(cond, bar) do { unsigned _sp = 0; while (cond) { __builtin_amdgcn_s_sleep(1); \
    if ((++_sp & 255u) == 0u) { if (xb_ld(&(bar)[XB_TMO])) break; if (_sp > XB_SPIN_CAP) { atomicAdd(&(bar)[XB_TMO], 1u); break; } } } } while (0)

struct XcdBarrier { unsigned* bar; unsigned x; volatile LAS unsigned* st; };

__device__ __forceinline__ XcdBarrier xcd_barrier_post(unsigned* bar, volatile LAS unsigned* st) {
    XcdBarrier b; b.bar = bar; b.x = xb_xcc_id(); b.st = st;
    if (threadIdx.x == 0) (void)xb_add(&bar[XB_XCNT(b.x)], 1u);
    return b;
}
__device__ __forceinline__ void xcd_barrier_complete(unsigned* bar, unsigned x, unsigned& nloc, unsigned& nx) {
    const unsigned G = gridDim.x * gridDim.y * gridDim.z;
    unsigned sum, cnt, mine, sp = 0u;
    for (;;) {
        sum = 0u; cnt = 0u; mine = 0u;
#pragma unroll
        for (unsigned j = 0; j < 16; ++j) { const unsigned c = xb_ld(&bar[XB_XCNT(j)]); sum += c; cnt += (c > 0u) ? 1u : 0u; mine = (j == x) ? c : mine; }
        if (sum == G) break;
        __builtin_amdgcn_s_sleep(1);
        if ((++sp & 255u) == 0u) { if (xb_ld(&bar[XB_TMO])) break; if (sp > XB_SPIN_CAP) { atomicAdd(&bar[XB_TMO], 1u); break; } }
    }
    nloc = mine > 0u ? mine : 1u; nx = cnt > 0u ? cnt : 1u;
}
__device__ __forceinline__ void xcd_barrier(const XcdBarrier& b) {
    asm volatile("s_waitcnt vmcnt(0)" ::: "memory");
    __syncthreads();
    if (threadIdx.x == 0) {
        unsigned* bar = b.bar;
        __builtin_amdgcn_s_waitcnt(0);
        unsigned nloc = b.st[0], nx = b.st[1];
        if (nloc == 0u) { xcd_barrier_complete(bar, b.x, nloc, nx); b.st[0] = nloc; b.st[1] = nx; }
        const unsigned old = xb_add(&bar[XB_XSUB(b.x)], 1u);
        const unsigned gen = old / nloc;
        if (old + 1u == (gen + 1u) * nloc) {
            __builtin_amdgcn_fence(__ATOMIC_RELEASE, "agent");
            asm volatile("s_waitcnt vmcnt(0)" ::: "memory");
            const unsigned og = xb_add(&bar[XB_TOP], 1u);
            const unsigned tg = og / nx;
            if (og + 1u == (tg + 1u) * nx) xb_add(&bar[XB_TOPGEN], 1u);
            else XB_SPIN(xb_ld(&bar[XB_TOPGEN]) == tg, bar);
            __builtin_amdgcn_fence(__ATOMIC_ACQUIRE, "agent");
            xb_add(&bar[XB_XGEN(b.x)], 1u);
            asm volatile("s_waitcnt vmcnt(0)" ::: "memory");
        } else {
            XB_SPIN(xb_ld(&bar[XB_XGEN(b.x)]) == gen, bar);
            __builtin_amdgcn_fence(__ATOMIC_ACQUIRE, "agent");
            asm volatile("s_waitcnt vmcnt(0)" ::: "memory");
        }
    }
    __syncthreads();
}

DI int tid_() { int t = threadIdx.x; asm volatile("" : "+v"(t)); return t; }
typedef __bf16 bf16v2 __attribute__((ext_vector_type(2)));
DI unsigned cvt_pk_bf16(float lo, float hi) { f32x2 v = {lo, hi}; bf16v2 b = __builtin_convertvector(v, bf16v2); return __builtin_bit_cast(unsigned, b); }
DI float bf2f(bf16_t x) { return __uint_as_float((unsigned)x << 16); }
DI float bflo(unsigned w) { return __uint_as_float(w << 16); }
DI float bfhi(unsigned w) { return __uint_as_float(w & 0xffff0000u); }
DI bf16_t f2bf(float x) { return (bf16_t)(cvt_pk_bf16(x, 0.f) & 0xffffu); }
DI float sigmoidf_(float x) { return 1.0f / (1.0f + __expf(-x)); }
DI float tanhf_(float x) { const float t = __expf(-2.0f * fabsf(x)); const float r = (1.0f - t) / (1.0f + t); return x < 0.f ? -r : r; }
template <int CTRL> DI float dpp_f(float v) { return __builtin_bit_cast(float, __builtin_amdgcn_update_dpp(0, __builtin_bit_cast(int, v), CTRL, 0xF, 0xF, true)); }
DI float rdlane(float v, int l) { return __builtin_bit_cast(float, __builtin_amdgcn_readlane(__builtin_bit_cast(int, v), l)); }
DI float red8_sum(float v) { v += dpp_f<0xB1>(v); v += dpp_f<0x4E>(v); v += dpp_f<0x141>(v); return v; }
DI float red16_sum(float v) { v = red8_sum(v); v += dpp_f<0x140>(v); return v; }
DI float wave_sum(float v) { v = red16_sum(v); return (rdlane(v, 0) + rdlane(v, 16)) + (rdlane(v, 32) + rdlane(v, 48)); }
DI float red8_max(float v) { v = fmaxf(v, dpp_f<0xB1>(v)); v = fmaxf(v, dpp_f<0x4E>(v)); v = fmaxf(v, dpp_f<0x141>(v)); return v; }
DI float wave_max(float v) { v = red8_max(v); v = fmaxf(v, dpp_f<0x140>(v)); return fmaxf(fmaxf(rdlane(v, 0), rdlane(v, 16)), fmaxf(rdlane(v, 32), rdlane(v, 48))); }

DI bf16_t* H16(const Params& p) { return (bf16_t*)(p.ws + OFF_H16 + 2048); }
DI float* h32row_(float* out, unsigned char* ws, int prow) {
    const int b = prow >= LP ? 1 : 0, t = prow - b * LP;
    return t < NMETA ? (float*)(ws + OFF_META32) + (size_t)(b * NMETA + t) * D_ : out + ((size_t)b * SEQ + (t - NMETA)) * D_;
}
DI float* h32row(const Params& p, int prow) { return h32row_(p.out, p.ws, prow); }
DI unsigned* CTRL(const Params& p) { return (unsigned*)(p.ws + OFF_CTRL); }

DI void phase_init(const Params& p) {
    bf16_t* h16 = H16(p);
    const float* x = p.in[I_X]; const float* meta = p.in[I_META];
    const int tid0 = tid_(); const int half = tid0 >> 8, t4 = (tid0 & 255) * 4;
    for (int rp = blockIdx.x; rp < NTOK / 2; rp += gridDim.x) {
        const int n = rp * 2 + half; const int b = n >= LSEQ ? 1 : 0, t = n - b * LSEQ; const int prow = b * LP + t;
        const float* src = t < NMETA ? meta + t * D_ + t4 : x + ((size_t)b * SEQ + (t - NMETA)) * D_ + t4;
        const f32x4 v = *(const f32x4*)src;
        *(f32x4*)(h32row(p, prow) + t4) = v;
        u32x2 w; w.x = cvt_pk_bf16(v[0], v[1]); w.y = cvt_pk_bf16(v[2], v[3]);
        *(u32x2*)(h16 + (size_t)prow * D_ + t4) = w;
    }
    for (int zr = blockIdx.x; zr < 225; zr += gridDim.x) {
        const long prow = zr == 224 ? -1 : (long)(zr / 112) * LP + LSEQ + (zr % 112);
        *(unsigned*)(h16 + prow * D_ + tid0 * 2) = 0u;
    }
}

struct Job { const float* src; int Kvalid, Kpad, N, ldsrc; bf16_t* dst; int ld_dst, kofs, rowmode, rowbase; const float* scale; int scalemode; };

DI void cvt_mat(float* T, int& tctr, const Job& jb) {
    if (jb.N == 0) return;
    const int tk = jb.Kpad >> 6, tn = (jb.N + 63) >> 6, nt = tk * tn;
    const int G = gridDim.x;
    int first = ((int)blockIdx.x - (tctr % G) + G) % G;
    const int tid = tid_();
    for (int i = first; i < nt; i += G) {
        const int k0 = (i / tn) << 6, n0 = (i % tn) << 6;
        {
            const int kk = tid >> 4, n4 = (tid & 15) * 4;
#pragma unroll
            for (int ps = 0; ps < 2; ++ps) {
                const int k = k0 + kk + 32 * ps, n = n0 + n4;
                f32x4 v = (f32x4){0.f, 0.f, 0.f, 0.f};
                if (k < jb.Kvalid && n < jb.N) {
                    v = *(const f32x4*)(jb.src + (size_t)k * jb.ldsrc + n);
                    float s = 1.0f;
                    if (jb.scalemode == 1) s = jb.scale[k]; else if (jb.scalemode == 2) s = 1.0f - jb.scale[k];
                    v = v * s;
                }
                float* tp = T + (kk + 32 * ps) * 65 + n4;
                tp[0] = v[0]; tp[1] = v[1]; tp[2] = v[2]; tp[3] = v[3];
            }
        }
        __syncthreads();
        {
            const int n = tid >> 3, k8 = (tid & 7) * 8;
            if (n0 + n < jb.N) {
                const int ng = n0 + n;
                const int row = jb.rowmode == 0 ? jb.rowbase + ng : jb.rowbase + 32 * (ng >> 4) + (ng & 15);
                const float* tp = T + k8 * 65 + n;
                u32x4 w;
                w.x = cvt_pk_bf16(tp[0], tp[65]); w.y = cvt_pk_bf16(tp[130], tp[195]); w.z = cvt_pk_bf16(tp[260], tp[325]); w.w = cvt_pk_bf16(tp[390], tp[455]);
                *(u32x4*)(jb.dst + (size_t)row * jb.ld_dst + jb.kofs + k0 + k8) = w;
            }
        }
        __syncthreads();
    }
    tctr += nt;
}

DI bf16_t* WL_BIG(const Params& p) { return (bf16_t*)(p.ws + OFF_WL); }
DI bf16_t* WL_LORA2(const Params& p) { return (bf16_t*)(p.ws + OFF_WL + (size_t)WBIG_ROWS * 2048 * 2); }
DI bf16_t* WL_OUT(const Params& p) { return (bf16_t*)(p.ws + OFF_WL + (size_t)WBIG_ROWS * 2048 * 2 + (size_t)1024 * LO1_W * 2); }
DI bf16_t* WL_WQ(const Params& p) { return (bf16_t*)(p.ws + OFF_WL + (size_t)2048 * 1024 * 2); }
DI bf16_t* WS_GU(const Params& p) { return (bf16_t*)(p.ws + OFF_WSH); }
DI bf16_t* WS_DN(const Params& p) { return (bf16_t*)(p.ws + OFF_WSH + (size_t)512 * 1024 * 2); }
DI bf16_t* WS_RT(const Params& p) { return (bf16_t*)(p.ws + OFF_WSH + (size_t)512 * 1024 * 2 + (size_t)1024 * 256 * 2); }
DI bf16_t* WM_GU(const Params& p) { return (bf16_t*)(p.ws + OFF_WMOE); }
DI bf16_t* WM_DN(const Params& p) { return (bf16_t*)(p.ws + OFF_WMOE + (size_t)NE * 512 * 1024 * 2); }

DI Job mkjob(const float* src, int Kv, int Kp, int N, int ldsrc, bf16_t* dst, int ld_dst, int kofs, int rowmode, int rowbase, const float* scale, int scalemode) {
    Job j; j.src = src; j.Kvalid = Kv; j.Kpad = Kp; j.N = N; j.ldsrc = ldsrc; j.dst = dst; j.ld_dst = ld_dst; j.kofs = kofs; j.rowmode = rowmode; j.rowbase = rowbase; j.scale = scale; j.scalemode = scalemode; return j;
}

DI Job get_job(const Params& p, int l, int j) {
    Job z = mkjob(nullptr, 0, 0, 0, 0, nullptr, 0, 0, 0, 0, nullptr, 0);
    if (j < 19) {
        if (l < 2) {
            const float* mu = p.in[I_MU] + (size_t)l * 6 * D_;
            bf16_t* big = WL_BIG(p); bf16_t* lo2 = WL_LORA2(p);
            if (j < 6) { const int s = j >> 1, part = j & 1; return mkjob(p.in[I_WRKV] + (size_t)(l * 3 + s) * D_ * D_, 1024, 1024, 1024, 1024, big, 2048, part * 1024, 0, s * 1024, mu + s * D_, 1 + part); }
            if (j < 8) { const int part = j & 1; return mkjob(p.in[I_WL1] + (size_t)l * D_ * 64, 1024, 1024, 64, 64, big, 2048, part * 1024, 0, 3072, mu + 3 * D_, 1 + part); }
            if (j < 10) { const int part = j & 1; return mkjob(p.in[I_AL1] + (size_t)l * D_ * 64, 1024, 1024, 64, 64, big, 2048, part * 1024, 0, 3136, mu + 4 * D_, 1 + part); }
            if (j < 12) { const int part = j & 1; return mkjob(p.in[I_GL1] + (size_t)l * D_ * 160, 1024, 1024, 160, 160, big, 2048, part * 1024, 0, 3200, mu + 5 * D_, 1 + part); }
            if (j < 14) { if (l != 1) return z; const int part = j & 1; return mkjob(p.in[I_VL1], 1024, 1024, 32, 32, big, 2048, part * 1024, 0, 3392, mu + 2 * D_, 1 + part); }
            if (j == 14) return mkjob(p.in[I_WL2] + (size_t)l * 64 * D_, 64, 64, 1024, 1024, lo2, 64, 0, 0, 0, nullptr, 0);
            if (j == 15) return mkjob(p.in[I_AL2] + (size_t)l * 64 * D_, 64, 64, 1024, 1024, lo2 + 1024 * 64, 64, 0, 0, 0, nullptr, 0);
            if (j == 16) return mkjob(p.in[I_GL2] + (size_t)l * 160 * D_, 160, 192, 1024, 1024, lo2 + 2 * 1024 * 64, 192, 0, 0, 0, nullptr, 0);
            if (j == 17) { if (l != 1) return z; return mkjob(p.in[I_VL2], 32, 64, 1024, 1024, lo2 + 2 * 1024 * 64 + 1024 * 192, 64, 0, 0, 0, nullptr, 0); }
            return mkjob(p.in[I_WOUT] + (size_t)l * D_ * D_, 1024, 1024, 1024, 1024, WL_OUT(p), 1024, 0, 0, 0, nullptr, 0);
        } else {
            const int a = l - 2;
            if (j == 0) { if (l != 2) return z; return mkjob(p.in[I_KVW], 1024, 1024, 2048, 2048, WL_BIG(p), 1024, 0, 0, 0, nullptr, 0); }
            if (j == 1) return mkjob(p.in[I_WQ] + (size_t)a * D_ * D_, 1024, 1024, 1024, 1024, WL_WQ(p), 1024, 0, 0, 0, nullptr, 0);
            if (j == 2) return mkjob(p.in[I_DAWO] + (size_t)a * D_ * D_, 1024, 1024, 1024, 1024, WL_OUT(p), 1024, 0, 0, 0, nullptr, 0);
            return z;
        }
    }
    j -= 19;
    if (j == 0) return mkjob(p.in[I_SG] + (size_t)l * D_ * FF, 1024, 1024, 256, 256, WS_GU(p), 1024, 0, 1, 0, nullptr, 0);
    if (j == 1) return mkjob(p.in[I_SU] + (size_t)l * D_ * FF, 1024, 1024, 256, 256, WS_GU(p), 1024, 0, 1, 16, nullptr, 0);
    if (j == 2) return mkjob(p.in[I_SD] + (size_t)l * FF * D_, 256, 256, 1024, 1024, WS_DN(p), 256, 0, 0, 0, nullptr, 0);
    if (j == 3) return mkjob(p.in[I_RTW] + (size_t)l * D_ * NE, 1024, 1024, 64, 64, WS_RT(p), 1024, 0, 0, 0, nullptr, 0);
    j -= 4;
    const int e = j / 3, w = j - e * 3;
    if (w == 0) return mkjob(p.in[I_MG] + ((size_t)l * NE + e) * D_ * FF, 1024, 1024, 256, 256, WM_GU(p) + (size_t)e * 512 * 1024, 1024, 0, 1, 0, nullptr, 0);
    if (w == 1) return mkjob(p.in[I_MU_] + ((size_t)l * NE + e) * D_ * FF, 1024, 1024, 256, 256, WM_GU(p) + (size_t)e * 512 * 1024, 1024, 0, 1, 16, nullptr, 0);
    return mkjob(p.in[I_MD] + ((size_t)l * NE + e) * FF * D_, 256, 256, 1024, 1024, WM_DN(p) + (size_t)e * 1024 * 256, 256, 0, 0, 0, nullptr, 0);
}

DI void phase_weights(const Params& p, unsigned char* lds, int l) {
    float* T = (float*)lds;
    int tctr = 0;
    for (int j = 0; j < 19 + 4 + NE * 3; ++j) { const Job jb = get_job(p, l, j); cvt_mat(T, tctr, jb); }
}

template <int BM, int BN, int WTM, int WTN, bool TRANS, class AP, class EPI>
DI void gemm_tile(unsigned char* lds, const AP& aptr, const bf16_t* __restrict__ Bt, size_t ldb, int K, const EPI& epi) {
    constexpr int WN_ = BN / WTN, MI = WTM / 16, NI = WTN / 16;
    static_assert((BM / WTM) * WN_ == 8, "8 waves");
    constexpr int CA = BM * 8 / NTHR, CB = BN * 8 / NTHR;
    static_assert(CA >= 1 && CB >= 1, "tile too small");
    constexpr int ABYTES = BM * 128, STAGE = (BM + BN) * 128;
    const int tid = tid_(), lane = tid & 63, wid = tid >> 6, wm = wid / WN_, wn = wid % WN_;
    const bf16_t* ap[CA]; const bf16_t* bp[CB]; unsigned aoff[CA], boff[CB];
#pragma unroll
    for (int i = 0; i < CA; ++i) { const int id = tid + NTHR * i, row = id >> 3, c = id & 7; ap[i] = aptr(row) + c * 8; aoff[i] = row * 128 + ((c ^ ((row >> 1) & 7)) << 4); }
#pragma unroll
    for (int i = 0; i < CB; ++i) { const int id = tid + NTHR * i, row = id >> 3, c = id & 7; bp[i] = Bt + (size_t)row * ldb + c * 8; boff[i] = ABYTES + row * 128 + ((c ^ ((row >> 1) & 7)) << 4); }
    u32x4 ra[CA], rb[CB];
    f32x4 acc[MI][NI];
#pragma unroll
    for (int mi = 0; mi < MI; ++mi)
#pragma unroll
        for (int ni = 0; ni < NI; ++ni) acc[mi][ni] = (f32x4){0.f, 0.f, 0.f, 0.f};
    const int nk = K >> 6;
#pragma unroll
    for (int i = 0; i < CA; ++i) ra[i] = *(const u32x4*)(ap[i]);
#pragma unroll
    for (int i = 0; i < CB; ++i) rb[i] = *(const u32x4*)(bp[i]);
#pragma unroll
    for (int i = 0; i < CA; ++i) *(u32x4*)(lds + aoff[i]) = ra[i];
#pragma unroll
    for (int i = 0; i < CB; ++i) *(u32x4*)(lds + boff[i]) = rb[i];
    __syncthreads();
    const int fr = lane & 15, fq = lane >> 4, sw = (fr >> 1) & 7;
    for (int kt = 0; kt < nk; ++kt) {
        const unsigned char* cur = lds + (kt & 1) * STAGE;
        unsigned char* nxt = lds + ((kt + 1) & 1) * STAGE;
        const bool more = kt + 1 < nk;
        if (more) {
#pragma unroll
            for (int i = 0; i < CA; ++i) ra[i] = *(const u32x4*)(ap[i] + (kt + 1) * 64);
#pragma unroll
            for (int i = 0; i < CB; ++i) rb[i] = *(const u32x4*)(bp[i] + (kt + 1) * 64);
        }
#pragma unroll
        for (int ks = 0; ks < 2; ++ks) {
            bf16x8 af[MI], bfr[NI];
            const int ch = ((ks * 4 + fq) ^ sw) << 4;
#pragma unroll
            for (int mi = 0; mi < MI; ++mi) af[mi] = *(const bf16x8*)(cur + (wm * WTM + mi * 16 + fr) * 128 + ch);
#pragma unroll
            for (int ni = 0; ni < NI; ++ni) bfr[ni] = *(const bf16x8*)(cur + ABYTES + (wn * WTN + ni * 16 + fr) * 128 + ch);
#pragma unroll
            for (int mi = 0; mi < MI; ++mi)
#pragma unroll
                for (int ni = 0; ni < NI; ++ni)
                    acc[mi][ni] = TRANS ? __builtin_amdgcn_mfma_f32_16x16x32_bf16(bfr[ni], af[mi], acc[mi][ni], 0, 0, 0)
                                        : __builtin_amdgcn_mfma_f32_16x16x32_bf16(af[mi], bfr[ni], acc[mi][ni], 0, 0, 0);
        }
        if (more) {
#pragma unroll
            for (int i = 0; i < CA; ++i) *(u32x4*)(nxt + aoff[i]) = ra[i];
#pragma unroll
            for (int i = 0; i < CB; ++i) *(u32x4*)(nxt + boff[i]) = rb[i];
        }
        __syncthreads();
    }
    epi.template run<MI, NI>(acc, wm * WTM, wn * WTN, fr, fq);
}

struct APlain { const bf16_t* base; size_t ld; DI const bf16_t* operator()(int r) const { return base + (size_t)r * ld; } };
struct AClamp { const bf16_t* base; int last; DI const bf16_t* operator()(int r) const { return base + (size_t)(r < last ? r : last) * FF; } };
struct AGather { const bf16_t* base; const int* rows; int nrows; DI const bf16_t* operator()(int r) const { const int rr = r < nrows ? r : nrows - 1; return base + (size_t)rows[rr] * D_; } };

DI void st_bf4(bf16_t* dst, f32x4 v) { u32x2 w; w.x = cvt_pk_bf16(v[0], v[1]); w.y = cvt_pk_bf16(v[2], v[3]); *(u32x2*)dst = w; }

struct EpiR1 {
    bf16_t* dst; int kind; int m0, n0;
    template <int MI, int NI> DI void run(const f32x4 (&acc)[MI][NI], int rb, int cb, int fr, int fq) const {
#pragma unroll
        for (int ni = 0; ni < NI; ++ni) {
            const int col = n0 + cb + ni * 16 + 4 * fq;
            if (col >= 3456) continue;
#pragma unroll
            for (int mi = 0; mi < MI; ++mi) {
                const size_t row = (size_t)(m0 + rb + mi * 16 + fr);
                f32x4 a = acc[mi][ni];
                if (kind == 0) {
                    st_bf4(dst + row * D_ + (col & 1023), a);
                } else {
                    const int c = col - 3072;
                    if (c < 64) { a[0] = tanhf_(a[0]); a[1] = tanhf_(a[1]); a[2] = tanhf_(a[2]); a[3] = tanhf_(a[3]); }
                    else if (c >= 128 && c < 288) { a[0] = sigmoidf_(a[0]); a[1] = sigmoidf_(a[1]); a[2] = sigmoidf_(a[2]); a[3] = sigmoidf_(a[3]); }
                    else if ((c >= 288 && c < 320) || c >= 352) a = (f32x4){0.f, 0.f, 0.f, 0.f};
                    st_bf4(dst + row * LO1_W + c, a);
                }
            }
        }
    }
};
struct EpiLora2 {
    int mode; float* wdec; bf16_t* dst; const bf16_t* vfirst; const float* bias; int m0, n0;
    template <int MI, int NI> DI void run(const f32x4 (&acc)[MI][NI], int rb, int cb, int fr, int fq) const {
#pragma unroll
        for (int ni = 0; ni < NI; ++ni) {
            const int col = n0 + cb + ni * 16 + 4 * fq;
            f32x4 bv = (f32x4){0.f, 0.f, 0.f, 0.f};
            if (mode != 2) bv = *(const f32x4*)(bias + col);
#pragma unroll
            for (int mi = 0; mi < MI; ++mi) {
                const size_t off = (size_t)(m0 + rb + mi * 16 + fr) * D_ + col;
                f32x4 a = acc[mi][ni] + bv;
                if (mode == 0) {
#pragma unroll
                    for (int i = 0; i < 4; ++i) a[i] = -0.6065306597126334f * sigmoidf_(a[i]);
                    *(f32x4*)(wdec + off) = a;
                } else if (mode == 1) {
#pragma unroll
                    for (int i = 0; i < 4; ++i) a[i] = sigmoidf_(a[i]);
                    st_bf4(dst + off, a);
                } else if (mode == 2) {
                    st_bf4(dst + off, a);
                } else {
                    const u32x2 vv = *(const u32x2*)(dst + off), vf = *(const u32x2*)(vfirst + off);
                    const float v0 = bflo(vv.x), v1 = bfhi(vv.x), v2 = bflo(vv.y), v3 = bfhi(vv.y);
                    const float f0 = bflo(vf.x), f1 = bfhi(vf.x), f2 = bflo(vf.y), f3 = bfhi(vf.y);
                    f32x4 o;
                    o[0] = v0 + (f0 - v0) * sigmoidf_(a[0]); o[1] = v1 + (f1 - v1) * sigmoidf_(a[1]); o[2] = v2 + (f2 - v2) * sigmoidf_(a[2]); o[3] = v3 + (f3 - v3) * sigmoidf_(a[3]);
                    st_bf4(dst + off, o);
                }
            }
        }
    }
};
struct EpiResid {
    float* out; unsigned char* ws; int m0, n0;
    template <int MI, int NI> DI void run(const f32x4 (&acc)[MI][NI], int rb, int cb, int fr, int fq) const {
#pragma unroll
        for (int mi = 0; mi < MI; ++mi) {
            const int prow = m0 + rb + mi * 16 + fr;
            const int t = prow >= LP ? prow - LP : prow;
            if (t >= LSEQ) continue;
            float* hr = h32row_(out, ws, prow);
#pragma unroll
            for (int ni = 0; ni < NI; ++ni) {
                const int col = n0 + cb + ni * 16 + 4 * fq;
                f32x4 h = *(const f32x4*)(hr + col);
                *(f32x4*)(hr + col) = h * DN_ALPHA + acc[mi][ni];
            }
        }
    }
};
struct EpiQK {
    bf16_t* dst; float scale; int m0, n0;
    template <int MI, int NI> DI void run(const f32x4 (&acc)[MI][NI], int rb, int cb, int fr, int fq) const {
#pragma unroll
        for (int mi = 0; mi < MI; ++mi) {
            const int prow = m0 + rb + mi * 16 + fr;
            const int b = prow >= LP ? 1 : 0, t = prow - b * LP;
#pragma unroll
            for (int ni = 0; ni < NI; ++ni) {
                const int col = n0 + cb + ni * 16 + 4 * fq;
                const int hc = col >> 6, dd = col & 63;
                st_bf4(dst + (((size_t)(b * 16 + hc)) * LP + t) * 64 + dd, acc[mi][ni] * scale);
            }
        }
    }
};
struct EpiVt {
    bf16_t* dst; int m0, n0;
    template <int MI, int NI> DI void run(const f32x4 (&acc)[MI][NI], int rb, int cb, int fr, int fq) const {
#pragma unroll
        for (int mi = 0; mi < MI; ++mi) {
            const int prow = m0 + rb + mi * 16 + 4 * fq;
            const int b = prow >= LP ? 1 : 0, t = prow - b * LP;
#pragma unroll
            for (int ni = 0; ni < NI; ++ni) {
                const int col = n0 + cb + ni * 16 + fr;
                st_bf4(dst + ((size_t)(b * 1024 + col)) * LP + t, acc[mi][ni]);
            }
        }
    }
};
struct EpiM1 {
    bf16_t* dst; const float* gate; int row0, nrows, n0;
    template <int MI, int NI> DI void run(const f32x4 (&acc)[MI][NI], int rb, int cb, int fr, int fq) const {
#pragma unroll
        for (int mi = 0; mi < MI; ++mi) {
            const int r = rb + mi * 16 + fr;
            if (r >= nrows) continue;
            const float gw = gate ? gate[row0 + r] : 1.0f;
#pragma unroll
            for (int ni = 0; ni < NI; ni += 2) {
                const int hc = ((n0 + cb + ni * 16) >> 1) + 4 * fq;
                const f32x4 g = acc[mi][ni], u = acc[mi][ni + 1];
                f32x4 o;
#pragma unroll
                for (int i = 0; i < 4; ++i) o[i] = g[i] * sigmoidf_(g[i]) * u[i] * gw;
                st_bf4(dst + (size_t)(row0 + r) * FF + hc, o);
            }
        }
    }
};
struct EpiM2 {
    bf16_t* dst; int row0, nrows, n0;
    template <int MI, int NI> DI void run(const f32x4 (&acc)[MI][NI], int rb, int cb, int fr, int fq) const {
#pragma unroll
        for (int mi = 0; mi < MI; ++mi) {
            const int r = rb + mi * 16 + fr;
            if (r >= nrows) continue;
#pragma unroll
            for (int ni = 0; ni < NI; ++ni) st_bf4(dst + (size_t)(row0 + r) * D_ + n0 + cb + ni * 16 + 4 * fq, acc[mi][ni]);
        }
    }
};
struct EpiLds {
    float* dst;
    template <int MI, int NI> DI void run(const f32x4 (&acc)[MI][NI], int rb, int cb, int fr, int fq) const {
#pragma unroll
        for (int mi = 0; mi < MI; ++mi)
#pragma unroll
            for (int ni = 0; ni < NI; ++ni) {
                float* d = dst + (rb + mi * 16 + fr) * 65 + cb + ni * 16 + 4 * fq;
                d[0] = acc[mi][ni][0]; d[1] = acc[mi][ni][1]; d[2] = acc[mi][ni][2]; d[3] = acc[mi][ni][3];
            }
    }
};

DI bf16_t* SCR16(const Params& p, size_t off) { return (bf16_t*)(p.ws + OFF_SCR + off); }
DI bf16_t* VFIRST(const Params& p) { return (bf16_t*)(p.ws + OFF_KV); }
DI bf16_t* KBUF(const Params& p) { return (bf16_t*)(p.ws + OFF_KV); }
DI bf16_t* VTBUF(const Params& p) { return (bf16_t*)(p.ws + OFF_KV + SZ_ACT16); }

DI void phase_r1(const Params& p, unsigned char* lds, int l) {
    constexpr int NT = WBIG_ROWS / 256;
    EpiR1 e;
    for (int u = blockIdx.x; u < MT * NT; u += gridDim.x) {
        const int mt = u / NT, nt = u - mt * NT;
        e.m0 = mt * 128; e.n0 = nt * 256;
        if (nt < 4) { e.kind = 0; e.dst = SCR16(p, SCR_R); } else if (nt < 8) { e.kind = 0; e.dst = SCR16(p, SCR_K); }
        else if (nt < 12) { e.kind = 0; e.dst = l == 0 ? VFIRST(p) : SCR16(p, SCR_V); } else { e.kind = 1; e.dst = SCR16(p, SCR_LO1); }
        APlain a; a.base = H16(p) + (size_t)(mt * 128) * D_ - D_; a.ld = D_;
        gemm_tile<128, 256, 64, 64, true>(lds, a, WL_BIG(p) + (size_t)(nt * 256) * 2048, 2048, 2048, e);
    }
}
DI void phase_r2(const Params& p, unsigned char* lds, int l) {
    const int ng = l == 1 ? 4 : 3;
    for (int u = blockIdx.x; u < ng * MT * 4; u += gridDim.x) {
        const int g = u / (MT * 4), r = u - g * (MT * 4), mt = r >> 2, nt = r & 3;
        EpiLora2 e; e.mode = g; e.m0 = mt * 128; e.n0 = nt * 256; e.wdec = (float*)(p.ws + OFF_SCR + SCR_W); e.vfirst = VFIRST(p); e.bias = nullptr; e.dst = nullptr;
        APlain a; a.ld = LO1_W; const bf16_t* lo1 = SCR16(p, SCR_LO1) + (size_t)(mt * 128) * LO1_W;
        const bf16_t* lo2 = WL_LORA2(p);
        if (g == 0) { e.bias = p.in[I_W0] + l * D_; a.base = lo1; gemm_tile<128, 256, 64, 64, true>(lds, a, lo2 + (size_t)(nt * 256) * 64, 64, 64, e); }
        else if (g == 1) { e.bias = p.in[I_A0] + l * D_; e.dst = SCR16(p, SCR_A); a.base = lo1 + 64; gemm_tile<128, 256, 64, 64, true>(lds, a, lo2 + 1024 * 64 + (size_t)(nt * 256) * 64, 64, 64, e); }
        else if (g == 2) { e.dst = SCR16(p, SCR_G); a.base = lo1 + 128; gemm_tile<128, 256, 64, 64, true>(lds, a, lo2 + 2 * 1024 * 64 + (size_t)(nt * 256) * 192, 192, 192, e); }
        else { e.bias = p.in[I_V0]; e.dst = SCR16(p, SCR_V); a.base = lo1 + 320; gemm_tile<128, 256, 64, 64, true>(lds, a, lo2 + 2 * 1024 * 64 + 1024 * 192 + (size_t)(nt * 256) * 64, 64, 64, e); }
    }
}

DI void phase_scan(const Params& p, unsigned char* lds, int l) {
    float* sR = (float*)lds; float* sW = sR + 2048; float* sK = sW + 2048; float* sA = sK + 2048; float* sB = sA + 2048; float* sV = sB + 2048; float* sY = sV + 2048; float* sBon = sY + 2048;
    const int tid = tid_(), lane = tid & 63, wid = tid >> 6, vi = tid >> 3, q = tid & 7;
    const bf16_t* R = SCR16(p, SCR_R); const bf16_t* Kp = SCR16(p, SCR_K); const bf16_t* V = l == 0 ? VFIRST(p) : SCR16(p, SCR_V);
    const bf16_t* A = SCR16(p, SCR_A); const bf16_t* G = SCR16(p, SCR_G); const float* Wd = (const float*)(p.ws + OFF_SCR + SCR_W); bf16_t* Z = SCR16(p, SCR_Z);
    for (int unit = blockIdx.x; unit < NB * 16; unit += gridDim.x) {
        const int b = unit >> 4, h = unit & 15, hc = h * 64 + lane;
        const float c_kk = p.in[I_KK][l * D_ + hc], c_ka = p.in[I_KA][l * D_ + hc], c_rk = p.in[I_RK][l * D_ + hc], c_lg = p.in[I_LNXG][l * D_ + hc], c_lb = p.in[I_LNXB][l * D_ + hc];
        f32x2 S[4];
#pragma unroll
        for (int j = 0; j < 4; ++j) S[j] = (f32x2){0.f, 0.f};
        float pr[4], pk[4], pv[4], pa[4], pw[4];
        const size_t base0 = ((size_t)b * LP) * D_ + hc;
#pragma unroll
        for (int j = 0; j < 4; ++j) { const size_t e = base0 + (size_t)(wid * 4 + j) * D_; pr[j] = bf2f(R[e]); pk[j] = bf2f(Kp[e]); pv[j] = bf2f(V[e]); pa[j] = bf2f(A[e]); pw[j] = __expf(Wd[e]); }
        constexpr int NCH = (LSEQ + 31) / 32;
        for (int ch = 0; ch < NCH; ++ch) {
#pragma unroll
            for (int j = 0; j < 4; ++j) {
                const int tt = wid * 4 + j;
                const float kkr = pk[j] * c_kk;
                const float n2 = wave_sum(kkr * kkr);
                const float kk = kkr / fmaxf(sqrtf(n2), 1e-12f);
                const float k2 = pk[j] * (1.0f + (pa[j] - 1.0f) * c_ka);
                const float bon = wave_sum(pr[j] * k2 * c_rk);
                sR[tt * 64 + lane] = pr[j]; sW[tt * 64 + lane] = pw[j]; sK[tt * 64 + lane] = k2; sA[tt * 64 + lane] = -kk; sB[tt * 64 + lane] = kk * pa[j]; sV[tt * 64 + lane] = pv[j];
                if (lane == 0) sBon[tt] = bon;
            }
            __syncthreads();
            if (ch + 1 < NCH) {
#pragma unroll
                for (int j = 0; j < 4; ++j) { const size_t e = base0 + (size_t)((ch + 1) * 32 + wid * 4 + j) * D_; pr[j] = bf2f(R[e]); pk[j] = bf2f(Kp[e]); pv[j] = bf2f(V[e]); pa[j] = bf2f(A[e]); pw[j] = __expf(Wd[e]); }
            }
#pragma unroll 4
            for (int tt = 0; tt < 32; ++tt) {
                const f32x4 a0 = *(const f32x4*)(sA + tt * 64 + q * 8), a1 = *(const f32x4*)(sA + tt * 64 + q * 8 + 4);
                const f32x4 w0 = *(const f32x4*)(sW + tt * 64 + q * 8), w1 = *(const f32x4*)(sW + tt * 64 + q * 8 + 4);
                const f32x4 b0 = *(const f32x4*)(sB + tt * 64 + q * 8), b1 = *(const f32x4*)(sB + tt * 64 + q * 8 + 4);
                const f32x4 k0 = *(const f32x4*)(sK + tt * 64 + q * 8), k1 = *(const f32x4*)(sK + tt * 64 + q * 8 + 4);
                const f32x4 r0 = *(const f32x4*)(sR + tt * 64 + q * 8), r1 = *(const f32x4*)(sR + tt * 64 + q * 8 + 4);
                const float vv = sV[tt * 64 + vi];
                f32x2 d2 = S[0] * (f32x2){a0[0], a0[1]};
                d2 = S[1] * (f32x2){a0[2], a0[3]} + d2; d2 = S[2] * (f32x2){a1[0], a1[1]} + d2; d2 = S[3] * (f32x2){a1[2], a1[3]} + d2;
                const float sa = red8_sum(d2.x + d2.y);
                const f32x2 sa2 = (f32x2){sa, sa}, v2 = (f32x2){vv, vv};
                S[0] = S[0] * (f32x2){w0[0], w0[1]} + (sa2 * (f32x2){b0[0], b0[1]} + v2 * (f32x2){k0[0], k0[1]});
                S[1] = S[1] * (f32x2){w0[2], w0[3]} + (sa2 * (f32x2){b0[2], b0[3]} + v2 * (f32x2){k0[2], k0[3]});
                S[2] = S[2] * (f32x2){w1[0], w1[1]} + (sa2 * (f32x2){b1[0], b1[1]} + v2 * (f32x2){k1[0], k1[1]});
                S[3] = S[3] * (f32x2){w1[2], w1[3]} + (sa2 * (f32x2){b1[2], b1[3]} + v2 * (f32x2){k1[2], k1[3]});
                f32x2 y2 = S[0] * (f32x2){r0[0], r0[1]};
                y2 = S[1] * (f32x2){r0[2], r0[3]} + y2; y2 = S[2] * (f32x2){r1[0], r1[1]} + y2; y2 = S[3] * (f32x2){r1[2], r1[3]} + y2;
                const float y = red8_sum(y2.x + y2.y);
                if (q == 0) sY[tt * 64 + vi] = y;
            }
            __syncthreads();
#pragma unroll
            for (int j = 0; j < 4; ++j) {
                const int tt = wid * 4 + j;
                const float y = sY[tt * 64 + lane];
                const float mean = wave_sum(y) * (1.0f / 64.0f);
                const float dlt = y - mean;
                const float var = wave_sum(dlt * dlt) * (1.0f / 64.0f);
                const float yn = dlt * rsqrtf(var + 64e-5f) * c_lg + c_lb;
                const size_t e = base0 + (size_t)(ch * 32 + tt) * D_;
                const float g = bf2f(G[e]);
                Z[e] = f2bf((yn + sBon[tt] * sV[tt * 64 + lane]) * g);
            }
            __syncthreads();
        }
    }
}


DI unsigned img_off(int row, int col) { return (unsigned)(row * 128 + ((((col >> 3) ^ ((row >> 1) & 7)) << 4) | ((col & 7) << 1))); }
DI void mm64(const unsigned char* Aimg, const unsigned char* Bimg, int mb, int nh, int fr, int g, f32x4 (&acc)[2]) {
#pragma unroll
    for (int ks = 0; ks < 2; ++ks) {
        const int ch = ((ks * 4 + g) ^ ((fr >> 1) & 7)) << 4;
        const bf16x8 a = *(const bf16x8*)(Aimg + (16 * mb + fr) * 128 + ch);
#pragma unroll
        for (int nbi = 0; nbi < 2; ++nbi) {
            const bf16x8 b = *(const bf16x8*)(Bimg + (16 * (2 * nh + nbi) + fr) * 128 + ch);
            acc[nbi] = __builtin_amdgcn_mfma_f32_16x16x32_bf16(b, a, acc[nbi], 0, 0, 0);
        }
    }
}
DI void st_img4(unsigned char* img, int row, int col4, f32x4 v) { u32x2 w; w.x = cvt_pk_bf16(v[0], v[1]); w.y = cvt_pk_bf16(v[2], v[3]); *(u32x2*)(img + img_off(row, col4)) = w; }
DI f32x4 ld_img4(const unsigned char* img, int row, int col4) { const u32x2 w = *(const u32x2*)(img + img_off(row, col4)); return (f32x4){bflo(w.x), bfhi(w.x), bflo(w.y), bfhi(w.y)}; }
#define ZACC(a) do { a[0] = (f32x4){0.f, 0.f, 0.f, 0.f}; a[1] = (f32x4){0.f, 0.f, 0.f, 0.f}; } while (0)

DI void phase_scanA(const Params& p, unsigned char* lds, int l) {
    const int tid = tid_(), lane = tid & 63, wid = tid >> 6, fr = lane & 15, g = lane >> 4, mb = wid >> 1, nh = wid & 1;
    float* seg = (float*)(lds + 16 * 8192); float* gC = seg + 512;
#define SL(i) (lds + (i) * 8192)
    bf16_t* R = SCR16(p, SCR_R); bf16_t* Kp = SCR16(p, SCR_K); const bf16_t* V = l == 0 ? VFIRST(p) : SCR16(p, SCR_V); bf16_t* A = SCR16(p, SCR_A);
    const float* LW = (const float*)(p.ws + OFF_SCR + SCR_W); float* bonus = (float*)(p.ws + OFF_SCR + SCR_LO1); bf16_t* Qs = SCR16(p, SCR_QS);
    for (int unit = blockIdx.x; unit < NB * 16 * NCHR; unit += gridDim.x) {
        const int c = unit % NCHR, bh = unit / NCHR, b = bh >> 4, h = bh & 15;
        const size_t base = ((size_t)(b * LP + 64 * c)) * D_ + h * 64;
        const int hc = l * D_ + h * 64 + lane;
        const float c_kk = p.in[I_KK][hc], c_ka = p.in[I_KA][hc], c_rk = p.in[I_RK][hc];
        float vr[8], vk2[8], vv[8], vas[8], vbs[8], lwv[8], cum[8];
        float run = 0.f;
#pragma unroll
        for (int j = 0; j < 8; ++j) {
            const int t = 8 * wid + j; const size_t e = base + (size_t)t * D_ + lane;
            const float r = bf2f(R[e]), k = bf2f(Kp[e]), v = bf2f(V[e]), a = bf2f(A[e]), lw = LW[e];
            const float kkr = k * c_kk; const float n2 = wave_sum(kkr * kkr);
            const float kk = kkr / fmaxf(sqrtf(n2), 1e-12f);
            const float k2 = k * (1.0f + (a - 1.0f) * c_ka);
            const float bon = wave_sum(r * k2 * c_rk);
            if (lane == 0) bonus[((size_t)(b * LP + 64 * c + t)) * 16 + h] = bon;
            run += lw; cum[j] = run; lwv[j] = lw; vr[j] = r; vk2[j] = k2; vv[j] = v; vas[j] = -kk; vbs[j] = kk * a;
        }
        seg[wid * 64 + lane] = run;
        __syncthreads();
        float off = 0.f, tot = 0.f;
#pragma unroll
        for (int w2 = 0; w2 < 8; ++w2) { const float sg = seg[w2 * 64 + lane]; off += w2 < wid ? sg : 0.f; tot += sg; }
        if (wid == 0) gC[lane] = __expf(tot);
        {
            float tA[8], tB[8], tK[8];
#pragma unroll
            for (int j = 0; j < 8; ++j) {
                const int t = 8 * wid + j;
                const float cu = cum[j] + off, cp = cu - lwv[j];
                const float ea = __expf(cp), er = __expf(cu), ei = __expf(-cu), eh = __expf(tot - cu);
                const float At = vas[j] * ea, Rt = vr[j] * er, Bt = vbs[j] * ei, Kt = vk2[j] * ei;
                const unsigned o = img_off(t, lane);
                *(bf16_t*)(SL(5) + o) = f2bf(At); *(bf16_t*)(SL(0) + o) = f2bf(Rt); *(bf16_t*)(SL(6) + o) = f2bf(Bt); *(bf16_t*)(SL(7) + o) = f2bf(Kt);
                tA[j] = At; tB[j] = vbs[j] * eh; tK[j] = vk2[j] * eh;
            }
            const unsigned ot = (unsigned)(lane * 128 + ((wid ^ ((lane >> 1) & 7)) << 4));
            u32x4 w;
            w.x = cvt_pk_bf16(tA[0], tA[1]); w.y = cvt_pk_bf16(tA[2], tA[3]); w.z = cvt_pk_bf16(tA[4], tA[5]); w.w = cvt_pk_bf16(tA[6], tA[7]); *(u32x4*)(SL(1) + ot) = w;
            w.x = cvt_pk_bf16(vv[0], vv[1]); w.y = cvt_pk_bf16(vv[2], vv[3]); w.z = cvt_pk_bf16(vv[4], vv[5]); w.w = cvt_pk_bf16(vv[6], vv[7]); *(u32x4*)(SL(2) + ot) = w;
            w.x = cvt_pk_bf16(tB[0], tB[1]); w.y = cvt_pk_bf16(tB[2], tB[3]); w.z = cvt_pk_bf16(tB[4], tB[5]); w.w = cvt_pk_bf16(tB[6], tB[7]); *(u32x4*)(SL(3) + ot) = w;
            w.x = cvt_pk_bf16(tK[0], tK[1]); w.y = cvt_pk_bf16(tK[2], tK[3]); w.z = cvt_pk_bf16(tK[4], tK[5]); w.w = cvt_pk_bf16(tK[6], tK[7]); *(u32x4*)(SL(4) + ot) = w;
        }
        __syncthreads();
        f32x4 acc[2];
        const int row = 16 * mb + fr;
        ZACC(acc); mm64(SL(5), SL(6), mb, nh, fr, g, acc);
#pragma unroll
        for (int nbi = 0; nbi < 2; ++nbi) { const int c0 = 16 * (2 * nh + nbi) + 4 * g; f32x4 m = acc[nbi];
#pragma unroll
            for (int i = 0; i < 4; ++i) m[i] = (c0 + i < row) ? m[i] : 0.f;
            st_img4(SL(8), row, c0, m);
#pragma unroll
            for (int i = 0; i < 4; ++i) m[i] += (c0 + i == row) ? 1.0f : 0.f;
            st_img4(SL(13), row, c0, m); }
        ZACC(acc); mm64(SL(6), SL(5), mb, nh, fr, g, acc);
#pragma unroll
        for (int nbi = 0; nbi < 2; ++nbi) { const int c0 = 16 * (2 * nh + nbi) + 4 * g; f32x4 m = acc[nbi];
#pragma unroll
            for (int i = 0; i < 4; ++i) m[i] = (row < c0 + i) ? m[i] : 0.f;
            st_img4(SL(9), row, c0, m); }
        ZACC(acc); mm64(SL(5), SL(7), mb, nh, fr, g, acc);
#pragma unroll
        for (int nbi = 0; nbi < 2; ++nbi) { const int c0 = 16 * (2 * nh + nbi) + 4 * g; f32x4 m = acc[nbi];
#pragma unroll
            for (int i = 0; i < 4; ++i) m[i] = (c0 + i < row) ? m[i] : 0.f;
            st_img4(SL(10), row, c0, m); }
        ZACC(acc); mm64(SL(0), SL(6), mb, nh, fr, g, acc);
#pragma unroll
        for (int nbi = 0; nbi < 2; ++nbi) { const int c0 = 16 * (2 * nh + nbi) + 4 * g; f32x4 m = acc[nbi];
#pragma unroll
            for (int i = 0; i < 4; ++i) m[i] = (c0 + i <= row) ? m[i] : 0.f;
            st_img4(SL(11), row, c0, m); }
        ZACC(acc); mm64(SL(0), SL(7), mb, nh, fr, g, acc);
#pragma unroll
        for (int nbi = 0; nbi < 2; ++nbi) { const int c0 = 16 * (2 * nh + nbi) + 4 * g; f32x4 m = acc[nbi];
#pragma unroll
            for (int i = 0; i < 4; ++i) m[i] = (c0 + i <= row) ? m[i] : 0.f;
            st_img4(SL(12), row, c0, m); }
        __syncthreads();
#define MMST(dst, Ai, Bi) do { ZACC(acc); mm64(SL(Ai), SL(Bi), mb, nh, fr, g, acc); st_img4(SL(dst), row, 16 * (2 * nh) + 4 * g, acc[0]); st_img4(SL(dst), row, 16 * (2 * nh + 1) + 4 * g, acc[1]); } while (0)
#define MMUPD(dst, Ti, Bi) do { ZACC(acc); mm64(SL(Ti), SL(Bi), mb, nh, fr, g, acc); \
        st_img4(SL(dst), row, 16 * (2 * nh) + 4 * g, acc[0] + ld_img4(SL(Ti), row, 16 * (2 * nh) + 4 * g)); \
        st_img4(SL(dst), row, 16 * (2 * nh + 1) + 4 * g, acc[1] + ld_img4(SL(Ti), row, 16 * (2 * nh + 1) + 4 * g)); } while (0)
        MMST(7, 2, 10); MMST(14, 8, 9); MMST(15, 9, 8);
        __syncthreads();
        MMST(5, 14, 15); MMST(6, 15, 14); MMUPD(8, 13, 15);
        __syncthreads();
        MMST(14, 5, 6); MMST(15, 6, 5); MMUPD(9, 8, 6);
        __syncthreads();
        MMST(5, 14, 15); MMST(6, 15, 14); MMUPD(8, 9, 15);
        __syncthreads();
        MMST(15, 6, 5); MMUPD(9, 8, 6);
        __syncthreads();
        MMUPD(8, 9, 15);
        __syncthreads();
        MMST(5, 1, 8); MMST(6, 7, 8);
        __syncthreads();
        ZACC(acc); mm64(SL(11), SL(5), mb, nh, fr, g, acc);
#pragma unroll
        for (int nbi = 0; nbi < 2; ++nbi) { const int c0 = 16 * (2 * nh + nbi) + 4 * g; st_bf4(R + base + (size_t)row * D_ + c0, acc[nbi] + ld_img4(SL(0), row, c0)); }
        ZACC(acc); mm64(SL(11), SL(6), mb, nh, fr, g, acc); mm64(SL(12), SL(2), mb, nh, fr, g, acc);
#pragma unroll
        for (int nbi = 0; nbi < 2; ++nbi) { const int c0 = 16 * (2 * nh + nbi) + 4 * g; st_bf4(Kp + base + (size_t)row * D_ + c0, acc[nbi]); }
        ZACC(acc); mm64(SL(3), SL(5), mb, nh, fr, g, acc);
#pragma unroll
        for (int nbi = 0; nbi < 2; ++nbi) { const int c0 = 16 * (2 * nh + nbi) + 4 * g; f32x4 m = acc[nbi];
#pragma unroll
            for (int i = 0; i < 4; ++i) m[i] += (c0 + i == row) ? gC[row] : 0.f;
            st_bf4(A + base + (size_t)row * D_ + c0, m); }
        ZACC(acc); mm64(SL(6), SL(3), mb, nh, fr, g, acc); mm64(SL(2), SL(4), mb, nh, fr, g, acc);
#pragma unroll
        for (int nbi = 0; nbi < 2; ++nbi) { const int c0 = 16 * (2 * nh + nbi) + 4 * g; st_bf4(Qs + (size_t)unit * 4096 + row * 64 + c0, acc[nbi]); }
        __syncthreads();
    }
#undef SL
}

DI void phase_scanB(const Params& p, int l) {
    const int tid = tid_(), lane = tid & 63, wid = tid >> 6, fr = lane & 15, g = lane >> 4;
    if (wid >= 4) return;
    const bf16_t* A = SCR16(p, SCR_A); const bf16_t* Qs = SCR16(p, SCR_QS); bf16_t* SC = SCR16(p, SCR_W);
    for (int unit = blockIdx.x; unit < NB * 16; unit += gridDim.x) {
        const int b = unit >> 4, h = unit & 15, v = 16 * wid + fr;
        f32x4 X[4];
#pragma unroll
        for (int kb = 0; kb < 4; ++kb) X[kb] = (f32x4){0.f, 0.f, 0.f, 0.f};
        u32x2 pa[4][2][2], pq[4];
        {
            const size_t abase = ((size_t)(b * LP)) * D_ + h * 64; const size_t qb = (size_t)(unit * NCHR) * 4096 + v * 64;
#pragma unroll
            for (int kb = 0; kb < 4; ++kb) {
                pq[kb] = *(const u32x2*)(Qs + qb + 16 * kb + 4 * g);
#pragma unroll
                for (int ks = 0; ks < 2; ++ks) { const bf16_t* ap = A + abase + (size_t)(16 * kb + fr) * D_ + 32 * ks + 4 * g; pa[kb][ks][0] = *(const u32x2*)ap; pa[kb][ks][1] = *(const u32x2*)(ap + 16); }
            }
        }
        for (int c = 0; c < NCHR; ++c) {
            const size_t ch = (size_t)(unit * NCHR + c);
            u32x2 ca[4][2][2], cq[4];
#pragma unroll
            for (int kb = 0; kb < 4; ++kb) { cq[kb] = pq[kb];
#pragma unroll
                for (int ks = 0; ks < 2; ++ks) { ca[kb][ks][0] = pa[kb][ks][0]; ca[kb][ks][1] = pa[kb][ks][1]; } }
            if (c + 1 < NCHR) {
                const size_t abase = ((size_t)(b * LP + 64 * (c + 1))) * D_ + h * 64; const size_t qb = (ch + 1) * 4096 + v * 64;
#pragma unroll
                for (int kb = 0; kb < 4; ++kb) {
                    pq[kb] = *(const u32x2*)(Qs + qb + 16 * kb + 4 * g);
#pragma unroll
                    for (int ks = 0; ks < 2; ++ks) { const bf16_t* ap = A + abase + (size_t)(16 * kb + fr) * D_ + 32 * ks + 4 * g; pa[kb][ks][0] = *(const u32x2*)ap; pa[kb][ks][1] = *(const u32x2*)(ap + 16); }
                }
            }
#pragma unroll
            for (int kb = 0; kb < 4; ++kb) st_bf4(SC + ch * 4096 + v * 64 + 16 * kb + 4 * g, X[kb]);
            bf16x8 xp[2];
#pragma unroll
            for (int ks = 0; ks < 2; ++ks) {
                u32x4 w; w.x = cvt_pk_bf16(X[2 * ks][0], X[2 * ks][1]); w.y = cvt_pk_bf16(X[2 * ks][2], X[2 * ks][3]);
                w.z = cvt_pk_bf16(X[2 * ks + 1][0], X[2 * ks + 1][1]); w.w = cvt_pk_bf16(X[2 * ks + 1][2], X[2 * ks + 1][3]);
                xp[ks] = __builtin_bit_cast(bf16x8, w);
            }
#pragma unroll
            for (int kb = 0; kb < 4; ++kb) {
                f32x4 acc = (f32x4){bflo(cq[kb].x), bfhi(cq[kb].x), bflo(cq[kb].y), bfhi(cq[kb].y)};
#pragma unroll
                for (int ks = 0; ks < 2; ++ks) {
                    const bf16x8 af = __builtin_bit_cast(bf16x8, (u32x4){ca[kb][ks][0].x, ca[kb][ks][0].y, ca[kb][ks][1].x, ca[kb][ks][1].y});
                    acc = __builtin_amdgcn_mfma_f32_16x16x32_bf16(af, xp[ks], acc, 0, 0, 0);
                }
                X[kb] = acc;
            }
        }
    }
}

DI void phase_scanC(const Params& p, unsigned char* lds, int l) {
    const int tid = tid_(), lane = tid & 63, wid = tid >> 6, fr = lane & 15, g = lane >> 4, mb = wid >> 1, nh = wid & 1;
    float* Yl = (float*)(lds + 16384);
    const bf16_t* R = SCR16(p, SCR_R); const bf16_t* Kp = SCR16(p, SCR_K); const bf16_t* V = l == 0 ? VFIRST(p) : SCR16(p, SCR_V);
    const bf16_t* G = SCR16(p, SCR_G); const bf16_t* SC = SCR16(p, SCR_W); const float* bonus = (const float*)(p.ws + OFF_SCR + SCR_LO1); bf16_t* Z = SCR16(p, SCR_Z);
    for (int unit = blockIdx.x; unit < NB * 16 * NCHR; unit += gridDim.x) {
        const int c = unit % NCHR, bh = unit / NCHR, b = bh >> 4, h = bh & 15;
        const size_t base = ((size_t)(b * LP + 64 * c)) * D_ + h * 64;
        const int hc = l * D_ + h * 64 + lane;
        const float c_lg = p.in[I_LNXG][hc], c_lb = p.in[I_LNXB][hc];
        {
            const int row = tid >> 3, c8 = tid & 7;
            const u32x4 rp = *(const u32x4*)(R + base + (size_t)row * D_ + c8 * 8);
            const u32x4 sc = *(const u32x4*)(SC + (size_t)unit * 4096 + row * 64 + c8 * 8);
            const unsigned o = (unsigned)(row * 128 + ((c8 ^ ((row >> 1) & 7)) << 4));
            *(u32x4*)(lds + o) = rp; *(u32x4*)(lds + 8192 + o) = sc;
        }
        __syncthreads();
        f32x4 acc[2]; ZACC(acc);
        mm64(lds, lds + 8192, mb, nh, fr, g, acc);
        const int row = 16 * mb + fr;
#pragma unroll
        for (int nbi = 0; nbi < 2; ++nbi) {
            const int c0 = 16 * (2 * nh + nbi) + 4 * g;
            const u32x2 y0 = *(const u32x2*)(Kp + base + (size_t)row * D_ + c0);
            float* d = Yl + row * 65 + c0;
            d[0] = acc[nbi][0] + bflo(y0.x); d[1] = acc[nbi][1] + bfhi(y0.x); d[2] = acc[nbi][2] + bflo(y0.y); d[3] = acc[nbi][3] + bfhi(y0.y);
        }
        __syncthreads();
#pragma unroll
        for (int j = 0; j < 8; ++j) {
            const int t = 8 * wid + j;
            const float y = Yl[t * 65 + lane];
            const float mean = wave_sum(y) * (1.0f / 64.0f);
            const float dlt = y - mean;
            const float var = wave_sum(dlt * dlt) * (1.0f / 64.0f);
            const float yn = dlt * rsqrtf(var + 64e-5f) * c_lg + c_lb;
            const size_t e = base + (size_t)t * D_ + lane;
            const float bon = bonus[((size_t)(b * LP + 64 * c + t)) * 16 + h];
            Z[e] = f2bf((yn + bon * bf2f(V[e])) * bf2f(G[e]));
        }
        __syncthreads();
    }
}

DI void phase_outproj(const Params& p, unsigned char* lds) {
    EpiResid e; e.out = p.out; e.ws = p.ws;
    for (int u = blockIdx.x; u < MT * 4; u += gridDim.x) {
        const int mt = u >> 2, nt = u & 3;
        e.m0 = mt * 128; e.n0 = nt * 256;
        APlain a; a.base = SCR16(p, SCR_Z) + (size_t)(mt * 128) * D_; a.ld = D_;
        gemm_tile<128, 256, 64, 64, true>(lds, a, WL_OUT(p) + (size_t)(nt * 256) * D_, D_, D_, e);
    }
}

template <bool COMBINE>
DI void phase_ln(const Params& p, const float* gam, const float* bet) {
    const int tid0 = tid_(); const int lane = tid0 & 63, wid = tid0 >> 6;
    bf16_t* h16 = H16(p);
    const int* tok_slot = (const int*)(p.ws + OFF_TAB) + 2 * NSLOT;
    const bf16_t* Y = SCR16(p, SCR_Y);
    const int c0 = lane * 16;
    f32x4 g4[4], b4[4];
#pragma unroll
    for (int i = 0; i < 4; ++i) { g4[i] = *(const f32x4*)(gam + c0 + 4 * i); b4[i] = *(const f32x4*)(bet + c0 + 4 * i); }
    for (int n = blockIdx.x * 8 + wid; n < NTOK; n += gridDim.x * 8) {
        const int b = n >= LSEQ ? 1 : 0, t = n - b * LSEQ, prow = b * LP + t;
        float* hr = h32row(p, prow);
        f32x4 x[4];
#pragma unroll
        for (int i = 0; i < 4; ++i) x[i] = *(const f32x4*)(hr + c0 + 4 * i);
        if (COMBINE) {
#pragma unroll
            for (int i = 0; i < 4; ++i) x[i] = x[i] * DN_ALPHA;
#pragma unroll
            for (int k = 0; k < 9; ++k) {
                const bf16_t* src = k == 8 ? h16 + (size_t)prow * D_ : Y + (size_t)tok_slot[n * 8 + k] * D_;
                const u32x4 w0 = *(const u32x4*)(src + c0), w1 = *(const u32x4*)(src + c0 + 8);
                x[0][0] += bflo(w0.x); x[0][1] += bfhi(w0.x); x[0][2] += bflo(w0.y); x[0][3] += bfhi(w0.y);
                x[1][0] += bflo(w0.z); x[1][1] += bfhi(w0.z); x[1][2] += bflo(w0.w); x[1][3] += bfhi(w0.w);
                x[2][0] += bflo(w1.x); x[2][1] += bfhi(w1.x); x[2][2] += bflo(w1.y); x[2][3] += bfhi(w1.y);
                x[3][0] += bflo(w1.z); x[3][1] += bfhi(w1.z); x[3][2] += bflo(w1.w); x[3][3] += bfhi(w1.w);
            }
        }
        float s = 0.f;
#pragma unroll
        for (int i = 0; i < 4; ++i) s += (x[i][0] + x[i][1]) + (x[i][2] + x[i][3]);
        const float mean = wave_sum(s) * (1.0f / 1024.0f);
        float qv = 0.f;
#pragma unroll
        for (int i = 0; i < 4; ++i) { const f32x4 d = x[i] - mean; qv += (d[0] * d[0] + d[1] * d[1]) + (d[2] * d[2] + d[3] * d[3]); }
        const float rstd = rsqrtf(wave_sum(qv) * (1.0f / 1024.0f) + LN_EPS);
        u32x4 o0, o1;
#pragma unroll
        for (int i = 0; i < 4; ++i) { x[i] = (x[i] - mean) * rstd * g4[i] + b4[i]; *(f32x4*)(hr + c0 + 4 * i) = x[i]; }
        o0.x = cvt_pk_bf16(x[0][0], x[0][1]); o0.y = cvt_pk_bf16(x[0][2], x[0][3]); o0.z = cvt_pk_bf16(x[1][0], x[1][1]); o0.w = cvt_pk_bf16(x[1][2], x[1][3]);
        o1.x = cvt_pk_bf16(x[2][0], x[2][1]); o1.y = cvt_pk_bf16(x[2][2], x[2][3]); o1.z = cvt_pk_bf16(x[3][0], x[3][1]); o1.w = cvt_pk_bf16(x[3][2], x[3][3]);
        *(u32x4*)(h16 + (size_t)prow * D_ + c0) = o0; *(u32x4*)(h16 + (size_t)prow * D_ + c0 + 8) = o1;
    }
}

DI void phase_qkv(const Params& p, unsigned char* lds, int l) {
    const int nq = MT * 4, nk = l == 2 ? MT * 4 : 0, nv = nk;
    for (int u = blockIdx.x; u < nq + nk + nv; u += gridDim.x) {
        if (u < nq + nk) {
            const bool isq = u < nq; const int r = isq ? u : u - nq, mt = r >> 2, nt = r & 3;
            EpiQK e; e.m0 = mt * 128; e.n0 = nt * 256; e.dst = isq ? SCR16(p, 0) : KBUF(p); e.scale = isq ? 0.125f * 1.4426950408889634f : 1.0f;
            APlain a; a.base = H16(p) + (size_t)(mt * 128) * D_; a.ld = D_;
            const bf16_t* B = isq ? WL_WQ(p) + (size_t)(nt * 256) * D_ : WL_BIG(p) + (size_t)(nt * 256) * D_;
            gemm_tile<128, 256, 64, 64, true>(lds, a, B, D_, D_, e);
        } else {
            const int r = u - nq - nk, mt = r >> 2, nt = r & 3;
            EpiVt e; e.m0 = mt * 128; e.n0 = nt * 256; e.dst = VTBUF(p);
            APlain a; a.base = H16(p) + (size_t)(mt * 128) * D_; a.ld = D_;
            gemm_tile<128, 256, 64, 64, false>(lds, a, WL_BIG(p) + (size_t)(1024 + nt * 256) * D_, D_, D_, e);
        }
    }
}

DI int crow32(int i, int h) { return (i & 3) + 8 * (i >> 2) + 4 * h; }

DI void phase_attn(const Params& p, unsigned char* lds, int j, int rep = 0) {
    const int tid = tid_(), lane = tid & 63, wid = tid >> 6, cmap = wid >> 2, rg = wid & 3, ql = lane & 31, hh = lane >> 5;
    const float lam_init = j == 0 ? (float)(0.8 - 0.6 * 0.5488116360940264) : (float)(0.8 - 0.6 * 0.4065696597405991);
    float d1 = 0.f, d2 = 0.f;
    for (int i = 0; i < 64; ++i) { d1 += p.in[I_LQ1][j * 64 + i] * p.in[I_LK1][j * 64 + i]; d2 += p.in[I_LQ2][j * 64 + i] * p.in[I_LK2][j * 64 + i]; }
    const float lam = __expf(d1) - __expf(d2) + lam_init;
    const float post = 1.0f - lam_init;
    const bf16_t* Q = SCR16(p, 0); const bf16_t* Kb = KBUF(p); const bf16_t* Vt = VTBUF(p); bf16_t* Z = SCR16(p, SCR_Z);
    const float* subg = p.in[I_SUBG] + j * 128;
    unsigned* ctr = CTRL(p) + CT_ATTNQ + 64 * (j + 2 * rep);
    constexpr int STG = 32768;
    unsigned* s_u = (unsigned*)(lds + 2 * STG);
    constexpr int NQB = LP / 128;
    const int total = NB * 8 * NQB;
    const int krow = tid >> 3, kc8 = tid & 7;
    const unsigned koff = krow * 128 + ((kc8 ^ ((krow >> 1) & 7)) << 4);
    for (;;) {
        if (tid == 0) *s_u = atomicAdd(ctr, 1u);
        __syncthreads();
        const int u = (int)*s_u;
        __syncthreads();
        if (u >= total) break;
        const int qb = NQB - 1 - u / 16, bh = u & 15, b = bh >> 3, head = bh & 7;
        const int q0 = qb * 128 + rg * 32;
        bf16x8 qf[4];
        {
            const bf16_t* qp = Q + (((size_t)(b * 16 + head * 2 + cmap)) * LP + q0 + ql) * 64 + 8 * hh;
#pragma unroll
            for (int s = 0; s < 4; ++s) qf[s] = *(const bf16x8*)(qp + 16 * s);
        }
        const bf16_t* k0p = Kb + (((size_t)(b * 16 + head * 2 + 0)) * LP) * 64 + krow * 64 + kc8 * 8;
        const bf16_t* k1p = Kb + (((size_t)(b * 16 + head * 2 + 1)) * LP) * 64 + krow * 64 + kc8 * 8;
        const bf16_t* vp0 = Vt + ((size_t)(b * 1024 + head * 128 + krow)) * LP + kc8 * 8;
        const bf16_t* vp1 = vp0 + (size_t)64 * LP;
        const int ntile = 2 * qb + 2;
        f32x16 O[4];
#pragma unroll
        for (int i = 0; i < 4; ++i)
#pragma unroll
            for (int r = 0; r < 16; ++r) O[i][r] = 0.f;
        float m_run = -1e30f, l_run = 0.f;
        u32x4 rk0, rk1, rv0, rv1;
        rk0 = *(const u32x4*)(k0p); rk1 = *(const u32x4*)(k1p); rv0 = *(const u32x4*)(vp0); rv1 = *(const u32x4*)(vp1);
        auto stage_write = [&](unsigned char* st) {
            *(u32x4*)(st + koff) = rk0; *(u32x4*)(st + 8192 + koff) = rk1;
            {
                const int r0 = krow, r1 = krow + 64;
                const int s0 = (r0 >> 1) & 15, s1 = (r1 >> 1) & 15;
                unsigned char* vb = st + 16384;
                *(u32x2*)(vb + r0 * 128 + (((2 * kc8) ^ s0) << 3)) = (u32x2){rv0.x, rv0.y};
                *(u32x2*)(vb + r0 * 128 + (((2 * kc8 + 1) ^ s0) << 3)) = (u32x2){rv0.z, rv0.w};
                *(u32x2*)(vb + r1 * 128 + (((2 * kc8) ^ s1) << 3)) = (u32x2){rv1.x, rv1.y};
                *(u32x2*)(vb + r1 * 128 + (((2 * kc8 + 1) ^ s1) << 3)) = (u32x2){rv1.z, rv1.w};
            }
        };
        stage_write(lds);
        __syncthreads();
        for (int kt = 0; kt < ntile; ++kt) {
            const unsigned char* cur = lds + (kt & 1) * STG;
            const bool more = kt + 1 < ntile;
            if (more) {
                const size_t ko = (size_t)(kt + 1) * 64 * 64, vo = (size_t)(kt + 1) * 64;
                rk0 = *(const u32x4*)(k0p + ko); rk1 = *(const u32x4*)(k1p + ko); rv0 = *(const u32x4*)(vp0 + vo); rv1 = *(const u32x4*)(vp1 + vo);
            }
            const int key0 = kt * 64;
            if (key0 <= q0 + 31) {
                const unsigned char* kst = cur + cmap * 8192;
                f32x16 sc[2];
#pragma unroll
                for (int kb = 0; kb < 2; ++kb) {
#pragma unroll
                    for (int r = 0; r < 16; ++r) sc[kb][r] = 0.f;
                    const int row = kb * 32 + ql;
#pragma unroll
                    for (int s = 0; s < 4; ++s) {
                        const bf16x8 kf = *(const bf16x8*)(kst + row * 128 + (((2 * s + hh) ^ ((row >> 1) & 7)) << 4));
                        sc[kb] = __builtin_amdgcn_mfma_f32_32x32x16_bf16(kf, qf[s], sc[kb], 0, 0, 0);
                    }
                }
                if (key0 + 63 > q0) {
                    const int qq = q0 + ql;
#pragma unroll
                    for (int kb = 0; kb < 2; ++kb)
#pragma unroll
                        for (int r = 0; r < 16; ++r) { const int key = key0 + kb * 32 + crow32(r, hh); if (key > qq) sc[kb][r] = -INFINITY; }
                }
                float mx = sc[0][0];
#pragma unroll
                for (int kb = 0; kb < 2; ++kb)
#pragma unroll
                    for (int r = 0; r < 16; ++r) mx = fmaxf(mx, sc[kb][r]);
                mx = fmaxf(mx, __shfl_xor(mx, 32));
                const float m_new = fmaxf(m_run, mx);
                const float alpha = __builtin_amdgcn_exp2f(m_run - m_new);
                m_run = m_new;
                float ps = 0.f;
#pragma unroll
                for (int kb = 0; kb < 2; ++kb)
#pragma unroll
                    for (int r = 0; r < 16; ++r) { const float e = __builtin_amdgcn_exp2f(sc[kb][r] - m_new); sc[kb][r] = e; ps += e; }
                l_run = l_run * alpha + ps;
#pragma unroll
                for (int i = 0; i < 4; ++i)
#pragma unroll
                    for (int r = 0; r < 16; ++r) O[i][r] *= alpha;
                const unsigned char* vst = cur + 16384;
#pragma unroll
                for (int s = 0; s < 4; ++s) {
                    const int kb = s >> 1, r0 = 8 * (s & 1);
                    u32x4 pw;
                    pw.x = cvt_pk_bf16(sc[kb][r0 + 0], sc[kb][r0 + 1]); pw.y = cvt_pk_bf16(sc[kb][r0 + 2], sc[kb][r0 + 3]);
                    pw.z = cvt_pk_bf16(sc[kb][r0 + 4], sc[kb][r0 + 5]); pw.w = cvt_pk_bf16(sc[kb][r0 + 6], sc[kb][r0 + 7]);
                    const bf16x8 pf = __builtin_bit_cast(bf16x8, pw);
#pragma unroll
                    for (int dvb = 0; dvb < 4; ++dvb) {
                        const int row = dvb * 32 + ql, sw = (row >> 1) & 15;
                        const u32x2 lo = *(const u32x2*)(vst + row * 128 + (((4 * s + hh) ^ sw) << 3));
                        const u32x2 hi = *(const u32x2*)(vst + row * 128 + (((4 * s + 2 + hh) ^ sw) << 3));
                        const bf16x8 vf = __builtin_bit_cast(bf16x8, (u32x4){lo.x, lo.y, hi.x, hi.y});
                        O[dvb] = __builtin_amdgcn_mfma_f32_32x32x16_bf16(vf, pf, O[dvb], 0, 0, 0);
                    }
                }
            }
            if (more) stage_write(lds + ((kt + 1) & 1) * STG);
            __syncthreads();
        }
        const float l_tot = l_run + __shfl_xor(l_run, 32);
        const float inv = 1.0f / l_tot;
        float* xb = (float*)lds + rg * 4096;
        if (cmap == 1) {
            const float sc1 = lam * inv;
#pragma unroll
            for (int i = 0; i < 4; ++i)
#pragma unroll
                for (int r = 0; r < 16; ++r) xb[(i * 16 + r) * 64 + lane] = O[i][r] * sc1;
        }
        __syncthreads();
        if (cmap == 0) {
            float ss = 0.f;
#pragma unroll
            for (int i = 0; i < 4; ++i)
#pragma unroll
                for (int r = 0; r < 16; ++r) { const float o = O[i][r] * inv - xb[(i * 16 + r) * 64 + lane]; O[i][r] = o; ss += o * o; }
            ss += __shfl_xor(ss, 32);
            const float rn = rsqrtf(ss * (1.0f / 128.0f) + 1e-5f) * post;
            bf16_t* zp = Z + ((size_t)(b * LP + q0 + ql)) * D_ + head * 128;
#pragma unroll
            for (int i = 0; i < 4; ++i)
#pragma unroll
                for (int g = 0; g < 4; ++g) {
                    const int dv = i * 32 + 8 * g + 4 * hh;
                    const f32x4 sg = *(const f32x4*)(subg + dv);
                    f32x4 o; o[0] = O[i][4 * g + 0] * rn * sg[0]; o[1] = O[i][4 * g + 1] * rn * sg[1]; o[2] = O[i][4 * g + 2] * rn * sg[2]; o[3] = O[i][4 * g + 3] * rn * sg[3];
                    st_bf4(zp + dv, o);
                }
        }
        __syncthreads();
    }
}

DI int* TAB_IDX(const Params& p) { return (int*)(p.ws + OFF_TAB); }
DI float* TAB_GATE(const Params& p) { return (float*)(p.ws + OFF_TAB) + NSLOT; }
DI int* TAB_TOKSLOT(const Params& p) { return (int*)(p.ws + OFF_TAB) + 2 * NSLOT; }
DI int* TAB_SLOTTOK(const Params& p) { return (int*)(p.ws + OFF_TAB) + 3 * NSLOT; }
DI float* TAB_SLOTGATE(const Params& p) { return (float*)(p.ws + OFF_TAB) + 4 * NSLOT; }
DI int* TAB_TILES(const Params& p) { return (int*)(p.ws + OFF_TAB) + 5 * NSLOT; }

DI void phase_router(const Params& p, unsigned char* lds, int l) {
    float* lg = (float*)(lds + 2 * (128 + 64) * 128);
    unsigned* hist = (unsigned*)(lds + 2 * (128 + 64) * 128 + 128 * 65 * 4);
    const int tid = tid_(), lane = tid & 63, wid = tid >> 6;
    if (tid < 64) hist[tid] = 0u;
    __syncthreads();
    const float bias = p.in[I_RTB][l * NE + lane];
    int* idx = TAB_IDX(p); float* gt = TAB_GATE(p);
    for (int mt = blockIdx.x; mt < MT; mt += gridDim.x) {
        EpiLds e; e.dst = lg;
        APlain a; a.base = H16(p) + (size_t)(mt * 128) * D_; a.ld = D_;
        gemm_tile<128, 64, 16, 64, true>(lds, a, WS_RT(p), D_, D_, e);
        __syncthreads();
        for (int rr = 0; rr < 16; ++rr) {
            const int prow = mt * 128 + wid * 16 + rr;
            const int b = prow >= LP ? 1 : 0, t = prow - b * LP;
            if (t >= LSEQ) continue;
            const int n = b * LSEQ + t;
            const float s = sigmoidf_(lg[(wid * 16 + rr) * 65 + lane]);
            const float sel = s + bias;
            const float m1 = red8_max(sel);
            const unsigned long long eq = __ballot(sel == m1);
            const unsigned gb = (unsigned)(eq >> ((lane >> 3) * 8)) & 0xffu;
            const int first = __builtin_ctz(gb | 0x100u);
            const float sel2 = (lane & 7) == first ? -INFINITY : sel;
            const float gs = m1 + red8_max(sel2);
            int rank = 0;
#pragma unroll
            for (int g = 0; g < 8; ++g) { const float o = rdlane(gs, g * 8); rank += (o > gs || (o == gs && g < (lane >> 3))) ? 1 : 0; }
            float cur = rank < 4 ? sel : -INFINITY;
            float wsum = 0.f, my_s = 0.f; int my_i = 0;
#pragma unroll
            for (int k = 0; k < 8; ++k) {
                const float m = wave_max(cur);
                const unsigned long long bal = __ballot(cur == m);
                const int win = __builtin_ctzll(bal | (1ull << 63));
                const float swv = rdlane(s, win);
                wsum += swv;
                if (lane == k) { my_i = win; my_s = swv; }
                if (lane == win) cur = -INFINITY;
            }
            if (lane < 8) {
                idx[n * 8 + lane] = my_i; gt[n * 8 + lane] = my_s / wsum * 2.5f;
                atomicAdd(hist + my_i, 1u);
            }
        }
        __syncthreads();
    }
    __syncthreads();
    if (tid < 64 && hist[tid]) atomicAdd(CTRL(p) + CT_CNT + 64 * l + tid, (unsigned)hist[tid]);
}

DI void phase_scatter(const Params& p, unsigned char* lds, int l) {
    unsigned* cnt = (unsigned*)lds; unsigned* lh = cnt + 64; unsigned* lbase = lh + 64; unsigned* lcur = lbase + 64; unsigned* start = lcur + 64;
    const int tid = tid_();
    unsigned* gc = CTRL(p) + CT_CNT + 64 * l; unsigned* gcur = CTRL(p) + CT_CUR + 64 * l;
    if (tid < 64) { cnt[tid] = __hip_atomic_load(gc + tid, __ATOMIC_RELAXED, __HIP_MEMORY_SCOPE_AGENT); lh[tid] = 0u; lcur[tid] = 0u; }
    __syncthreads();
    if (tid < 64) { unsigned s = 0; for (int e = 0; e < tid; ++e) s += cnt[e]; start[tid] = s; }
    const int per = (NTOK + gridDim.x - 1) / gridDim.x;
    const int n0 = blockIdx.x * per, n1 = n0 + per < NTOK ? n0 + per : NTOK;
    const int* idx = TAB_IDX(p); const float* gt = TAB_GATE(p);
    int* tok_slot = TAB_TOKSLOT(p); int* slot_tok = TAB_SLOTTOK(p); float* slot_gate = TAB_SLOTGATE(p);
    __syncthreads();
    for (int i = n0 * 8 + tid; i < n1 * 8; i += NTHR) atomicAdd(lh + idx[i], 1u);
    __syncthreads();
    if (tid < 64) lbase[tid] = start[tid] + (lh[tid] ? atomicAdd(gcur + tid, (unsigned)lh[tid]) : 0u);
    __syncthreads();
    for (int i = n0 * 8 + tid; i < n1 * 8; i += NTHR) {
        const int e = idx[i], n = i >> 3;
        const unsigned pos = lbase[e] + atomicAdd(lcur + e, 1u);
        const int b = n >= LSEQ ? 1 : 0, t = n - b * LSEQ;
        slot_tok[pos] = b * LP + t; slot_gate[pos] = gt[i]; tok_slot[i] = (int)pos;
    }
    if (blockIdx.x == 0 && tid < 64) {
        unsigned tb = 0; for (int e = 0; e < tid; ++e) tb += (cnt[e] + 127) >> 7;
        const unsigned nt = (cnt[tid] + 127) >> 7;
        int* tiles = TAB_TILES(p);
        for (unsigned i = 0; i < nt; ++i) { int* tp = tiles + (tb + i) * 4; tp[0] = tid; tp[1] = (int)(start[tid] + 128 * i); const int rem = (int)cnt[tid] - 128 * (int)i; tp[2] = rem < 128 ? rem : 128; tp[3] = 0; }
        if (tid == 63) CTRL(p)[CT_NT + l] = tb + nt;
    }
}

DI void phase_m1(const Params& p, unsigned char* lds, int l) {
    const int T = (int)CTRL(p)[CT_NT + l];
    const int* tiles = TAB_TILES(p);
    for (int u = blockIdx.x; u < (T + MT) * 2; u += gridDim.x) {
        const int tile = u >> 1, half = u & 1;
        EpiM1 e; e.n0 = half * 256;
        if (tile < T) {
            const int ex = tiles[tile * 4], s0 = tiles[tile * 4 + 1], nr = tiles[tile * 4 + 2];
            e.dst = SCR16(p, SCR_H); e.gate = TAB_SLOTGATE(p); e.row0 = s0; e.nrows = nr;
            AGather a; a.base = H16(p); a.rows = TAB_SLOTTOK(p) + s0; a.nrows = nr;
            gemm_tile<128, 256, 64, 64, true>(lds, a, WM_GU(p) + ((size_t)ex * 512 + half * 256) * D_, D_, D_, e);
        } else {
            const int mt = tile - T;
            e.dst = SCR16(p, SCR_HS); e.gate = nullptr; e.row0 = mt * 128; e.nrows = 128;
            APlain a; a.base = H16(p) + (size_t)(mt * 128) * D_; a.ld = D_;
            gemm_tile<128, 256, 64, 64, true>(lds, a, WS_GU(p) + (size_t)(half * 256) * D_, D_, D_, e);
        }
    }
}
DI void phase_m2(const Params& p, unsigned char* lds, int l) {
    const int T = (int)CTRL(p)[CT_NT + l];
    const int* tiles = TAB_TILES(p);
    for (int u = blockIdx.x; u < (T + MT) * 4; u += gridDim.x) {
        const int tile = u >> 2, nq = u & 3;
        EpiM2 e; e.n0 = nq * 256;
        if (tile < T) {
            const int ex = tiles[tile * 4], s0 = tiles[tile * 4 + 1], nr = tiles[tile * 4 + 2];
            e.dst = SCR16(p, SCR_Y); e.row0 = s0; e.nrows = nr;
            int last = NSLOT - 1 - s0; if (last > 127) last = 127;
            AClamp a;
            a.base = SCR16(p, SCR_H) + (size_t)s0 * FF; a.last = last;
            gemm_tile<128, 256, 64, 64, true>(lds, a, WM_DN(p) + ((size_t)ex * 1024 + nq * 256) * FF, FF, FF, e);
        } else {
            const int mt = tile - T;
            e.dst = H16(p); e.row0 = mt * 128; e.nrows = 128;
            APlain a; a.base = SCR16(p, SCR_HS) + (size_t)(mt * 128) * FF; a.ld = FF;
            gemm_tile<128, 256, 64, 64, true>(lds, a, WS_DN(p) + (size_t)(nq * 256) * FF, FF, FF, e);
        }
    }
}

__global__ void __launch_bounds__(NTHR, 2) mega(Params p) {
    extern __shared__ __attribute__((aligned(16))) unsigned char lds[];
    LAS unsigned* xbw = (LAS unsigned*)(lds + LDS_BAR);
    if (threadIdx.x == 0) { xbw[0] = 0u; xbw[1] = 0u; xbw[2] = 0u; xbw[3] = 0u; }
    __syncthreads();
    XcdBarrier bar = xcd_barrier_post(CTRL(p), (volatile LAS unsigned*)xbw);
    phase_init(p);
    phase_weights(p, lds, 0);
    xcd_barrier(bar);
    for (int l = 0; l < 4; ++l) {
        if (l < 2) {
            phase_r1(p, lds, l); xcd_barrier(bar);
            phase_r2(p, lds, l); xcd_barrier(bar);
#ifdef SCAN_SEQ
            phase_scan(p, lds, l); xcd_barrier(bar);
#else
            phase_scanA(p, lds, l); xcd_barrier(bar);
            phase_scanB(p, l); xcd_barrier(bar);
            phase_scanC(p, lds, l); xcd_barrier(bar);
#endif
        } else {
            phase_qkv(p, lds, l); xcd_barrier(bar);
            phase_attn(p, lds, l - 2); xcd_barrier(bar);
#ifdef REP_ATTN
            phase_attn(p, lds, l - 2, 1); xcd_barrier(bar);
#endif
        }
        phase_outproj(p, lds); xcd_barrier(bar);
        phase_ln<false>(p, p.in[I_LNMG] + l * D_, p.in[I_LNMB] + l * D_); xcd_barrier(bar);
        phase_router(p, lds, l); xcd_barrier(bar);
        phase_scatter(p, lds, l); xcd_barrier(bar);
        phase_m1(p, lds, l); xcd_barrier(bar);
        phase_m2(p, lds, l); xcd_barrier(bar);
        phase_ln<true>(p, p.in[I_LNFG] + l * D_, p.in[I_LNFB] + l * D_);
        if (l < 3) phase_weights(p, lds, l + 1);
        xcd_barrier(bar);
    }
}

extern "C" void kernel_launch(void* const* d_in, const int* in_sizes, int n_in, void* d_out, int out_size, void* d_ws, size_t ws_size, hipStream_t stream) {
    constexpr size_t kDynLds = LDS_BAR + 256;
    static int grid = 0;
    if (!grid) {
        int dev = 0, cus = 0, per_cu = 0;
        hipGetDevice(&dev);
        hipDeviceGetAttribute(&cus, hipDeviceAttributeMultiprocessorCount, dev);
        hipFuncSetAttribute((const void*)mega, hipFuncAttributeMaxDynamicSharedMemorySize, (int)kDynLds);
        hipOccupancyMaxActiveBlocksPerMultiprocessor(&per_cu, mega, NTHR, kDynLds);
        grid = cus * (per_cu < 1 ? per_cu : 1);
        if (grid <= 0) grid = 0;
    }
    if (n_in < 41 || ws_size < WS_NEED || grid <= 0) { fprintf(stderr, "kernel_launch: bad config (n_in %d ws %zu need %zu grid %d)\n", n_in, ws_size, (size_t)WS_NEED, grid); return; }
    hipMemsetAsync(d_ws, 0, 65536, stream);
    Params p; memset(&p, 0, sizeof(p));
    for (int i = 0; i < 41; ++i) p.in[i] = (const float*)d_in[i];
    p.out = (float*)d_out; p.ws = (unsigned char*)d_ws;
    hipLaunchKernelGGL(mega, dim3(grid), dim3(NTHR), kDynLds, stream, p);
}
#ifdef PHASE_TEST
#define PK(name, body) __global__ void __launch_bounds__(NTHR, 2) name(Params p, int l) { extern __shared__ __attribute__((aligned(16))) unsigned char lds[]; body; }
PK(t_init, phase_init(p))
PK(t_weights, phase_weights(p, lds, l))
PK(t_r1, phase_r1(p, lds, l))
PK(t_r2, phase_r2(p, lds, l))
PK(t_scan, phase_scan(p, lds, l))
PK(t_scanA, phase_scanA(p, lds, l))
PK(t_scanB, phase_scanB(p, l))
PK(t_scanC, phase_scanC(p, lds, l))
PK(t_outproj, phase_outproj(p, lds))
PK(t_ln0, phase_ln<false>(p, p.in[I_LNMG], p.in[I_LNMB]))
PK(t_ln1, phase_ln<true>(p, p.in[I_LNMG], p.in[I_LNMB]))
PK(t_qkv, phase_qkv(p, lds, l))
PK(t_attn, phase_attn(p, lds, l))
PK(t_router, phase_router(p, lds, l))
PK(t_scatter, phase_scatter(p, lds, l))
PK(t_m1, phase_m1(p, lds, l))
PK(t_m2, phase_m2(p, lds, l))
#endif
```

```cpp
#include <hip/hip_runtime.h>
#include <stdint.h>
#include <stdio.h>
#include <string.h>

#define DI __device__ __forceinline__
typedef unsigned short bf16_t;
typedef short bf16x8 __attribute__((ext_vector_type(8)));
typedef short s16x4 __attribute__((ext_vector_type(4)));
typedef float f32x2 __attribute__((ext_vector_type(2)));
typedef float f32x4 __attribute__((ext_vector_type(4)));
typedef float f32x16 __attribute__((ext_vector_type(16)));
typedef unsigned u32x4 __attribute__((ext_vector_type(4)));
typedef unsigned u32x2 __attribute__((ext_vector_type(2)));

constexpr int D_ = 1024, NB = 2, SEQ = 16384, NMETA = 16, LSEQ = SEQ + NMETA, LP = 16512, NP = NB * LP, NTOK = NB * LSEQ;
constexpr int NE = 64, TOPK = 8, FF = 256, NSLOT = NTOK * TOPK;
constexpr int NTHR = 512;
constexpr int LDS_BAR = 145408;
constexpr int NCHR = 257;
constexpr int MT = NP / 128;
constexpr float DN_ALPHA = 1.6817928305074290f;
constexpr float LN_EPS = 1e-5f;
constexpr int WBIG_ROWS = 3584, LO1_W = 384;

constexpr size_t AL(size_t x) { return (x + 255) & ~(size_t)255; }
constexpr size_t OFF_CTRL = 0;
constexpr size_t OFF_META32 = 65536;
constexpr size_t OFF_H16 = OFF_META32 + (size_t)NB * NMETA * D_ * 4;
constexpr size_t SZ_ACT16 = (size_t)NP * D_ * 2;
constexpr size_t OFF_KV = AL(OFF_H16 + SZ_ACT16 + 2048);
constexpr size_t OFF_WL = AL(OFF_KV + 2 * SZ_ACT16);
constexpr size_t SZ_WL = (size_t)WBIG_ROWS * 2048 * 2 + (size_t)1024 * LO1_W * 2 + (size_t)1024 * 1024 * 2;
constexpr size_t OFF_WSH = AL(OFF_WL + SZ_WL);
constexpr size_t SZ_WSH = (size_t)512 * 1024 * 2 + (size_t)1024 * 256 * 2 + (size_t)64 * 1024 * 2;
constexpr size_t OFF_WMOE = AL(OFF_WSH + SZ_WSH);
constexpr size_t SZ_WMOE = (size_t)NE * (512 * 1024 + 1024 * 256) * 2;
constexpr size_t OFF_TAB = AL(OFF_WMOE + SZ_WMOE);
constexpr size_t SZ_TAB = (size_t)NSLOT * 4 * 5 + 65536;
constexpr size_t OFF_SCR = AL(OFF_TAB + SZ_TAB);
constexpr size_t SCR_R = 0, SCR_K = SZ_ACT16, SCR_V = 2 * SZ_ACT16, SCR_G = 3 * SZ_ACT16, SCR_A = 4 * SZ_ACT16, SCR_Z = 5 * SZ_ACT16;
constexpr size_t SCR_W = 6 * SZ_ACT16;
constexpr size_t SCR_LO1 = SCR_W + 2 * SZ_ACT16;
constexpr size_t SCR_QS = SCR_LO1 + (size_t)NP * LO1_W * 2;
constexpr size_t SZ_SCR_RW = SCR_QS + SZ_ACT16;
constexpr size_t SCR_H = 0;
constexpr size_t SCR_HS = AL((size_t)NSLOT * 256 * 2);
constexpr size_t SCR_Y = AL(SCR_HS + (size_t)NP * 256 * 2);
constexpr size_t SZ_SCR_MOE = SCR_Y + (size_t)NSLOT * 1024 * 2;
constexpr size_t SZ_SCR = SZ_SCR_MOE > SZ_SCR_RW ? SZ_SCR_MOE : SZ_SCR_RW;
constexpr size_t WS_NEED = OFF_SCR + SZ_SCR + 4096;

constexpr int CT_ATTNQ = 4096;
constexpr int CT_CNT = 4352;
constexpr int CT_CUR = 4608;
constexpr int CT_NT = 4864;

struct Params {
    const float* in[41];
    float* out;
    unsigned char* ws;
};
enum { I_X = 0, I_META, I_LNMG, I_LNMB, I_LNFG, I_LNFB, I_MU, I_WRKV, I_W0, I_WL1, I_WL2, I_A0, I_AL1, I_AL2, I_GL1, I_GL2, I_KK, I_KA, I_RK, I_LNXG, I_LNXB, I_WOUT,
       I_V0, I_VL1, I_VL2, I_KVW, I_WQ, I_LQ1, I_LK1, I_LQ2, I_LK2, I_SUBG, I_DAWO, I_RTW, I_RTB, I_MG, I_MU_, I_MD, I_SG, I_SU, I_SD };

#define XB_TMO      128
#define XB_XCNT(j)  (256  + 64 * (j))
#define XB_XSUB(j)  (1280 + 64 * (j))
#define XB_XGEN(j)  (2304 + 64 * (j))
#define XB_TOP      3328
#define XB_TOPGEN   3392
#define XCD_BAR_WORDS 3456
#define XB_SPIN_CAP (1u << 22)
#define LAS __attribute__((address_space(3)))

__device__ __forceinline__ unsigned xb_ld(unsigned* p)              { return __hip_atomic_load(p, __ATOMIC_RELAXED, __HIP_MEMORY_SCOPE_AGENT); }
__device__ __forceinline__ unsigned xb_add(unsigned* p, unsigned v) { return __hip_atomic_fetch_add(p, v, __ATOMIC_RELAXED, __HIP_MEMORY_SCOPE_AGENT); }
__device__ __forceinline__ unsigned xb_xcc_id() { return (unsigned)__builtin_amdgcn_s_getreg((3 << 11) | 20) & 0xFu; }
#define XB_SPIN(cond, bar) do { unsigned _sp = 0; while (cond) { __builtin_amdgcn_s_sleep(1); \
    if ((++_sp & 255u) == 0u) { if (xb_ld(&(bar)[XB_TMO])) break; if (_sp > XB_SPIN_CAP) { atomicAdd(&(bar)[XB_TMO], 1u); break; } } } } while (0)

struct XcdBarrier { unsigned* bar; unsigned x; volatile LAS unsigned* st; };

__device__ __forceinline__ XcdBarrier xcd_barrier_post(unsigned* bar, volatile LAS unsigned* st) {
    XcdBarrier b; b.bar = bar; b.x = xb_xcc_id(); b.st = st;
    if (threadIdx.x == 0) (void)xb_add(&bar[XB_XCNT(b.x)], 1u);
    return b;
}
__device__ __forceinline__ void xcd_barrier_complete(unsigned* bar, unsigned x, unsigned& nloc, unsigned& nx) {
    const unsigned G = gridDim.x * gridDim.y * gridDim.z;
    unsigned sum, cnt, mine, sp = 0u;
    for (;;) {
        sum = 0u; cnt = 0u; mine = 0u;
#pragma unroll
        for (unsigned j = 0; j < 16; ++j) { const unsigned c = xb_ld(&bar[XB_XCNT(j)]); sum += c; cnt += (c > 0u) ? 1u : 0u; mine = (j == x) ? c : mine; }
        if (sum == G) break;
        __builtin_amdgcn_s_sleep(1);
        if ((++sp & 255u) == 0u) { if (xb_ld(&bar[XB_TMO])) break; if (sp > XB_SPIN_CAP) { atomicAdd(&bar[XB_TMO], 1u); break; } }
    }
    nloc = mine > 0u ? mine : 1u; nx = cnt > 0u ? cnt : 1u;
}
__device__ __forceinline__ void xcd_barrier(const XcdBarrier& b) {
    asm volatile("s_waitcnt vmcnt(0)" ::: "memory");
    __syncthreads();
    if (threadIdx.x == 0) {
        unsigned* bar = b.bar;
        __builtin_amdgcn_s_waitcnt(0);
        unsigned nloc = b.st[0], nx = b.st[1];
        if (nloc == 0u) { xcd_barrier_complete(bar, b.x, nloc, nx); b.st[0] = nloc; b.st[1] = nx; }
        const unsigned old = xb_add(&bar[XB_XSUB(b.x)], 1u);
        const unsigned gen = old / nloc;
        if (old + 1u == (gen + 1u) * nloc) {
            __builtin_amdgcn_fence(__ATOMIC_RELEASE, "agent");
            asm volatile("s_waitcnt vmcnt(0)" ::: "memory");
            const unsigned og = xb_add(&bar[XB_TOP], 1u);
            const unsigned tg = og / nx;
            if (og + 1u == (tg + 1u) * nx) xb_add(&bar[XB_TOPGEN], 1u);
            else XB_SPIN(xb_ld(&bar[XB_TOPGEN]) == tg, bar);
            __builtin_amdgcn_fence(__ATOMIC_ACQUIRE, "agent");
            xb_add(&bar[XB_XGEN(b.x)], 1u);
            asm volatile("s_waitcnt vmcnt(0)" ::: "memory");
        } else {
            XB_SPIN(xb_ld(&bar[XB_XGEN(b.x)]) == gen, bar);
            __builtin_amdgcn_fence(__ATOMIC_ACQUIRE, "agent");
            asm volatile("s_waitcnt vmcnt(0)" ::: "memory");
        }
    }
    __syncthreads();
}

DI int tid_() { int t = threadIdx.x; asm volatile("" : "+v"(t)); return t; }
typedef __bf16 bf16v2 __attribute__((ext_vector_type(2)));
DI unsigned cvt_pk_bf16(float lo, float hi) { f32x2 v = {lo, hi}; bf16v2 b = __builtin_convertvector(v, bf16v2); return __builtin_bit_cast(unsigned, b); }
DI float bf2f(bf16_t x) { return __uint_as_float((unsigned)x << 16); }
DI float bflo(unsigned w) { return __uint_as_float(w << 16); }
DI float bfhi(unsigned w) { return __uint_as_float(w & 0xffff0000u); }
DI bf16_t f2bf(float x) { return (bf16_t)(cvt_pk_bf16(x, 0.f) & 0xffffu); }
DI float sigmoidf_(float x) { return 1.0f / (1.0f + __expf(-x)); }
DI float tanhf_(float x) { const float t = __expf(-2.0f * fabsf(x)); const float r = (1.0f - t) / (1.0f + t); return x < 0.f ? -r : r; }
template <int CTRL> DI float dpp_f(float v) { return __builtin_bit_cast(float, __builtin_amdgcn_update_dpp(0, __builtin_bit_cast(int, v), CTRL, 0xF, 0xF, true)); }
DI float rdlane(float v, int l) { return __builtin_bit_cast(float, __builtin_amdgcn_readlane(__builtin_bit_cast(int, v), l)); }
DI float red8_sum(float v) { v += dpp_f<0xB1>(v); v += dpp_f<0x4E>(v); v += dpp_f<0x141>(v); return v; }
DI float red16_sum(float v) { v = red8_sum(v); v += dpp_f<0x140>(v); return v; }
DI float wave_sum(float v) { v = red16_sum(v); return (rdlane(v, 0) + rdlane(v, 16)) + (rdlane(v, 32) + rdlane(v, 48)); }
DI float red8_max(float v) { v = fmaxf(v, dpp_f<0xB1>(v)); v = fmaxf(v, dpp_f<0x4E>(v)); v = fmaxf(v, dpp_f<0x141>(v)); return v; }
DI float wave_max(float v) { v = red8_max(v); v = fmaxf(v, dpp_f<0x140>(v)); return fmaxf(fmaxf(rdlane(v, 0), rdlane(v, 16)), fmaxf(rdlane(v, 32), rdlane(v, 48))); }

DI bf16_t* H16(const Params& p) { return (bf16_t*)(p.ws + OFF_H16 + 2048); }
DI float* h32row_(float* out, unsigned char* ws, int prow) {
    const int b = prow >= LP ? 1 : 0, t = prow - b * LP;
    return t < NMETA ? (float*)(ws + OFF_META32) + (size_t)(b * NMETA + t) * D_ : out + ((size_t)b * SEQ + (t - NMETA)) * D_;
}
DI float* h32row(const Params& p, int prow) { return h32row_(p.out, p.ws, prow); }
DI unsigned* CTRL(const Params& p) { return (unsigned*)(p.ws + OFF_CTRL); }

DI void phase_init(const Params& p) {
    bf16_t* h16 = H16(p);
    const float* x = p.in[I_X]; const float* meta = p.in[I_META];
    const int tid0 = tid_(); const int half = tid0 >> 8, t4 = (tid0 & 255) * 4;
    for (int rp = blockIdx.x; rp < NTOK / 2; rp += gridDim.x) {
        const int n = rp * 2 + half; const int b = n >= LSEQ ? 1 : 0, t = n - b * LSEQ; const int prow = b * LP + t;
        const float* src = t < NMETA ? meta + t * D_ + t4 : x + ((size_t)b * SEQ + (t - NMETA)) * D_ + t4;
        const f32x4 v = *(const f32x4*)src;
        *(f32x4*)(h32row(p, prow) + t4) = v;
        u32x2 w; w.x = cvt_pk_bf16(v[0], v[1]); w.y = cvt_pk_bf16(v[2], v[3]);
        *(u32x2*)(h16 + (size_t)prow * D_ + t4) = w;
    }
    for (int zr = blockIdx.x; zr < 225; zr += gridDim.x) {
        const long prow = zr == 224 ? -1 : (long)(zr / 112) * LP + LSEQ + (zr % 112);
        *(unsigned*)(h16 + prow * D_ + tid0 * 2) = 0u;
    }
}

struct Job { const float* src; int Kvalid, Kpad, N, ldsrc; bf16_t* dst; int ld_dst, kofs, rowmode, rowbase; const float* scale; int scalemode; };

DI void cvt_mat(float* T, int& tctr, const Job& jb) {
    if (jb.N == 0) return;
    const int tk = jb.Kpad >> 6, tn = (jb.N + 63) >> 6, nt = tk * tn;
    const int G = gridDim.x;
    int first = ((int)blockIdx.x - (tctr % G) + G) % G;
    const int tid = tid_();
    for (int i = first; i < nt; i += G) {
        const int k0 = (i / tn) << 6, n0 = (i % tn) << 6;
        {
            const int kk = tid >> 4, n4 = (tid & 15) * 4;
#pragma unroll
            for (int ps = 0; ps < 2; ++ps) {
                const int k = k0 + kk + 32 * ps, n = n0 + n4;
                f32x4 v = (f32x4){0.f, 0.f, 0.f, 0.f};
                if (k < jb.Kvalid && n < jb.N) {
                    v = *(const f32x4*)(jb.src + (size_t)k * jb.ldsrc + n);
                    float s = 1.0f;
                    if (jb.scalemode == 1) s = jb.scale[k]; else if (jb.scalemode == 2) s = 1.0f - jb.scale[k];
                    v = v * s;
                }
                float* tp = T + (kk + 32 * ps) * 65 + n4;
                tp[0] = v[0]; tp[1] = v[1]; tp[2] = v[2]; tp[3] = v[3];
            }
        }
        __syncthreads();
        {
            const int n = tid >> 3, k8 = (tid & 7) * 8;
            if (n0 + n < jb.N) {
                const int ng = n0 + n;
                const int row = jb.rowmode == 0 ? jb.rowbase + ng : jb.rowbase + 32 * (ng >> 4) + (ng & 15);
                const float* tp = T + k8 * 65 + n;
                u32x4 w;
                w.x = cvt_pk_bf16(tp[0], tp[65]); w.y = cvt_pk_bf16(tp[130], tp[195]); w.z = cvt_pk_bf16(tp[260], tp[325]); w.w = cvt_pk_bf16(tp[390], tp[455]);
                *(u32x4*)(jb.dst + (size_t)row * jb.ld_dst + jb.kofs + k0 + k8) = w;
            }
        }
        __syncthreads();
    }
    tctr += nt;
}

DI bf16_t* WL_BIG(const Params& p) { return (bf16_t*)(p.ws + OFF_WL); }
DI bf16_t* WL_LORA2(const Params& p) { return (bf16_t*)(p.ws + OFF_WL + (size_t)WBIG_ROWS * 2048 * 2); }
DI bf16_t* WL_OUT(const Params& p) { return (bf16_t*)(p.ws + OFF_WL + (size_t)WBIG_ROWS * 2048 * 2 + (size_t)1024 * LO1_W * 2); }
DI bf16_t* WL_WQ(const Params& p) { return (bf16_t*)(p.ws + OFF_WL + (size_t)2048 * 1024 * 2); }
DI bf16_t* WS_GU(const Params& p) { return (bf16_t*)(p.ws + OFF_WSH); }
DI bf16_t* WS_DN(const Params& p) { return (bf16_t*)(p.ws + OFF_WSH + (size_t)512 * 1024 * 2); }
DI bf16_t* WS_RT(const Params& p) { return (bf16_t*)(p.ws + OFF_WSH + (size_t)512 * 1024 * 2 + (size_t)1024 * 256 * 2); }
DI bf16_t* WM_GU(const Params& p) { return (bf16_t*)(p.ws + OFF_WMOE); }
DI bf16_t* WM_DN(const Params& p) { return (bf16_t*)(p.ws + OFF_WMOE + (size_t)NE * 512 * 1024 * 2); }

DI Job mkjob(const float* src, int Kv, int Kp, int N, int ldsrc, bf16_t* dst, int ld_dst, int kofs, int rowmode, int rowbase, const float* scale, int scalemode) {
    Job j; j.src = src; j.Kvalid = Kv; j.Kpad = Kp; j.N = N; j.ldsrc = ldsrc; j.dst = dst; j.ld_dst = ld_dst; j.kofs = kofs; j.rowmode = rowmode; j.rowbase = rowbase; j.scale = scale; j.scalemode = scalemode; return j;
}

DI Job get_job(const Params& p, int l, int j) {
    Job z = mkjob(nullptr, 0, 0, 0, 0, nullptr, 0, 0, 0, 0, nullptr, 0);
    if (j < 19) {
        if (l < 2) {
            const float* mu = p.in[I_MU] + (size_t)l * 6 * D_;
            bf16_t* big = WL_BIG(p); bf16_t* lo2 = WL_LORA2(p);
            if (j < 6) { const int s = j >> 1, part = j & 1; return mkjob(p.in[I_WRKV] + (size_t)(l * 3 + s) * D_ * D_, 1024, 1024, 1024, 1024, big, 2048, part * 1024, 0, s * 1024, mu + s * D_, 1 + part); }
            if (j < 8) { const int part = j & 1; return mkjob(p.in[I_WL1] + (size_t)l * D_ * 64, 1024, 1024, 64, 64, big, 2048, part * 1024, 0, 3072, mu + 3 * D_, 1 + part); }
            if (j < 10) { const int part = j & 1; return mkjob(p.in[I_AL1] + (size_t)l * D_ * 64, 1024, 1024, 64, 64, big, 2048, part * 1024, 0, 3136, mu + 4 * D_, 1 + part); }
            if (j < 12) { const int part = j & 1; return mkjob(p.in[I_GL1] + (size_t)l * D_ * 160, 1024, 1024, 160, 160, big, 2048, part * 1024, 0, 3200, mu + 5 * D_, 1 + part); }
            if (j < 14) { if (l != 1) return z; const int part = j & 1; return mkjob(p.in[I_VL1], 1024, 1024, 32, 32, big, 2048, part * 1024, 0, 3392, mu + 2 * D_, 1 + part); }
            if (j == 14) return mkjob(p.in[I_WL2] + (size_t)l * 64 * D_, 64, 64, 1024, 1024, lo2, 64, 0, 0, 0, nullptr, 0);
            if (j == 15) return mkjob(p.in[I_AL2] + (size_t)l * 64 * D_, 64, 64, 1024, 1024, lo2 + 1024 * 64, 64, 0, 0, 0, nullptr, 0);
            if (j == 16) return mkjob(p.in[I_GL2] + (size_t)l * 160 * D_, 160, 192, 1024, 1024, lo2 + 2 * 1024 * 64, 192, 0, 0, 0, nullptr, 0);
            if (j == 17) { if (l != 1) return z; return mkjob(p.in[I_VL2], 32, 64, 1024, 1024, lo2 + 2 * 1024 * 64 + 1024 * 192, 64, 0, 0, 0, nullptr, 0); }
            return mkjob(p.in[I_WOUT] + (size_t)l * D_ * D_, 1024, 1024, 1024, 1024, WL_OUT(p), 1024, 0, 0, 0, nullptr, 0);
        } else {
            const int a = l - 2;
            if (j == 0) { if (l != 2) return z; return mkjob(p.in[I_KVW], 1024, 1024, 2048, 2048, WL_BIG(p), 1024, 0, 0, 0, nullptr, 0); }
            if (j == 1) return mkjob(p.in[I_WQ] + (size_t)a * D_ * D_, 1024, 1024, 1024, 1024, WL_WQ(p), 1024, 0, 0, 0, nullptr, 0);
            if (j == 2) return mkjob(p.in[I_DAWO] + (size_t)a * D_ * D_, 1024, 1024, 1024, 1024, WL_OUT(p), 1024, 0, 0, 0, nullptr, 0);
            return z;
        }
    }
    j -= 19;
    if (j == 0) return mkjob(p.in[I_SG] + (size_t)l * D_ * FF, 1024, 1024, 256, 256, WS_GU(p), 1024, 0, 1, 0, nullptr, 0);
    if (j == 1) return mkjob(p.in[I_SU] + (size_t)l * D_ * FF, 1024, 1024, 256, 256, WS_GU(p), 1024, 0, 1, 16, nullptr, 0);
    if (j == 2) return mkjob(p.in[I_SD] + (size_t)l * FF * D_, 256, 256, 1024, 1024, WS_DN(p), 256, 0, 0, 0, nullptr, 0);
    if (j == 3) return mkjob(p.in[I_RTW] + (size_t)l * D_ * NE, 1024, 1024, 64, 64, WS_RT(p), 1024, 0, 0, 0, nullptr, 0);
    j -= 4;
    const int e = j / 3, w = j - e * 3;
    if (w == 0) return mkjob(p.in[I_MG] + ((size_t)l * NE + e) * D_ * FF, 1024, 1024, 256, 256, WM_GU(p) + (size_t)e * 512 * 1024, 1024, 0, 1, 0, nullptr, 0);
    if (w == 1) return mkjob(p.in[I_MU_] + ((size_t)l * NE + e) * D_ * FF, 1024, 1024, 256, 256, WM_GU(p) + (size_t)e * 512 * 1024, 1024, 0, 1, 16, nullptr, 0);
    return mkjob(p.in[I_MD] + ((size_t)l * NE + e) * FF * D_, 256, 256, 1024, 1024, WM_DN(p) + (size_t)e * 1024 * 256, 256, 0, 0, 0, nullptr, 0);
}

DI void phase_weights(const Params& p, unsigned char* lds, int l) {
    float* T = (float*)lds;
    int tctr = 0;
    for (int j = 0; j < 19 + 4 + NE * 3; ++j) { const Job jb = get_job(p, l, j); cvt_mat(T, tctr, jb); }
}

template <int BM, int BN, int WTM, int WTN, bool TRANS, class AP, class EPI>
DI void gemm_tile(unsigned char* lds, const AP& aptr, const bf16_t* __restrict__ Bt, size_t ldb, int K, const EPI& epi) {
    constexpr int WN_ = BN / WTN, MI = WTM / 16, NI = WTN / 16;
    static_assert((BM / WTM) * WN_ == 8, "8 waves");
    constexpr int CA = BM * 8 / NTHR, CB = BN * 8 / NTHR;
    static_assert(CA >= 1 && CB >= 1, "tile too small");
    constexpr int ABYTES = BM * 128, STAGE = (BM + BN) * 128;
    const int tid = tid_(), lane = tid & 63, wid = tid >> 6, wm = wid / WN_, wn = wid % WN_;
    const bf16_t* ap[CA]; const bf16_t* bp[CB]; unsigned aoff[CA], boff[CB];
#pragma unroll
    for (int i = 0; i < CA; ++i) { const int id = tid + NTHR * i, row = id >> 3, c = id & 7; ap[i] = aptr(row) + c * 8; aoff[i] = row * 128 + ((c ^ ((row >> 1) & 7)) << 4); }
#pragma unroll
    for (int i = 0; i < CB; ++i) { const int id = tid + NTHR * i, row = id >> 3, c = id & 7; bp[i] = Bt + (size_t)row * ldb + c * 8; boff[i] = ABYTES + row * 128 + ((c ^ ((row >> 1) & 7)) << 4); }
    u32x4 ra[CA], rb[CB];
    f32x4 acc[MI][NI];
#pragma unroll
    for (int mi = 0; mi < MI; ++mi)
#pragma unroll
        for (int ni = 0; ni < NI; ++ni) acc[mi][ni] = (f32x4){0.f, 0.f, 0.f, 0.f};
    const int nk = K >> 6;
#pragma unroll
    for (int i = 0; i < CA; ++i) ra[i] = *(const u32x4*)(ap[i]);
#pragma unroll
    for (int i = 0; i < CB; ++i) rb[i] = *(const u32x4*)(bp[i]);
#pragma unroll
    for (int i = 0; i < CA; ++i) *(u32x4*)(lds + aoff[i]) = ra[i];
#pragma unroll
    for (int i = 0; i < CB; ++i) *(u32x4*)(lds + boff[i]) = rb[i];
    __syncthreads();
    const int fr = lane & 15, fq = lane >> 4, sw = (fr >> 1) & 7;
    for (int kt = 0; kt < nk; ++kt) {
        const unsigned char* cur = lds + (kt & 1) * STAGE;
        unsigned char* nxt = lds + ((kt + 1) & 1) * STAGE;
        const bool more = kt + 1 < nk;
        if (more) {
#pragma unroll
            for (int i = 0; i < CA; ++i) ra[i] = *(const u32x4*)(ap[i] + (kt + 1) * 64);
#pragma unroll
            for (int i = 0; i < CB; ++i) rb[i] = *(const u32x4*)(bp[i] + (kt + 1) * 64);
        }
#pragma unroll
        for (int ks = 0; ks < 2; ++ks) {
            bf16x8 af[MI], bfr[NI];
            const int ch = ((ks * 4 + fq) ^ sw) << 4;
#pragma unroll
            for (int mi = 0; mi < MI; ++mi) af[mi] = *(const bf16x8*)(cur + (wm * WTM + mi * 16 + fr) * 128 + ch);
#pragma unroll
            for (int ni = 0; ni < NI; ++ni) bfr[ni] = *(const bf16x8*)(cur + ABYTES + (wn * WTN + ni * 16 + fr) * 128 + ch);
#pragma unroll
            for (int mi = 0; mi < MI; ++mi)
#pragma unroll
                for (int ni = 0; ni < NI; ++ni)
                    acc[mi][ni] = TRANS ? __builtin_amdgcn_mfma_f32_16x16x32_bf16(bfr[ni], af[mi], acc[mi][ni], 0, 0, 0)
                                        : __builtin_amdgcn_mfma_f32_16x16x32_bf16(af[mi], bfr[ni], acc[mi][ni], 0, 0, 0);
        }
        if (more) {
#pragma unroll
            for (int i = 0; i < CA; ++i) *(u32x4*)(nxt + aoff[i]) = ra[i];
#pragma unroll
            for (int i = 0; i < CB; ++i) *(u32x4*)(nxt + boff[i]) = rb[i];
        }
        __syncthreads();
    }
    epi.template run<MI, NI>(acc, wm * WTM, wn * WTN, fr, fq);
}

struct APlain { const bf16_t* base; size_t ld; DI const bf16_t* operator()(int r) const { return base + (size_t)r * ld; } };
struct AClamp { const bf16_t* base; int last; DI const bf16_t* operator()(int r) const { return base + (size_t)(r < last ? r : last) * FF; } };
struct AGather { const bf16_t* base; const int* rows; int nrows; DI const bf16_t* operator()(int r) const { const int rr = r < nrows ? r : nrows - 1; return base + (size_t)rows[rr] * D_; } };

DI void st_bf4(bf16_t* dst, f32x4 v) { u32x2 w; w.x = cvt_pk_bf16(v[0], v[1]); w.y = cvt_pk_bf16(v[2], v[3]); *(u32x2*)dst = w; }

struct EpiR1 {
    bf16_t* dst; int kind; int m0, n0;
    template <int MI, int NI> DI void run(const f32x4 (&acc)[MI][NI], int rb, int cb, int fr, int fq) const {
#pragma unroll
        for (int ni = 0; ni < NI; ++ni) {
            const int col = n0 + cb + ni * 16 + 4 * fq;
            if (col >= 3456) continue;
#pragma unroll
            for (int mi = 0; mi < MI; ++mi) {
                const size_t row = (size_t)(m0 + rb + mi * 16 + fr);
                f32x4 a = acc[mi][ni];
                if (kind == 0) {
                    st_bf4(dst + row * D_ + (col & 1023), a);
                } else {
                    const int c = col - 3072;
                    if (c < 64) { a[0] = tanhf_(a[0]); a[1] = tanhf_(a[1]); a[2] = tanhf_(a[2]); a[3] = tanhf_(a[3]); }
                    else if (c >= 128 && c < 288) { a[0] = sigmoidf_(a[0]); a[1] = sigmoidf_(a[1]); a[2] = sigmoidf_(a[2]); a[3] = sigmoidf_(a[3]); }
                    else if ((c >= 288 && c < 320) || c >= 352) a = (f32x4){0.f, 0.f, 0.f, 0.f};
                    st_bf4(dst + row * LO1_W + c, a);
                }
            }
        }
    }
};
struct EpiLora2 {
    int mode; float* wdec; bf16_t* dst; const bf16_t* vfirst; const float* bias; int m0, n0;
    template <int MI, int NI> DI void run(const f32x4 (&acc)[MI][NI], int rb, int cb, int fr, int fq) const {
#pragma unroll
        for (int ni = 0; ni < NI; ++ni) {
            const int col = n0 + cb + ni * 16 + 4 * fq;
            f32x4 bv = (f32x4){0.f, 0.f, 0.f, 0.f};
            if (mode != 2) bv = *(const f32x4*)(bias + col);
#pragma unroll
            for (int mi = 0; mi < MI; ++mi) {
                const size_t off = (size_t)(m0 + rb + mi * 16 + fr) * D_ + col;
                f32x4 a = acc[mi][ni] + bv;
                if (mode == 0) {
#pragma unroll
                    for (int i = 0; i < 4; ++i) a[i] = -0.6065306597126334f * sigmoidf_(a[i]);
                    *(f32x4*)(wdec + off) = a;
                } else if (mode == 1) {
#pragma unroll
                    for (int i = 0; i < 4; ++i) a[i] = sigmoidf_(a[i]);
                    st_bf4(dst + off, a);
                } else if (mode == 2) {
                    st_bf4(dst + off, a);
                } else {
                    const u32x2 vv = *(const u32x2*)(dst + off), vf = *(const u32x2*)(vfirst + off);
                    const float v0 = bflo(vv.x), v1 = bfhi(vv.x), v2 = bflo(vv.y), v3 = bfhi(vv.y);
                    const float f0 = bflo(vf.x), f1 = bfhi(vf.x), f2 = bflo(vf.y), f3 = bfhi(vf.y);
                    f32x4 o;
                    o[0] = v0 + (f0 - v0) * sigmoidf_(a[0]); o[1] = v1 + (f1 - v1) * sigmoidf_(a[1]); o[2] = v2 + (f2 - v2) * sigmoidf_(a[2]); o[3] = v3 + (f3 - v3) * sigmoidf_(a[3]);
                    st_bf4(dst + off, o);
                }
            }
        }
    }
};
struct EpiResid {
    float* out; unsigned char* ws; int m0, n0;
    template <int MI, int NI> DI void run(const f32x4 (&acc)[MI][NI], int rb, int cb, int fr, int fq) const {
#pragma unroll
        for (int mi = 0; mi < MI; ++mi) {
            const int prow = m0 + rb + mi * 16 + fr;
            const int t = prow >= LP ? prow - LP : prow;
            if (t >= LSEQ) continue;
            float* hr = h32row_(out, ws, prow);
#pragma unroll
            for (int ni = 0; ni < NI; ++ni) {
                const int col = n0 + cb + ni * 16 + 4 * fq;
                f32x4 h = *(const f32x4*)(hr + col);
                *(f32x4*)(hr + col) = h * DN_ALPHA + acc[mi][ni];
            }
        }
    }
};
struct EpiQK {
    bf16_t* dst; float scale; int m0, n0;
    template <int MI, int NI> DI void run(const f32x4 (&acc)[MI][NI], int rb, int cb, int fr, int fq) const {
#pragma unroll
        for (int mi = 0; mi < MI; ++mi) {
            const int prow = m0 + rb + mi * 16 + fr;
            const int b = prow >= LP ? 1 : 0, t = prow - b * LP;
#pragma unroll
            for (int ni = 0; ni < NI; ++ni) {
                const int col = n0 + cb + ni * 16 + 4 * fq;
                const int hc = col >> 6, dd = col & 63;
                st_bf4(dst + (((size_t)(b * 16 + hc)) * LP + t) * 64 + dd, acc[mi][ni] * scale);
            }
        }
    }
};
struct EpiVt {
    bf16_t* dst; int m0, n0;
    template <int MI, int NI> DI void run(const f32x4 (&acc)[MI][NI], int rb, int cb, int fr, int fq) const {
#pragma unroll
        for (int mi = 0; mi < MI; ++mi) {
            const int prow = m0 + rb + mi * 16 + 4 * fq;
            const int b = prow >= LP ? 1 : 0, t = prow - b * LP;
#pragma unroll
            for (int ni = 0; ni < NI; ++ni) {
                const int col = n0 + cb + ni * 16 + fr;
                st_bf4(dst + ((size_t)(b * 1024 + col)) * LP + t, acc[mi][ni]);
            }
        }
    }
};
struct EpiM1 {
    bf16_t* dst; const float* gate; int row0, nrows, n0;
    template <int MI, int NI> DI void run(const f32x4 (&acc)[MI][NI], int rb, int cb, int fr, int fq) const {
#pragma unroll
        for (int mi = 0; mi < MI; ++mi) {
            const int r = rb + mi * 16 + fr;
            if (r >= nrows) continue;
            const float gw = gate ? gate[row0 + r] : 1.0f;
#pragma unroll
            for (int ni = 0; ni < NI; ni += 2) {
                const int hc = ((n0 + cb + ni * 16) >> 1) + 4 * fq;
                const f32x4 g = acc[mi][ni], u = acc[mi][ni + 1];
                f32x4 o;
#pragma unroll
                for (int i = 0; i < 4; ++i) o[i] = g[i] * sigmoidf_(g[i]) * u[i] * gw;
                st_bf4(dst + (size_t)(row0 + r) * FF + hc, o);
            }
        }
    }
};
struct EpiM2 {
    bf16_t* dst; int row0, nrows, n0;
    template <int MI, int NI> DI void run(const f32x4 (&acc)[MI][NI], int rb, int cb, int fr, int fq) const {
#pragma unroll
        for (int mi = 0; mi < MI; ++mi) {
            const int r = rb + mi * 16 + fr;
            if (r >= nrows) continue;
#pragma unroll
            for (int ni = 0; ni < NI; ++ni) st_bf4(dst + (size_t)(row0 + r) * D_ + n0 + cb + ni * 16 + 4 * fq, acc[mi][ni]);
        }
    }
};
struct EpiLds {
    float* dst;
    template <int MI, int NI> DI void run(const f32x4 (&acc)[MI][NI], int rb, int cb, int fr, int fq) const {
#pragma unroll
        for (int mi = 0; mi < MI; ++mi)
#pragma unroll
            for (int ni = 0; ni < NI; ++ni) {
                float* d = dst + (rb + mi * 16 + fr) * 65 + cb + ni * 16 + 4 * fq;
                d[0] = acc[mi][ni][0]; d[1] = acc[mi][ni][1]; d[2] = acc[mi][ni][2]; d[3] = acc[mi][ni][3];
            }
    }
};

DI bf16_t* SCR16(const Params& p, size_t off) { return (bf16_t*)(p.ws + OFF_SCR + off); }
DI bf16_t* VFIRST(const Params& p) { return (bf16_t*)(p.ws + OFF_KV); }
DI bf16_t* KBUF(const Params& p) { return (bf16_t*)(p.ws + OFF_KV); }
DI bf16_t* VTBUF(const Params& p) { return (bf16_t*)(p.ws + OFF_KV + SZ_ACT16); }

DI void phase_r1(const Params& p, unsigned char* lds, int l) {
    constexpr int NT = WBIG_ROWS / 256;
    EpiR1 e;
    for (int u = blockIdx.x; u < MT * NT; u += gridDim.x) {
        const int mt = u / NT, nt = u - mt * NT;
        e.m0 = mt * 128; e.n0 = nt * 256;
        if (nt < 4) { e.kind = 0; e.dst = SCR16(p, SCR_R); } else if (nt < 8) { e.kind = 0; e.dst = SCR16(p, SCR_K); }
        else if (nt < 12) { e.kind = 0; e.dst = l == 0 ? VFIRST(p) : SCR16(p, SCR_V); } else { e.kind = 1; e.dst = SCR16(p, SCR_LO1); }
        APlain a; a.base = H16(p) + (size_t)(mt * 128) * D_ - D_; a.ld = D_;
        gemm_tile<128, 256, 64, 64, true>(lds, a, WL_BIG(p) + (size_t)(nt * 256) * 2048, 2048, 2048, e);
    }
}
DI void phase_r2(const Params& p, unsigned char* lds, int l) {
    const int ng = l == 1 ? 4 : 3;
    for (int u = blockIdx.x; u < ng * MT * 4; u += gridDim.x) {
        const int g = u / (MT * 4), r = u - g * (MT * 4), mt = r >> 2, nt = r & 3;
        EpiLora2 e; e.mode = g; e.m0 = mt * 128; e.n0 = nt * 256; e.wdec = (float*)(p.ws + OFF_SCR + SCR_W); e.vfirst = VFIRST(p); e.bias = nullptr; e.dst = nullptr;
        APlain a; a.ld = LO1_W; const bf16_t* lo1 = SCR16(p, SCR_LO1) + (size_t)(mt * 128) * LO1_W;
        const bf16_t* lo2 = WL_LORA2(p);
        if (g == 0) { e.bias = p.in[I_W0] + l * D_; a.base = lo1; gemm_tile<128, 256, 64, 64, true>(lds, a, lo2 + (size_t)(nt * 256) * 64, 64, 64, e); }
        else if (g == 1) { e.bias = p.in[I_A0] + l * D_; e.dst = SCR16(p, SCR_A); a.base = lo1 + 64; gemm_tile<128, 256, 64, 64, true>(lds, a, lo2 + 1024 * 64 + (size_t)(nt * 256) * 64, 64, 64, e); }
        else if (g == 2) { e.dst = SCR16(p, SCR_G); a.base = lo1 + 128; gemm_tile<128, 256, 64, 64, true>(lds, a, lo2 + 2 * 1024 * 64 + (size_t)(nt * 256) * 192, 192, 192, e); }
        else { e.bias = p.in[I_V0]; e.dst = SCR16(p, SCR_V); a.base = lo1 + 320; gemm_tile<128, 256, 64, 64, true>(lds, a, lo2 + 2 * 1024 * 64 + 1024 * 192 + (size_t)(nt * 256) * 64, 64, 64, e); }
    }
}

DI void phase_scan(const Params& p, unsigned char* lds, int l) {
    float* sR = (float*)lds; float* sW = sR + 2048; float* sK = sW + 2048; float* sA = sK + 2048; float* sB = sA + 2048; float* sV = sB + 2048; float* sY = sV + 2048; float* sBon = sY + 2048;
    const int tid = tid_(), lane = tid & 63, wid = tid >> 6, vi = tid >> 3, q = tid & 7;
    const bf16_t* R = SCR16(p, SCR_R); const bf16_t* Kp = SCR16(p, SCR_K); const bf16_t* V = l == 0 ? VFIRST(p) : SCR16(p, SCR_V);
    const bf16_t* A = SCR16(p, SCR_A); const bf16_t* G = SCR16(p, SCR_G); const float* Wd = (const float*)(p.ws + OFF_SCR + SCR_W); bf16_t* Z = SCR16(p, SCR_Z);
    for (int unit = blockIdx.x; unit < NB * 16; unit += gridDim.x) {
        const int b = unit >> 4, h = unit & 15, hc = h * 64 + lane;
        const float c_kk = p.in[I_KK][l * D_ + hc], c_ka = p.in[I_KA][l * D_ + hc], c_rk = p.in[I_RK][l * D_ + hc], c_lg = p.in[I_LNXG][l * D_ + hc], c_lb = p.in[I_LNXB][l * D_ + hc];
        f32x2 S[4];
#pragma unroll
        for (int j = 0; j < 4; ++j) S[j] = (f32x2){0.f, 0.f};
        float pr[4], pk[4], pv[4], pa[4], pw[4];
        const size_t base0 = ((size_t)b * LP) * D_ + hc;
#pragma unroll
        for (int j = 0; j < 4; ++j) { const size_t e = base0 + (size_t)(wid * 4 + j) * D_; pr[j] = bf2f(R[e]); pk[j] = bf2f(Kp[e]); pv[j] = bf2f(V[e]); pa[j] = bf2f(A[e]); pw[j] = __expf(Wd[e]); }
        constexpr int NCH = (LSEQ + 31) / 32;
        for (int ch = 0; ch < NCH; ++ch) {
#pragma unroll
            for (int j = 0; j < 4; ++j) {
                const int tt = wid * 4 + j;
                const float kkr = pk[j] * c_kk;
                const float n2 = wave_sum(kkr * kkr);
                const float kk = kkr / fmaxf(sqrtf(n2), 1e-12f);
                const float k2 = pk[j] * (1.0f + (pa[j] - 1.0f) * c_ka);
                const float bon = wave_sum(pr[j] * k2 * c_rk);
                sR[tt * 64 + lane] = pr[j]; sW[tt * 64 + lane] = pw[j]; sK[tt * 64 + lane] = k2; sA[tt * 64 + lane] = -kk; sB[tt * 64 + lane] = kk * pa[j]; sV[tt * 64 + lane] = pv[j];
                if (lane == 0) sBon[tt] = bon;
            }
            __syncthreads();
            if (ch + 1 < NCH) {
#pragma unroll
                for (int j = 0; j < 4; ++j) { const size_t e = base0 + (size_t)((ch + 1) * 32 + wid * 4 + j) * D_; pr[j] = bf2f(R[e]); pk[j] = bf2f(Kp[e]); pv[j] = bf2f(V[e]); pa[j] = bf2f(A[e]); pw[j] = __expf(Wd[e]); }
            }
#pragma unroll 4
            for (int tt = 0; tt < 32; ++tt) {
                const f32x4 a0 = *(const f32x4*)(sA + tt * 64 + q * 8), a1 = *(const f32x4*)(sA + tt * 64 + q * 8 + 4);
                const f32x4 w0 = *(const f32x4*)(sW + tt * 64 + q * 8), w1 = *(const f32x4*)(sW + tt * 64 + q * 8 + 4);
                const f32x4 b0 = *(const f32x4*)(sB + tt * 64 + q * 8), b1 = *(const f32x4*)(sB + tt * 64 + q * 8 + 4);
                const f32x4 k0 = *(const f32x4*)(sK + tt * 64 + q * 8), k1 = *(const f32x4*)(sK + tt * 64 + q * 8 + 4);
                const f32x4 r0 = *(const f32x4*)(sR + tt * 64 + q * 8), r1 = *(const f32x4*)(sR + tt * 64 + q * 8 + 4);
                const float vv = sV[tt * 64 + vi];
                f32x2 d2 = S[0] * (f32x2){a0[0], a0[1]};
                d2 = S[1] * (f32x2){a0[2], a0[3]} + d2; d2 = S[2] * (f32x2){a1[0], a1[1]} + d2; d2 = S[3] * (f32x2){a1[2], a1[3]} + d2;
                const float sa = red8_sum(d2.x + d2.y);
                const f32x2 sa2 = (f32x2){sa, sa}, v2 = (f32x2){vv, vv};
                S[0] = S[0] * (f32x2){w0[0], w0[1]} + (sa2 * (f32x2){b0[0], b0[1]} + v2 * (f32x2){k0[0], k0[1]});
                S[1] = S[1] * (f32x2){w0[2], w0[3]} + (sa2 * (f32x2){b0[2], b0[3]} + v2 * (f32x2){k0[2], k0[3]});
                S[2] = S[2] * (f32x2){w1[0], w1[1]} + (sa2 * (f32x2){b1[0], b1[1]} + v2 * (f32x2){k1[0], k1[1]});
                S[3] = S[3] * (f32x2){w1[2], w1[3]} + (sa2 * (f32x2){b1[2], b1[3]} + v2 * (f32x2){k1[2], k1[3]});
                f32x2 y2 = S[0] * (f32x2){r0[0], r0[1]};
                y2 = S[1] * (f32x2){r0[2], r0[3]} + y2; y2 = S[2] * (f32x2){r1[0], r1[1]} + y2; y2 = S[3] * (f32x2){r1[2], r1[3]} + y2;
                const float y = red8_sum(y2.x + y2.y);
                if (q == 0) sY[tt * 64 + vi] = y;
            }
            __syncthreads();
#pragma unroll
            for (int j = 0; j < 4; ++j) {
                const int tt = wid * 4 + j;
                const float y = sY[tt * 64 + lane];
                const float mean = wave_sum(y) * (1.0f / 64.0f);
                const float dlt = y - mean;
                const float var = wave_sum(dlt * dlt) * (1.0f / 64.0f);
                const float yn = dlt * rsqrtf(var + 64e-5f) * c_lg + c_lb;
                const size_t e = base0 + (size_t)(ch * 32 + tt) * D_;
                const float g = bf2f(G[e]);
                Z[e] = f2bf((yn + sBon[tt] * sV[tt * 64 + lane]) * g);
            }
            __syncthreads();
        }
    }
}


DI unsigned img_off(int row, int col) { return (unsigned)(row * 128 + ((((col >> 3) ^ ((row >> 1) & 7)) << 4) | ((col & 7) << 1))); }
DI void mm64(const unsigned char* Aimg, const unsigned char* Bimg, int mb, int nh, int fr, int g, f32x4 (&acc)[2]) {
#pragma unroll
    for (int ks = 0; ks < 2; ++ks) {
        const int ch = ((ks * 4 + g) ^ ((fr >> 1) & 7)) << 4;
        const bf16x8 a = *(const bf16x8*)(Aimg + (16 * mb + fr) * 128 + ch);
#pragma unroll
        for (int nbi = 0; nbi < 2; ++nbi) {
            const bf16x8 b = *(const bf16x8*)(Bimg + (16 * (2 * nh + nbi) + fr) * 128 + ch);
            acc[nbi] = __builtin_amdgcn_mfma_f32_16x16x32_bf16(b, a, acc[nbi], 0, 0, 0);
        }
    }
}
DI void st_img4(unsigned char* img, int row, int col4, f32x4 v) { u32x2 w; w.x = cvt_pk_bf16(v[0], v[1]); w.y = cvt_pk_bf16(v[2], v[3]); *(u32x2*)(img + img_off(row, col4)) = w; }
DI f32x4 ld_img4(const unsigned char* img, int row, int col4) { const u32x2 w = *(const u32x2*)(img + img_off(row, col4)); return (f32x4){bflo(w.x), bfhi(w.x), bflo(w.y), bfhi(w.y)}; }
#define ZACC(a) do { a[0] = (f32x4){0.f, 0.f, 0.f, 0.f}; a[1] = (f32x4){0.f, 0.f, 0.f, 0.f}; } while (0)

DI void phase_scanA(const Params& p, unsigned char* lds, int l) {
    const int tid = tid_(), lane = tid & 63, wid = tid >> 6, fr = lane & 15, g = lane >> 4, mb = wid >> 1, nh = wid & 1;
    float* seg = (float*)(lds + 16 * 8192); float* gC = seg + 512;
#define SL(i) (lds + (i) * 8192)
    bf16_t* R = SCR16(p, SCR_R); bf16_t* Kp = SCR16(p, SCR_K); const bf16_t* V = l == 0 ? VFIRST(p) : SCR16(p, SCR_V); bf16_t* A = SCR16(p, SCR_A);
    const float* LW = (const float*)(p.ws + OFF_SCR + SCR_W); float* bonus = (float*)(p.ws + OFF_SCR + SCR_LO1); bf16_t* Qs = SCR16(p, SCR_QS);
    for (int unit = blockIdx.x; unit < NB * 16 * NCHR; unit += gridDim.x) {
        const int c = unit % NCHR, bh = unit / NCHR, b = bh >> 4, h = bh & 15;
        const size_t base = ((size_t)(b * LP + 64 * c)) * D_ + h * 64;
        const int hc = l * D_ + h * 64 + lane;
        const float c_kk = p.in[I_KK][hc], c_ka = p.in[I_KA][hc], c_rk = p.in[I_RK][hc];
        float vr[8], vk2[8], vv[8], vas[8], vbs[8], lwv[8], cum[8];
        float run = 0.f;
#pragma unroll
        for (int j = 0; j < 8; ++j) {
            const int t = 8 * wid + j; const size_t e = base + (size_t)t * D_ + lane;
            const float r = bf2f(R[e]), k = bf2f(Kp[e]), v = bf2f(V[e]), a = bf2f(A[e]), lw = LW[e];
            const float kkr = k * c_kk; const float n2 = wave_sum(kkr * kkr);
            const float kk = kkr / fmaxf(sqrtf(n2), 1e-12f);
            const float k2 = k * (1.0f + (a - 1.0f) * c_ka);
            const float bon = wave_sum(r * k2 * c_rk);
            if (lane == 0) bonus[((size_t)(b * LP + 64 * c + t)) * 16 + h] = bon;
            run += lw; cum[j] = run; lwv[j] = lw; vr[j] = r; vk2[j] = k2; vv[j] = v; vas[j] = -kk; vbs[j] = kk * a;
        }
        seg[wid * 64 + lane] = run;
        __syncthreads();
        float off = 0.f, tot = 0.f;
#pragma unroll
        for (int w2 = 0; w2 < 8; ++w2) { const float sg = seg[w2 * 64 + lane]; off += w2 < wid ? sg : 0.f; tot += sg; }
        if (wid == 0) gC[lane] = __expf(tot);
        {
            float tA[8], tB[8], tK[8];
#pragma unroll
            for (int j = 0; j < 8; ++j) {
                const int t = 8 * wid + j;
                const float cu = cum[j] + off, cp = cu - lwv[j];
                const float ea = __expf(cp), er = __expf(cu), ei = __expf(-cu), eh = __expf(tot - cu);
                const float At = vas[j] * ea, Rt = vr[j] * er, Bt = vbs[j] * ei, Kt = vk2[j] * ei;
                const unsigned o = img_off(t, lane);
                *(bf16_t*)(SL(5) + o) = f2bf(At); *(bf16_t*)(SL(0) + o) = f2bf(Rt); *(bf16_t*)(SL(6) + o) = f2bf(Bt); *(bf16_t*)(SL(7) + o) = f2bf(Kt);
                tA[j] = At; tB[j] = vbs[j] * eh; tK[j] = vk2[j] * eh;
            }
            const unsigned ot = (unsigned)(lane * 128 + ((wid ^ ((lane >> 1) & 7)) << 4));
            u32x4 w;
            w.x = cvt_pk_bf16(tA[0], tA[1]); w.y = cvt_pk_bf16(tA[2], tA[3]); w.z = cvt_pk_bf16(tA[4], tA[5]); w.w = cvt_pk_bf16(tA[6], tA[7]); *(u32x4*)(SL(1) + ot) = w;
            w.x = cvt_pk_bf16(vv[0], vv[1]); w.y = cvt_pk_bf16(vv[2], vv[3]); w.z = cvt_pk_bf16(vv[4], vv[5]); w.w = cvt_pk_bf16(vv[6], vv[7]); *(u32x4*)(SL(2) + ot) = w;
            w.x = cvt_pk_bf16(tB[0], tB[1]); w.y = cvt_pk_bf16(tB[2], tB[3]); w.z = cvt_pk_bf16(tB[4], tB[5]); w.w = cvt_pk_bf16(tB[6], tB[7]); *(u32x4*)(SL(3) + ot) = w;
            w.x = cvt_pk_bf16(tK[0], tK[1]); w.y = cvt_pk_bf16(tK[2], tK[3]); w.z = cvt_pk_bf16(tK[4], tK[5]); w.w = cvt_pk_bf16(tK[6], tK[7]); *(u32x4*)(SL(4) + ot) = w;
        }
        __syncthreads();
        f32x4 acc[2];
        const int row = 16 * mb + fr;
        ZACC(acc); mm64(SL(5), SL(6), mb, nh, fr, g, acc);
#pragma unroll
        for (int nbi = 0; nbi < 2; ++nbi) { const int c0 = 16 * (2 * nh + nbi) + 4 * g; f32x4 m = acc[nbi];
#pragma unroll
            for (int i = 0; i < 4; ++i) m[i] = (c0 + i < row) ? m[i] : 0.f;
            st_img4(SL(8), row, c0, m);
#pragma unroll
            for (int i = 0; i < 4; ++i) m[i] += (c0 + i == row) ? 1.0f : 0.f;
            st_img4(SL(13), row, c0, m); }
        ZACC(acc); mm64(SL(6), SL(5), mb, nh, fr, g, acc);
#pragma unroll
        for (int nbi = 0; nbi < 2; ++nbi) { const int c0 = 16 * (2 * nh + nbi) + 4 * g; f32x4 m = acc[nbi];
#pragma unroll
            for (int i = 0; i < 4; ++i) m[i] = (row < c0 + i) ? m[i] : 0.f;
            st_img4(SL(9), row, c0, m); }
        ZACC(acc); mm64(SL(5), SL(7), mb, nh, fr, g, acc);
#pragma unroll
        for (int nbi = 0; nbi < 2; ++nbi) { const int c0 = 16 * (2 * nh + nbi) + 4 * g; f32x4 m = acc[nbi];
#pragma unroll
            for (int i = 0; i < 4; ++i) m[i] = (c0 + i < row) ? m[i] : 0.f;
            st_img4(SL(10), row, c0, m); }
        ZACC(acc); mm64(SL(0), SL(6), mb, nh, fr, g, acc);
#pragma unroll
        for (int nbi = 0; nbi < 2; ++nbi) { const int c0 = 16 * (2 * nh + nbi) + 4 * g; f32x4 m = acc[nbi];
#pragma unroll
            for (int i = 0; i < 4; ++i) m[i] = (c0 + i <= row) ? m[i] : 0.f;
            st_img4(SL(11), row, c0, m); }
        ZACC(acc); mm64(SL(0), SL(7), mb, nh, fr, g, acc);
#pragma unroll
        for (int nbi = 0; nbi < 2; ++nbi) { const int c0 = 16 * (2 * nh + nbi) + 4 * g; f32x4 m = acc[nbi];
#pragma unroll
            for (int i = 0; i < 4; ++i) m[i] = (c0 + i <= row) ? m[i] : 0.f;
            st_img4(SL(12), row, c0, m); }
        __syncthreads();
#define MMST(dst, Ai, Bi) do { ZACC(acc); mm64(SL(Ai), SL(Bi), mb, nh, fr, g, acc); st_img4(SL(dst), row, 16 * (2 * nh) + 4 * g, acc[0]); st_img4(SL(dst), row, 16 * (2 * nh + 1) + 4 * g, acc[1]); } while (0)
#define MMUPD(dst, Ti, Bi) do { ZACC(acc); mm64(SL(Ti), SL(Bi), mb, nh, fr, g, acc); \
        st_img4(SL(dst), row, 16 * (2 * nh) + 4 * g, acc[0] + ld_img4(SL(Ti), row, 16 * (2 * nh) + 4 * g)); \
        st_img4(SL(dst), row, 16 * (2 * nh + 1) + 4 * g, acc[1] + ld_img4(SL(Ti), row, 16 * (2 * nh + 1) + 4 * g)); } while (0)
        MMST(7, 2, 10); MMST(14, 8, 9); MMST(15, 9, 8);
        __syncthreads();
        MMST(5, 14, 15); MMST(6, 15, 14); MMUPD(8, 13, 15);
        __syncthreads();
        MMST(14, 5, 6); MMST(15, 6, 5); MMUPD(9, 8, 6);
        __syncthreads();
        MMST(5, 14, 15); MMST(6, 15, 14); MMUPD(8, 9, 15);
        __syncthreads();
        MMST(15, 6, 5); MMUPD(9, 8, 6);
        __syncthreads();
        MMUPD(8, 9, 15);
        __syncthreads();
        MMST(5, 1, 8); MMST(6, 7, 8);
        __syncthreads();
        ZACC(acc); mm64(SL(11), SL(5), mb, nh, fr, g, acc);
#pragma unroll
        for (int nbi = 0; nbi < 2; ++nbi) { const int c0 = 16 * (2 * nh + nbi) + 4 * g; st_bf4(R + base + (size_t)row * D_ + c0, acc[nbi] + ld_img4(SL(0), row, c0)); }
        ZACC(acc); mm64(SL(11), SL(6), mb, nh, fr, g, acc); mm64(SL(12), SL(2), mb, nh, fr, g, acc);
#pragma unroll
        for (int nbi = 0; nbi < 2; ++nbi) { const int c0 = 16 * (2 * nh + nbi) + 4 * g; st_bf4(Kp + base + (size_t)row * D_ + c0, acc[nbi]); }
        ZACC(acc); mm64(SL(3), SL(5), mb, nh, fr, g, acc);
#pragma unroll
        for (int nbi = 0; nbi < 2; ++nbi) { const int c0 = 16 * (2 * nh + nbi) + 4 * g; f32x4 m = acc[nbi];
#pragma unroll
            for (int i = 0; i < 4; ++i) m[i] += (c0 + i == row) ? gC[row] : 0.f;
            const int cp = (c0 & 32) + 8 * ((c0 >> 2) & 3) + 4 * ((c0 >> 4) & 1);
            st_bf4(A + base + (size_t)row * D_ + cp, m); }
        ZACC(acc); mm64(SL(6), SL(3), mb, nh, fr, g, acc); mm64(SL(2), SL(4), mb, nh, fr, g, acc);
#pragma unroll
        for (int nbi = 0; nbi < 2; ++nbi) { const int c0 = 16 * (2 * nh + nbi) + 4 * g; st_bf4(Qs + (size_t)unit * 4096 + row * 64 + 16 * ((c0 >> 2) & 3) + 4 * (c0 >> 4), acc[nbi]); }
        __syncthreads();
    }
#undef SL
}

struct ScanBSet { u32x4 a[4][2]; u32x4 q[2]; };
DI void scanB_load(ScanBSet& s, const bf16_t* A, const bf16_t* Qs, int b, int h, int unit, int c, int v, int fr, int g) {
    const size_t abase = ((size_t)(b * LP + 64 * c)) * D_ + h * 64 + 8 * g;
#pragma unroll
    for (int kb = 0; kb < 4; ++kb)
#pragma unroll
        for (int ks = 0; ks < 2; ++ks) s.a[kb][ks] = *(const u32x4*)(A + abase + (size_t)(16 * kb + fr) * D_ + 32 * ks);
    const bf16_t* qp = Qs + (size_t)(unit * NCHR + c) * 4096 + v * 64 + 16 * g;
    s.q[0] = *(const u32x4*)qp; s.q[1] = *(const u32x4*)(qp + 8);
}
DI void scanB_step(const ScanBSet& s, f32x4 (&X)[4], bf16_t* SC, size_t ch, int v, int g) {
#pragma unroll
    for (int kb = 0; kb < 4; ++kb) st_bf4(SC + ch * 4096 + v * 64 + 16 * kb + 4 * g, X[kb]);
    bf16x8 xp[2];
#pragma unroll
    for (int ks = 0; ks < 2; ++ks) {
        u32x4 w; w.x = cvt_pk_bf16(X[2 * ks][0], X[2 * ks][1]); w.y = cvt_pk_bf16(X[2 * ks][2], X[2 * ks][3]);
        w.z = cvt_pk_bf16(X[2 * ks + 1][0], X[2 * ks + 1][1]); w.w = cvt_pk_bf16(X[2 * ks + 1][2], X[2 * ks + 1][3]);
        xp[ks] = __builtin_bit_cast(bf16x8, w);
    }
    const unsigned qw[8] = {s.q[0].x, s.q[0].y, s.q[0].z, s.q[0].w, s.q[1].x, s.q[1].y, s.q[1].z, s.q[1].w};
#pragma unroll
    for (int kb = 0; kb < 4; ++kb) {
        f32x4 acc = (f32x4){bflo(qw[2 * kb]), bfhi(qw[2 * kb]), bflo(qw[2 * kb + 1]), bfhi(qw[2 * kb + 1])};
#pragma unroll
        for (int ks = 0; ks < 2; ++ks) acc = __builtin_amdgcn_mfma_f32_16x16x32_bf16(__builtin_bit_cast(bf16x8, s.a[kb][ks]), xp[ks], acc, 0, 0, 0);
        X[kb] = acc;
    }
}
DI void phase_scanB(const Params& p, int l) {
    const int tid = tid_(), lane = tid & 63, wid = tid >> 6, fr = lane & 15, g = lane >> 4;
    if (wid >= 4) return;
    const bf16_t* A = SCR16(p, SCR_A); const bf16_t* Qs = SCR16(p, SCR_QS); bf16_t* SC = SCR16(p, SCR_W);
    for (int unit = blockIdx.x; unit < NB * 16; unit += gridDim.x) {
        const int b = unit >> 4, h = unit & 15, v = 16 * wid + fr;
        f32x4 X[4];
#pragma unroll
        for (int kb = 0; kb < 4; ++kb) X[kb] = (f32x4){0.f, 0.f, 0.f, 0.f};
        ScanBSet s0, s1, s2, s3;
        scanB_load(s0, A, Qs, b, h, unit, 0, v, fr, g); scanB_load(s1, A, Qs, b, h, unit, 1, v, fr, g); scanB_load(s2, A, Qs, b, h, unit, 2, v, fr, g);
        for (int c = 0; c < NCHR - 1; c += 4) {
            const size_t ch = (size_t)(unit * NCHR + c);
            scanB_load(s3, A, Qs, b, h, unit, c + 3, v, fr, g);
            scanB_step(s0, X, SC, ch, v, g);
            scanB_load(s0, A, Qs, b, h, unit, c + 4, v, fr, g);
            scanB_step(s1, X, SC, ch + 1, v, g);
            scanB_load(s1, A, Qs, b, h, unit, c + 5 < NCHR ? c + 5 : NCHR - 1, v, fr, g);
            scanB_step(s2, X, SC, ch + 2, v, g);
            scanB_load(s2, A, Qs, b, h, unit, c + 6 < NCHR ? c + 6 : NCHR - 1, v, fr, g);
            scanB_step(s3, X, SC, ch + 3, v, g);
        }
#pragma unroll
        for (int kb = 0; kb < 4; ++kb) st_bf4(SC + (size_t)(unit * NCHR + NCHR - 1) * 4096 + v * 64 + 16 * kb + 4 * g, X[kb]);
    }
}

DI void phase_scanC(const Params& p, unsigned char* lds, int l) {
    const int tid = tid_(), lane = tid & 63, wid = tid >> 6, fr = lane & 15, g = lane >> 4, mb = wid >> 1, nh = wid & 1;
    float* Yl = (float*)(lds + 16384);
    const bf16_t* R = SCR16(p, SCR_R); const bf16_t* Kp = SCR16(p, SCR_K); const bf16_t* V = l == 0 ? VFIRST(p) : SCR16(p, SCR_V);
    const bf16_t* G = SCR16(p, SCR_G); const bf16_t* SC = SCR16(p, SCR_W); const float* bonus = (const float*)(p.ws + OFF_SCR + SCR_LO1); bf16_t* Z = SCR16(p, SCR_Z);
    for (int unit = blockIdx.x; unit < NB * 16 * NCHR; unit += gridDim.x) {
        const int c = unit % NCHR, bh = unit / NCHR, b = bh >> 4, h = bh & 15;
        const size_t base = ((size_t)(b * LP + 64 * c)) * D_ + h * 64;
        const int hc = l * D_ + h * 64 + lane;
        const float c_lg = p.in[I_LNXG][hc], c_lb = p.in[I_LNXB][hc];
        {
            const int row = tid >> 3, c8 = tid & 7;
            const u32x4 rp = *(const u32x4*)(R + base + (size_t)row * D_ + c8 * 8);
            const u32x4 sc = *(const u32x4*)(SC + (size_t)unit * 4096 + row * 64 + c8 * 8);
            const unsigned o = (unsigned)(row * 128 + ((c8 ^ ((row >> 1) & 7)) << 4));
            *(u32x4*)(lds + o) = rp; *(u32x4*)(lds + 8192 + o) = sc;
        }
        __syncthreads();
        f32x4 acc[2]; ZACC(acc);
        mm64(lds, lds + 8192, mb, nh, fr, g, acc);
        const int row = 16 * mb + fr;
#pragma unroll
        for (int nbi = 0; nbi < 2; ++nbi) {
            const int c0 = 16 * (2 * nh + nbi) + 4 * g;
            const u32x2 y0 = *(const u32x2*)(Kp + base + (size_t)row * D_ + c0);
            float* d = Yl + row * 65 + c0;
            d[0] = acc[nbi][0] + bflo(y0.x); d[1] = acc[nbi][1] + bfhi(y0.x); d[2] = acc[nbi][2] + bflo(y0.y); d[3] = acc[nbi][3] + bfhi(y0.y);
        }
        __syncthreads();
#pragma unroll
        for (int j = 0; j < 8; ++j) {
            const int t = 8 * wid + j;
            const float y = Yl[t * 65 + lane];
            const float mean = wave_sum(y) * (1.0f / 64.0f);
            const float dlt = y - mean;
            const float var = wave_sum(dlt * dlt) * (1.0f / 64.0f);
            const float yn = dlt * rsqrtf(var + 64e-5f) * c_lg + c_lb;
            const size_t e = base + (size_t)t * D_ + lane;
            const float bon = bonus[((size_t)(b * LP + 64 * c + t)) * 16 + h];
            Z[e] = f2bf((yn + bon * bf2f(V[e])) * bf2f(G[e]));
        }
        __syncthreads();
    }
}

DI void phase_outproj(const Params& p, unsigned char* lds) {
    EpiResid e; e.out = p.out; e.ws = p.ws;
    for (int u = blockIdx.x; u < MT * 4; u += gridDim.x) {
        const int mt = u >> 2, nt = u & 3;
        e.m0 = mt * 128; e.n0 = nt * 256;
        APlain a; a.base = SCR16(p, SCR_Z) + (size_t)(mt * 128) * D_; a.ld = D_;
        gemm_tile<128, 256, 64, 64, true>(lds, a, WL_OUT(p) + (size_t)(nt * 256) * D_, D_, D_, e);
    }
}

template <bool COMBINE>
DI void phase_ln(const Params& p, const float* gam, const float* bet) {
    const int tid0 = tid_(); const int lane = tid0 & 63, wid = tid0 >> 6;
    bf16_t* h16 = H16(p);
    const int* tok_slot = (const int*)(p.ws + OFF_TAB) + 2 * NSLOT;
    const bf16_t* Y = SCR16(p, SCR_Y);
    const int c0 = lane * 16;
    f32x4 g4[4], b4[4];
#pragma unroll
    for (int i = 0; i < 4; ++i) { g4[i] = *(const f32x4*)(gam + c0 + 4 * i); b4[i] = *(const f32x4*)(bet + c0 + 4 * i); }
    for (int n = blockIdx.x * 8 + wid; n < NTOK; n += gridDim.x * 8) {
        const int b = n >= LSEQ ? 1 : 0, t = n - b * LSEQ, prow = b * LP + t;
        float* hr = h32row(p, prow);
        f32x4 x[4];
#pragma unroll
        for (int i = 0; i < 4; ++i) x[i] = *(const f32x4*)(hr + c0 + 4 * i);
        if (COMBINE) {
#pragma unroll
            for (int i = 0; i < 4; ++i) x[i] = x[i] * DN_ALPHA;
#pragma unroll
            for (int k = 0; k < 9; ++k) {
                const bf16_t* src = k == 8 ? h16 + (size_t)prow * D_ : Y + (size_t)tok_slot[n * 8 + k] * D_;
                const u32x4 w0 = *(const u32x4*)(src + c0), w1 = *(const u32x4*)(src + c0 + 8);
                x[0][0] += bflo(w0.x); x[0][1] += bfhi(w0.x); x[0][2] += bflo(w0.y); x[0][3] += bfhi(w0.y);
                x[1][0] += bflo(w0.z); x[1][1] += bfhi(w0.z); x[1][2] += bflo(w0.w); x[1][3] += bfhi(w0.w);
                x[2][0] += bflo(w1.x); x[2][1] += bfhi(w1.x); x[2][2] += bflo(w1.y); x[2][3] += bfhi(w1.y);
                x[3][0] += bflo(w1.z); x[3][1] += bfhi(w1.z); x[3][2] += bflo(w1.w); x[3][3] += bfhi(w1.w);
            }
        }
        float s = 0.f;
#pragma unroll
        for (int i = 0; i < 4; ++i) s += (x[i][0] + x[i][1]) + (x[i][2] + x[i][3]);
        const float mean = wave_sum(s) * (1.0f / 1024.0f);
        float qv = 0.f;
#pragma unroll
        for (int i = 0; i < 4; ++i) { const f32x4 d = x[i] - mean; qv += (d[0] * d[0] + d[1] * d[1]) + (d[2] * d[2] + d[3] * d[3]); }
        const float rstd = rsqrtf(wave_sum(qv) * (1.0f / 1024.0f) + LN_EPS);
        u32x4 o0, o1;
#pragma unroll
        for (int i = 0; i < 4; ++i) { x[i] = (x[i] - mean) * rstd * g4[i] + b4[i]; *(f32x4*)(hr + c0 + 4 * i) = x[i]; }
        o0.x = cvt_pk_bf16(x[0][0], x[0][1]); o0.y = cvt_pk_bf16(x[0][2], x[0][3]); o0.z = cvt_pk_bf16(x[1][0], x[1][1]); o0.w = cvt_pk_bf16(x[1][2], x[1][3]);
        o1.x = cvt_pk_bf16(x[2][0], x[2][1]); o1.y = cvt_pk_bf16(x[2][2], x[2][3]); o1.z = cvt_pk_bf16(x[3][0], x[3][1]); o1.w = cvt_pk_bf16(x[3][2], x[3][3]);
        *(u32x4*)(h16 + (size_t)prow * D_ + c0) = o0; *(u32x4*)(h16 + (size_t)prow * D_ + c0 + 8) = o1;
    }
}

DI void phase_qkv(const Params& p, unsigned char* lds, int l) {
    const int nq = MT * 4, nk = l == 2 ? MT * 4 : 0, nv = nk;
    for (int u = blockIdx.x; u < nq + nk + nv; u += gridDim.x) {
        if (u < nq + nk) {
            const bool isq = u < nq; const int r = isq ? u : u - nq, mt = r >> 2, nt = r & 3;
            EpiQK e; e.m0 = mt * 128; e.n0 = nt * 256; e.dst = isq ? SCR16(p, 0) : KBUF(p); e.scale = isq ? 0.125f * 1.4426950408889634f : 1.0f;
            APlain a; a.base = H16(p) + (size_t)(mt * 128) * D_; a.ld = D_;
            const bf16_t* B = isq ? WL_WQ(p) + (size_t)(nt * 256) * D_ : WL_BIG(p) + (size_t)(nt * 256) * D_;
            gemm_tile<128, 256, 64, 64, true>(lds, a, B, D_, D_, e);
        } else {
            const int r = u - nq - nk, mt = r >> 2, nt = r & 3;
            EpiVt e; e.m0 = mt * 128; e.n0 = nt * 256; e.dst = VTBUF(p);
            APlain a; a.base = H16(p) + (size_t)(mt * 128) * D_; a.ld = D_;
            gemm_tile<128, 256, 64, 64, false>(lds, a, WL_BIG(p) + (size_t)(1024 + nt * 256) * D_, D_, D_, e);
        }
    }
}

DI int crow32(int i, int h) { return (i & 3) + 8 * (i >> 2) + 4 * h; }

DI void phase_attn(const Params& p, unsigned char* lds, int j, int rep = 0) {
    const int tid = tid_(), lane = tid & 63, wid = tid >> 6, cmap = wid >> 2, rg = wid & 3, ql = lane & 31, hh = lane >> 5;
    const float lam_init = j == 0 ? (float)(0.8 - 0.6 * 0.5488116360940264) : (float)(0.8 - 0.6 * 0.4065696597405991);
    float d1 = 0.f, d2 = 0.f;
    for (int i = 0; i < 64; ++i) { d1 += p.in[I_LQ1][j * 64 + i] * p.in[I_LK1][j * 64 + i]; d2 += p.in[I_LQ2][j * 64 + i] * p.in[I_LK2][j * 64 + i]; }
    const float lam = __expf(d1) - __expf(d2) + lam_init;
    const float post = 1.0f - lam_init;
    const bf16_t* Q = SCR16(p, 0); const bf16_t* Kb = KBUF(p); const bf16_t* Vt = VTBUF(p); bf16_t* Z = SCR16(p, SCR_Z);
    const float* subg = p.in[I_SUBG] + j * 128;
    unsigned* ctr = CTRL(p) + CT_ATTNQ + 64 * (j + 2 * rep);
    constexpr int STG = 32768;
    unsigned* s_u = (unsigned*)(lds + 2 * STG);
    constexpr int NQB = LP / 128;
    const int total = NB * 8 * NQB;
    const int krow = tid >> 3, kc8 = tid & 7;
    const unsigned koff = krow * 128 + ((kc8 ^ ((krow >> 1) & 7)) << 4);
    for (;;) {
        if (tid == 0) *s_u = atomicAdd(ctr, 1u);
        __syncthreads();
        const int u = (int)*s_u;
        __syncthreads();
        if (u >= total) break;
        const int qb = NQB - 1 - u / 16, bh = u & 15, b = bh >> 3, head = bh & 7;
        const int q0 = qb * 128 + rg * 32;
        bf16x8 qf[4];
        {
            const bf16_t* qp = Q + (((size_t)(b * 16 + head * 2 + cmap)) * LP + q0 + ql) * 64 + 8 * hh;
#pragma unroll
            for (int s = 0; s < 4; ++s) qf[s] = *(const bf16x8*)(qp + 16 * s);
        }
        const bf16_t* k0p = Kb + (((size_t)(b * 16 + head * 2 + 0)) * LP) * 64 + krow * 64 + kc8 * 8;
        const bf16_t* k1p = Kb + (((size_t)(b * 16 + head * 2 + 1)) * LP) * 64 + krow * 64 + kc8 * 8;
        const bf16_t* vp0 = Vt + ((size_t)(b * 1024 + head * 128 + krow)) * LP + kc8 * 8;
        const bf16_t* vp1 = vp0 + (size_t)64 * LP;
        const int ntile = 2 * qb + 2;
        f32x16 O[4];
#pragma unroll
        for (int i = 0; i < 4; ++i)
#pragma unroll
            for (int r = 0; r < 16; ++r) O[i][r] = 0.f;
        float m_run = -1e30f, l_run = 0.f;
        u32x4 rk0, rk1, rv0, rv1;
        rk0 = *(const u32x4*)(k0p); rk1 = *(const u32x4*)(k1p); rv0 = *(const u32x4*)(vp0); rv1 = *(const u32x4*)(vp1);
        auto stage_write = [&](unsigned char* st) {
            *(u32x4*)(st + koff) = rk0; *(u32x4*)(st + 8192 + koff) = rk1;
            {
                const int r0 = krow, r1 = krow + 64;
                const int s0 = (r0 >> 1) & 15, s1 = (r1 >> 1) & 15;
                unsigned char* vb = st + 16384;
                *(u32x2*)(vb + r0 * 128 + (((2 * kc8) ^ s0) << 3)) = (u32x2){rv0.x, rv0.y};
                *(u32x2*)(vb + r0 * 128 + (((2 * kc8 + 1) ^ s0) << 3)) = (u32x2){rv0.z, rv0.w};
                *(u32x2*)(vb + r1 * 128 + (((2 * kc8) ^ s1) << 3)) = (u32x2){rv1.x, rv1.y};
                *(u32x2*)(vb + r1 * 128 + (((2 * kc8 + 1) ^ s1) << 3)) = (u32x2){rv1.z, rv1.w};
            }
        };
        stage_write(lds);
        __syncthreads();
        for (int kt = 0; kt < ntile; ++kt) {
            const unsigned char* cur = lds + (kt & 1) * STG;
            const bool more = kt + 1 < ntile;
            if (more) {
                const size_t ko = (size_t)(kt + 1) * 64 * 64, vo = (size_t)(kt + 1) * 64;
                rk0 = *(const u32x4*)(k0p + ko); rk1 = *(const u32x4*)(k1p + ko); rv0 = *(const u32x4*)(vp0 + vo); rv1 = *(const u32x4*)(vp1 + vo);
            }
            const int key0 = kt * 64;
            if (key0 <= q0 + 31) {
                const unsigned char* kst = cur + cmap * 8192;
                f32x16 sc[2];
#pragma unroll
                for (int kb = 0; kb < 2; ++kb) {
#pragma unroll
                    for (int r = 0; r < 16; ++r) sc[kb][r] = 0.f;
                    const int row = kb * 32 + ql;
#pragma unroll
                    for (int s = 0; s < 4; ++s) {
                        const bf16x8 kf = *(const bf16x8*)(kst + row * 128 + (((2 * s + hh) ^ ((row >> 1) & 7)) << 4));
                        sc[kb] = __builtin_amdgcn_mfma_f32_32x32x16_bf16(kf, qf[s], sc[kb], 0, 0, 0);
                    }
                }
                if (key0 + 63 > q0) {
                    const int qq = q0 + ql;
#pragma unroll
                    for (int kb = 0; kb < 2; ++kb)
#pragma unroll
                        for (int r = 0; r < 16; ++r) { const int key = key0 + kb * 32 + crow32(r, hh); if (key > qq) sc[kb][r] = -INFINITY; }
                }
                float mx = sc[0][0];
#pragma unroll
                for (int kb = 0; kb < 2; ++kb)
#pragma unroll
                    for (int r = 0; r < 16; ++r) mx = fmaxf(mx, sc[kb][r]);
                mx = fmaxf(mx, __shfl_xor(mx, 32));
                const float m_new = fmaxf(m_run, mx);
                const float alpha = __builtin_amdgcn_exp2f(m_run - m_new);
                m_run = m_new;
                float ps = 0.f;
#pragma unroll
                for (int kb = 0; kb < 2; ++kb)
#pragma unroll
                    for (int r = 0; r < 16; ++r) { const float e = __builtin_amdgcn_exp2f(sc[kb][r] - m_new); sc[kb][r] = e; ps += e; }
                l_run = l_run * alpha + ps;
#pragma unroll
                for (int i = 0; i < 4; ++i)
#pragma unroll
                    for (int r = 0; r < 16; ++r) O[i][r] *= alpha;
                const unsigned char* vst = cur + 16384;
#pragma unroll
                for (int s = 0; s < 4; ++s) {
                    const int kb = s >> 1, r0 = 8 * (s & 1);
                    u32x4 pw;
                    pw.x = cvt_pk_bf16(sc[kb][r0 + 0], sc[kb][r0 + 1]); pw.y = cvt_pk_bf16(sc[kb][r0 + 2], sc[kb][r0 + 3]);
                    pw.z = cvt_pk_bf16(sc[kb][r0 + 4], sc[kb][r0 + 5]); pw.w = cvt_pk_bf16(sc[kb][r0 + 6], sc[kb][r0 + 7]);
                    const bf16x8 pf = __builtin_bit_cast(bf16x8, pw);
#pragma unroll
                    for (int dvb = 0; dvb < 4; ++dvb) {
                        const int row = dvb * 32 + ql, sw = (row >> 1) & 15;
                        const u32x2 lo = *(const u32x2*)(vst + row * 128 + (((4 * s + hh) ^ sw) << 3));
                        const u32x2 hi = *(const u32x2*)(vst + row * 128 + (((4 * s + 2 + hh) ^ sw) << 3));
                        const bf16x8 vf = __builtin_bit_cast(bf16x8, (u32x4){lo.x, lo.y, hi.x, hi.y});
                        O[dvb] = __builtin_amdgcn_mfma_f32_32x32x16_bf16(vf, pf, O[dvb], 0, 0, 0);
                    }
                }
            }
            if (more) stage_write(lds + ((kt + 1) & 1) * STG);
            __syncthreads();
        }
        const float l_tot = l_run + __shfl_xor(l_run, 32);
        const float inv = 1.0f / l_tot;
        float* xb = (float*)lds + rg * 4096;
        if (cmap == 1) {
            const float sc1 = lam * inv;
#pragma unroll
            for (int i = 0; i < 4; ++i)
#pragma unroll
                for (int r = 0; r < 16; ++r) xb[(i * 16 + r) * 64 + lane] = O[i][r] * sc1;
        }
        __syncthreads();
        if (cmap == 0) {
            float ss = 0.f;
#pragma unroll
            for (int i = 0; i < 4; ++i)
#pragma unroll
                for (int r = 0; r < 16; ++r) { const float o = O[i][r] * inv - xb[(i * 16 + r) * 64 + lane]; O[i][r] = o; ss += o * o; }
            ss += __shfl_xor(ss, 32);
            const float rn = rsqrtf(ss * (1.0f / 128.0f) + 1e-5f) * post;
            bf16_t* zp = Z + ((size_t)(b * LP + q0 + ql)) * D_ + head * 128;
#pragma unroll
            for (int i = 0; i < 4; ++i)
#pragma unroll
                for (int g = 0; g < 4; ++g) {
                    const int dv = i * 32 + 8 * g + 4 * hh;
                    const f32x4 sg = *(const f32x4*)(subg + dv);
                    f32x4 o; o[0] = O[i][4 * g + 0] * rn * sg[0]; o[1] = O[i][4 * g + 1] * rn * sg[1]; o[2] = O[i][4 * g + 2] * rn * sg[2]; o[3] = O[i][4 * g + 3] * rn * sg[3];
                    st_bf4(zp + dv, o);
                }
        }
        __syncthreads();
    }
}

DI int* TAB_IDX(const Params& p) { return (int*)(p.ws + OFF_TAB); }
DI float* TAB_GATE(const Params& p) { return (float*)(p.ws + OFF_TAB) + NSLOT; }
DI int* TAB_TOKSLOT(const Params& p) { return (int*)(p.ws + OFF_TAB) + 2 * NSLOT; }
DI int* TAB_SLOTTOK(const Params& p) { return (int*)(p.ws + OFF_TAB) + 3 * NSLOT; }
DI float* TAB_SLOTGATE(const Params& p) { return (float*)(p.ws + OFF_TAB) + 4 * NSLOT; }
DI int* TAB_TILES(const Params& p) { return (int*)(p.ws + OFF_TAB) + 5 * NSLOT; }

DI void phase_router(const Params& p, unsigned char* lds, int l) {
    float* lg = (float*)(lds + 2 * (128 + 64) * 128);
    unsigned* hist = (unsigned*)(lds + 2 * (128 + 64) * 128 + 128 * 65 * 4);
    const int tid = tid_(), lane = tid & 63, wid = tid >> 6;
    if (tid < 64) hist[tid] = 0u;
    __syncthreads();
    const float bias = p.in[I_RTB][l * NE + lane];
    int* idx = TAB_IDX(p); float* gt = TAB_GATE(p);
    for (int mt = blockIdx.x; mt < MT; mt += gridDim.x) {
        EpiLds e; e.dst = lg;
        APlain a; a.base = H16(p) + (size_t)(mt * 128) * D_; a.ld = D_;
        gemm_tile<128, 64, 16, 64, true>(lds, a, WS_RT(p), D_, D_, e);
        __syncthreads();
        for (int rr = 0; rr < 16; ++rr) {
            const int prow = mt * 128 + wid * 16 + rr;
            const int b = prow >= LP ? 1 : 0, t = prow - b * LP;
            if (t >= LSEQ) continue;
            const int n = b * LSEQ + t;
            const float s = sigmoidf_(lg[(wid * 16 + rr) * 65 + lane]);
            const float sel = s + bias;
            const float m1 = red8_max(sel);
            const unsigned long long eq = __ballot(sel == m1);
            const unsigned gb = (unsigned)(eq >> ((lane >> 3) * 8)) & 0xffu;
            const int first = __builtin_ctz(gb | 0x100u);
            const float sel2 = (lane & 7) == first ? -INFINITY : sel;
            const float gs = m1 + red8_max(sel2);
            int rank = 0;
#pragma unroll
            for (int g = 0; g < 8; ++g) { const float o = rdlane(gs, g * 8); rank += (o > gs || (o == gs && g < (lane >> 3))) ? 1 : 0; }
            float cur = rank < 4 ? sel : -INFINITY;
            float wsum = 0.f, my_s = 0.f; int my_i = 0;
#pragma unroll
            for (int k = 0; k < 8; ++k) {
                const float m = wave_max(cur);
                const unsigned long long bal = __ballot(cur == m);
                const int win = __builtin_ctzll(bal | (1ull << 63));
                const float swv = rdlane(s, win);
                wsum += swv;
                if (lane == k) { my_i = win; my_s = swv; }
                if (lane == win) cur = -INFINITY;
            }
            if (lane < 8) {
                idx[n * 8 + lane] = my_i; gt[n * 8 + lane] = my_s / wsum * 2.5f;
                atomicAdd(hist + my_i, 1u);
            }
        }
        __syncthreads();
    }
    __syncthreads();
    if (tid < 64 && hist[tid]) atomicAdd(CTRL(p) + CT_CNT + 64 * l + tid, (unsigned)hist[tid]);
}

DI void phase_scatter(const Params& p, unsigned char* lds, int l) {
    unsigned* cnt = (unsigned*)lds; unsigned* lh = cnt + 64; unsigned* lbase = lh + 64; unsigned* lcur = lbase + 64; unsigned* start = lcur + 64;
    const int tid = tid_();
    unsigned* gc = CTRL(p) + CT_CNT + 64 * l; unsigned* gcur = CTRL(p) + CT_CUR + 64 * l;
    if (tid < 64) { cnt[tid] = __hip_atomic_load(gc + tid, __ATOMIC_RELAXED, __HIP_MEMORY_SCOPE_AGENT); lh[tid] = 0u; lcur[tid] = 0u; }
    __syncthreads();
    if (tid < 64) { unsigned s = 0; for (int e = 0; e < tid; ++e) s += cnt[e]; start[tid] = s; }
    const int per = (NTOK + gridDim.x - 1) / gridDim.x;
    const int n0 = blockIdx.x * per, n1 = n0 + per < NTOK ? n0 + per : NTOK;
    const int* idx = TAB_IDX(p); const float* gt = TAB_GATE(p);
    int* tok_slot = TAB_TOKSLOT(p); int* slot_tok = TAB_SLOTTOK(p); float* slot_gate = TAB_SLOTGATE(p);
    __syncthreads();
    for (int i = n0 * 8 + tid; i < n1 * 8; i += NTHR) atomicAdd(lh + idx[i], 1u);
    __syncthreads();
    if (tid < 64) lbase[tid] = start[tid] + (lh[tid] ? atomicAdd(gcur + tid, (unsigned)lh[tid]) : 0u);
    __syncthreads();
    for (int i = n0 * 8 + tid; i < n1 * 8; i += NTHR) {
        const int e = idx[i], n = i >> 3;
        const unsigned pos = lbase[e] + atomicAdd(lcur + e, 1u);
        const int b = n >= LSEQ ? 1 : 0, t = n - b * LSEQ;
        slot_tok[pos] = b * LP + t; slot_gate[pos] = gt[i]; tok_slot[i] = (int)pos;
    }
    if (blockIdx.x == 0 && tid < 64) {
        unsigned tb = 0; for (int e = 0; e < tid; ++e) tb += (cnt[e] + 127) >> 7;
        const unsigned nt = (cnt[tid] + 127) >> 7;
        int* tiles = TAB_TILES(p);
        for (unsigned i = 0; i < nt; ++i) { int* tp = tiles + (tb + i) * 4; tp[0] = tid; tp[1] = (int)(start[tid] + 128 * i); const int rem = (int)cnt[tid] - 128 * (int)i; tp[2] = rem < 128 ? rem : 128; tp[3] = 0; }
        if (tid == 63) CTRL(p)[CT_NT + l] = tb + nt;
    }
}

DI void phase_m1(const Params& p, unsigned char* lds, int l) {
    const int T = (int)CTRL(p)[CT_NT + l];
    const int* tiles = TAB_TILES(p);
    for (int u = blockIdx.x; u < (T + MT) * 2; u += gridDim.x) {
        const int tile = u >> 1, half = u & 1;
        EpiM1 e; e.n0 = half * 256;
        if (tile < T) {
            const int ex = tiles[tile * 4], s0 = tiles[tile * 4 + 1], nr = tiles[tile * 4 + 2];
            e.dst = SCR16(p, SCR_H); e.gate = TAB_SLOTGATE(p); e.row0 = s0; e.nrows = nr;
            AGather a; a.base = H16(p); a.rows = TAB_SLOTTOK(p) + s0; a.nrows = nr;
            gemm_tile<128, 256, 64, 64, true>(lds, a, WM_GU(p) + ((size_t)ex * 512 + half * 256) * D_, D_, D_, e);
        } else {
            const int mt = tile - T;
            e.dst = SCR16(p, SCR_HS); e.gate = nullptr; e.row0 = mt * 128; e.nrows = 128;
            APlain a; a.base = H16(p) + (size_t)(mt * 128) * D_; a.ld = D_;
            gemm_tile<128, 256, 64, 64, true>(lds, a, WS_GU(p) + (size_t)(half * 256) * D_, D_, D_, e);
        }
    }
}
DI void phase_m2(const Params& p, unsigned char* lds, int l) {
    const int T = (int)CTRL(p)[CT_NT + l];
    const int* tiles = TAB_TILES(p);
    for (int u = blockIdx.x; u < (T + MT) * 4; u += gridDim.x) {
        const int tile = u >> 2, nq = u & 3;
        EpiM2 e; e.n0 = nq * 256;
        if (tile < T) {
            const int ex = tiles[tile * 4], s0 = tiles[tile * 4 + 1], nr = tiles[tile * 4 + 2];
            e.dst = SCR16(p, SCR_Y); e.row0 = s0; e.nrows = nr;
            int last = NSLOT - 1 - s0; if (last > 127) last = 127;
            AClamp a;
            a.base = SCR16(p, SCR_H) + (size_t)s0 * FF; a.last = last;
            gemm_tile<128, 256, 64, 64, true>(lds, a, WM_DN(p) + ((size_t)ex * 1024 + nq * 256) * FF, FF, FF, e);
        } else {
            const int mt = tile - T;
            e.dst = H16(p); e.row0 = mt * 128; e.nrows = 128;
            APlain a; a.base = SCR16(p, SCR_HS) + (size_t)(mt * 128) * FF; a.ld = FF;
            gemm_tile<128, 256, 64, 64, true>(lds, a, WS_DN(p) + (size_t)(nq * 256) * FF, FF, FF, e);
        }
    }
}

__global__ void __launch_bounds__(NTHR, 2) mega(Params p) {
    extern __shared__ __attribute__((aligned(16))) unsigned char lds[];
    LAS unsigned* xbw = (LAS unsigned*)(lds + LDS_BAR);
    if (threadIdx.x == 0) { xbw[0] = 0u; xbw[1] = 0u; xbw[2] = 0u; xbw[3] = 0u; }
    __syncthreads();
    XcdBarrier bar = xcd_barrier_post(CTRL(p), (volatile LAS unsigned*)xbw);
    phase_init(p);
    phase_weights(p, lds, 0);
    xcd_barrier(bar);
    for (int l = 0; l < 4; ++l) {
        if (l < 2) {
            phase_r1(p, lds, l); xcd_barrier(bar);
            phase_r2(p, lds, l); xcd_barrier(bar);
#ifdef SCAN_SEQ
            phase_scan(p, lds, l); xcd_barrier(bar);
#else
            phase_scanA(p, lds, l); xcd_barrier(bar);
            phase_scanB(p, l); xcd_barrier(bar);
#ifdef REP_B
            phase_scanB(p, l); xcd_barrier(bar);
#endif
            phase_scanC(p, lds, l); xcd_barrier(bar);
#ifdef REP_C
            phase_scanC(p, lds, l); xcd_barrier(bar);
#endif
#endif
        } else {
            phase_qkv(p, lds, l); xcd_barrier(bar);
            phase_attn(p, lds, l - 2); xcd_barrier(bar);
#ifdef REP_ATTN
            phase_attn(p, lds, l - 2, 1); xcd_barrier(bar);
#endif
        }
        phase_outproj(p, lds); xcd_barrier(bar);
        phase_ln<false>(p, p.in[I_LNMG] + l * D_, p.in[I_LNMB] + l * D_); xcd_barrier(bar);
        phase_router(p, lds, l); xcd_barrier(bar);
        phase_scatter(p, lds, l); xcd_barrier(bar);
        phase_m1(p, lds, l); xcd_barrier(bar);
        phase_m2(p, lds, l); xcd_barrier(bar);
        phase_ln<true>(p, p.in[I_LNFG] + l * D_, p.in[I_LNFB] + l * D_);
        if (l < 3) phase_weights(p, lds, l + 1);
        xcd_barrier(bar);
    }
}

extern "C" void kernel_launch(void* const* d_in, const int* in_sizes, int n_in, void* d_out, int out_size, void* d_ws, size_t ws_size, hipStream_t stream) {
    constexpr size_t kDynLds = LDS_BAR + 256;
    static int grid = 0;
    if (!grid) {
        int dev = 0, cus = 0, per_cu = 0;
        hipGetDevice(&dev);
        hipDeviceGetAttribute(&cus, hipDeviceAttributeMultiprocessorCount, dev);
        hipFuncSetAttribute((const void*)mega, hipFuncAttributeMaxDynamicSharedMemorySize, (int)kDynLds);
        hipOccupancyMaxActiveBlocksPerMultiprocessor(&per_cu, mega, NTHR, kDynLds);
        grid = cus * (per_cu < 1 ? per_cu : 1);
        if (grid <= 0) grid = 0;
    }
    if (n_in < 41 || ws_size < WS_NEED || grid <= 0) { fprintf(stderr, "kernel_launch: bad config (n_in %d ws %zu need %zu grid %d)\n", n_in, ws_size, (size_t)WS_NEED, grid); return; }
    hipMemsetAsync(d_ws, 0, 65536, stream);
    Params p; memset(&p, 0, sizeof(p));
    for (int i = 0; i < 41; ++i) p.in[i] = (const float*)d_in[i];
    p.out = (float*)d_out; p.ws = (unsigned char*)d_ws;
    hipLaunchKernelGGL(mega, dim3(grid), dim3(NTHR), kDynLds, stream, p);
}
#ifdef PHASE_TEST
#define PK(name, body) __global__ void __launch_bounds__(NTHR, 2) name(Params p, int l) { extern __shared__ __attribute__((aligned(16))) unsigned char lds[]; body; }
PK(t_init, phase_init(p))
PK(t_weights, phase_weights(p, lds, l))
PK(t_r1, phase_r1(p, lds, l))
PK(t_r2, phase_r2(p, lds, l))
PK(t_scan, phase_scan(p, lds, l))
PK(t_scanA, phase_scanA(p, lds, l))
PK(t_scanB, phase_scanB(p, l))
PK(t_scanC, phase_scanC(p, lds, l))
PK(t_outproj, phase_outproj(p, lds))
PK(t_ln0, phase_ln<false>(p, p.in[I_LNMG], p.in[I_LNMB]))
PK(t_ln1, phase_ln<true>(p, p.in[I_LNMG], p.in[I_LNMB]))
PK(t_qkv, phase_qkv(p, lds, l))
PK(t_attn, phase_attn(p, lds, l))
PK(t_router, phase_router(p, lds, l))
PK(t_scatter, phase_scatter(p, lds, l))
PK(t_m1, phase_m1(p, lds, l))
PK(t_m2, phase_m2(p, lds, l))
#endif
```

```cpp
#include <hip/hip_runtime.h>
#include <stdint.h>
#include <stdio.h>
#include <string.h>

#define DI __device__ __forceinline__
typedef unsigned short bf16_t;
typedef short bf16x8 __attribute__((ext_vector_type(8)));
typedef short s16x4 __attribute__((ext_vector_type(4)));
typedef float f32x2 __attribute__((ext_vector_type(2)));
typedef float f32x4 __attribute__((ext_vector_type(4)));
typedef float f32x16 __attribute__((ext_vector_type(16)));
typedef unsigned u32x4 __attribute__((ext_vector_type(4)));
typedef unsigned u32x2 __attribute__((ext_vector_type(2)));

constexpr int D_ = 1024, NB = 2, SEQ = 16384, NMETA = 16, LSEQ = SEQ + NMETA, LP = 16512, NP = NB * LP, NTOK = NB * LSEQ;
constexpr int NE = 64, TOPK = 8, FF = 256, NSLOT = NTOK * TOPK;
constexpr int NTHR = 512;
constexpr int LDS_BAR = 145408;
constexpr int NCHR = 257;
constexpr int MT = NP / 128;
constexpr float DN_ALPHA = 1.6817928305074290f;
constexpr float LN_EPS = 1e-5f;
constexpr int WBIG_ROWS = 3584, LO1_W = 384;

constexpr size_t AL(size_t x) { return (x + 255) & ~(size_t)255; }
constexpr size_t OFF_CTRL = 0;
constexpr size_t OFF_META32 = 65536;
constexpr size_t OFF_H16 = OFF_META32 + (size_t)NB * NMETA * D_ * 4;
constexpr size_t SZ_ACT16 = (size_t)NP * D_ * 2;
constexpr size_t OFF_KV = AL(OFF_H16 + SZ_ACT16 + 2048);
constexpr size_t OFF_WL = AL(OFF_KV + 2 * SZ_ACT16);
constexpr size_t SZ_WL = (size_t)WBIG_ROWS * 2048 * 2 + (size_t)1024 * LO1_W * 2 + (size_t)1024 * 1024 * 2;
constexpr size_t OFF_WSH = AL(OFF_WL + SZ_WL);
constexpr size_t SZ_WSH = (size_t)512 * 1024 * 2 + (size_t)1024 * 256 * 2 + (size_t)64 * 1024 * 2;
constexpr size_t OFF_WMOE = AL(OFF_WSH + SZ_WSH);
constexpr size_t SZ_WMOE = (size_t)NE * (512 * 1024 + 1024 * 256) * 2;
constexpr size_t OFF_TAB = AL(OFF_WMOE + SZ_WMOE);
constexpr size_t SZ_TAB = (size_t)NSLOT * 4 * 5 + 65536;
constexpr size_t OFF_SCR = AL(OFF_TAB + SZ_TAB);
constexpr size_t SCR_R = 0, SCR_K = SZ_ACT16, SCR_V = 2 * SZ_ACT16, SCR_G = 3 * SZ_ACT16, SCR_A = 4 * SZ_ACT16, SCR_Z = 5 * SZ_ACT16;
constexpr size_t SCR_W = 6 * SZ_ACT16;
constexpr size_t SCR_LO1 = SCR_W + 2 * SZ_ACT16;
constexpr size_t SCR_QS = SCR_LO1 + (size_t)NP * LO1_W * 2;
constexpr size_t SZ_SCR_RW = SCR_QS + SZ_ACT16;
constexpr size_t SCR_H = 0;
constexpr size_t SCR_HS = AL((size_t)NSLOT * 256 * 2);
constexpr size_t SCR_Y = AL(SCR_HS + (size_t)NP * 256 * 2);
constexpr size_t SZ_SCR_MOE = SCR_Y + (size_t)NSLOT * 1024 * 2;
constexpr size_t SZ_SCR = SZ_SCR_MOE > SZ_SCR_RW ? SZ_SCR_MOE : SZ_SCR_RW;
constexpr size_t WS_NEED = OFF_SCR + SZ_SCR + 4096;

constexpr int CT_ATTNQ = 4096;
constexpr int CT_CNT = 4352;
constexpr int CT_CUR = 4608;
constexpr int CT_NT = 4864;

struct Params {
    const float* in[41];
    float* out;
    unsigned char* ws;
};
enum { I_X = 0, I_META, I_LNMG, I_LNMB, I_LNFG, I_LNFB, I_MU, I_WRKV, I_W0, I_WL1, I_WL2, I_A0, I_AL1, I_AL2, I_GL1, I_GL2, I_KK, I_KA, I_RK, I_LNXG, I_LNXB, I_WOUT,
       I_V0, I_VL1, I_VL2, I_KVW, I_WQ, I_LQ1, I_LK1, I_LQ2, I_LK2, I_SUBG, I_DAWO, I_RTW, I_RTB, I_MG, I_MU_, I_MD, I_SG, I_SU, I_SD };

#define XB_TMO      128
#define XB_XCNT(j)  (256  + 64 * (j))
#define XB_XSUB(j)  (1280 + 64 * (j))
#define XB_XGEN(j)  (2304 + 64 * (j))
#define XB_TOP      3328
#define XB_TOPGEN   3392
#define XCD_BAR_WORDS 3456
#define XB_SPIN_CAP (1u << 22)
#define LAS __attribute__((address_space(3)))

__device__ __forceinline__ unsigned xb_ld(unsigned* p)              { return __hip_atomic_load(p, __ATOMIC_RELAXED, __HIP_MEMORY_SCOPE_AGENT); }
__device__ __forceinline__ unsigned xb_add(unsigned* p, unsigned v) { return __hip_atomic_fetch_add(p, v, __ATOMIC_RELAXED, __HIP_MEMORY_SCOPE_AGENT); }
__device__ __forceinline__ unsigned xb_xcc_id() { return (unsigned)__builtin_amdgcn_s_getreg((3 << 11) | 20) & 0xFu; }
#define XB_SPIN(cond, bar) do { unsigned _sp = 0; while (cond) { __builtin_amdgcn_s_sleep(1); \
    if ((++_sp & 255u) == 0u) { if (xb_ld(&(bar)[XB_TMO])) break; if (_sp > XB_SPIN_CAP) { atomicAdd(&(bar)[XB_TMO], 1u); break; } } } } while (0)

struct XcdBarrier { unsigned* bar; unsigned x; volatile LAS unsigned* st; };

__device__ __forceinline__ XcdBarrier xcd_barrier_post(unsigned* bar, volatile LAS unsigned* st) {
    XcdBarrier b; b.bar = bar; b.x = xb_xcc_id(); b.st = st;
    if (threadIdx.x == 0) (void)xb_add(&bar[XB_XCNT(b.x)], 1u);
    return b;
}
__device__ __forceinline__ void xcd_barrier_complete(unsigned* bar, unsigned x, unsigned& nloc, unsigned& nx) {
    const unsigned G = gridDim.x * gridDim.y * gridDim.z;
    unsigned sum, cnt, mine, sp = 0u;
    for (;;) {
        sum = 0u; cnt = 0u; mine = 0u;
#pragma unroll
        for (unsigned j = 0; j < 16; ++j) { const unsigned c = xb_ld(&bar[XB_XCNT(j)]); sum += c; cnt += (c > 0u) ? 1u : 0u; mine = (j == x) ? c : mine; }
        if (sum == G) break;
        __builtin_amdgcn_s_sleep(1);
        if ((++sp & 255u) == 0u) { if (xb_ld(&bar[XB_TMO])) break; if (sp > XB_SPIN_CAP) { atomicAdd(&bar[XB_TMO], 1u); break; } }
    }
    nloc = mine > 0u ? mine : 1u; nx = cnt > 0u ? cnt : 1u;
}
__device__ __forceinline__ void xcd_barrier(const XcdBarrier& b) {
    asm volatile("s_waitcnt vmcnt(0)" ::: "memory");
    __syncthreads();
    if (threadIdx.x == 0) {
        unsigned* bar = b.bar;
        __builtin_amdgcn_s_waitcnt(0);
        unsigned nloc = b.st[0], nx = b.st[1];
        if (nloc == 0u) { xcd_barrier_complete(bar, b.x, nloc, nx); b.st[0] = nloc; b.st[1] = nx; }
        const unsigned old = xb_add(&bar[XB_XSUB(b.x)], 1u);
        const unsigned gen = old / nloc;
        if (old + 1u == (gen + 1u) * nloc) {
            __builtin_amdgcn_fence(__ATOMIC_RELEASE, "agent");
            asm volatile("s_waitcnt vmcnt(0)" ::: "memory");
            const unsigned og = xb_add(&bar[XB_TOP], 1u);
            const unsigned tg = og / nx;
            if (og + 1u == (tg + 1u) * nx) xb_add(&bar[XB_TOPGEN], 1u);
            else XB_SPIN(xb_ld(&bar[XB_TOPGEN]) == tg, bar);
            __builtin_amdgcn_fence(__ATOMIC_ACQUIRE, "agent");
            xb_add(&bar[XB_XGEN(b.x)], 1u);
            asm volatile("s_waitcnt vmcnt(0)" ::: "memory");
        } else {
            XB_SPIN(xb_ld(&bar[XB_XGEN(b.x)]) == gen, bar);
            __builtin_amdgcn_fence(__ATOMIC_ACQUIRE, "agent");
            asm volatile("s_waitcnt vmcnt(0)" ::: "memory");
        }
    }
    __syncthreads();
}

DI int tid_() { int t = threadIdx.x; asm volatile("" : "+v"(t)); return t; }
typedef __bf16 bf16v2 __attribute__((ext_vector_type(2)));
DI unsigned cvt_pk_bf16(float lo, float hi) { f32x2 v = {lo, hi}; bf16v2 b = __builtin_convertvector(v, bf16v2); return __builtin_bit_cast(unsigned, b); }
DI float bf2f(bf16_t x) { return __uint_as_float((unsigned)x << 16); }
DI float bflo(unsigned w) { return __uint_as_float(w << 16); }
DI float bfhi(unsigned w) { return __uint_as_float(w & 0xffff0000u); }
DI bf16_t f2bf(float x) { return (bf16_t)(cvt_pk_bf16(x, 0.f) & 0xffffu); }
DI float sigmoidf_(float x) { return 1.0f / (1.0f + __expf(-x)); }
DI float tanhf_(float x) { const float t = __expf(-2.0f * fabsf(x)); const float r = (1.0f - t) / (1.0f + t); return x < 0.f ? -r : r; }
template <int CTRL> DI float dpp_f(float v) { return __builtin_bit_cast(float, __builtin_amdgcn_update_dpp(0, __builtin_bit_cast(int, v), CTRL, 0xF, 0xF, true)); }
DI float rdlane(float v, int l) { return __builtin_bit_cast(float, __builtin_amdgcn_readlane(__builtin_bit_cast(int, v), l)); }
DI float red8_sum(float v) { v += dpp_f<0xB1>(v); v += dpp_f<0x4E>(v); v += dpp_f<0x141>(v); return v; }
DI float red16_sum(float v) { v = red8_sum(v); v += dpp_f<0x140>(v); return v; }
DI float wave_sum(float v) { v = red16_sum(v); return (rdlane(v, 0) + rdlane(v, 16)) + (rdlane(v, 32) + rdlane(v, 48)); }
DI float red8_max(float v) { v = fmaxf(v, dpp_f<0xB1>(v)); v = fmaxf(v, dpp_f<0x4E>(v)); v = fmaxf(v, dpp_f<0x141>(v)); return v; }
DI float wave_max(float v) { v = red8_max(v); v = fmaxf(v, dpp_f<0x140>(v)); return fmaxf(fmaxf(rdlane(v, 0), rdlane(v, 16)), fmaxf(rdlane(v, 32), rdlane(v, 48))); }

DI bf16_t* H16(const Params& p) { return (bf16_t*)(p.ws + OFF_H16 + 2048); }
DI float* h32row_(float* out, unsigned char* ws, int prow) {
    const int b = prow >= LP ? 1 : 0, t = prow - b * LP;
    return t < NMETA ? (float*)(ws + OFF_META32) + (size_t)(b * NMETA + t) * D_ : out + ((size_t)b * SEQ + (t - NMETA)) * D_;
}
DI float* h32row(const Params& p, int prow) { return h32row_(p.out, p.ws, prow); }
DI unsigned* CTRL(const Params& p) { return (unsigned*)(p.ws + OFF_CTRL); }

DI void phase_init(const Params& p) {
    bf16_t* h16 = H16(p);
    const float* x = p.in[I_X]; const float* meta = p.in[I_META];
    const int tid0 = tid_(); const int half = tid0 >> 8, t4 = (tid0 & 255) * 4;
    for (int rp = blockIdx.x; rp < NTOK / 2; rp += gridDim.x) {
        const int n = rp * 2 + half; const int b = n >= LSEQ ? 1 : 0, t = n - b * LSEQ; const int prow = b * LP + t;
        const float* src = t < NMETA ? meta + t * D_ + t4 : x + ((size_t)b * SEQ + (t - NMETA)) * D_ + t4;
        const f32x4 v = *(const f32x4*)src;
        *(f32x4*)(h32row(p, prow) + t4) = v;
        u32x2 w; w.x = cvt_pk_bf16(v[0], v[1]); w.y = cvt_pk_bf16(v[2], v[3]);
        *(u32x2*)(h16 + (size_t)prow * D_ + t4) = w;
    }
    for (int zr = blockIdx.x; zr < 225; zr += gridDim.x) {
        const long prow = zr == 224 ? -1 : (long)(zr / 112) * LP + LSEQ + (zr % 112);
        *(unsigned*)(h16 + prow * D_ + tid0 * 2) = 0u;
    }
}

struct Job { const float* src; int Kvalid, Kpad, N, ldsrc; bf16_t* dst; int ld_dst, kofs, rowmode, rowbase; const float* scale; int scalemode; };

DI void cvt_mat(float* T, int& tctr, const Job& jb) {
    if (jb.N == 0) return;
    const int tk = jb.Kpad >> 6, tn = (jb.N + 63) >> 6, nt = tk * tn;
    const int G = gridDim.x;
    int first = ((int)blockIdx.x - (tctr % G) + G) % G;
    const int tid = tid_();
    for (int i = first; i < nt; i += G) {
        const int k0 = (i / tn) << 6, n0 = (i % tn) << 6;
        {
            const int kk = tid >> 4, n4 = (tid & 15) * 4;
#pragma unroll
            for (int ps = 0; ps < 2; ++ps) {
                const int k = k0 + kk + 32 * ps, n = n0 + n4;
                f32x4 v = (f32x4){0.f, 0.f, 0.f, 0.f};
                if (k < jb.Kvalid && n < jb.N) {
                    v = *(const f32x4*)(jb.src + (size_t)k * jb.ldsrc + n);
                    float s = 1.0f;
                    if (jb.scalemode == 1) s = jb.scale[k]; else if (jb.scalemode == 2) s = 1.0f - jb.scale[k];
                    v = v * s;
                }
                float* tp = T + (kk + 32 * ps) * 65 + n4;
                tp[0] = v[0]; tp[1] = v[1]; tp[2] = v[2]; tp[3] = v[3];
            }
        }
        __syncthreads();
        {
            const int n = tid >> 3, k8 = (tid & 7) * 8;
            if (n0 + n < jb.N) {
                const int ng = n0 + n;
                const int row = jb.rowmode == 0 ? jb.rowbase + ng : jb.rowbase + 32 * (ng >> 4) + (ng & 15);
                const float* tp = T + k8 * 65 + n;
                u32x4 w;
                w.x = cvt_pk_bf16(tp[0], tp[65]); w.y = cvt_pk_bf16(tp[130], tp[195]); w.z = cvt_pk_bf16(tp[260], tp[325]); w.w = cvt_pk_bf16(tp[390], tp[455]);
                *(u32x4*)(jb.dst + (size_t)row * jb.ld_dst + jb.kofs + k0 + k8) = w;
            }
        }
        __syncthreads();
    }
    tctr += nt;
}

DI bf16_t* WL_BIG(const Params& p) { return (bf16_t*)(p.ws + OFF_WL); }
DI bf16_t* WL_LORA2(const Params& p) { return (bf16_t*)(p.ws + OFF_WL + (size_t)WBIG_ROWS * 2048 * 2); }
DI bf16_t* WL_OUT(const Params& p) { return (bf16_t*)(p.ws + OFF_WL + (size_t)WBIG_ROWS * 2048 * 2 + (size_t)1024 * LO1_W * 2); }
DI bf16_t* WL_WQ(const Params& p) { return (bf16_t*)(p.ws + OFF_WL + (size_t)2048 * 1024 * 2); }
DI bf16_t* WS_GU(const Params& p) { return (bf16_t*)(p.ws + OFF_WSH); }
DI bf16_t* WS_DN(const Params& p) { return (bf16_t*)(p.ws + OFF_WSH + (size_t)512 * 1024 * 2); }
DI bf16_t* WS_RT(const Params& p) { return (bf16_t*)(p.ws + OFF_WSH + (size_t)512 * 1024 * 2 + (size_t)1024 * 256 * 2); }
DI bf16_t* WM_GU(const Params& p) { return (bf16_t*)(p.ws + OFF_WMOE); }
DI bf16_t* WM_DN(const Params& p) { return (bf16_t*)(p.ws + OFF_WMOE + (size_t)NE * 512 * 1024 * 2); }

DI Job mkjob(const float* src, int Kv, int Kp, int N, int ldsrc, bf16_t* dst, int ld_dst, int kofs, int rowmode, int rowbase, const float* scale, int scalemode) {
    Job j; j.src = src; j.Kvalid = Kv; j.Kpad = Kp; j.N = N; j.ldsrc = ldsrc; j.dst = dst; j.ld_dst = ld_dst; j.kofs = kofs; j.rowmode = rowmode; j.rowbase = rowbase; j.scale = scale; j.scalemode = scalemode; return j;
}

DI Job get_job(const Params& p, int l, int j) {
    Job z = mkjob(nullptr, 0, 0, 0, 0, nullptr, 0, 0, 0, 0, nullptr, 0);
    if (j < 19) {
        if (l < 2) {
            const float* mu = p.in[I_MU] + (size_t)l * 6 * D_;
            bf16_t* big = WL_BIG(p); bf16_t* lo2 = WL_LORA2(p);
            if (j < 6) { const int s = j >> 1, part = j & 1; return mkjob(p.in[I_WRKV] + (size_t)(l * 3 + s) * D_ * D_, 1024, 1024, 1024, 1024, big, 2048, part * 1024, 0, s * 1024, mu + s * D_, 1 + part); }
            if (j < 8) { const int part = j & 1; return mkjob(p.in[I_WL1] + (size_t)l * D_ * 64, 1024, 1024, 64, 64, big, 2048, part * 1024, 0, 3072, mu + 3 * D_, 1 + part); }
            if (j < 10) { const int part = j & 1; return mkjob(p.in[I_AL1] + (size_t)l * D_ * 64, 1024, 1024, 64, 64, big, 2048, part * 1024, 0, 3136, mu + 4 * D_, 1 + part); }
            if (j < 12) { const int part = j & 1; return mkjob(p.in[I_GL1] + (size_t)l * D_ * 160, 1024, 1024, 160, 160, big, 2048, part * 1024, 0, 3200, mu + 5 * D_, 1 + part); }
            if (j < 14) { if (l != 1) return z; const int part = j & 1; return mkjob(p.in[I_VL1], 1024, 1024, 32, 32, big, 2048, part * 1024, 0, 3392, mu + 2 * D_, 1 + part); }
            if (j == 14) return mkjob(p.in[I_WL2] + (size_t)l * 64 * D_, 64, 64, 1024, 1024, lo2, 64, 0, 0, 0, nullptr, 0);
            if (j == 15) return mkjob(p.in[I_AL2] + (size_t)l * 64 * D_, 64, 64, 1024, 1024, lo2 + 1024 * 64, 64, 0, 0, 0, nullptr, 0);
            if (j == 16) return mkjob(p.in[I_GL2] + (size_t)l * 160 * D_, 160, 192, 1024, 1024, lo2 + 2 * 1024 * 64, 192, 0, 0, 0, nullptr, 0);
            if (j == 17) { if (l != 1) return z; return mkjob(p.in[I_VL2], 32, 64, 1024, 1024, lo2 + 2 * 1024 * 64 + 1024 * 192, 64, 0, 0, 0, nullptr, 0); }
            return mkjob(p.in[I_WOUT] + (size_t)l * D_ * D_, 1024, 1024, 1024, 1024, WL_OUT(p), 1024, 0, 0, 0, nullptr, 0);
        } else {
            const int a = l - 2;
            if (j == 0) { if (l != 2) return z; return mkjob(p.in[I_KVW], 1024, 1024, 2048, 2048, WL_BIG(p), 1024, 0, 0, 0, nullptr, 0); }
            if (j == 1) return mkjob(p.in[I_WQ] + (size_t)a * D_ * D_, 1024, 1024, 1024, 1024, WL_WQ(p), 1024, 0, 0, 0, nullptr, 0);
            if (j == 2) return mkjob(p.in[I_DAWO] + (size_t)a * D_ * D_, 1024, 1024, 1024, 1024, WL_OUT(p), 1024, 0, 0, 0, nullptr, 0);
            return z;
        }
    }
    j -= 19;
    if (j == 0) return mkjob(p.in[I_SG] + (size_t)l * D_ * FF, 1024, 1024, 256, 256, WS_GU(p), 1024, 0, 1, 0, nullptr, 0);
    if (j == 1) return mkjob(p.in[I_SU] + (size_t)l * D_ * FF, 1024, 1024, 256, 256, WS_GU(p), 1024, 0, 1, 16, nullptr, 0);
    if (j == 2) return mkjob(p.in[I_SD] + (size_t)l * FF * D_, 256, 256, 1024, 1024, WS_DN(p), 256, 0, 0, 0, nullptr, 0);
    if (j == 3) return mkjob(p.in[I_RTW] + (size_t)l * D_ * NE, 1024, 1024, 64, 64, WS_RT(p), 1024, 0, 0, 0, nullptr, 0);
    j -= 4;
    const int e = j / 3, w = j - e * 3;
    if (w == 0) return mkjob(p.in[I_MG] + ((size_t)l * NE + e) * D_ * FF, 1024, 1024, 256, 256, WM_GU(p) + (size_t)e * 512 * 1024, 1024, 0, 1, 0, nullptr, 0);
    if (w == 1) return mkjob(p.in[I_MU_] + ((size_t)l * NE + e) * D_ * FF, 1024, 1024, 256, 256, WM_GU(p) + (size_t)e * 512 * 1024, 1024, 0, 1, 16, nullptr, 0);
    return mkjob(p.in[I_MD] + ((size_t)l * NE + e) * FF * D_, 256, 256, 1024, 1024, WM_DN(p) + (size_t)e * 1024 * 256, 256, 0, 0, 0, nullptr, 0);
}

DI void phase_weights(const Params& p, unsigned char* lds, int l) {
    float* T = (float*)lds;
    int tctr = 0;
    for (int j = 0; j < 19 + 4 + NE * 3; ++j) { const Job jb = get_job(p, l, j); cvt_mat(T, tctr, jb); }
}

template <int BM, int BN, int WTM, int WTN, bool TRANS, class AP, class EPI>
DI void gemm_tile(unsigned char* lds, const AP& aptr, const bf16_t* __restrict__ Bt, size_t ldb, int K, const EPI& epi, size_t akstride = 64) {
    constexpr int WN_ = BN / WTN, MI = WTM / 16, NI = WTN / 16;
    static_assert((BM / WTM) * WN_ == 8, "8 waves");
    constexpr int CA = BM * 8 / NTHR, CB = BN * 8 / NTHR;
    static_assert(CA >= 1 && CB >= 1, "tile too small");
    constexpr int ABYTES = BM * 128, STAGE = (BM + BN) * 128;
    const int tid = tid_(), lane = tid & 63, wid = tid >> 6, wm = wid / WN_, wn = wid % WN_;
    const bf16_t* ap[CA]; const bf16_t* bp[CB]; unsigned aoff[CA], boff[CB];
#pragma unroll
    for (int i = 0; i < CA; ++i) { const int id = tid + NTHR * i, row = id >> 3, c = id & 7; ap[i] = aptr(row) + c * 8; aoff[i] = row * 128 + ((c ^ ((row >> 1) & 7)) << 4); }
#pragma unroll
    for (int i = 0; i < CB; ++i) { const int id = tid + NTHR * i, row = id >> 3, c = id & 7; bp[i] = Bt + (size_t)row * ldb + c * 8; boff[i] = ABYTES + row * 128 + ((c ^ ((row >> 1) & 7)) << 4); }
    u32x4 ra[CA], rb[CB];
    f32x4 acc[MI][NI];
#pragma unroll
    for (int mi = 0; mi < MI; ++mi)
#pragma unroll
        for (int ni = 0; ni < NI; ++ni) acc[mi][ni] = (f32x4){0.f, 0.f, 0.f, 0.f};
    const int nk = K >> 6;
#pragma unroll
    for (int i = 0; i < CA; ++i) ra[i] = *(const u32x4*)(ap[i]);
#pragma unroll
    for (int i = 0; i < CB; ++i) rb[i] = *(const u32x4*)(bp[i]);
#pragma unroll
    for (int i = 0; i < CA; ++i) *(u32x4*)(lds + aoff[i]) = ra[i];
#pragma unroll
    for (int i = 0; i < CB; ++i) *(u32x4*)(lds + boff[i]) = rb[i];
    __syncthreads();
    const int fr = lane & 15, fq = lane >> 4, sw = (fr >> 1) & 7;
    for (int kt = 0; kt < nk; ++kt) {
        const unsigned char* cur = lds + (kt & 1) * STAGE;
        unsigned char* nxt = lds + ((kt + 1) & 1) * STAGE;
        const bool more = kt + 1 < nk;
        if (more) {
#pragma unroll
            for (int i = 0; i < CA; ++i) ra[i] = *(const u32x4*)(ap[i] + (size_t)(kt + 1) * akstride);
#pragma unroll
            for (int i = 0; i < CB; ++i) rb[i] = *(const u32x4*)(bp[i] + (kt + 1) * 64);
        }
#pragma unroll
        for (int ks = 0; ks < 2; ++ks) {
            bf16x8 af[MI], bfr[NI];
            const int ch = ((ks * 4 + fq) ^ sw) << 4;
#pragma unroll
            for (int mi = 0; mi < MI; ++mi) af[mi] = *(const bf16x8*)(cur + (wm * WTM + mi * 16 + fr) * 128 + ch);
#pragma unroll
            for (int ni = 0; ni < NI; ++ni) bfr[ni] = *(const bf16x8*)(cur + ABYTES + (wn * WTN + ni * 16 + fr) * 128 + ch);
#pragma unroll
            for (int mi = 0; mi < MI; ++mi)
#pragma unroll
                for (int ni = 0; ni < NI; ++ni)
                    acc[mi][ni] = TRANS ? __builtin_amdgcn_mfma_f32_16x16x32_bf16(bfr[ni], af[mi], acc[mi][ni], 0, 0, 0)
                                        : __builtin_amdgcn_mfma_f32_16x16x32_bf16(af[mi], bfr[ni], acc[mi][ni], 0, 0, 0);
        }
        if (more) {
#pragma unroll
            for (int i = 0; i < CA; ++i) *(u32x4*)(nxt + aoff[i]) = ra[i];
#pragma unroll
            for (int i = 0; i < CB; ++i) *(u32x4*)(nxt + boff[i]) = rb[i];
        }
        __syncthreads();
    }
    epi.template run<MI, NI>(acc, wm * WTM, wn * WTN, fr, fq);
}

struct APlain { const bf16_t* base; size_t ld; DI const bf16_t* operator()(int r) const { return base + (size_t)r * ld; } };
struct AClamp { const bf16_t* base; int last; DI const bf16_t* operator()(int r) const { return base + (size_t)(r < last ? r : last) * FF; } };
struct AGather { const bf16_t* base; const int* rows; int nrows; DI const bf16_t* operator()(int r) const { const int rr = r < nrows ? r : nrows - 1; return base + (size_t)rows[rr] * D_; } };

DI size_t hm_off(int prow, int col) { const int b = prow >= LP ? 1 : 0, t = prow - b * LP; return ((size_t)((b * 16 + (col >> 6)) * LP + t)) * 64 + (col & 63); }
DI void st_bf4(bf16_t* dst, f32x4 v) { u32x2 w; w.x = cvt_pk_bf16(v[0], v[1]); w.y = cvt_pk_bf16(v[2], v[3]); *(u32x2*)dst = w; }

struct EpiR1 {
    bf16_t* dst; int kind; int m0, n0;
    template <int MI, int NI> DI void run(const f32x4 (&acc)[MI][NI], int rb, int cb, int fr, int fq) const {
#pragma unroll
        for (int ni = 0; ni < NI; ++ni) {
            const int col = n0 + cb + ni * 16 + 4 * fq;
            if (col >= 3456) continue;
#pragma unroll
            for (int mi = 0; mi < MI; ++mi) {
                const size_t row = (size_t)(m0 + rb + mi * 16 + fr);
                f32x4 a = acc[mi][ni];
                if (kind == 0) {
                    st_bf4(dst + hm_off((int)row, col & 1023), a);
                } else {
                    const int c = col - 3072;
                    if (c < 64) { a[0] = tanhf_(a[0]); a[1] = tanhf_(a[1]); a[2] = tanhf_(a[2]); a[3] = tanhf_(a[3]); }
                    else if (c >= 128 && c < 288) { a[0] = sigmoidf_(a[0]); a[1] = sigmoidf_(a[1]); a[2] = sigmoidf_(a[2]); a[3] = sigmoidf_(a[3]); }
                    else if ((c >= 288 && c < 320) || c >= 352) a = (f32x4){0.f, 0.f, 0.f, 0.f};
                    st_bf4(dst + row * LO1_W + c, a);
                }
            }
        }
    }
};
struct EpiLora2 {
    int mode; float* wdec; bf16_t* dst; const bf16_t* vfirst; const float* bias; int m0, n0;
    template <int MI, int NI> DI void run(const f32x4 (&acc)[MI][NI], int rb, int cb, int fr, int fq) const {
#pragma unroll
        for (int ni = 0; ni < NI; ++ni) {
            const int col = n0 + cb + ni * 16 + 4 * fq;
            f32x4 bv = (f32x4){0.f, 0.f, 0.f, 0.f};
            if (mode != 2) bv = *(const f32x4*)(bias + col);
#pragma unroll
            for (int mi = 0; mi < MI; ++mi) {
                const size_t off = hm_off(m0 + rb + mi * 16 + fr, col);
                f32x4 a = acc[mi][ni] + bv;
                if (mode == 0) {
#pragma unroll
                    for (int i = 0; i < 4; ++i) a[i] = -0.6065306597126334f * sigmoidf_(a[i]);
                    *(f32x4*)(wdec + off) = a;
                } else if (mode == 1) {
#pragma unroll
                    for (int i = 0; i < 4; ++i) a[i] = sigmoidf_(a[i]);
                    st_bf4(dst + off, a);
                } else if (mode == 2) {
                    st_bf4(dst + off, a);
                } else {
                    const u32x2 vv = *(const u32x2*)(dst + off), vf = *(const u32x2*)(vfirst + off);
                    const float v0 = bflo(vv.x), v1 = bfhi(vv.x), v2 = bflo(vv.y), v3 = bfhi(vv.y);
                    const float f0 = bflo(vf.x), f1 = bfhi(vf.x), f2 = bflo(vf.y), f3 = bfhi(vf.y);
                    f32x4 o;
                    o[0] = v0 + (f0 - v0) * sigmoidf_(a[0]); o[1] = v1 + (f1 - v1) * sigmoidf_(a[1]); o[2] = v2 + (f2 - v2) * sigmoidf_(a[2]); o[3] = v3 + (f3 - v3) * sigmoidf_(a[3]);
                    st_bf4(dst + off, o);
                }
            }
        }
    }
};
struct EpiResid {
    float* out; unsigned char* ws; int m0, n0;
    template <int MI, int NI> DI void run(const f32x4 (&acc)[MI][NI], int rb, int cb, int fr, int fq) const {
#pragma unroll
        for (int mi = 0; mi < MI; ++mi) {
            const int prow = m0 + rb + mi * 16 + fr;
            const int t = prow >= LP ? prow - LP : prow;
            if (t >= LSEQ) continue;
            float* hr = h32row_(out, ws, prow);
#pragma unroll
            for (int ni = 0; ni < NI; ++ni) {
                const int col = n0 + cb + ni * 16 + 4 * fq;
                f32x4 h = *(const f32x4*)(hr + col);
                *(f32x4*)(hr + col) = h * DN_ALPHA + acc[mi][ni];
            }
        }
    }
};
struct EpiQK {
    bf16_t* dst; float scale; int m0, n0;
    template <int MI, int NI> DI void run(const f32x4 (&acc)[MI][NI], int rb, int cb, int fr, int fq) const {
#pragma unroll
        for (int mi = 0; mi < MI; ++mi) {
            const int prow = m0 + rb + mi * 16 + fr;
            const int b = prow >= LP ? 1 : 0, t = prow - b * LP;
#pragma unroll
            for (int ni = 0; ni < NI; ++ni) {
                const int col = n0 + cb + ni * 16 + 4 * fq;
                const int hc = col >> 6, dd = col & 63;
                st_bf4(dst + (((size_t)(b * 16 + hc)) * LP + t) * 64 + dd, acc[mi][ni] * scale);
            }
        }
    }
};
struct EpiVt {
    bf16_t* dst; int m0, n0;
    template <int MI, int NI> DI void run(const f32x4 (&acc)[MI][NI], int rb, int cb, int fr, int fq) const {
#pragma unroll
        for (int mi = 0; mi < MI; ++mi) {
            const int prow = m0 + rb + mi * 16 + 4 * fq;
            const int b = prow >= LP ? 1 : 0, t = prow - b * LP;
#pragma unroll
            for (int ni = 0; ni < NI; ++ni) {
                const int col = n0 + cb + ni * 16 + fr;
                st_bf4(dst + ((size_t)(b * 1024 + col)) * LP + t, acc[mi][ni]);
            }
        }
    }
};
struct EpiM1 {
    bf16_t* dst; const float* gate; int row0, nrows, n0;
    template <int MI, int NI> DI void run(const f32x4 (&acc)[MI][NI], int rb, int cb, int fr, int fq) const {
#pragma unroll
        for (int mi = 0; mi < MI; ++mi) {
            const int r = rb + mi * 16 + fr;
            if (r >= nrows) continue;
            const float gw = gate ? gate[row0 + r] : 1.0f;
#pragma unroll
            for (int ni = 0; ni < NI; ni += 2) {
                const int hc = ((n0 + cb + ni * 16) >> 1) + 4 * fq;
                const f32x4 g = acc[mi][ni], u = acc[mi][ni + 1];
                f32x4 o;
#pragma unroll
                for (int i = 0; i < 4; ++i) o[i] = g[i] * sigmoidf_(g[i]) * u[i] * gw;
                st_bf4(dst + (size_t)(row0 + r) * FF + hc, o);
            }
        }
    }
};
struct EpiM2 {
    bf16_t* dst; int row0, nrows, n0;
    template <int MI, int NI> DI void run(const f32x4 (&acc)[MI][NI], int rb, int cb, int fr, int fq) const {
#pragma unroll
        for (int mi = 0; mi < MI; ++mi) {
            const int r = rb + mi * 16 + fr;
            if (r >= nrows) continue;
#pragma unroll
            for (int ni = 0; ni < NI; ++ni) st_bf4(dst + (size_t)(row0 + r) * D_ + n0 + cb + ni * 16 + 4 * fq, acc[mi][ni]);
        }
    }
};
struct EpiLds {
    float* dst;
    template <int MI, int NI> DI void run(const f32x4 (&acc)[MI][NI], int rb, int cb, int fr, int fq) const {
#pragma unroll
        for (int mi = 0; mi < MI; ++mi)
#pragma unroll
            for (int ni = 0; ni < NI; ++ni) {
                float* d = dst + (rb + mi * 16 + fr) * 65 + cb + ni * 16 + 4 * fq;
                d[0] = acc[mi][ni][0]; d[1] = acc[mi][ni][1]; d[2] = acc[mi][ni][2]; d[3] = acc[mi][ni][3];
            }
    }
};

DI bf16_t* SCR16(const Params& p, size_t off) { return (bf16_t*)(p.ws + OFF_SCR + off); }
DI bf16_t* VFIRST(const Params& p) { return (bf16_t*)(p.ws + OFF_KV); }
DI bf16_t* KBUF(const Params& p) { return (bf16_t*)(p.ws + OFF_KV); }
DI bf16_t* VTBUF(const Params& p) { return (bf16_t*)(p.ws + OFF_KV + SZ_ACT16); }

DI void phase_r1(const Params& p, unsigned char* lds, int l) {
    constexpr int NT = WBIG_ROWS / 256;
    EpiR1 e;
    for (int u = blockIdx.x; u < MT * NT; u += gridDim.x) {
        const int mt = u / NT, nt = u - mt * NT;
        e.m0 = mt * 128; e.n0 = nt * 256;
        if (nt < 4) { e.kind = 0; e.dst = SCR16(p, SCR_R); } else if (nt < 8) { e.kind = 0; e.dst = SCR16(p, SCR_K); }
        else if (nt < 12) { e.kind = 0; e.dst = l == 0 ? VFIRST(p) : SCR16(p, SCR_V); } else { e.kind = 1; e.dst = SCR16(p, SCR_LO1); }
        APlain a; a.base = H16(p) + (size_t)(mt * 128) * D_ - D_; a.ld = D_;
        gemm_tile<128, 256, 64, 64, true>(lds, a, WL_BIG(p) + (size_t)(nt * 256) * 2048, 2048, 2048, e);
    }
}
DI void phase_r2(const Params& p, unsigned char* lds, int l) {
    const int ng = l == 1 ? 4 : 3;
    for (int u = blockIdx.x; u < ng * MT * 4; u += gridDim.x) {
        const int g = u / (MT * 4), r = u - g * (MT * 4), mt = r >> 2, nt = r & 3;
        EpiLora2 e; e.mode = g; e.m0 = mt * 128; e.n0 = nt * 256; e.wdec = (float*)(p.ws + OFF_SCR + SCR_W); e.vfirst = VFIRST(p); e.bias = nullptr; e.dst = nullptr;
        APlain a; a.ld = LO1_W; const bf16_t* lo1 = SCR16(p, SCR_LO1) + (size_t)(mt * 128) * LO1_W;
        const bf16_t* lo2 = WL_LORA2(p);
        if (g == 0) { e.bias = p.in[I_W0] + l * D_; a.base = lo1; gemm_tile<128, 256, 64, 64, true>(lds, a, lo2 + (size_t)(nt * 256) * 64, 64, 64, e); }
        else if (g == 1) { e.bias = p.in[I_A0] + l * D_; e.dst = SCR16(p, SCR_A); a.base = lo1 + 64; gemm_tile<128, 256, 64, 64, true>(lds, a, lo2 + 1024 * 64 + (size_t)(nt * 256) * 64, 64, 64, e); }
        else if (g == 2) { e.dst = SCR16(p, SCR_G); a.base = lo1 + 128; gemm_tile<128, 256, 64, 64, true>(lds, a, lo2 + 2 * 1024 * 64 + (size_t)(nt * 256) * 192, 192, 192, e); }
        else { e.bias = p.in[I_V0]; e.dst = SCR16(p, SCR_V); a.base = lo1 + 320; gemm_tile<128, 256, 64, 64, true>(lds, a, lo2 + 2 * 1024 * 64 + 1024 * 192 + (size_t)(nt * 256) * 64, 64, 64, e); }
    }
}

DI unsigned img_off(int row, int col) { return (unsigned)(row * 128 + ((((col >> 3) ^ ((row >> 1) & 7)) << 4) | ((col & 7) << 1))); }
DI void mm64(const unsigned char* Aimg, const unsigned char* Bimg, int mb, int nh, int fr, int g, f32x4 (&acc)[2]) {
#pragma unroll
    for (int ks = 0; ks < 2; ++ks) {
        const int ch = ((ks * 4 + g) ^ ((fr >> 1) & 7)) << 4;
        const bf16x8 a = *(const bf16x8*)(Aimg + (16 * mb + fr) * 128 + ch);
#pragma unroll
        for (int nbi = 0; nbi < 2; ++nbi) {
            const bf16x8 b = *(const bf16x8*)(Bimg + (16 * (2 * nh + nbi) + fr) * 128 + ch);
            acc[nbi] = __builtin_amdgcn_mfma_f32_16x16x32_bf16(b, a, acc[nbi], 0, 0, 0);
        }
    }
}
DI void st_img4(unsigned char* img, int row, int col4, f32x4 v) { u32x2 w; w.x = cvt_pk_bf16(v[0], v[1]); w.y = cvt_pk_bf16(v[2], v[3]); *(u32x2*)(img + img_off(row, col4)) = w; }
DI f32x4 ld_img4(const unsigned char* img, int row, int col4) { const u32x2 w = *(const u32x2*)(img + img_off(row, col4)); return (f32x4){bflo(w.x), bfhi(w.x), bflo(w.y), bfhi(w.y)}; }
#define ZACC(a) do { a[0] = (f32x4){0.f, 0.f, 0.f, 0.f}; a[1] = (f32x4){0.f, 0.f, 0.f, 0.f}; } while (0)

DI void phase_scanA(const Params& p, unsigned char* lds, int l) {
    const int tid = tid_(), lane = tid & 63, wid = tid >> 6, fr = lane & 15, g = lane >> 4, mb = wid >> 1, nh = wid & 1;
    float* seg = (float*)(lds + 16 * 8192); float* gC = seg + 512;
#define SL(i) (lds + (i) * 8192)
    bf16_t* R = SCR16(p, SCR_R); bf16_t* Kp = SCR16(p, SCR_K); const bf16_t* V = l == 0 ? VFIRST(p) : SCR16(p, SCR_V); bf16_t* A = SCR16(p, SCR_A);
    const float* LW = (const float*)(p.ws + OFF_SCR + SCR_W); float* bonus = (float*)(p.ws + OFF_SCR + SCR_LO1); bf16_t* Qs = SCR16(p, SCR_QS);
    for (int unit = blockIdx.x; unit < NB * 16 * NCHR; unit += gridDim.x) {
        const int c = unit % NCHR, bh = unit / NCHR, h = bh & 15;
        const size_t base = ((size_t)bh * LP + 64 * c) * 64;
        const int hc = l * D_ + h * 64 + lane;
        const float c_kk = p.in[I_KK][hc], c_ka = p.in[I_KA][hc], c_rk = p.in[I_RK][hc];
        float vr[8], vk2[8], vv[8], vas[8], vbs[8], lwv[8], cum[8];
        float run = 0.f;
#pragma unroll
        for (int j = 0; j < 8; ++j) {
            const int t = 8 * wid + j; const size_t e = base + (size_t)t * 64 + lane;
            const float r = bf2f(R[e]), k = bf2f(Kp[e]), v = bf2f(V[e]), a = bf2f(A[e]), lw = LW[e];
            const float kkr = k * c_kk; const float n2 = wave_sum(kkr * kkr);
            const float kk = kkr / fmaxf(sqrtf(n2), 1e-12f);
            const float k2 = k * (1.0f + (a - 1.0f) * c_ka);
            const float bon = wave_sum(r * k2 * c_rk);
            if (lane == 0) bonus[(size_t)bh * LP + 64 * c + t] = bon;
            run += lw; cum[j] = run; lwv[j] = lw; vr[j] = r; vk2[j] = k2; vv[j] = v; vas[j] = -kk; vbs[j] = kk * a;
        }
        seg[wid * 64 + lane] = run;
        __syncthreads();
        float off = 0.f, tot = 0.f;
#pragma unroll
        for (int w2 = 0; w2 < 8; ++w2) { const float sg = seg[w2 * 64 + lane]; off += w2 < wid ? sg : 0.f; tot += sg; }
        if (wid == 0) gC[lane] = __expf(tot);
        {
            float tA[8], tB[8], tK[8];
#pragma unroll
            for (int j = 0; j < 8; ++j) {
                const int t = 8 * wid + j;
                const float cu = cum[j] + off, cp = cu - lwv[j];
                const float ea = __expf(cp), er = __expf(cu), ei = __expf(-cu), eh = __expf(tot - cu);
                const float At = vas[j] * ea, Rt = vr[j] * er, Bt = vbs[j] * ei, Kt = vk2[j] * ei;
                const unsigned o = img_off(t, lane);
                *(bf16_t*)(SL(5) + o) = f2bf(At); *(bf16_t*)(SL(0) + o) = f2bf(Rt); *(bf16_t*)(SL(6) + o) = f2bf(Bt); *(bf16_t*)(SL(7) + o) = f2bf(Kt);
                tA[j] = At; tB[j] = vbs[j] * eh; tK[j] = vk2[j] * eh;
            }
            const unsigned ot = (unsigned)(lane * 128 + ((wid ^ ((lane >> 1) & 7)) << 4));
            u32x4 w;
            w.x = cvt_pk_bf16(tA[0], tA[1]); w.y = cvt_pk_bf16(tA[2], tA[3]); w.z = cvt_pk_bf16(tA[4], tA[5]); w.w = cvt_pk_bf16(tA[6], tA[7]); *(u32x4*)(SL(1) + ot) = w;
            w.x = cvt_pk_bf16(vv[0], vv[1]); w.y = cvt_pk_bf16(vv[2], vv[3]); w.z = cvt_pk_bf16(vv[4], vv[5]); w.w = cvt_pk_bf16(vv[6], vv[7]); *(u32x4*)(SL(2) + ot) = w;
            w.x = cvt_pk_bf16(tB[0], tB[1]); w.y = cvt_pk_bf16(tB[2], tB[3]); w.z = cvt_pk_bf16(tB[4], tB[5]); w.w = cvt_pk_bf16(tB[6], tB[7]); *(u32x4*)(SL(3) + ot) = w;
            w.x = cvt_pk_bf16(tK[0], tK[1]); w.y = cvt_pk_bf16(tK[2], tK[3]); w.z = cvt_pk_bf16(tK[4], tK[5]); w.w = cvt_pk_bf16(tK[6], tK[7]); *(u32x4*)(SL(4) + ot) = w;
        }
        __syncthreads();
        f32x4 acc[2];
        const int row = 16 * mb + fr;
        ZACC(acc); mm64(SL(5), SL(6), mb, nh, fr, g, acc);
#pragma unroll
        for (int nbi = 0; nbi < 2; ++nbi) { const int c0 = 16 * (2 * nh + nbi) + 4 * g; f32x4 m = acc[nbi];
#pragma unroll
            for (int i = 0; i < 4; ++i) m[i] = (c0 + i < row) ? m[i] : 0.f;
            st_img4(SL(8), row, c0, m);
#pragma unroll
            for (int i = 0; i < 4; ++i) m[i] += (c0 + i == row) ? 1.0f : 0.f;
            st_img4(SL(13), row, c0, m); }
        ZACC(acc); mm64(SL(6), SL(5), mb, nh, fr, g, acc);
#pragma unroll
        for (int nbi = 0; nbi < 2; ++nbi) { const int c0 = 16 * (2 * nh + nbi) + 4 * g; f32x4 m = acc[nbi];
#pragma unroll
            for (int i = 0; i < 4; ++i) m[i] = (row < c0 + i) ? m[i] : 0.f;
            st_img4(SL(9), row, c0, m); }
        ZACC(acc); mm64(SL(5), SL(7), mb, nh, fr, g, acc);
#pragma unroll
        for (int nbi = 0; nbi < 2; ++nbi) { const int c0 = 16 * (2 * nh + nbi) + 4 * g; f32x4 m = acc[nbi];
#pragma unroll
            for (int i = 0; i < 4; ++i) m[i] = (c0 + i < row) ? m[i] : 0.f;
            st_img4(SL(10), row, c0, m); }
        ZACC(acc); mm64(SL(0), SL(6), mb, nh, fr, g, acc);
#pragma unroll
        for (int nbi = 0; nbi < 2; ++nbi) { const int c0 = 16 * (2 * nh + nbi) + 4 * g; f32x4 m = acc[nbi];
#pragma unroll
            for (int i = 0; i < 4; ++i) m[i] = (c0 + i <= row) ? m[i] : 0.f;
            st_img4(SL(11), row, c0, m); }
        ZACC(acc); mm64(SL(0), SL(7), mb, nh, fr, g, acc);
#pragma unroll
        for (int nbi = 0; nbi < 2; ++nbi) { const int c0 = 16 * (2 * nh + nbi) + 4 * g; f32x4 m = acc[nbi];
#pragma unroll
            for (int i = 0; i < 4; ++i) m[i] = (c0 + i <= row) ? m[i] : 0.f;
            st_img4(SL(12), row, c0, m); }
        __syncthreads();
#define MMST(dst, Ai, Bi) do { ZACC(acc); mm64(SL(Ai), SL(Bi), mb, nh, fr, g, acc); st_img4(SL(dst), row, 16 * (2 * nh) + 4 * g, acc[0]); st_img4(SL(dst), row, 16 * (2 * nh + 1) + 4 * g, acc[1]); } while (0)
#define MMUPD(dst, Ti, Bi) do { ZACC(acc); mm64(SL(Ti), SL(Bi), mb, nh, fr, g, acc); \
        st_img4(SL(dst), row, 16 * (2 * nh) + 4 * g, acc[0] + ld_img4(SL(Ti), row, 16 * (2 * nh) + 4 * g)); \
        st_img4(SL(dst), row, 16 * (2 * nh + 1) + 4 * g, acc[1] + ld_img4(SL(Ti), row, 16 * (2 * nh + 1) + 4 * g)); } while (0)
        MMST(7, 2, 10); MMST(14, 8, 9); MMST(15, 9, 8);
        __syncthreads();
        MMST(5, 14, 15); MMST(6, 15, 14); MMUPD(8, 13, 15);
        __syncthreads();
        MMST(14, 5, 6); MMST(15, 6, 5); MMUPD(9, 8, 6);
        __syncthreads();
        MMST(5, 14, 15); MMST(6, 15, 14); MMUPD(8, 9, 15);
        __syncthreads();
        MMST(15, 6, 5); MMUPD(9, 8, 6);
        __syncthreads();
        MMUPD(8, 9, 15);
        __syncthreads();
        MMST(5, 1, 8); MMST(6, 7, 8);
        __syncthreads();
        ZACC(acc); mm64(SL(11), SL(5), mb, nh, fr, g, acc);
#pragma unroll
        for (int nbi = 0; nbi < 2; ++nbi) { const int c0 = 16 * (2 * nh + nbi) + 4 * g; st_bf4(R + base + (size_t)row * 64 + c0, acc[nbi] + ld_img4(SL(0), row, c0)); }
        ZACC(acc); mm64(SL(11), SL(6), mb, nh, fr, g, acc); mm64(SL(12), SL(2), mb, nh, fr, g, acc);
#pragma unroll
        for (int nbi = 0; nbi < 2; ++nbi) { const int c0 = 16 * (2 * nh + nbi) + 4 * g; st_bf4(Kp + base + (size_t)row * 64 + c0, acc[nbi]); }
        ZACC(acc); mm64(SL(3), SL(5), mb, nh, fr, g, acc);
#pragma unroll
        for (int nbi = 0; nbi < 2; ++nbi) { const int c0 = 16 * (2 * nh + nbi) + 4 * g; f32x4 m = acc[nbi];
#pragma unroll
            for (int i = 0; i < 4; ++i) m[i] += (c0 + i == row) ? gC[row] : 0.f;
            const int cp = (c0 & 32) + 8 * ((c0 >> 2) & 3) + 4 * ((c0 >> 4) & 1);
            st_bf4(A + base + (size_t)row * 64 + cp, m); }
        ZACC(acc); mm64(SL(6), SL(3), mb, nh, fr, g, acc); mm64(SL(2), SL(4), mb, nh, fr, g, acc);
#pragma unroll
        for (int nbi = 0; nbi < 2; ++nbi) { const int c0 = 16 * (2 * nh + nbi) + 4 * g; st_bf4(Qs + (size_t)unit * 4096 + row * 64 + 16 * ((c0 >> 2) & 3) + 4 * (c0 >> 4), acc[nbi]); }
        __syncthreads();
    }
#undef SL
}

DI void phase_scanB(const Params& p, unsigned char* lds, int l) {
    const int tid = tid_(), lane = tid & 63, wid = tid >> 6, fr = lane & 15, g = lane >> 4;
    const bf16_t* A = SCR16(p, SCR_A); const bf16_t* Qs = SCR16(p, SCR_QS); bf16_t* SC = SCR16(p, SCR_W);
    const int srow = tid >> 3, sc8 = tid & 7;
    const unsigned soff = (unsigned)(srow * 128 + ((sc8 ^ ((srow >> 1) & 7)) << 4));
    constexpr int NBAT = (NCHR - 1) / 8;
    for (int unit = blockIdx.x; unit < NB * 16; unit += gridDim.x) {
        const int v = 16 * (wid & 3) + fr;
        const bf16_t* pa = A + ((size_t)unit * LP) * 64 + tid * 8;
        const bf16_t* pq = Qs + ((size_t)unit * NCHR) * 4096 + tid * 8;
        f32x4 X[4];
#pragma unroll
        for (int kb = 0; kb < 4; ++kb) X[kb] = (f32x4){0.f, 0.f, 0.f, 0.f};
        u32x4 ra[8], rq[8];
#pragma unroll
        for (int j = 0; j < 8; ++j) { ra[j] = *(const u32x4*)(pa + (size_t)j * 4096); rq[j] = *(const u32x4*)(pq + (size_t)j * 4096); }
#pragma unroll
        for (int j = 0; j < 8; ++j) { *(u32x4*)(lds + j * 8192 + soff) = ra[j]; *(u32x4*)(lds + 65536 + j * 8192 + soff) = rq[j]; }
#pragma unroll
        for (int j = 0; j < 8; ++j) { ra[j] = *(const u32x4*)(pa + (size_t)(8 + j) * 4096); rq[j] = *(const u32x4*)(pq + (size_t)(8 + j) * 4096); }
        __syncthreads();
        for (int bt = 0; bt < NBAT; ++bt) {
            if (wid < 4) {
#pragma unroll 2
                for (int s8 = 0; s8 < 8; ++s8) {
                    const size_t ch = (size_t)unit * NCHR + bt * 8 + s8;
                    const unsigned char* pimg = lds + s8 * 8192; const unsigned char* qimg = lds + 65536 + s8 * 8192;
#pragma unroll
                    for (int kb = 0; kb < 4; ++kb) st_bf4(SC + ch * 4096 + v * 64 + 16 * kb + 4 * g, X[kb]);
                    bf16x8 xp[2];
#pragma unroll
                    for (int ks = 0; ks < 2; ++ks) {
                        u32x4 w; w.x = cvt_pk_bf16(X[2 * ks][0], X[2 * ks][1]); w.y = cvt_pk_bf16(X[2 * ks][2], X[2 * ks][3]);
                        w.z = cvt_pk_bf16(X[2 * ks + 1][0], X[2 * ks + 1][1]); w.w = cvt_pk_bf16(X[2 * ks + 1][2], X[2 * ks + 1][3]);
                        xp[ks] = __builtin_bit_cast(bf16x8, w);
                    }
                    const int sw = (fr >> 1) & 7;
                    const u32x4 q0 = *(const u32x4*)(qimg + v * 128 + (((2 * g) ^ sw) << 4)), q1 = *(const u32x4*)(qimg + v * 128 + (((2 * g + 1) ^ sw) << 4));
                    const unsigned qw[8] = {q0.x, q0.y, q0.z, q0.w, q1.x, q1.y, q1.z, q1.w};
#pragma unroll
                    for (int kb = 0; kb < 4; ++kb) {
                        f32x4 acc = (f32x4){bflo(qw[2 * kb]), bfhi(qw[2 * kb]), bflo(qw[2 * kb + 1]), bfhi(qw[2 * kb + 1])};
#pragma unroll
                        for (int ks = 0; ks < 2; ++ks) {
                            const bf16x8 af = *(const bf16x8*)(pimg + (16 * kb + fr) * 128 + (((4 * ks + g) ^ sw) << 4));
                            acc = __builtin_amdgcn_mfma_f32_16x16x32_bf16(af, xp[ks], acc, 0, 0, 0);
                        }
                        X[kb] = acc;
                    }
                }
            }
            __syncthreads();
            if (bt + 1 < NBAT) {
#pragma unroll
                for (int j = 0; j < 8; ++j) { *(u32x4*)(lds + j * 8192 + soff) = ra[j]; *(u32x4*)(lds + 65536 + j * 8192 + soff) = rq[j]; }
                if (bt + 2 < NBAT) {
#pragma unroll
                    for (int j = 0; j < 8; ++j) { ra[j] = *(const u32x4*)(pa + (size_t)((bt + 2) * 8 + j) * 4096); rq[j] = *(const u32x4*)(pq + (size_t)((bt + 2) * 8 + j) * 4096); }
                }
            }
            __syncthreads();
        }
        if (wid < 4) {
#pragma unroll
            for (int kb = 0; kb < 4; ++kb) st_bf4(SC + ((size_t)unit * NCHR + NCHR - 1) * 4096 + v * 64 + 16 * kb + 4 * g, X[kb]);
        }
    }
}

DI void phase_scanC(const Params& p, unsigned char* lds, int l) {
    const int tid = tid_(), lane = tid & 63, wid = tid >> 6, fr = lane & 15, g = lane >> 4, mb = wid >> 1, nh = wid & 1;
    float* Yl = (float*)(lds + 16384);
    const bf16_t* R = SCR16(p, SCR_R); const bf16_t* Kp = SCR16(p, SCR_K); const bf16_t* V = l == 0 ? VFIRST(p) : SCR16(p, SCR_V);
    const bf16_t* G = SCR16(p, SCR_G); const bf16_t* SC = SCR16(p, SCR_W); const float* bonus = (const float*)(p.ws + OFF_SCR + SCR_LO1); bf16_t* Z = SCR16(p, SCR_Z);
    for (int unit = blockIdx.x; unit < NB * 16 * NCHR; unit += gridDim.x) {
        const int c = unit % NCHR, bh = unit / NCHR, h = bh & 15;
        const size_t base = ((size_t)bh * LP + 64 * c) * 64;
        const int hc = l * D_ + h * 64 + lane;
        const float c_lg = p.in[I_LNXG][hc], c_lb = p.in[I_LNXB][hc];
        {
            const int row = tid >> 3, c8 = tid & 7;
            const u32x4 rp = *(const u32x4*)(R + base + (size_t)row * 64 + c8 * 8);
            const u32x4 sc = *(const u32x4*)(SC + (size_t)unit * 4096 + row * 64 + c8 * 8);
            const unsigned o = (unsigned)(row * 128 + ((c8 ^ ((row >> 1) & 7)) << 4));
            *(u32x4*)(lds + o) = rp; *(u32x4*)(lds + 8192 + o) = sc;
        }
        __syncthreads();
        f32x4 acc[2]; ZACC(acc);
        mm64(lds, lds + 8192, mb, nh, fr, g, acc);
        const int row = 16 * mb + fr;
#pragma unroll
        for (int nbi = 0; nbi < 2; ++nbi) {
            const int c0 = 16 * (2 * nh + nbi) + 4 * g;
            const u32x2 y0 = *(const u32x2*)(Kp + base + (size_t)row * 64 + c0);
            float* d = Yl + row * 65 + c0;
            d[0] = acc[nbi][0] + bflo(y0.x); d[1] = acc[nbi][1] + bfhi(y0.x); d[2] = acc[nbi][2] + bflo(y0.y); d[3] = acc[nbi][3] + bfhi(y0.y);
        }
        __syncthreads();
#pragma unroll
        for (int j = 0; j < 8; ++j) {
            const int t = 8 * wid + j;
            const float y = Yl[t * 65 + lane];
            const float mean = wave_sum(y) * (1.0f / 64.0f);
            const float dlt = y - mean;
            const float var = wave_sum(dlt * dlt) * (1.0f / 64.0f);
            const float yn = dlt * rsqrtf(var + 64e-5f) * c_lg + c_lb;
            const size_t e = base + (size_t)t * 64 + lane;
            const float bon = bonus[(size_t)bh * LP + 64 * c + t];
            Z[e] = f2bf((yn + bon * bf2f(V[e])) * bf2f(G[e]));
        }
        __syncthreads();
    }
}

DI void phase_outproj(const Params& p, unsigned char* lds, bool hm) {
    EpiResid e; e.out = p.out; e.ws = p.ws;
    for (int u = blockIdx.x; u < MT * 4; u += gridDim.x) {
        const int mt = u >> 2, nt = u & 3;
        e.m0 = mt * 128; e.n0 = nt * 256;
        APlain a;
        if (hm) { const int b = mt * 128 >= LP ? 1 : 0, t0 = mt * 128 - b * LP; a.base = SCR16(p, SCR_Z) + ((size_t)(b * 16) * LP + t0) * 64; a.ld = 64; }
        else { a.base = SCR16(p, SCR_Z) + (size_t)(mt * 128) * D_; a.ld = D_; }
        gemm_tile<128, 256, 64, 64, true>(lds, a, WL_OUT(p) + (size_t)(nt * 256) * D_, D_, D_, e, hm ? (size_t)LP * 64 : (size_t)64);
    }
}

template <bool COMBINE>
DI void phase_ln(const Params& p, const float* gam, const float* bet) {
    const int tid0 = tid_(); const int lane = tid0 & 63, wid = tid0 >> 6;
    bf16_t* h16 = H16(p);
    const int* tok_slot = (const int*)(p.ws + OFF_TAB) + 2 * NSLOT;
    const bf16_t* Y = SCR16(p, SCR_Y);
    const int c0 = lane * 16;
    f32x4 g4[4], b4[4];
#pragma unroll
    for (int i = 0; i < 4; ++i) { g4[i] = *(const f32x4*)(gam + c0 + 4 * i); b4[i] = *(const f32x4*)(bet + c0 + 4 * i); }
    for (int n = blockIdx.x * 8 + wid; n < NTOK; n += gridDim.x * 8) {
        const int b = n >= LSEQ ? 1 : 0, t = n - b * LSEQ, prow = b * LP + t;
        float* hr = h32row(p, prow);
        f32x4 x[4];
#pragma unroll
        for (int i = 0; i < 4; ++i) x[i] = *(const f32x4*)(hr + c0 + 4 * i);
        if (COMBINE) {
#pragma unroll
            for (int i = 0; i < 4; ++i) x[i] = x[i] * DN_ALPHA;
#pragma unroll
            for (int k = 0; k < 9; ++k) {
                const bf16_t* src = k == 8 ? h16 + (size_t)prow * D_ : Y + (size_t)tok_slot[n * 8 + k] * D_;
                const u32x4 w0 = *(const u32x4*)(src + c0), w1 = *(const u32x4*)(src + c0 + 8);
                x[0][0] += bflo(w0.x); x[0][1] += bfhi(w0.x); x[0][2] += bflo(w0.y); x[0][3] += bfhi(w0.y);
                x[1][0] += bflo(w0.z); x[1][1] += bfhi(w0.z); x[1][2] += bflo(w0.w); x[1][3] += bfhi(w0.w);
                x[2][0] += bflo(w1.x); x[2][1] += bfhi(w1.x); x[2][2] += bflo(w1.y); x[2][3] += bfhi(w1.y);
                x[3][0] += bflo(w1.z); x[3][1] += bfhi(w1.z); x[3][2] += bflo(w1.w); x[3][3] += bfhi(w1.w);
            }
        }
        float s = 0.f;
#pragma unroll
        for (int i = 0; i < 4; ++i) s += (x[i][0] + x[i][1]) + (x[i][2] + x[i][3]);
        const float mean = wave_sum(s) * (1.0f / 1024.0f);
        float qv = 0.f;
#pragma unroll
        for (int i = 0; i < 4; ++i) { const f32x4 d = x[i] - mean; qv += (d[0] * d[0] + d[1] * d[1]) + (d[2] * d[2] + d[3] * d[3]); }
        const float rstd = rsqrtf(wave_sum(qv) * (1.0f / 1024.0f) + LN_EPS);
        u32x4 o0, o1;
#pragma unroll
        for (int i = 0; i < 4; ++i) { x[i] = (x[i] - mean) * rstd * g4[i] + b4[i]; *(f32x4*)(hr + c0 + 4 * i) = x[i]; }
        o0.x = cvt_pk_bf16(x[0][0], x[0][1]); o0.y = cvt_pk_bf16(x[0][2], x[0][3]); o0.z = cvt_pk_bf16(x[1][0], x[1][1]); o0.w = cvt_pk_bf16(x[1][2], x[1][3]);
        o1.x = cvt_pk_bf16(x[2][0], x[2][1]); o1.y = cvt_pk_bf16(x[2][2], x[2][3]); o1.z = cvt_pk_bf16(x[3][0], x[3][1]); o1.w = cvt_pk_bf16(x[3][2], x[3][3]);
        *(u32x4*)(h16 + (size_t)prow * D_ + c0) = o0; *(u32x4*)(h16 + (size_t)prow * D_ + c0 + 8) = o1;
    }
}

DI void phase_qkv(const Params& p, unsigned char* lds, int l) {
    const int nq = MT * 4, nk = l == 2 ? MT * 4 : 0, nv = nk;
    for (int u = blockIdx.x; u < nq + nk + nv; u += gridDim.x) {
        if (u < nq + nk) {
            const bool isq = u < nq; const int r = isq ? u : u - nq, mt = r >> 2, nt = r & 3;
            EpiQK e; e.m0 = mt * 128; e.n0 = nt * 256; e.dst = isq ? SCR16(p, 0) : KBUF(p); e.scale = isq ? 0.125f * 1.4426950408889634f : 1.0f;
            APlain a; a.base = H16(p) + (size_t)(mt * 128) * D_; a.ld = D_;
            const bf16_t* B = isq ? WL_WQ(p) + (size_t)(nt * 256) * D_ : WL_BIG(p) + (size_t)(nt * 256) * D_;
            gemm_tile<128, 256, 64, 64, true>(lds, a, B, D_, D_, e);
        } else {
            const int r = u - nq - nk, mt = r >> 2, nt = r & 3;
            EpiVt e; e.m0 = mt * 128; e.n0 = nt * 256; e.dst = VTBUF(p);
            APlain a; a.base = H16(p) + (size_t)(mt * 128) * D_; a.ld = D_;
            gemm_tile<128, 256, 64, 64, false>(lds, a, WL_BIG(p) + (size_t)(1024 + nt * 256) * D_, D_, D_, e);
        }
    }
}

DI int crow32(int i, int h) { return (i & 3) + 8 * (i >> 2) + 4 * h; }

DI void phase_attn(const Params& p, unsigned char* lds, int j, int rep = 0) {
    const int tid = tid_(), lane = tid & 63, wid = tid >> 6, cmap = wid >> 2, rg = wid & 3, ql = lane & 31, hh = lane >> 5;
    const float lam_init = j == 0 ? (float)(0.8 - 0.6 * 0.5488116360940264) : (float)(0.8 - 0.6 * 0.4065696597405991);
    float d1 = 0.f, d2 = 0.f;
    for (int i = 0; i < 64; ++i) { d1 += p.in[I_LQ1][j * 64 + i] * p.in[I_LK1][j * 64 + i]; d2 += p.in[I_LQ2][j * 64 + i] * p.in[I_LK2][j * 64 + i]; }
    const float lam = __expf(d1) - __expf(d2) + lam_init;
    const float post = 1.0f - lam_init;
    const bf16_t* Q = SCR16(p, 0); const bf16_t* Kb = KBUF(p); const bf16_t* Vt = VTBUF(p); bf16_t* Z = SCR16(p, SCR_Z);
    const float* subg = p.in[I_SUBG] + j * 128;
    unsigned* ctr = CTRL(p) + CT_ATTNQ + 64 * (j + 2 * rep);
    constexpr int STG = 32768;
    unsigned* s_u = (unsigned*)(lds + 2 * STG);
    constexpr int NQB = LP / 128;
    const int total = NB * 8 * NQB;
    const int krow = tid >> 3, kc8 = tid & 7;
    const unsigned koff = krow * 128 + ((kc8 ^ ((krow >> 1) & 7)) << 4);
    for (;;) {
        if (tid == 0) *s_u = atomicAdd(ctr, 1u);
        __syncthreads();
        const int u = (int)*s_u;
        __syncthreads();
        if (u >= total) break;
        const int qb = NQB - 1 - u / 16, bh = u & 15, b = bh >> 3, head = bh & 7;
        const int q0 = qb * 128 + rg * 32;
        bf16x8 qf[4];
        {
            const bf16_t* qp = Q + (((size_t)(b * 16 + head * 2 + cmap)) * LP + q0 + ql) * 64 + 8 * hh;
#pragma unroll
            for (int s = 0; s < 4; ++s) qf[s] = *(const bf16x8*)(qp + 16 * s);
        }
        const bf16_t* k0p = Kb + (((size_t)(b * 16 + head * 2 + 0)) * LP) * 64 + krow * 64 + kc8 * 8;
        const bf16_t* k1p = Kb + (((size_t)(b * 16 + head * 2 + 1)) * LP) * 64 + krow * 64 + kc8 * 8;
        const bf16_t* vp0 = Vt + ((size_t)(b * 1024 + head * 128 + krow)) * LP + kc8 * 8;
        const bf16_t* vp1 = vp0 + (size_t)64 * LP;
        const int ntile = 2 * qb + 2;
        f32x16 O[4];
#pragma unroll
        for (int i = 0; i < 4; ++i)
#pragma unroll
            for (int r = 0; r < 16; ++r) O[i][r] = 0.f;
        float m_run = -1e30f, l_run = 0.f;
        u32x4 rk0, rk1, rv0, rv1;
        rk0 = *(const u32x4*)(k0p); rk1 = *(const u32x4*)(k1p); rv0 = *(const u32x4*)(vp0); rv1 = *(const u32x4*)(vp1);
        auto stage_write = [&](unsigned char* st) {
            *(u32x4*)(st + koff) = rk0; *(u32x4*)(st + 8192 + koff) = rk1;
            {
                const int r0 = krow, r1 = krow + 64;
                const int s0 = (r0 >> 1) & 15, s1 = (r1 >> 1) & 15;
                unsigned char* vb = st + 16384;
                *(u32x2*)(vb + r0 * 128 + (((2 * kc8) ^ s0) << 3)) = (u32x2){rv0.x, rv0.y};
                *(u32x2*)(vb + r0 * 128 + (((2 * kc8 + 1) ^ s0) << 3)) = (u32x2){rv0.z, rv0.w};
                *(u32x2*)(vb + r1 * 128 + (((2 * kc8) ^ s1) << 3)) = (u32x2){rv1.x, rv1.y};
                *(u32x2*)(vb + r1 * 128 + (((2 * kc8 + 1) ^ s1) << 3)) = (u32x2){rv1.z, rv1.w};
            }
        };
        stage_write(lds);
        __syncthreads();
        for (int kt = 0; kt < ntile; ++kt) {
            const unsigned char* cur = lds + (kt & 1) * STG;
            const bool more = kt + 1 < ntile;
            if (more) {
                const size_t ko = (size_t)(kt + 1) * 64 * 64, vo = (size_t)(kt + 1) * 64;
                rk0 = *(const u32x4*)(k0p + ko); rk1 = *(const u32x4*)(k1p + ko); rv0 = *(const u32x4*)(vp0 + vo); rv1 = *(const u32x4*)(vp1 + vo);
            }
            const int key0 = kt * 64;
            if (key0 <= q0 + 31) {
                const unsigned char* kst = cur + cmap * 8192;
                f32x16 sc[2];
#pragma unroll
                for (int kb = 0; kb < 2; ++kb) {
#pragma unroll
                    for (int r = 0; r < 16; ++r) sc[kb][r] = 0.f;
                    const int row = kb * 32 + ql;
#pragma unroll
                    for (int s = 0; s < 4; ++s) {
                        const bf16x8 kf = *(const bf16x8*)(kst + row * 128 + (((2 * s + hh) ^ ((row >> 1) & 7)) << 4));
                        sc[kb] = __builtin_amdgcn_mfma_f32_32x32x16_bf16(kf, qf[s], sc[kb], 0, 0, 0);
                    }
                }
                if (key0 + 63 > q0) {
                    const int qq = q0 + ql;
#pragma unroll
                    for (int kb = 0; kb < 2; ++kb)
#pragma unroll
                        for (int r = 0; r < 16; ++r) { const int key = key0 + kb * 32 + crow32(r, hh); if (key > qq) sc[kb][r] = -INFINITY; }
                }
                float mx = sc[0][0];
#pragma unroll
                for (int kb = 0; kb < 2; ++kb)
#pragma unroll
                    for (int r = 0; r < 16; ++r) mx = fmaxf(mx, sc[kb][r]);
                mx = fmaxf(mx, __shfl_xor(mx, 32));
                const float m_new = fmaxf(m_run, mx);
                const float alpha = __builtin_amdgcn_exp2f(m_run - m_new);
                m_run = m_new;
                float ps = 0.f;
#pragma unroll
                for (int kb = 0; kb < 2; ++kb)
#pragma unroll
                    for (int r = 0; r < 16; ++r) { const float e = __builtin_amdgcn_exp2f(sc[kb][r] - m_new); sc[kb][r] = e; ps += e; }
                l_run = l_run * alpha + ps;
#pragma unroll
                for (int i = 0; i < 4; ++i)
#pragma unroll
                    for (int r = 0; r < 16; ++r) O[i][r] *= alpha;
                const unsigned char* vst = cur + 16384;
#pragma unroll
                for (int s = 0; s < 4; ++s) {
                    const int kb = s >> 1, r0 = 8 * (s & 1);
                    u32x4 pw;
                    pw.x = cvt_pk_bf16(sc[kb][r0 + 0], sc[kb][r0 + 1]); pw.y = cvt_pk_bf16(sc[kb][r0 + 2], sc[kb][r0 + 3]);
                    pw.z = cvt_pk_bf16(sc[kb][r0 + 4], sc[kb][r0 + 5]); pw.w = cvt_pk_bf16(sc[kb][r0 + 6], sc[kb][r0 + 7]);
                    const bf16x8 pf = __builtin_bit_cast(bf16x8, pw);
#pragma unroll
                    for (int dvb = 0; dvb < 4; ++dvb) {
                        const int row = dvb * 32 + ql, sw = (row >> 1) & 15;
                        const u32x2 lo = *(const u32x2*)(vst + row * 128 + (((4 * s + hh) ^ sw) << 3));
                        const u32x2 hi = *(const u32x2*)(vst + row * 128 + (((4 * s + 2 + hh) ^ sw) << 3));
                        const bf16x8 vf = __builtin_bit_cast(bf16x8, (u32x4){lo.x, lo.y, hi.x, hi.y});
                        O[dvb] = __builtin_amdgcn_mfma_f32_32x32x16_bf16(vf, pf, O[dvb], 0, 0, 0);
                    }
                }
            }
            if (more) stage_write(lds + ((kt + 1) & 1) * STG);
            __syncthreads();
        }
        const float l_tot = l_run + __shfl_xor(l_run, 32);
        const float inv = 1.0f / l_tot;
        float* xb = (float*)lds + rg * 4096;
        if (cmap == 1) {
            const float sc1 = lam * inv;
#pragma unroll
            for (int i = 0; i < 4; ++i)
#pragma unroll
                for (int r = 0; r < 16; ++r) xb[(i * 16 + r) * 64 + lane] = O[i][r] * sc1;
        }
        __syncthreads();
        if (cmap == 0) {
            float ss = 0.f;
#pragma unroll
            for (int i = 0; i < 4; ++i)
#pragma unroll
                for (int r = 0; r < 16; ++r) { const float o = O[i][r] * inv - xb[(i * 16 + r) * 64 + lane]; O[i][r] = o; ss += o * o; }
            ss += __shfl_xor(ss, 32);
            const float rn = rsqrtf(ss * (1.0f / 128.0f) + 1e-5f) * post;
            bf16_t* zp = Z + ((size_t)(b * LP + q0 + ql)) * D_ + head * 128;
#pragma unroll
            for (int i = 0; i < 4; ++i)
#pragma unroll
                for (int g = 0; g < 4; ++g) {
                    const int dv = i * 32 + 8 * g + 4 * hh;
                    const f32x4 sg = *(const f32x4*)(subg + dv);
                    f32x4 o; o[0] = O[i][4 * g + 0] * rn * sg[0]; o[1] = O[i][4 * g + 1] * rn * sg[1]; o[2] = O[i][4 * g + 2] * rn * sg[2]; o[3] = O[i][4 * g + 3] * rn * sg[3];
                    st_bf4(zp + dv, o);
                }
        }
        __syncthreads();
    }
}

DI int* TAB_IDX(const Params& p) { return (int*)(p.ws + OFF_TAB); }
DI float* TAB_GATE(const Params& p) { return (float*)(p.ws + OFF_TAB) + NSLOT; }
DI int* TAB_TOKSLOT(const Params& p) { return (int*)(p.ws + OFF_TAB) + 2 * NSLOT; }
DI int* TAB_SLOTTOK(const Params& p) { return (int*)(p.ws + OFF_TAB) + 3 * NSLOT; }
DI float* TAB_SLOTGATE(const Params& p) { return (float*)(p.ws + OFF_TAB) + 4 * NSLOT; }
DI int* TAB_TILES(const Params& p) { return (int*)(p.ws + OFF_TAB) + 5 * NSLOT; }

DI void phase_router(const Params& p, unsigned char* lds, int l) {
    float* lg = (float*)(lds + 2 * (128 + 64) * 128);
    unsigned* hist = (unsigned*)(lds + 2 * (128 + 64) * 128 + 128 * 65 * 4);
    const int tid = tid_(), lane = tid & 63, wid = tid >> 6;
    if (tid < 64) hist[tid] = 0u;
    __syncthreads();
    const float bias = p.in[I_RTB][l * NE + lane];
    int* idx = TAB_IDX(p); float* gt = TAB_GATE(p);
    for (int mt = blockIdx.x; mt < MT; mt += gridDim.x) {
        EpiLds e; e.dst = lg;
        APlain a; a.base = H16(p) + (size_t)(mt * 128) * D_; a.ld = D_;
        gemm_tile<128, 64, 16, 64, true>(lds, a, WS_RT(p), D_, D_, e);
        __syncthreads();
        for (int rr = 0; rr < 16; ++rr) {
            const int prow = mt * 128 + wid * 16 + rr;
            const int b = prow >= LP ? 1 : 0, t = prow - b * LP;
            if (t >= LSEQ) continue;
            const int n = b * LSEQ + t;
            const float s = sigmoidf_(lg[(wid * 16 + rr) * 65 + lane]);
            const float sel = s + bias;
            const float m1 = red8_max(sel);
            const unsigned long long eq = __ballot(sel == m1);
            const unsigned gb = (unsigned)(eq >> ((lane >> 3) * 8)) & 0xffu;
            const int first = __builtin_ctz(gb | 0x100u);
            const float sel2 = (lane & 7) == first ? -INFINITY : sel;
            const float gs = m1 + red8_max(sel2);
            int rank = 0;
#pragma unroll
            for (int g = 0; g < 8; ++g) { const float o = rdlane(gs, g * 8); rank += (o > gs || (o == gs && g < (lane >> 3))) ? 1 : 0; }
            float cur = rank < 4 ? sel : -INFINITY;
            float wsum = 0.f, my_s = 0.f; int my_i = 0;
#pragma unroll
            for (int k = 0; k < 8; ++k) {
                const float m = wave_max(cur);
                const unsigned long long bal = __ballot(cur == m);
                const int win = __builtin_ctzll(bal | (1ull << 63));
                const float swv = rdlane(s, win);
                wsum += swv;
                if (lane == k) { my_i = win; my_s = swv; }
                if (lane == win) cur = -INFINITY;
            }
            if (lane < 8) {
                idx[n * 8 + lane] = my_i; gt[n * 8 + lane] = my_s / wsum * 2.5f;
                atomicAdd(hist + my_i, 1u);
            }
        }
        __syncthreads();
    }
    __syncthreads();
    if (tid < 64 && hist[tid]) atomicAdd(CTRL(p) + CT_CNT + 64 * l + tid, (unsigned)hist[tid]);
}

DI void phase_scatter(const Params& p, unsigned char* lds, int l) {
    unsigned* cnt = (unsigned*)lds; unsigned* lh = cnt + 64; unsigned* lbase = lh + 64; unsigned* lcur = lbase + 64; unsigned* start = lcur + 64;
    const int tid = tid_();
    unsigned* gc = CTRL(p) + CT_CNT + 64 * l; unsigned* gcur = CTRL(p) + CT_CUR + 64 * l;
    if (tid < 64) { cnt[tid] = __hip_atomic_load(gc + tid, __ATOMIC_RELAXED, __HIP_MEMORY_SCOPE_AGENT); lh[tid] = 0u; lcur[tid] = 0u; }
    __syncthreads();
    if (tid < 64) { unsigned s = 0; for (int e = 0; e < tid; ++e) s += cnt[e]; start[tid] = s; }
    const int per = (NTOK + gridDim.x - 1) / gridDim.x;
    const int n0 = blockIdx.x * per, n1 = n0 + per < NTOK ? n0 + per : NTOK;
    const int* idx = TAB_IDX(p); const float* gt = TAB_GATE(p);
    int* tok_slot = TAB_TOKSLOT(p); int* slot_tok = TAB_SLOTTOK(p); float* slot_gate = TAB_SLOTGATE(p);
    __syncthreads();
    for (int i = n0 * 8 + tid; i < n1 * 8; i += NTHR) atomicAdd(lh + idx[i], 1u);
    __syncthreads();
    if (tid < 64) lbase[tid] = start[tid] + (lh[tid] ? atomicAdd(gcur + tid, (unsigned)lh[tid]) : 0u);
    __syncthreads();
    for (int i = n0 * 8 + tid; i < n1 * 8; i += NTHR) {
        const int e = idx[i], n = i >> 3;
        const unsigned pos = lbase[e] + atomicAdd(lcur + e, 1u);
        const int b = n >= LSEQ ? 1 : 0, t = n - b * LSEQ;
        slot_tok[pos] = b * LP + t; slot_gate[pos] = gt[i]; tok_slot[i] = (int)pos;
    }
    if (blockIdx.x == 0 && tid < 64) {
        unsigned tb = 0; for (int e = 0; e < tid; ++e) tb += (cnt[e] + 127) >> 7;
        const unsigned nt = (cnt[tid] + 127) >> 7;
        int* tiles = TAB_TILES(p);
        for (unsigned i = 0; i < nt; ++i) { int* tp = tiles + (tb + i) * 4; tp[0] = tid; tp[1] = (int)(start[tid] + 128 * i); const int rem = (int)cnt[tid] - 128 * (int)i; tp[2] = rem < 128 ? rem : 128; tp[3] = 0; }
        if (tid == 63) CTRL(p)[CT_NT + l] = tb + nt;
    }
}

DI void phase_m1(const Params& p, unsigned char* lds, int l) {
    const int T = (int)CTRL(p)[CT_NT + l];
    const int* tiles = TAB_TILES(p);
    for (int u = blockIdx.x; u < (T + MT) * 2; u += gridDim.x) {
        const int tile = u >> 1, half = u & 1;
        EpiM1 e; e.n0 = half * 256;
        if (tile < T) {
            const int ex = tiles[tile * 4], s0 = tiles[tile * 4 + 1], nr = tiles[tile * 4 + 2];
            e.dst = SCR16(p, SCR_H); e.gate = TAB_SLOTGATE(p); e.row0 = s0; e.nrows = nr;
            AGather a; a.base = H16(p); a.rows = TAB_SLOTTOK(p) + s0; a.nrows = nr;
            gemm_tile<128, 256, 64, 64, true>(lds, a, WM_GU(p) + ((size_t)ex * 512 + half * 256) * D_, D_, D_, e);
        } else {
            const int mt = tile - T;
            e.dst = SCR16(p, SCR_HS); e.gate = nullptr; e.row0 = mt * 128; e.nrows = 128;
            APlain a; a.base = H16(p) + (size_t)(mt * 128) * D_; a.ld = D_;
            gemm_tile<128, 256, 64, 64, true>(lds, a, WS_GU(p) + (size_t)(half * 256) * D_, D_, D_, e);
        }
    }
}
DI void phase_m2(const Params& p, unsigned char* lds, int l) {
    const int T = (int)CTRL(p)[CT_NT + l];
    const int* tiles = TAB_TILES(p);
    for (int u = blockIdx.x; u < (T + MT) * 4; u += gridDim.x) {
        const int tile = u >> 2, nq = u & 3;
        EpiM2 e; e.n0 = nq * 256;
        if (tile < T) {
            const int ex = tiles[tile * 4], s0 = tiles[tile * 4 + 1], nr = tiles[tile * 4 + 2];
            e.dst = SCR16(p, SCR_Y); e.row0 = s0; e.nrows = nr;
            int last = NSLOT - 1 - s0; if (last > 127) last = 127;
            AClamp a;
            a.base = SCR16(p, SCR_H) + (size_t)s0 * FF; a.last = last;
            gemm_tile<128, 256, 64, 64, true>(lds, a, WM_DN(p) + ((size_t)ex * 1024 + nq * 256) * FF, FF, FF, e);
        } else {
            const int mt = tile - T;
            e.dst = H16(p); e.row0 = mt * 128; e.nrows = 128;
            APlain a; a.base = SCR16(p, SCR_HS) + (size_t)(mt * 128) * FF; a.ld = FF;
            gemm_tile<128, 256, 64, 64, true>(lds, a, WS_DN(p) + (size_t)(nq * 256) * FF, FF, FF, e);
        }
    }
}

__global__ void __launch_bounds__(NTHR, 2) mega(Params p) {
    extern __shared__ __attribute__((aligned(16))) unsigned char lds[];
    LAS unsigned* xbw = (LAS unsigned*)(lds + LDS_BAR);
    if (threadIdx.x == 0) { xbw[0] = 0u; xbw[1] = 0u; xbw[2] = 0u; xbw[3] = 0u; }
    __syncthreads();
    XcdBarrier bar = xcd_barrier_post(CTRL(p), (volatile LAS unsigned*)xbw);
    phase_init(p);
    phase_weights(p, lds, 0);
    xcd_barrier(bar);
    for (int l = 0; l < 4; ++l) {
        if (l < 2) {
            phase_r1(p, lds, l); xcd_barrier(bar);
            phase_r2(p, lds, l); xcd_barrier(bar);
            phase_scanA(p, lds, l); xcd_barrier(bar);
            phase_scanB(p, lds, l); xcd_barrier(bar);
#ifdef REP_B
            phase_scanB(p, lds, l); xcd_barrier(bar);
#endif
            phase_scanC(p, lds, l); xcd_barrier(bar);
#ifdef REP_C
            phase_scanC(p, lds, l); xcd_barrier(bar);
#endif
        } else {
            phase_qkv(p, lds, l); xcd_barrier(bar);
            phase_attn(p, lds, l - 2); xcd_barrier(bar);
#ifdef REP_ATTN
            phase_attn(p, lds, l - 2, 1); xcd_barrier(bar);
#endif
        }
        phase_outproj(p, lds, l < 2); xcd_barrier(bar);
        phase_ln<false>(p, p.in[I_LNMG] + l * D_, p.in[I_LNMB] + l * D_); xcd_barrier(bar);
        phase_router(p, lds, l); xcd_barrier(bar);
        phase_scatter(p, lds, l); xcd_barrier(bar);
        phase_m1(p, lds, l); xcd_barrier(bar);
        phase_m2(p, lds, l); xcd_barrier(bar);
        phase_ln<true>(p, p.in[I_LNFG] + l * D_, p.in[I_LNFB] + l * D_);
        if (l < 3) phase_weights(p, lds, l + 1);
        xcd_barrier(bar);
    }
}

extern "C" void kernel_launch(void* const* d_in, const int* in_sizes, int n_in, void* d_out, int out_size, void* d_ws, size_t ws_size, hipStream_t stream) {
    constexpr size_t kDynLds = LDS_BAR + 256;
    static int grid = 0;
    if (!grid) {
        int dev = 0, cus = 0, per_cu = 0;
        hipGetDevice(&dev);
        hipDeviceGetAttribute(&cus, hipDeviceAttributeMultiprocessorCount, dev);
        hipFuncSetAttribute((const void*)mega, hipFuncAttributeMaxDynamicSharedMemorySize, (int)kDynLds);
        hipOccupancyMaxActiveBlocksPerMultiprocessor(&per_cu, mega, NTHR, kDynLds);
        grid = cus * (per_cu < 1 ? per_cu : 1);
        if (grid <= 0) grid = 0;
    }
    if (n_in < 41 || ws_size < WS_NEED || grid <= 0) { fprintf(stderr, "kernel_launch: bad config (n_in %d ws %zu need %zu grid %d)\n", n_in, ws_size, (size_t)WS_NEED, grid); return; }
    hipMemsetAsync(d_ws, 0, 65536, stream);
    Params p; memset(&p, 0, sizeof(p));
    for (int i = 0; i < 41; ++i) p.in[i] = (const float*)d_in[i];
    p.out = (float*)d_out; p.ws = (unsigned char*)d_ws;
    hipLaunchKernelGGL(mega, dim3(grid), dim3(NTHR), kDynLds, stream, p);
}
#ifdef PHASE_TEST
#define PK(name, body) __global__ void __launch_bounds__(NTHR, 2) name(Params p, int l) { extern __shared__ __attribute__((aligned(16))) unsigned char lds[]; body; }
PK(t_init, phase_init(p))
PK(t_weights, phase_weights(p, lds, l))
PK(t_r1, phase_r1(p, lds, l))
PK(t_r2, phase_r2(p, lds, l))
PK(t_scanA, phase_scanA(p, lds, l))
PK(t_scanB, phase_scanB(p, lds, l))
PK(t_scanC, phase_scanC(p, lds, l))
PK(t_outproj, phase_outproj(p, lds, l < 2))
PK(t_ln0, phase_ln<false>(p, p.in[I_LNMG], p.in[I_LNMB]))
PK(t_ln1, phase_ln<true>(p, p.in[I_LNMG], p.in[I_LNMB]))
PK(t_qkv, phase_qkv(p, lds, l))
PK(t_attn, phase_attn(p, lds, l))
PK(t_router, phase_router(p, lds, l))
PK(t_scatter, phase_scatter(p, lds, l))
PK(t_m1, phase_m1(p, lds, l))
PK(t_m2, phase_m2(p, lds, l))
#endif
```

```cpp
#include <hip/hip_runtime.h>
#include <stdint.h>
#include <stdio.h>
#include <string.h>

#define DI __device__ __forceinline__
typedef unsigned short bf16_t;
typedef short bf16x8 __attribute__((ext_vector_type(8)));
typedef short s16x4 __attribute__((ext_vector_type(4)));
typedef float f32x2 __attribute__((ext_vector_type(2)));
typedef float f32x4 __attribute__((ext_vector_type(4)));
typedef float f32x16 __attribute__((ext_vector_type(16)));
typedef unsigned u32x4 __attribute__((ext_vector_type(4)));
typedef unsigned u32x2 __attribute__((ext_vector_type(2)));

constexpr int D_ = 1024, NB = 2, SEQ = 16384, NMETA = 16, LSEQ = SEQ + NMETA, LP = 16512, NP = NB * LP, NTOK = NB * LSEQ;
constexpr int NE = 64, TOPK = 8, FF = 256, NSLOT = NTOK * TOPK;
constexpr int NTHR = 512;
constexpr int LDS_BAR = 145408;
constexpr int NCHR = 257;
constexpr int MT = NP / 128;
constexpr float DN_ALPHA = 1.6817928305074290f;
constexpr float LN_EPS = 1e-5f;
constexpr int WBIG_ROWS = 3584, LO1_W = 384;

constexpr size_t AL(size_t x) { return (x + 255) & ~(size_t)255; }
constexpr size_t OFF_CTRL = 0;
constexpr size_t OFF_META32 = 65536;
constexpr size_t OFF_H16 = OFF_META32 + (size_t)NB * NMETA * D_ * 4;
constexpr size_t SZ_ACT16 = (size_t)NP * D_ * 2;
constexpr size_t OFF_KV = AL(OFF_H16 + SZ_ACT16 + 2048);
constexpr size_t OFF_WL = AL(OFF_KV + 2 * SZ_ACT16);
constexpr size_t SZ_WL = (size_t)WBIG_ROWS * 2048 * 2 + (size_t)1024 * LO1_W * 2 + (size_t)1024 * 1024 * 2;
constexpr size_t OFF_WSH = AL(OFF_WL + SZ_WL);
constexpr size_t SZ_WSH = (size_t)512 * 1024 * 2 + (size_t)1024 * 256 * 2 + (size_t)64 * 1024 * 2;
constexpr size_t OFF_WMOE = AL(OFF_WSH + SZ_WSH);
constexpr size_t SZ_WMOE = (size_t)NE * (512 * 1024 + 1024 * 256) * 2;
constexpr size_t OFF_TAB = AL(OFF_WMOE + SZ_WMOE);
constexpr size_t SZ_TAB = (size_t)NSLOT * 4 * 5 + 65536;
constexpr size_t OFF_SCR = AL(OFF_TAB + SZ_TAB);
constexpr size_t SCR_R = 0, SCR_K = SZ_ACT16, SCR_V = 2 * SZ_ACT16, SCR_G = 3 * SZ_ACT16, SCR_A = 4 * SZ_ACT16, SCR_Z = 5 * SZ_ACT16;
constexpr size_t SCR_W = 6 * SZ_ACT16;
constexpr size_t SCR_LO1 = SCR_W + 2 * SZ_ACT16;
constexpr size_t SCR_QS = SCR_LO1 + (size_t)NP * LO1_W * 2;
constexpr size_t SZ_SCR_RW = SCR_QS + SZ_ACT16;
constexpr size_t SCR_H = 0;
constexpr size_t SCR_HS = AL((size_t)NSLOT * 256 * 2);
constexpr size_t SCR_Y = AL(SCR_HS + (size_t)NP * 256 * 2);
constexpr size_t SCR_YSH = AL(SCR_Y + (size_t)NSLOT * 1024);
constexpr size_t SZ_SCR_MOE = SCR_Y + (size_t)NSLOT * 1024 * 2;
constexpr size_t SZ_SCR = SZ_SCR_MOE > SZ_SCR_RW ? SZ_SCR_MOE : SZ_SCR_RW;
constexpr size_t WS_NEED = OFF_SCR + SZ_SCR + 4096;

constexpr int CT_ATTNQ = 4096;
constexpr int CT_CNT = 4352;
constexpr int CT_CUR = 4608;
constexpr int CT_NT = 4864;

struct Params {
    const float* in[41];
    float* out;
    unsigned char* ws;
};
typedef const __attribute__((address_space(4))) Params* PP;
DI PP P_() { PP q = (PP)__builtin_amdgcn_kernarg_segment_ptr(); asm volatile("" : "+s"(q)); return q; }
enum { I_X = 0, I_META, I_LNMG, I_LNMB, I_LNFG, I_LNFB, I_MU, I_WRKV, I_W0, I_WL1, I_WL2, I_A0, I_AL1, I_AL2, I_GL1, I_GL2, I_KK, I_KA, I_RK, I_LNXG, I_LNXB, I_WOUT,
       I_V0, I_VL1, I_VL2, I_KVW, I_WQ, I_LQ1, I_LK1, I_LQ2, I_LK2, I_SUBG, I_DAWO, I_RTW, I_RTB, I_MG, I_MU_, I_MD, I_SG, I_SU, I_SD };

#define XB_TMO      128
#define XB_XCNT(j)  (256  + 64 * (j))
#define XB_XSUB(j)  (1280 + 64 * (j))
#define XB_XGEN(j)  (2304 + 64 * (j))
#define XB_TOP      3328
#define XB_TOPGEN   3392
#define XCD_BAR_WORDS 3456
#define XB_SPIN_CAP (1u << 22)
#define LAS __attribute__((address_space(3)))

__device__ __forceinline__ unsigned xb_ld(unsigned* p)              { return __hip_atomic_load(p, __ATOMIC_RELAXED, __HIP_MEMORY_SCOPE_AGENT); }
__device__ __forceinline__ unsigned xb_add(unsigned* p, unsigned v) { return __hip_atomic_fetch_add(p, v, __ATOMIC_RELAXED, __HIP_MEMORY_SCOPE_AGENT); }
__device__ __forceinline__ unsigned xb_xcc_id() { return (unsigned)__builtin_amdgcn_s_getreg((3 << 11) | 20) & 0xFu; }
#define XB_SPIN(cond, bar) do { unsigned _sp = 0; while (cond) { __builtin_amdgcn_s_sleep(1); \
    if ((++_sp & 255u) == 0u) { if (xb_ld(&(bar)[XB_TMO])) break; if (_sp > XB_SPIN_CAP) { atomicAdd(&(bar)[XB_TMO], 1u); break; } } } } while (0)

struct XcdBarrier { unsigned* bar; unsigned x; volatile LAS unsigned* st; };

__device__ __forceinline__ XcdBarrier xcd_barrier_post(unsigned* bar, volatile LAS unsigned* st) {
    XcdBarrier b; b.bar = bar; b.x = xb_xcc_id(); b.st = st;
    if (threadIdx.x == 0) (void)xb_add(&bar[XB_XCNT(b.x)], 1u);
    return b;
}
__device__ __forceinline__ void xcd_barrier_complete(unsigned* bar, unsigned x, unsigned& nloc, unsigned& nx) {
    const unsigned G = gridDim.x * gridDim.y * gridDim.z;
    unsigned sum, cnt, mine, sp = 0u;
    for (;;) {
        sum = 0u; cnt = 0u; mine = 0u;
#pragma unroll
        for (unsigned j = 0; j < 16; ++j) { const unsigned c = xb_ld(&bar[XB_XCNT(j)]); sum += c; cnt += (c > 0u) ? 1u : 0u; mine = (j == x) ? c : mine; }
        if (sum == G) break;
        __builtin_amdgcn_s_sleep(1);
        if ((++sp & 255u) == 0u) { if (xb_ld(&bar[XB_TMO])) break; if (sp > XB_SPIN_CAP) { atomicAdd(&bar[XB_TMO], 1u); break; } }
    }
    nloc = mine > 0u ? mine : 1u; nx = cnt > 0u ? cnt : 1u;
}
__device__ __forceinline__ void xcd_barrier(const XcdBarrier& b) {
    asm volatile("s_waitcnt vmcnt(0)" ::: "memory");
    __syncthreads();
    if (threadIdx.x == 0) {
        unsigned* bar = b.bar;
        __builtin_amdgcn_s_waitcnt(0);
        unsigned nloc = b.st[0], nx = b.st[1];
        if (nloc == 0u) { xcd_barrier_complete(bar, b.x, nloc, nx); b.st[0] = nloc; b.st[1] = nx; }
        const unsigned old = xb_add(&bar[XB_XSUB(b.x)], 1u);
        const unsigned gen = old / nloc;
        if (old + 1u == (gen + 1u) * nloc) {
            __builtin_amdgcn_fence(__ATOMIC_RELEASE, "agent");
            asm volatile("s_waitcnt vmcnt(0)" ::: "memory");
            const unsigned og = xb_add(&bar[XB_TOP], 1u);
            const unsigned tg = og / nx;
            if (og + 1u == (tg + 1u) * nx) xb_add(&bar[XB_TOPGEN], 1u);
            else XB_SPIN(xb_ld(&bar[XB_TOPGEN]) == tg, bar);
            __builtin_amdgcn_fence(__ATOMIC_ACQUIRE, "agent");
            xb_add(&bar[XB_XGEN(b.x)], 1u);
            asm volatile("s_waitcnt vmcnt(0)" ::: "memory");
        } else {
            XB_SPIN(xb_ld(&bar[XB_XGEN(b.x)]) == gen, bar);
            __builtin_amdgcn_fence(__ATOMIC_ACQUIRE, "agent");
            asm volatile("s_waitcnt vmcnt(0)" ::: "memory");
        }
    }
    __syncthreads();
}

struct Params;
DI int tid_() { int t = threadIdx.x; asm volatile("" : "+v"(t)); return t; }
DI int lane_now() { int l; asm volatile("v_mbcnt_lo_u32_b32 %0, -1, 0\n\tv_mbcnt_hi_u32_b32 %0, -1, %0" : "=v"(l)); return l; }
typedef __bf16 bf16v2 __attribute__((ext_vector_type(2)));
DI unsigned cvt_pk_bf16(float lo, float hi) { f32x2 v = {lo, hi}; bf16v2 b = __builtin_convertvector(v, bf16v2); return __builtin_bit_cast(unsigned, b); }
DI float bf2f(bf16_t x) { return __uint_as_float((unsigned)x << 16); }
DI float bflo(unsigned w) { return __uint_as_float(w << 16); }
DI float bfhi(unsigned w) { return __uint_as_float(w & 0xffff0000u); }
DI bf16_t f2bf(float x) { return (bf16_t)(cvt_pk_bf16(x, 0.f) & 0xffffu); }
DI float sigmoidf_(float x) { return 1.0f / (1.0f + __expf(-x)); }
DI float tanhf_(float x) { const float t = __expf(-2.0f * fabsf(x)); const float r = (1.0f - t) / (1.0f + t); return x < 0.f ? -r : r; }
template <int CTRL> DI float dpp_f(float v) { return __builtin_bit_cast(float, __builtin_amdgcn_update_dpp(0, __builtin_bit_cast(int, v), CTRL, 0xF, 0xF, true)); }
DI float rdlane(float v, int l) { return __builtin_bit_cast(float, __builtin_amdgcn_readlane(__builtin_bit_cast(int, v), l)); }
DI float red8_sum(float v) { v += dpp_f<0xB1>(v); v += dpp_f<0x4E>(v); v += dpp_f<0x141>(v); return v; }
DI float red16_sum(float v) { v = red8_sum(v); v += dpp_f<0x140>(v); return v; }
DI float wave_sum(float v) { v = red16_sum(v); return (rdlane(v, 0) + rdlane(v, 16)) + (rdlane(v, 32) + rdlane(v, 48)); }
DI float red8_max(float v) { v = fmaxf(v, dpp_f<0xB1>(v)); v = fmaxf(v, dpp_f<0x4E>(v)); v = fmaxf(v, dpp_f<0x141>(v)); return v; }
DI float wave_max(float v) { v = red8_max(v); v = fmaxf(v, dpp_f<0x140>(v)); return fmaxf(fmaxf(rdlane(v, 0), rdlane(v, 16)), fmaxf(rdlane(v, 32), rdlane(v, 48))); }

DI bf16_t* H16(PP p) { return (bf16_t*)(p->ws + OFF_H16 + 2048); }
DI float* h32row_(float* out, unsigned char* ws, int prow) {
    const int b = prow >= LP ? 1 : 0, t = prow - b * LP;
    return t < NMETA ? (float*)(ws + OFF_META32) + (size_t)(b * NMETA + t) * D_ : out + ((size_t)b * SEQ + (t - NMETA)) * D_;
}
DI float* h32row(PP p, int prow) { return h32row_(p->out, p->ws, prow); }
DI unsigned* CTRL(PP p) { return (unsigned*)(p->ws + OFF_CTRL); }
DI XcdBarrier mkbar(PP p, unsigned char* lds) { XcdBarrier b; b.bar = CTRL(p); b.x = xb_xcc_id(); b.st = (volatile LAS unsigned*)(lds + LDS_BAR); return b; }

DI int pk4_fp8(f32x4 a) { return __builtin_amdgcn_cvt_pk_fp8_f32(a[2], a[3], __builtin_amdgcn_cvt_pk_fp8_f32(a[0], a[1], 0, false), true); }
DI unsigned char* H8BUF(PP p) { return p->ws + OFF_KV + SZ_ACT16 + SZ_ACT16 / 2; }
DI void phase_init(PP p) {
    bf16_t* h16 = H16(p);
    const float* x = p->in[I_X]; const float* meta = p->in[I_META];
    const int tid0 = tid_(); const int half = tid0 >> 8, t4 = (tid0 & 255) * 4;
    for (int rp = blockIdx.x; rp < NTOK / 2; rp += gridDim.x) {
        const int n = rp * 2 + half; const int b = n >= LSEQ ? 1 : 0, t = n - b * LSEQ; const int prow = b * LP + t;
        const float* src = t < NMETA ? meta + t * D_ + t4 : x + ((size_t)b * SEQ + (t - NMETA)) * D_ + t4;
        const f32x4 v = *(const f32x4*)src;
        u32x2 w; w.x = cvt_pk_bf16(v[0], v[1]); w.y = cvt_pk_bf16(v[2], v[3]);
        *(u32x2*)(h16 + (size_t)prow * D_ + t4) = w;
        *(int*)(H8BUF(p) + (size_t)prow * D_ + t4) = pk4_fp8(v);
    }
    for (int zr = blockIdx.x; zr < 225; zr += gridDim.x) {
        const long prow = zr == 224 ? -1 : (long)(zr / 112) * LP + LSEQ + (zr % 112);
        *(unsigned*)(h16 + prow * D_ + tid0 * 2) = 0u;
        if (tid0 < 256) *(unsigned*)(H8BUF(p) + prow * D_ + tid0 * 4) = 0u;
    }
}

struct Job { const float* src; int Kvalid, Kpad, N, ldsrc; bf16_t* dst; int ld_dst, kofs, rowmode, rowbase; const float* scale; int scalemode; };

DI void cvt_mat(float* T, int& tctr, const Job& jb, int wk, int G) {
    if (jb.N == 0) return;
    const int tk = jb.Kpad >> 6, tn = (jb.N + 63) >> 6, nt = tk * tn;
    int first = (wk - (tctr % G) + G) % G;
    const int tid = tid_();
    for (int i = first; i < nt; i += G) {
        const int k0 = (i / tn) << 6, n0 = (i % tn) << 6;
        {
            const int kk = tid >> 4, n4 = (tid & 15) * 4;
#pragma unroll
            for (int ps = 0; ps < 2; ++ps) {
                const int k = k0 + kk + 32 * ps, n = n0 + n4;
                f32x4 v = (f32x4){0.f, 0.f, 0.f, 0.f};
                if (k < jb.Kvalid && n < jb.N) {
                    v = *(const f32x4*)(jb.src + (size_t)k * jb.ldsrc + n);
                    float s = 1.0f;
                    if ((jb.scalemode & 3) == 1) s = jb.scale[k]; else if ((jb.scalemode & 3) == 2) s = 1.0f - jb.scale[k];
                    v = v * s;
                }
                float* tp = T + (kk + 32 * ps) * 65 + n4;
                tp[0] = v[0]; tp[1] = v[1]; tp[2] = v[2]; tp[3] = v[3];
            }
        }
        __syncthreads();
        {
            const int n = tid >> 3, k8 = (tid & 7) * 8;
            if (n0 + n < jb.N) {
                const int ng = n0 + n;
                const int row = jb.rowmode == 0 ? jb.rowbase + ng : jb.rowbase + 32 * (ng >> 4) + (ng & 15);
                const float* tp = T + k8 * 65 + n;
                if (jb.scalemode & 8) {
                    u32x2 w8;
                    w8.x = (unsigned)__builtin_amdgcn_cvt_pk_fp8_f32(tp[130] * 32.f, tp[195] * 32.f, __builtin_amdgcn_cvt_pk_fp8_f32(tp[0] * 32.f, tp[65] * 32.f, 0, false), true);
                    w8.y = (unsigned)__builtin_amdgcn_cvt_pk_fp8_f32(tp[390] * 32.f, tp[455] * 32.f, __builtin_amdgcn_cvt_pk_fp8_f32(tp[260] * 32.f, tp[325] * 32.f, 0, false), true);
                    *(u32x2*)((unsigned char*)jb.dst + (size_t)row * jb.ld_dst + jb.kofs + k0 + k8) = w8;
                } else {
                u32x4 w;
                w.x = cvt_pk_bf16(tp[0], tp[65]); w.y = cvt_pk_bf16(tp[130], tp[195]); w.z = cvt_pk_bf16(tp[260], tp[325]); w.w = cvt_pk_bf16(tp[390], tp[455]);
                *(u32x4*)(jb.dst + (size_t)row * jb.ld_dst + jb.kofs + k0 + k8) = w;
                }
            }
        }
        __syncthreads();
    }
    tctr += nt;
}

DI bf16_t* WL_BIG(PP p) { return (bf16_t*)(p->ws + OFF_WL); }
DI bf16_t* WL_LORA2(PP p) { return (bf16_t*)(p->ws + OFF_WL + (size_t)WBIG_ROWS * 2048 * 2); }
DI bf16_t* WL_OUT(PP p) { return (bf16_t*)(p->ws + OFF_WL + (size_t)WBIG_ROWS * 2048 * 2 + (size_t)1024 * LO1_W * 2); }
DI bf16_t* WL_WQ(PP p) { return (bf16_t*)(p->ws + OFF_WL + (size_t)2048 * 1024 * 2); }
DI bf16_t* WS_GU(PP p) { return (bf16_t*)(p->ws + OFF_WSH); }
DI bf16_t* WS_DN(PP p) { return (bf16_t*)(p->ws + OFF_WSH + (size_t)512 * 1024 * 2); }
DI bf16_t* WS_RT(PP p) { return (bf16_t*)(p->ws + OFF_WSH + (size_t)512 * 1024 * 2 + (size_t)1024 * 256 * 2); }
DI bf16_t* WM_GU(PP p) { return (bf16_t*)(p->ws + OFF_WMOE); }
DI bf16_t* WM_DN(PP p) { return (bf16_t*)(p->ws + OFF_WMOE + (size_t)NE * 512 * 1024 * 2); }

DI Job mkjob(const float* src, int Kv, int Kp, int N, int ldsrc, bf16_t* dst, int ld_dst, int kofs, int rowmode, int rowbase, const float* scale, int scalemode) {
    Job j; j.src = src; j.Kvalid = Kv; j.Kpad = Kp; j.N = N; j.ldsrc = ldsrc; j.dst = dst; j.ld_dst = ld_dst; j.kofs = kofs; j.rowmode = rowmode; j.rowbase = rowbase; j.scale = scale; j.scalemode = scalemode; return j;
}

DI Job get_job(PP p, int l, int j) {
    Job z = mkjob(nullptr, 0, 0, 0, 0, nullptr, 0, 0, 0, 0, nullptr, 0);
    if (j < 19) {
        if (l < 2) {
            const float* mu = p->in[I_MU] + (size_t)l * 6 * D_;
            bf16_t* big = WL_BIG(p); bf16_t* lo2 = WL_LORA2(p);
            if (j < 6) { const int s = j >> 1, part = j & 1; return mkjob(p->in[I_WRKV] + (size_t)(l * 3 + s) * D_ * D_, 1024, 1024, 1024, 1024, big, 2048, part * 1024, 0, s * 1024, mu + s * D_, (1 + part) | 8); }
            if (j < 8) { const int part = j & 1; return mkjob(p->in[I_WL1] + (size_t)l * D_ * 64, 1024, 1024, 64, 64, big, 2048, part * 1024, 0, 3072, mu + 3 * D_, (1 + part) | 8); }
            if (j < 10) { const int part = j & 1; return mkjob(p->in[I_AL1] + (size_t)l * D_ * 64, 1024, 1024, 64, 64, big, 2048, part * 1024, 0, 3136, mu + 4 * D_, (1 + part) | 8); }
            if (j < 12) { const int part = j & 1; return mkjob(p->in[I_GL1] + (size_t)l * D_ * 160, 1024, 1024, 160, 160, big, 2048, part * 1024, 0, 3200, mu + 5 * D_, (1 + part) | 8); }
            if (j < 14) { if (l != 1) return z; const int part = j & 1; return mkjob(p->in[I_VL1], 1024, 1024, 32, 32, big, 2048, part * 1024, 0, 3392, mu + 2 * D_, (1 + part) | 8); }
            if (j == 14) return mkjob(p->in[I_WL2] + (size_t)l * 64 * D_, 64, 64, 1024, 1024, lo2, 64, 0, 0, 0, nullptr, 0);
            if (j == 15) return mkjob(p->in[I_AL2] + (size_t)l * 64 * D_, 64, 64, 1024, 1024, lo2 + 1024 * 64, 64, 0, 0, 0, nullptr, 0);
            if (j == 16) return mkjob(p->in[I_GL2] + (size_t)l * 160 * D_, 160, 192, 1024, 1024, lo2 + 2 * 1024 * 64, 192, 0, 0, 0, nullptr, 0);
            if (j == 17) { if (l != 1) return z; return mkjob(p->in[I_VL2], 32, 64, 1024, 1024, lo2 + 2 * 1024 * 64 + 1024 * 192, 64, 0, 0, 0, nullptr, 0); }
            return mkjob(p->in[I_WOUT] + (size_t)l * D_ * D_, 1024, 1024, 1024, 1024, WL_OUT(p), 1024, 0, 0, 0, nullptr, 0);
        } else {
            const int a = l - 2;
            if (j == 0) { if (l != 2) return z; return mkjob(p->in[I_KVW], 1024, 1024, 2048, 2048, WL_BIG(p), 1024, 0, 0, 0, nullptr, 8); }
            if (j == 1) return mkjob(p->in[I_WQ] + (size_t)a * D_ * D_, 1024, 1024, 1024, 1024, WL_WQ(p), 1024, 0, 0, 0, nullptr, 8);
            if (j == 2) return mkjob(p->in[I_DAWO] + (size_t)a * D_ * D_, 1024, 1024, 1024, 1024, WL_OUT(p), 1024, 0, 0, 0, nullptr, 0);
            return z;
        }
    }
    j -= 19;
    if (j == 0) return mkjob(p->in[I_SG] + (size_t)l * D_ * FF, 1024, 1024, 256, 256, WS_GU(p), 1024, 0, 1, 0, nullptr, 8);
    if (j == 1) return mkjob(p->in[I_SU] + (size_t)l * D_ * FF, 1024, 1024, 256, 256, WS_GU(p), 1024, 0, 1, 16, nullptr, 8);
    if (j == 2) return mkjob(p->in[I_SD] + (size_t)l * FF * D_, 256, 256, 1024, 1024, WS_DN(p), 256, 0, 0, 0, nullptr, 8);
    if (j == 3) return mkjob(p->in[I_RTW] + (size_t)l * D_ * NE, 1024, 1024, 64, 64, WS_RT(p), 1024, 0, 0, 0, nullptr, 0);
    j -= 4;
    const int e = j / 3, w = j - e * 3;
    if (w == 0) return mkjob(p->in[I_MG] + ((size_t)l * NE + e) * D_ * FF, 1024, 1024, 256, 256, WM_GU(p) + (size_t)e * 512 * 1024, 1024, 0, 1, 0, nullptr, 0);
    if (w == 1) return mkjob(p->in[I_MU_] + ((size_t)l * NE + e) * D_ * FF, 1024, 1024, 256, 256, WM_GU(p) + (size_t)e * 512 * 1024, 1024, 0, 1, 16, nullptr, 0);
    return mkjob(p->in[I_MD] + ((size_t)l * NE + e) * FF * D_, 256, 256, 1024, 1024, WM_DN(p) + (size_t)e * 1024 * 256, 256, 0, 0, 0, nullptr, 0);
}

DI void phase_weights(PP p, unsigned char* lds, int l, int part, int wg0) {
    if ((int)blockIdx.x < wg0) return;
    float* T = (float*)lds;
    int tctr = 0;
    const int j0 = part == 0 ? 0 : 23, j1 = part == 0 ? 23 : 23 + NE * 3;
    for (int j = j0; j < j1; ++j) { const Job jb = get_job(p, l, j); cvt_mat(T, tctr, jb, (int)blockIdx.x - wg0, (int)gridDim.x - wg0); }
}


template <int W>
DI void cvt_moe_stream(unsigned char* lds, const float* src, unsigned char* dst, int wk, int G, int tid) {
    const int kp = tid >> 4, n4 = (tid & 15) * 4, wn = tid >> 3, wk8 = (tid & 7) * 8;
    constexpr int NTL = NE * 64;
    constexpr int LD = W < 2 ? FF : D_, TSH = W < 2 ? 2 : 4, TMK = W < 2 ? 3 : 15;
    f32x4 a0, a1, b0, b1;
#define CVT_LD(X0, X1, Q) do { const int e_ = (Q) >> 6, tile_ = (Q) & 63, k0_ = (tile_ >> TSH) << 6, n0_ = (tile_ & TMK) << 6; \
        const float* sp_ = src + (size_t)e_ * D_ * FF + (size_t)(k0_ + 2 * kp) * LD + n0_ + n4; X0 = *(const f32x4*)sp_; X1 = *(const f32x4*)(sp_ + LD); } while (0)
    int q = wk;
    if (q < NTL) CVT_LD(a0, a1, q);
    if (q + G < NTL) CVT_LD(b0, b1, q + G);
    int buf = 0;
    for (; q < NTL; q += G) {
        unsigned char* T = lds + buf * 4608;
#pragma unroll
        for (int i = 0; i < 4; ++i) *(unsigned short*)(T + (n4 + i) * 72 + kp * 2) = (unsigned short)__builtin_amdgcn_cvt_pk_fp8_f32(a0[i] * 32.f, a1[i] * 32.f, 0, false);
        a0 = b0; a1 = b1;
        if (q + 2 * G < NTL) CVT_LD(b0, b1, q + 2 * G);
        __syncthreads();
        {
            const int e = q >> 6, tile = q & 63, k0 = (tile >> TSH) << 6, ng = ((tile & TMK) << 6) + wn;
            const u32x2 v = *(const u32x2*)(T + wn * 72 + wk8);
            if (W < 2) *(u32x2*)(dst + ((size_t)e * 512 + 32 * (ng >> 4) + (ng & 15) + 16 * W) * D_ + k0 + wk8) = v;
            else *(u32x2*)(dst + ((size_t)e * 1024 + ng) * FF + k0 + wk8) = v;
        }
        buf ^= 1;
    }
#undef CVT_LD
    __syncthreads();
}
DI void phase_weights_moe(PP p, unsigned char* lds, int l, int wg0) {
    if ((int)blockIdx.x < wg0) return;
    const int wk = (int)blockIdx.x - wg0, G = (int)gridDim.x - wg0, tid = tid_();
    cvt_moe_stream<0>(lds, p->in[I_MG] + (size_t)l * NE * D_ * FF, (unsigned char*)WM_GU(p), wk, G, tid);
    cvt_moe_stream<1>(lds, p->in[I_MU_] + (size_t)l * NE * D_ * FF, (unsigned char*)WM_GU(p), wk, G, tid);
    cvt_moe_stream<2>(lds, p->in[I_MD] + (size_t)l * NE * FF * D_, (unsigned char*)WM_DN(p), wk, G, tid);
}

typedef int i32x8t __attribute__((ext_vector_type(8)));
DI i32x8t cat16t(bf16x8 a, bf16x8 b) { const u32x4 x = __builtin_bit_cast(u32x4, a), y = __builtin_bit_cast(u32x4, b); return (i32x8t){(int)x.x, (int)x.y, (int)x.z, (int)x.w, (int)y.x, (int)y.y, (int)y.z, (int)y.w}; }
template <int BM, int BN, int WTM, int WTN, bool TRANS, bool FP8 = false, int SA = 0x7F7F7F7F, int SB = 0x7F7F7F7F, class AP, class EPI>
DI void gemm_tile(unsigned char* lds, const AP& aptr, const bf16_t* __restrict__ Bt, size_t ldb, int K, const EPI& epi, size_t akstride = 64) {
    constexpr int WN_ = BN / WTN, MI = WTM / 16, NI = WTN / 16;
    static_assert((BM / WTM) * WN_ == 8, "8 waves");
    constexpr int CA = BM * 8 / NTHR, CB = BN * 8 / NTHR;
    static_assert(CA >= 1 && CB >= 1, "tile too small");
    constexpr int ABYTES = BM * 128, STAGE = (BM + BN) * 128;
    const int tid = tid_(), lane = tid & 63, wid = tid >> 6, wm = wid / WN_, wn = wid % WN_;
    const bf16_t* ap[CA]; const bf16_t* bp[CB]; unsigned aoff[CA], boff[CB];
#pragma unroll
    for (int i = 0; i < CA; ++i) { const int id = tid + NTHR * i, row = id >> 3, c = id & 7; ap[i] = aptr(row) + c * 8; aoff[i] = row * 128 + ((c ^ ((row >> 1) & 7)) << 4); }
#pragma unroll
    for (int i = 0; i < CB; ++i) { const int id = tid + NTHR * i, row = id >> 3, c = id & 7; bp[i] = Bt + (size_t)row * ldb + c * 8; boff[i] = ABYTES + row * 128 + ((c ^ ((row >> 1) & 7)) << 4); }
    u32x4 ra[CA], rb[CB];
    f32x4 acc[MI][NI];
#pragma unroll
    for (int mi = 0; mi < MI; ++mi)
#pragma unroll
        for (int ni = 0; ni < NI; ++ni) acc[mi][ni] = (f32x4){0.f, 0.f, 0.f, 0.f};
    asm volatile("" : "+s"(K));
    const int nk = K >> 6;
#pragma unroll
    for (int i = 0; i < CA; ++i) ra[i] = *(const u32x4*)(ap[i]);
#pragma unroll
    for (int i = 0; i < CB; ++i) rb[i] = *(const u32x4*)(bp[i]);
#pragma unroll
    for (int i = 0; i < CA; ++i) *(u32x4*)(lds + aoff[i]) = ra[i];
#pragma unroll
    for (int i = 0; i < CB; ++i) *(u32x4*)(lds + boff[i]) = rb[i];
    __syncthreads();
    const int fr = lane & 15, fq = lane >> 4, sw = (fr >> 1) & 7;
    for (int kt = 0; kt < nk; ++kt) {
        const unsigned char* cur = lds + (kt & 1) * STAGE;
        unsigned char* nxt = lds + ((kt + 1) & 1) * STAGE;
        const bool more = kt + 1 < nk;
        if (more) {
#pragma unroll
            for (int i = 0; i < CA; ++i) ra[i] = *(const u32x4*)(ap[i] + (size_t)(kt + 1) * akstride);
#pragma unroll
            for (int i = 0; i < CB; ++i) rb[i] = *(const u32x4*)(bp[i] + (kt + 1) * 64);
        }
        if (FP8) {
            bf16x8 af[MI][2], bfr[NI][2];
#pragma unroll
            for (int ks = 0; ks < 2; ++ks) {
                const int ch = ((ks * 4 + fq) ^ sw) << 4;
#pragma unroll
                for (int mi = 0; mi < MI; ++mi) af[mi][ks] = *(const bf16x8*)(cur + (wm * WTM + mi * 16 + fr) * 128 + ch);
#pragma unroll
                for (int ni = 0; ni < NI; ++ni) bfr[ni][ks] = *(const bf16x8*)(cur + ABYTES + (wn * WTN + ni * 16 + fr) * 128 + ch);
            }
#pragma unroll
            for (int mi = 0; mi < MI; ++mi)
#pragma unroll
                for (int ni = 0; ni < NI; ++ni)
                    acc[mi][ni] = TRANS ? __builtin_amdgcn_mfma_scale_f32_16x16x128_f8f6f4(cat16t(bfr[ni][0], bfr[ni][1]), cat16t(af[mi][0], af[mi][1]), acc[mi][ni], 0, 0, 0, SB, 0, SA)
                                        : __builtin_amdgcn_mfma_scale_f32_16x16x128_f8f6f4(cat16t(af[mi][0], af[mi][1]), cat16t(bfr[ni][0], bfr[ni][1]), acc[mi][ni], 0, 0, 0, SA, 0, SB);
        } else {
#pragma unroll
        for (int ks = 0; ks < 2; ++ks) {
            bf16x8 af[MI], bfr[NI];
            const int ch = ((ks * 4 + fq) ^ sw) << 4;
#pragma unroll
            for (int mi = 0; mi < MI; ++mi) af[mi] = *(const bf16x8*)(cur + (wm * WTM + mi * 16 + fr) * 128 + ch);
#pragma unroll
            for (int ni = 0; ni < NI; ++ni) bfr[ni] = *(const bf16x8*)(cur + ABYTES + (wn * WTN + ni * 16 + fr) * 128 + ch);
#pragma unroll
            for (int mi = 0; mi < MI; ++mi)
#pragma unroll
                for (int ni = 0; ni < NI; ++ni)
                    acc[mi][ni] = TRANS ? __builtin_amdgcn_mfma_f32_16x16x32_bf16(bfr[ni], af[mi], acc[mi][ni], 0, 0, 0)
                                        : __builtin_amdgcn_mfma_f32_16x16x32_bf16(af[mi], bfr[ni], acc[mi][ni], 0, 0, 0);
        }
        }
        if (more) {
#pragma unroll
            for (int i = 0; i < CA; ++i) *(u32x4*)(nxt + aoff[i]) = ra[i];
#pragma unroll
            for (int i = 0; i < CB; ++i) *(u32x4*)(nxt + boff[i]) = rb[i];
        }
        __syncthreads();
    }
    epi.template run<MI, NI>(acc, wm * WTM, wn * WTN, fr, fq);
}

struct APlain { const bf16_t* base; size_t ld; DI const bf16_t* operator()(int r) const { return base + (size_t)r * ld; } };
struct AClamp { const bf16_t* base; int last; DI const bf16_t* operator()(int r) const { return base + (size_t)(r < last ? r : last) * FF; } };
struct AGather { const bf16_t* base; const int* rows; int nrows; DI const bf16_t* operator()(int r) const { const int rr = r < nrows ? r : nrows - 1; return base + (size_t)rows[rr] * D_; } };

DI size_t hm_off(int prow, int col) { const int b = prow >= LP ? 1 : 0, t = prow - b * LP; return ((size_t)((b * 16 + (col >> 6)) * LP + t)) * 64 + (col & 63); }
DI void st_bf4(bf16_t* dst, f32x4 v) { u32x2 w; w.x = cvt_pk_bf16(v[0], v[1]); w.y = cvt_pk_bf16(v[2], v[3]); *(u32x2*)dst = w; }

struct EpiR1 {
    bf16_t* dst; int kind; int m0, n0;
    template <int MI, int NI> DI void run(const f32x4 (&acc)[MI][NI], int rb, int cb, int fr, int fq) const {
#pragma unroll
        for (int ni = 0; ni < NI; ++ni) {
            const int col = n0 + cb + ni * 16 + 4 * fq;
            if (col >= 3456) continue;
#pragma unroll
            for (int mi = 0; mi < MI; ++mi) {
                const size_t row = (size_t)(m0 + rb + mi * 16 + fr);
                f32x4 a = acc[mi][ni];
                if (kind == 0) {
                    st_bf4(dst + hm_off((int)row, col & 1023), a);
                } else {
                    const int c = col - 3072;
                    if (c < 64) { a[0] = tanhf_(a[0]); a[1] = tanhf_(a[1]); a[2] = tanhf_(a[2]); a[3] = tanhf_(a[3]); }
                    else if (c >= 128 && c < 288) { a[0] = sigmoidf_(a[0]); a[1] = sigmoidf_(a[1]); a[2] = sigmoidf_(a[2]); a[3] = sigmoidf_(a[3]); }
                    else if ((c >= 288 && c < 320) || c >= 352) a = (f32x4){0.f, 0.f, 0.f, 0.f};
                    st_bf4(dst + row * LO1_W + c, a);
                }
            }
        }
    }
};
struct EpiLora2 {
    int mode; float* wdec; bf16_t* dst; const bf16_t* vfirst; const float* bias; int m0, n0;
    template <int MI, int NI> DI void run(const f32x4 (&acc)[MI][NI], int rb, int cb, int fr, int fq) const {
#pragma unroll
        for (int ni = 0; ni < NI; ++ni) {
            const int col = n0 + cb + ni * 16 + 4 * fq;
            f32x4 bv = (f32x4){0.f, 0.f, 0.f, 0.f};
            if (mode != 2) bv = *(const f32x4*)(bias + col);
#pragma unroll
            for (int mi = 0; mi < MI; ++mi) {
                const size_t off = hm_off(m0 + rb + mi * 16 + fr, col);
                f32x4 a = acc[mi][ni] + bv;
                if (mode == 0) {
#pragma unroll
                    for (int i = 0; i < 4; ++i) a[i] = -0.6065306597126334f * sigmoidf_(a[i]);
                    *(f32x4*)(wdec + off) = a;
                } else if (mode == 1) {
#pragma unroll
                    for (int i = 0; i < 4; ++i) a[i] = sigmoidf_(a[i]);
                    st_bf4(dst + off, a);
                } else if (mode == 2) {
                    st_bf4(dst + off, a);
                } else {
                    const u32x2 vv = *(const u32x2*)(dst + off), vf = *(const u32x2*)(vfirst + off);
                    const float v0 = bflo(vv.x), v1 = bfhi(vv.x), v2 = bflo(vv.y), v3 = bfhi(vv.y);
                    const float f0 = bflo(vf.x), f1 = bfhi(vf.x), f2 = bflo(vf.y), f3 = bfhi(vf.y);
                    f32x4 o;
                    o[0] = v0 + (f0 - v0) * sigmoidf_(a[0]); o[1] = v1 + (f1 - v1) * sigmoidf_(a[1]); o[2] = v2 + (f2 - v2) * sigmoidf_(a[2]); o[3] = v3 + (f3 - v3) * sigmoidf_(a[3]);
                    st_bf4(dst + off, o);
                }
            }
        }
    }
};
struct EpiResid {
    float* out; unsigned char* ws; int m0, n0;
    template <int MI, int NI> DI void run(const f32x4 (&acc)[MI][NI], int rb, int cb, int fr, int fq) const {
#pragma unroll
        for (int mi = 0; mi < MI; ++mi) {
            const int prow = m0 + rb + mi * 16 + fr;
            const int t = prow >= LP ? prow - LP : prow;
            if (t >= LSEQ) continue;
            float* hr = h32row_(out, ws, prow);
#pragma unroll
            for (int ni = 0; ni < NI; ++ni) {
                const int col = n0 + cb + ni * 16 + 4 * fq;
                f32x4 h = *(const f32x4*)(hr + col);
                *(f32x4*)(hr + col) = h * DN_ALPHA + acc[mi][ni];
            }
        }
    }
};
struct EpiMix {
    bf16_t* dst; int m0, n0;
    template <int MI, int NI> DI void run(const f32x4 (&acc)[MI][NI], int rb, int cb, int fr, int fq) const {
#pragma unroll
        for (int mi = 0; mi < MI; ++mi)
#pragma unroll
            for (int ni = 0; ni < NI; ++ni) st_bf4(dst + (size_t)(m0 + rb + mi * 16 + fr) * D_ + n0 + cb + ni * 16 + 4 * fq, acc[mi][ni]);
    }
};
struct EpiQK {
    bf16_t* dst; float scale; int m0, n0;
    template <int MI, int NI> DI void run(const f32x4 (&acc)[MI][NI], int rb, int cb, int fr, int fq) const {
#pragma unroll
        for (int mi = 0; mi < MI; ++mi) {
            const int prow = m0 + rb + mi * 16 + fr;
            const int b = prow >= LP ? 1 : 0, t = prow - b * LP;
#pragma unroll
            for (int ni = 0; ni < NI; ++ni) {
                const int col = n0 + cb + ni * 16 + 4 * fq;
                const int hc = col >> 6, dd = col & 63;
                st_bf4(dst + (((size_t)(b * 16 + hc)) * LP + t) * 64 + dd, acc[mi][ni] * scale);
            }
        }
    }
};
struct EpiQK8 {
    unsigned char* dst; float scale; int m0, n0;
    template <int MI, int NI> DI void run(const f32x4 (&acc)[MI][NI], int rb, int cb, int fr, int fq) const {
#pragma unroll
        for (int mi = 0; mi < MI; ++mi) {
            const int prow = m0 + rb + mi * 16 + fr;
            const int b = prow >= LP ? 1 : 0, t = prow - b * LP;
#pragma unroll
            for (int ni = 0; ni < NI; ++ni) {
                const int col = n0 + cb + ni * 16 + 4 * fq;
                const int hc = col >> 6, dd = col & 63;
                const f32x4 a = acc[mi][ni] * scale;
                *(int*)(dst + (((size_t)(b * 16 + hc)) * LP + t) * 64 + dd) = __builtin_amdgcn_cvt_pk_fp8_f32(a[2], a[3], __builtin_amdgcn_cvt_pk_fp8_f32(a[0], a[1], 0, false), true);
            }
        }
    }
};
struct EpiVt {
    bf16_t* dst; int m0, n0;
    template <int MI, int NI> DI void run(const f32x4 (&acc)[MI][NI], int rb, int cb, int fr, int fq) const {
#pragma unroll
        for (int mi = 0; mi < MI; ++mi) {
            const int prow = m0 + rb + mi * 16 + 4 * fq;
            const int b = prow >= LP ? 1 : 0, t = prow - b * LP;
#pragma unroll
            for (int ni = 0; ni < NI; ++ni) {
                const int col = n0 + cb + ni * 16 + fr;
                const int tp = (t & ~12) | ((t & 4) << 1) | ((t & 8) >> 1);
                st_bf4(dst + ((size_t)(b * 1024 + col)) * LP + tp, acc[mi][ni]);
            }
        }
    }
};
struct EpiVt8 {
    unsigned char* dst; int m0, n0;
    template <int MI, int NI> DI void run(const f32x4 (&acc)[MI][NI], int rb, int cb, int fr, int fq) const {
#pragma unroll
        for (int mi = 0; mi < MI; ++mi) {
            const int prow = m0 + rb + mi * 16 + 4 * fq;
            const int b = prow >= LP ? 1 : 0, t = prow - b * LP;
            const int pos = (t & ~63) | ((t & 4) << 3) | ((t & 32) >> 1) | ((t >> 1) & 12);
#pragma unroll
            for (int ni = 0; ni < NI; ++ni) {
                const int col = n0 + cb + ni * 16 + fr;
                const f32x4 a = acc[mi][ni];
                const int w = __builtin_amdgcn_cvt_pk_fp8_f32(a[2], a[3], __builtin_amdgcn_cvt_pk_fp8_f32(a[0], a[1], 0, false), true);
                *(int*)(dst + ((size_t)(b * 1024 + col)) * LP + pos) = w;
            }
        }
    }
};
struct EpiM1 {
    unsigned char* dst; const float* gate; int row0, nrows, n0;
    template <int MI, int NI> DI void run(const f32x4 (&acc)[MI][NI], int rb, int cb, int fr, int fq) const {
#pragma unroll
        for (int mi = 0; mi < MI; ++mi) {
            const int r = rb + mi * 16 + fr;
            if (r >= nrows) continue;
            const float gw = gate ? gate[row0 + r] : 1.0f;
#pragma unroll
            for (int ni = 0; ni < NI; ni += 2) {
                const int hc = ((n0 + cb + ni * 16) >> 1) + 4 * fq;
                const f32x4 g = acc[mi][ni], u = acc[mi][ni + 1];
                f32x4 o;
#pragma unroll
                for (int i = 0; i < 4; ++i) o[i] = g[i] * sigmoidf_(g[i]) * u[i] * gw * 8.0f;
                *(int*)(dst + (size_t)(row0 + r) * FF + hc) = pk4_fp8(o);
            }
        }
    }
};
struct EpiM2 {
    bf16_t* dst; int row0, nrows, n0;
    template <int MI, int NI> DI void run(const f32x4 (&acc)[MI][NI], int rb, int cb, int fr, int fq) const {
#pragma unroll
        for (int mi = 0; mi < MI; ++mi) {
            const int r = rb + mi * 16 + fr;
            if (r >= nrows) continue;
#pragma unroll
            for (int ni = 0; ni < NI; ++ni) st_bf4(dst + (size_t)(row0 + r) * D_ + n0 + cb + ni * 16 + 4 * fq, acc[mi][ni]);
        }
    }
};
struct EpiLds {
    float* dst;
    template <int MI, int NI> DI void run(const f32x4 (&acc)[MI][NI], int rb, int cb, int fr, int fq) const {
#pragma unroll
        for (int mi = 0; mi < MI; ++mi)
#pragma unroll
            for (int ni = 0; ni < NI; ++ni) {
                float* d = dst + (rb + mi * 16 + fr) * 65 + cb + ni * 16 + 4 * fq;
                d[0] = acc[mi][ni][0]; d[1] = acc[mi][ni][1]; d[2] = acc[mi][ni][2]; d[3] = acc[mi][ni][3];
            }
    }
};


namespace g8 {
constexpr int BM = 256, BK = 64, HALF = 128, HTB = HALF * BK * 2, STAGE_BYTES = 8 * HTB;
DI int lds_byte(int r, int c) { const int st = (r >> 4) * 2 + (c >> 5), rr = r & 15, cc = c & 31, ob = rr * 64 + cc * 2; return st * 1024 + (ob ^ (((ob >> 9) & 1) << 5)); }
DI void stage_rc(int b, int& R, int& C) { const int st = b / 1024, sb = b % 1024, swz = sb ^ (((sb >> 9) & 1) << 5); R = (st >> 1) * 16 + swz / 64; C = (st & 1) * 32 + (swz % 64) / 2; }
struct Unit { const char* ab; unsigned ao[2]; unsigned ag[2]; const char* bb; int m0, n0, x0, x1, x2; };

DI int perm32(int rho) { const int n = rho >> 4, i = rho & 15; return 8 * (i >> 2) + 4 * n + (i & 3); }
typedef int i32x8g __attribute__((ext_vector_type(8)));
typedef short s16x16g __attribute__((ext_vector_type(16)));
DI i32x8g cat16(bf16x8 a, bf16x8 b) { const u32x4 x = __builtin_bit_cast(u32x4, a), y = __builtin_bit_cast(u32x4, b); return (i32x8g){(int)x.x, (int)x.y, (int)x.z, (int)x.w, (int)y.x, (int)y.y, (int)y.z, (int)y.w}; }
template <bool TRANS, int GATHER, class Epi, class Sched, bool PERM = false, bool FP8 = false, int SA = 0x7F7F7F7F, int SB = 0x7F7F7F7F>
DI void gemm8(unsigned char* lds_, int K, size_t akstep, unsigned lda_bytes, const Sched& S, const Epi& E) {
    LAS unsigned char* lds = (LAS unsigned char*)lds_;
    const int tid = tid_(), wid = __builtin_amdgcn_readfirstlane(tid >> 6), lane = tid & 63, wr = wid >> 2, wc = wid & 3, fr = lane & 15, fq = lane >> 4;
    asm volatile("" : "+s"(K));
    const int nt = K / BK;
    unsigned voffB[2], voffA[2];
    { int R, C; stage_rc(tid * 16, R, C); const int Rb = PERM ? (64 * (R >> 5) + 16 * ((R & 15) >> 2) + 4 * ((R & 31) >> 4) + (R & 3)) : R;
      voffB[0] = (unsigned)(Rb * K + C) * 2u; voffA[0] = (unsigned)R * lda_bytes + (unsigned)C * 2u; voffB[1] = voffB[0]; voffA[1] = voffA[0]; }
    const size_t dB1 = (size_t)(PERM ? 128 : 64) * K * 2, dA1 = (size_t)64 * lda_bytes;
    const size_t hsA = (size_t)128 * lda_bytes;
    const size_t kstep = (size_t)(BK * 2);
    const size_t hstep = PERM ? (size_t)8 * K * 2 : (size_t)HALF * K * 2;
    const unsigned ldsw = (unsigned)wid * 1024u;
    const int aoff = lds_byte(wr * 64 + fr, fq * 8), boff = lds_byte(wc * 32 + fr, fq * 8);
#define G8_SA(b, h) (((b) * 2 + (h)) * HTB)
#define G8_SB(b, h) ((4 + (b) * 2 + (h)) * HTB)
#define G8_STAGEB(bufoff, gbase) do { _Pragma("unroll") for (int _i = 0; _i < 2; ++_i) { unsigned _vo = voffB[_i]; asm volatile("" : "+v"(_vo)); \
        __builtin_amdgcn_global_load_lds((const unsigned*)((const char*)(gbase) + _i * dB1 + _vo), (LAS unsigned*)(lds + (bufoff) + ldsw + _i * 8192), 16, 0, 0); } } while (0)
#define G8_STAGEA(bufoff, U, h, kofs) do { _Pragma("unroll") for (int _i = 0; _i < 2; ++_i) { unsigned _vo = GATHER == 2 ? ((((h) ? (U).ao[_i] >> 16 : (U).ao[_i] & 0xFFFFu) << 10) + voffA[_i]) : GATHER ? ((h) ? (U).ag[_i] : (U).ao[_i]) : voffA[_i]; asm volatile("" : "+v"(_vo)); \
        const char* _b = (U).ab + (GATHER ? (size_t)0 : (h) * hsA + _i * dA1) + (size_t)(kofs); \
        __builtin_amdgcn_global_load_lds((const unsigned*)(_b + _vo), (LAS unsigned*)(lds + (bufoff) + ldsw + _i * 8192), 16, 0, 0); } } while (0)
#define G8_STAGEA2(bufoff, h, kofs) do { _Pragma("unroll") for (int _i = 0; _i < 2; ++_i) { \
        const char* _b = (last ? nxt.ab : cur.ab) + (GATHER ? (size_t)0 : (h) * hsA + _i * dA1) + (size_t)(kofs); \
        unsigned _vo = GATHER == 2 ? ((((h) ? (last ? nxt.ao[_i] : cur.ao[_i]) >> 16 : (last ? nxt.ao[_i] : cur.ao[_i]) & 0xFFFFu) << 10) + voffA[_i]) \
                     : GATHER ? ((h) ? (last ? nxt.ag[_i] : cur.ag[_i]) : (last ? nxt.ao[_i] : cur.ao[_i])) : voffA[_i]; asm volatile("" : "+v"(_vo)); \
        __builtin_amdgcn_global_load_lds((const unsigned*)(_b + _vo), (LAS unsigned*)(lds + (bufoff) + ldsw + _i * 8192), 16, 0, 0); } } while (0)
#define G8_LDA(dst, b, h) do { _Pragma("unroll") for (int m = 0; m < (FP8 ? 2 : 4); ++m) _Pragma("unroll") for (int k = 0; k < 2; ++k) dst[m][k] = *(const LAS bf16x8*)(lds + G8_SA(b, h) + aoff + m * 2048 + k * 1024); } while (0)
#define G8_LDB(dst, b, h) do { _Pragma("unroll") for (int n = 0; n < 2; ++n) _Pragma("unroll") for (int k = 0; k < 2; ++k) dst[n][k] = *(const LAS bf16x8*)(lds + G8_SB(b, h) + boff + n * 2048 + k * 1024); } while (0)
#define G8_MMA(ai, bj, At, Bt) do { __builtin_amdgcn_s_setprio(1); _Pragma("unroll") for (int m = 0; m < 4; ++m) _Pragma("unroll") for (int n = 0; n < 2; ++n) _Pragma("unroll") for (int k = 0; k < 2; ++k) \
        acc[ai][bj][m][n] = TRANS ? __builtin_amdgcn_mfma_f32_16x16x32_bf16(Bt[n][k], At[m][k], acc[ai][bj][m][n], 0, 0, 0) \
                                  : __builtin_amdgcn_mfma_f32_16x16x32_bf16(At[m][k], Bt[n][k], acc[ai][bj][m][n], 0, 0, 0); __builtin_amdgcn_s_setprio(0); } while (0)
#define G8_LDA_HI(dst, b, h) do { _Pragma("unroll") for (int m = 0; m < 2; ++m) _Pragma("unroll") for (int k = 0; k < 2; ++k) dst[m][k] = *(const LAS bf16x8*)(lds + G8_SA(b, h) + aoff + (m + 2) * 2048 + k * 1024); } while (0)
#define G8_MMA8(ai, bj, mh, At, Bt) do { _Pragma("unroll") for (int m = 0; m < 2; ++m) _Pragma("unroll") for (int n = 0; n < 2; ++n) \
        acc[ai][bj][2 * (mh) + m][n] = TRANS ? __builtin_amdgcn_mfma_scale_f32_16x16x128_f8f6f4(cat16(Bt[n][0], Bt[n][1]), cat16(At[m][0], At[m][1]), acc[ai][bj][2 * (mh) + m][n], 0, 0, 0, SB, 0, SA) \
                                             : __builtin_amdgcn_mfma_scale_f32_16x16x128_f8f6f4(cat16(At[m][0], At[m][1]), cat16(Bt[n][0], Bt[n][1]), acc[ai][bj][2 * (mh) + m][n], 0, 0, 0, SA, 0, SB); } while (0)
#define G8_MMAS(ai, b, h) do { if (FP8) { __builtin_amdgcn_s_setprio(1); G8_MMA8(ai, 0, 0, At, B0); G8_MMA8(ai, 1, 0, At, B1); __builtin_amdgcn_s_setprio(0); G8_SCHED; G8_LDA_HI(At, b, h); G8_SCHED; \
        __builtin_amdgcn_s_setprio(1); G8_MMA8(ai, 0, 1, At, B0); G8_MMA8(ai, 1, 1, At, B1); __builtin_amdgcn_s_setprio(0); } else { G8_MMA(ai, 0, At, B0); G8_MMA(ai, 1, At, B1); } } while (0)
#define G8_WAIT_V(n) asm volatile("s_waitcnt vmcnt(" #n ")" ::: "memory")
#define G8_WAIT_L(n) asm volatile("s_waitcnt lgkmcnt(" #n ")" ::: "memory")
#define G8_BAR __builtin_amdgcn_s_barrier()
#define G8_SCHED __builtin_amdgcn_sched_barrier(0)
    Unit cur, nxt; int ui = 0;
    if (!S.next(0, cur)) return;
#define G8_UNIF(U) do { (U).m0 = __builtin_amdgcn_readfirstlane((U).m0); (U).n0 = __builtin_amdgcn_readfirstlane((U).n0); (U).x0 = __builtin_amdgcn_readfirstlane((U).x0); \
        (U).x1 = __builtin_amdgcn_readfirstlane((U).x1); (U).x2 = __builtin_amdgcn_readfirstlane((U).x2); } while (0)
    G8_UNIF(cur);
    f32x4 acc[2][2][4][2];
#pragma unroll
    for (int a = 0; a < 2; ++a)
#pragma unroll
        for (int b = 0; b < 2; ++b)
#pragma unroll
            for (int m = 0; m < 4; ++m)
#pragma unroll
                for (int n = 0; n < 2; ++n) acc[a][b][m][n] = (f32x4){0.f, 0.f, 0.f, 0.f};
    bf16x8 At[4][2], B0[2][2], B1[2][2];
    const char* cB = cur.bb;
    G8_STAGEB(G8_SB(0, 0), cB); G8_STAGEB(G8_SB(0, 1), cB + hstep); G8_STAGEA(G8_SA(0, 0), cur, 0, 0); G8_STAGEA(G8_SA(0, 1), cur, 1, 0);
    if (wr == 1) G8_BAR;
    G8_WAIT_V(2); G8_BAR;
    G8_STAGEB(G8_SB(1, 0), cB + kstep); G8_STAGEA(G8_SA(1, 0), cur, 0, akstep); G8_STAGEB(G8_SB(1, 1), cB + hstep + kstep);
    G8_WAIT_V(6); G8_BAR;
    for (;;) {
        const bool has_next = S.next(ui + 1, nxt);
        if (!has_next) nxt = cur;
        G8_UNIF(nxt);
        const char* nB = nxt.bb;
        for (int t = 0; t < nt; t += 2) {
            const bool last = (t == nt - 2);
            const size_t ka1 = (size_t)(t + 1) * akstep;
            const size_t ka2 = last ? (size_t)0 : (size_t)(t + 2) * akstep, ka3 = ka2 + akstep;
            const char* b2 = last ? nB : cB + (size_t)(t + 2) * kstep; const char* b3 = b2 + kstep;
            G8_LDB(B0, 0, 0); G8_LDB(B1, 0, 1); G8_SCHED; G8_LDA(At, 0, 0); G8_STAGEA(G8_SA(1, 1), cur, 1, ka1);
            G8_WAIT_V(8); G8_WAIT_L(0); G8_BAR; G8_MMAS(0, 0, 0); G8_BAR; G8_SCHED;
            G8_LDA(At, 0, 1); G8_STAGEB(G8_SB(0, 0), b2); G8_STAGEB(G8_SB(0, 1), b2 + hstep); G8_STAGEA2(G8_SA(0, 0), 0, ka2);
            G8_WAIT_V(8); G8_WAIT_L(0); G8_BAR; G8_MMAS(1, 0, 1); G8_BAR; G8_SCHED;
            G8_LDB(B0, 1, 0); G8_LDB(B1, 1, 1); G8_SCHED; G8_LDA(At, 1, 0); G8_STAGEA2(G8_SA(0, 1), 1, ka2);
            G8_WAIT_V(8); G8_WAIT_L(0); G8_BAR; G8_MMAS(0, 1, 0); G8_BAR; G8_SCHED;
            G8_LDA(At, 1, 1); G8_STAGEB(G8_SB(1, 0), b3); G8_STAGEB(G8_SB(1, 1), b3 + hstep); G8_STAGEA2(G8_SA(1, 0), 0, ka3);
            G8_WAIT_V(8); G8_WAIT_L(0); G8_BAR; G8_MMAS(1, 1, 1); G8_BAR; G8_SCHED;
        }
        if (wr == 0) G8_BAR;
        { const int ln = lane_now(); E.apply(acc, cur, wr, wc, ln & 15, ln >> 4); }
        if (!has_next) break;
#pragma unroll
        for (int a = 0; a < 2; ++a)
#pragma unroll
            for (int b = 0; b < 2; ++b)
#pragma unroll
                for (int m = 0; m < 4; ++m)
#pragma unroll
                    for (int n = 0; n < 2; ++n) acc[a][b][m][n] = (f32x4){0.f, 0.f, 0.f, 0.f};
        cur = nxt; cB = nB; ++ui;
        if (wr == 1) G8_BAR;
    }
    G8_WAIT_V(0);
    G8_BAR;
#undef G8_UNIF
#undef G8_SA
#undef G8_SB
#undef G8_STAGEA
#undef G8_STAGEA2
#undef G8_STAGEB
#undef G8_LDA
#undef G8_LDB
#undef G8_MMA
#undef G8_MMA8
#undef G8_MMAS
#undef G8_LDA_HI
#undef G8_WAIT_V
#undef G8_WAIT_L
#undef G8_BAR
#undef G8_SCHED
}
DI void piece_rc(int tid, int i, int& R, int& C) { stage_rc(tid * 16 + i * 8192, R, C); }
template <class EP> DI void quad_epi(const EP& e, const f32x4 (&acc)[2][2][4][2], int wr, int wc, int fr, int fq) {
#pragma unroll
    for (int ai = 0; ai < 2; ++ai)
#pragma unroll
        for (int bj = 0; bj < 2; ++bj) { e.template run<4, 2>(acc[ai][bj], 128 * ai + 64 * wr, 128 * bj + 32 * wc, fr, fq); __builtin_amdgcn_sched_barrier(0); }
}
}

DI bf16_t* SCR16(PP p, size_t off) { return (bf16_t*)(p->ws + OFF_SCR + off); }
DI bf16_t* VFIRST(PP p) { return (bf16_t*)(p->ws + OFF_KV); }
DI bf16_t* KBUF(PP p) { return (bf16_t*)(p->ws + OFF_KV); }
DI bf16_t* VTBUF(PP p) { return (bf16_t*)(p->ws + OFF_KV + SZ_ACT16); }

DI void phase_r1_old(PP p, unsigned char* lds, int l) {
    constexpr int NT = WBIG_ROWS / 256;
    EpiR1 e;
    for (int u = blockIdx.x; u < MT * NT; u += gridDim.x) {
        const int mt = u / NT, nt = u - mt * NT;
        e.m0 = mt * 128; e.n0 = nt * 256;
        if (nt < 4) { e.kind = 0; e.dst = SCR16(p, SCR_R); } else if (nt < 8) { e.kind = 0; e.dst = SCR16(p, SCR_K); }
        else if (nt < 12) { e.kind = 0; e.dst = l == 0 ? VFIRST(p) : SCR16(p, SCR_V); } else { e.kind = 1; e.dst = SCR16(p, SCR_LO1); }
        APlain a; a.base = H16(p) + (size_t)(mt * 128) * D_ - D_; a.ld = D_;
        gemm_tile<128, 256, 64, 64, true>(lds, a, WL_BIG(p) + (size_t)(nt * 256) * 2048, 2048, 2048, e);
    }
}
DI void phase_r2(PP p, unsigned char* lds, int l) {
    const int ng = l == 1 ? 4 : 3;
    for (int u = blockIdx.x; u < ng * MT * 4; u += gridDim.x) {
        const int g = u / (MT * 4), r = u - g * (MT * 4), mt = r >> 2, nt = r & 3;
        EpiLora2 e; e.mode = g; e.m0 = mt * 128; e.n0 = nt * 256; e.wdec = (float*)(p->ws + OFF_SCR + SCR_W); e.vfirst = VFIRST(p); e.bias = nullptr; e.dst = nullptr;
        APlain a; a.ld = LO1_W; const bf16_t* lo1 = SCR16(p, SCR_LO1) + (size_t)(mt * 128) * LO1_W;
        const bf16_t* lo2 = WL_LORA2(p);
        if (g == 0) { e.bias = p->in[I_W0] + l * D_; a.base = lo1; gemm_tile<128, 256, 64, 64, true>(lds, a, lo2 + (size_t)(nt * 256) * 64, 64, 64, e); }
        else if (g == 1) { e.bias = p->in[I_A0] + l * D_; e.dst = SCR16(p, SCR_A); a.base = lo1 + 64; gemm_tile<128, 256, 64, 64, true>(lds, a, lo2 + 1024 * 64 + (size_t)(nt * 256) * 64, 64, 64, e); }
        else if (g == 2) { e.dst = SCR16(p, SCR_G); a.base = lo1 + 128; gemm_tile<128, 256, 64, 64, true>(lds, a, lo2 + 2 * 1024 * 64 + (size_t)(nt * 256) * 192, 192, 192, e); }
        else { e.bias = p->in[I_V0]; e.dst = SCR16(p, SCR_V); a.base = lo1 + 320; gemm_tile<128, 256, 64, 64, true>(lds, a, lo2 + 2 * 1024 * 64 + 1024 * 192 + (size_t)(nt * 256) * 64, 64, 64, e); }
    }
}

DI unsigned img_off(int row, int col) { return (unsigned)(row * 128 + ((((col >> 3) ^ ((row >> 1) & 7)) << 4) | ((col & 7) << 1))); }
DI void mm64(const unsigned char* Aimg, const unsigned char* Bimg, int mb, int nh, int fr, int g, f32x4 (&acc)[2]) {
#pragma unroll
    for (int ks = 0; ks < 2; ++ks) {
        const int ch = ((ks * 4 + g) ^ ((fr >> 1) & 7)) << 4;
        const bf16x8 a = *(const bf16x8*)(Aimg + (16 * mb + fr) * 128 + ch);
#pragma unroll
        for (int nbi = 0; nbi < 2; ++nbi) {
            const bf16x8 b = *(const bf16x8*)(Bimg + (16 * (2 * nh + nbi) + fr) * 128 + ch);
            acc[nbi] = __builtin_amdgcn_mfma_f32_16x16x32_bf16(b, a, acc[nbi], 0, 0, 0);
        }
    }
}
DI void st_img4(unsigned char* img, int row, int col4, f32x4 v) { u32x2 w; w.x = cvt_pk_bf16(v[0], v[1]); w.y = cvt_pk_bf16(v[2], v[3]); *(u32x2*)(img + img_off(row, col4)) = w; }
DI void st_img4T(unsigned char* img, int row, int col4, f32x4 v) {
    const unsigned w0 = cvt_pk_bf16(v[0], v[1]), w1 = cvt_pk_bf16(v[2], v[3]);
    *(bf16_t*)(img + img_off(col4 + 0, row)) = (bf16_t)(w0 & 0xffffu); *(bf16_t*)(img + img_off(col4 + 1, row)) = (bf16_t)(w0 >> 16);
    *(bf16_t*)(img + img_off(col4 + 2, row)) = (bf16_t)(w1 & 0xffffu); *(bf16_t*)(img + img_off(col4 + 3, row)) = (bf16_t)(w1 >> 16);
}
DI f32x4 ld_img4(const unsigned char* img, int row, int col4) { const u32x2 w = *(const u32x2*)(img + img_off(row, col4)); return (f32x4){bflo(w.x), bfhi(w.x), bflo(w.y), bfhi(w.y)}; }
#define ZACC(a) do { a[0] = (f32x4){0.f, 0.f, 0.f, 0.f}; a[1] = (f32x4){0.f, 0.f, 0.f, 0.f}; } while (0)

DI float ldso_bf(const bf16_t* base, unsigned bo) { return bf2f(*(const bf16_t*)((const char*)base + bo)); }
DI float ldso_f(const float* base, unsigned bo) { return *(const float*)((const char*)base + bo); }
DI void stso_bf4(bf16_t* base, unsigned bo, f32x4 v) { u32x2 w; w.x = cvt_pk_bf16(v[0], v[1]); w.y = cvt_pk_bf16(v[2], v[3]); *(u32x2*)((char*)base + bo) = w; }
DI void phase_scanA(PP p, unsigned char* lds, int l) {
    const int tid = tid_(), lane = tid & 63, wid = tid >> 6, fr = lane & 15, g = lane >> 4, mb = wid >> 1, nh = wid & 1;
    float* seg = (float*)(lds + 16 * 8192); float* gC = seg + 512;
#define SL(i) (lds + (i) * 8192)
    bf16_t* R = SCR16(p, SCR_R); bf16_t* Kp = SCR16(p, SCR_K); const bf16_t* V = l == 0 ? VFIRST(p) : SCR16(p, SCR_V); bf16_t* A = SCR16(p, SCR_A);
    const float* LW = (const float*)(p->ws + OFF_SCR + SCR_W); float* bonus = (float*)(p->ws + OFF_SCR + SCR_LO1); bf16_t* Qs = SCR16(p, SCR_QS);
    const int NU = NB * 16 * NCHR;
    float pr_[8], pk_[8], pv_[8], pa_[8], pl_[8];
    if ((int)blockIdx.x < NU) {
        const int c = blockIdx.x % NCHR, bh = blockIdx.x / NCHR; const size_t base = ((size_t)bh * LP + 64 * c) * 64;
#pragma unroll
        for (int j = 0; j < 8; ++j) { unsigned lb = (unsigned)((8 * wid * 64 + lane) * 2); asm volatile("" : "+v"(lb));
            pr_[j] = ldso_bf(R + base + j * 64, lb); pk_[j] = ldso_bf(Kp + base + j * 64, lb); pv_[j] = ldso_bf(V + base + j * 64, lb); pa_[j] = ldso_bf(A + base + j * 64, lb); pl_[j] = ldso_f(LW + base + j * 64, lb * 2); }
    }
    for (int unit = blockIdx.x; unit < NU; unit += gridDim.x) {
        const int c = unit % NCHR, bh = unit / NCHR, h = bh & 15;
        const size_t base = ((size_t)bh * LP + 64 * c) * 64;
        const int hc = l * D_ + h * 64 + lane;
        const float c_kk = p->in[I_KK][hc], c_ka = p->in[I_KA][hc], c_rk = p->in[I_RK][hc];
        float vr[8], vk2[8], vv[8], vas[8], vbs[8], lwv[8], cum[8];
        float run = 0.f;
#pragma unroll
        for (int j = 0; j < 8; ++j) {
            const int t = 8 * wid + j;
            const float r = pr_[j], k = pk_[j], v = pv_[j], a = pa_[j], lw = pl_[j];
            const float kkr = k * c_kk; const float n2 = wave_sum(kkr * kkr);
            const float kk = kkr / fmaxf(sqrtf(n2), 1e-12f);
            const float k2 = k * (1.0f + (a - 1.0f) * c_ka);
            const float bon = wave_sum(r * k2 * c_rk);
            if (lane == 0) bonus[(size_t)bh * LP + 64 * c + t] = bon;
            run += lw; cum[j] = run; lwv[j] = lw; vr[j] = r; vk2[j] = k2; vv[j] = v; vas[j] = -kk; vbs[j] = kk * a;
        }
        seg[wid * 64 + lane] = run;
        __syncthreads();
        float off = 0.f, tot = 0.f;
#pragma unroll
        for (int w2 = 0; w2 < 8; ++w2) { const float sg = seg[w2 * 64 + lane]; off += w2 < wid ? sg : 0.f; tot += sg; }
        if (wid == 0) gC[lane] = __expf(tot);
        {
            float tA[8], tB[8], tK[8];
#pragma unroll
            for (int j = 0; j < 8; ++j) {
                const int t = 8 * wid + j;
                const float cu = cum[j] + off, cp = cu - lwv[j];
                const float ea = __expf(cp), er = __expf(cu), ei = __expf(-cu), eh = __expf(tot - cu);
                const float At = vas[j] * ea, Rt = vr[j] * er, Bt = vbs[j] * ei, Kt = vk2[j] * ei;
                const unsigned o = img_off(t, lane);
                *(bf16_t*)(SL(5) + o) = f2bf(At); *(bf16_t*)(SL(0) + o) = f2bf(Rt); *(bf16_t*)(SL(6) + o) = f2bf(Bt); *(bf16_t*)(SL(7) + o) = f2bf(Kt);
                tA[j] = At; tB[j] = vbs[j] * eh; tK[j] = vk2[j] * eh;
            }
            const unsigned ot = (unsigned)(lane * 128 + ((wid ^ ((lane >> 1) & 7)) << 4));
            u32x4 w;
            w.x = cvt_pk_bf16(tA[0], tA[1]); w.y = cvt_pk_bf16(tA[2], tA[3]); w.z = cvt_pk_bf16(tA[4], tA[5]); w.w = cvt_pk_bf16(tA[6], tA[7]); *(u32x4*)(SL(1) + ot) = w;
            w.x = cvt_pk_bf16(vv[0], vv[1]); w.y = cvt_pk_bf16(vv[2], vv[3]); w.z = cvt_pk_bf16(vv[4], vv[5]); w.w = cvt_pk_bf16(vv[6], vv[7]); *(u32x4*)(SL(2) + ot) = w;
            w.x = cvt_pk_bf16(tB[0], tB[1]); w.y = cvt_pk_bf16(tB[2], tB[3]); w.z = cvt_pk_bf16(tB[4], tB[5]); w.w = cvt_pk_bf16(tB[6], tB[7]); *(u32x4*)(SL(3) + ot) = w;
            w.x = cvt_pk_bf16(tK[0], tK[1]); w.y = cvt_pk_bf16(tK[2], tK[3]); w.z = cvt_pk_bf16(tK[4], tK[5]); w.w = cvt_pk_bf16(tK[6], tK[7]); *(u32x4*)(SL(4) + ot) = w;
        }
        __syncthreads();
        {
            const int un = unit + gridDim.x;
            if (un < NU) {
                const int cn = un % NCHR, bhn = un / NCHR; const size_t bn = ((size_t)bhn * LP + 64 * cn) * 64;
#pragma unroll
                for (int j = 0; j < 8; ++j) { unsigned lb = (unsigned)((8 * wid * 64 + lane) * 2); asm volatile("" : "+v"(lb));
                    pr_[j] = ldso_bf(R + bn + j * 64, lb); pk_[j] = ldso_bf(Kp + bn + j * 64, lb); pv_[j] = ldso_bf(V + bn + j * 64, lb); pa_[j] = ldso_bf(A + bn + j * 64, lb); pl_[j] = ldso_f(LW + bn + j * 64, lb * 2); }
            }
        }
        f32x4 acc[2];
        const int row = 16 * mb + fr;
        f32x4 aab[2], aak[2], arb[2], ark[2];
        ZACC(aab); ZACC(aak); ZACC(arb); ZACC(ark);
#pragma unroll
        for (int ks = 0; ks < 2; ++ks) {
            const int ch = ((ks * 4 + g) ^ ((fr >> 1) & 7)) << 4;
            const bf16x8 a5 = *(const bf16x8*)(SL(5) + (16 * mb + fr) * 128 + ch), a0 = *(const bf16x8*)(SL(0) + (16 * mb + fr) * 128 + ch);
#pragma unroll
            for (int nbi = 0; nbi < 2; ++nbi) {
                const bf16x8 b6 = *(const bf16x8*)(SL(6) + (16 * (2 * nh + nbi) + fr) * 128 + ch), b7 = *(const bf16x8*)(SL(7) + (16 * (2 * nh + nbi) + fr) * 128 + ch);
                aab[nbi] = __builtin_amdgcn_mfma_f32_16x16x32_bf16(b6, a5, aab[nbi], 0, 0, 0);
                aak[nbi] = __builtin_amdgcn_mfma_f32_16x16x32_bf16(b7, a5, aak[nbi], 0, 0, 0);
                arb[nbi] = __builtin_amdgcn_mfma_f32_16x16x32_bf16(b6, a0, arb[nbi], 0, 0, 0);
                ark[nbi] = __builtin_amdgcn_mfma_f32_16x16x32_bf16(b7, a0, ark[nbi], 0, 0, 0);
            }
        }
#pragma unroll
        for (int nbi = 0; nbi < 2; ++nbi) { const int c0 = 16 * (2 * nh + nbi) + 4 * g;
            f32x4 m = aab[nbi];
#pragma unroll
            for (int i = 0; i < 4; ++i) m[i] = (c0 + i < row) ? m[i] : 0.f;
            st_img4(SL(8), row, c0, m);
            st_img4T(SL(9), row, c0, m);
#pragma unroll
            for (int i = 0; i < 4; ++i) m[i] += (c0 + i == row) ? 1.0f : 0.f;
            st_img4(SL(13), row, c0, m);
            m = aak[nbi];
#pragma unroll
            for (int i = 0; i < 4; ++i) m[i] = (c0 + i < row) ? m[i] : 0.f;
            st_img4(SL(10), row, c0, m);
            m = arb[nbi];
#pragma unroll
            for (int i = 0; i < 4; ++i) m[i] = (c0 + i <= row) ? m[i] : 0.f;
            st_img4(SL(11), row, c0, m);
            m = ark[nbi];
#pragma unroll
            for (int i = 0; i < 4; ++i) m[i] = (c0 + i <= row) ? m[i] : 0.f;
            st_img4(SL(12), row, c0, m); }
        __syncthreads();
#define MMST(dst, Ai, Bi) do { ZACC(acc); mm64(SL(Ai), SL(Bi), mb, nh, fr, g, acc); st_img4(SL(dst), row, 16 * (2 * nh) + 4 * g, acc[0]); st_img4(SL(dst), row, 16 * (2 * nh + 1) + 4 * g, acc[1]); } while (0)
#define MMST2(dst, dstT, Ai, Bi) do { ZACC(acc); mm64(SL(Ai), SL(Bi), mb, nh, fr, g, acc); \
        st_img4(SL(dst), row, 16 * (2 * nh) + 4 * g, acc[0]); st_img4(SL(dst), row, 16 * (2 * nh + 1) + 4 * g, acc[1]); \
        st_img4T(SL(dstT), row, 16 * (2 * nh) + 4 * g, acc[0]); st_img4T(SL(dstT), row, 16 * (2 * nh + 1) + 4 * g, acc[1]); } while (0)
#define MMUPD(dst, Ti, Bi) do { ZACC(acc); mm64(SL(Ti), SL(Bi), mb, nh, fr, g, acc); \
        st_img4(SL(dst), row, 16 * (2 * nh) + 4 * g, acc[0] + ld_img4(SL(Ti), row, 16 * (2 * nh) + 4 * g)); \
        st_img4(SL(dst), row, 16 * (2 * nh + 1) + 4 * g, acc[1] + ld_img4(SL(Ti), row, 16 * (2 * nh + 1) + 4 * g)); } while (0)
        MMST(7, 2, 10); MMST2(14, 15, 8, 9);
        __syncthreads();
        MMST2(5, 6, 14, 15); MMUPD(8, 13, 15);
        __syncthreads();
        MMST2(14, 15, 5, 6); MMUPD(9, 8, 6);
        __syncthreads();
        MMST2(5, 6, 14, 15); MMUPD(8, 9, 15);
        __syncthreads();
        MMST(15, 6, 5); MMUPD(9, 8, 6);
        __syncthreads();
        MMUPD(8, 9, 15);
        __syncthreads();
        MMST(5, 1, 8); MMST(6, 7, 8);
        __syncthreads();
        ZACC(acc); mm64(SL(11), SL(5), mb, nh, fr, g, acc);
#pragma unroll
        for (int nbi = 0; nbi < 2; ++nbi) { const int c0 = 16 * (2 * nh + nbi) + 4 * g; unsigned bo = (unsigned)((row * 64 + c0) * 2); asm volatile("" : "+v"(bo)); stso_bf4(R + base, bo, acc[nbi] + ld_img4(SL(0), row, c0)); }
        ZACC(acc); mm64(SL(11), SL(6), mb, nh, fr, g, acc); mm64(SL(12), SL(2), mb, nh, fr, g, acc);
#pragma unroll
        for (int nbi = 0; nbi < 2; ++nbi) { const int c0 = 16 * (2 * nh + nbi) + 4 * g; unsigned bo = (unsigned)((row * 64 + c0) * 2); asm volatile("" : "+v"(bo)); stso_bf4(Kp + base, bo, acc[nbi]); }
        ZACC(acc); mm64(SL(3), SL(5), mb, nh, fr, g, acc);
#pragma unroll
        for (int nbi = 0; nbi < 2; ++nbi) { const int c0 = 16 * (2 * nh + nbi) + 4 * g; f32x4 m = acc[nbi];
#pragma unroll
            for (int i = 0; i < 4; ++i) m[i] += (c0 + i == row) ? gC[row] : 0.f;
            const int cp = (c0 & 32) + 8 * ((c0 >> 2) & 3) + 4 * ((c0 >> 4) & 1);
            unsigned bo = (unsigned)((row * 64 + cp) * 2); asm volatile("" : "+v"(bo)); stso_bf4(A + base, bo, m); }
        ZACC(acc); mm64(SL(6), SL(3), mb, nh, fr, g, acc); mm64(SL(2), SL(4), mb, nh, fr, g, acc);
#pragma unroll
        for (int nbi = 0; nbi < 2; ++nbi) { const int c0 = 16 * (2 * nh + nbi) + 4 * g; unsigned bo = (unsigned)((row * 64 + 16 * ((c0 >> 2) & 3) + 4 * (c0 >> 4)) * 2); asm volatile("" : "+v"(bo)); stso_bf4(Qs + (size_t)unit * 4096, bo, acc[nbi]); }
        __syncthreads();
    }
#undef SL
}

DI void phase_scanB(PP p, unsigned char* lds, int l) {
    const int tid = tid_(), lane = tid & 63, wid = tid >> 6, fr = lane & 15, g = lane >> 4;
    const bf16_t* A = SCR16(p, SCR_A); const bf16_t* Qs = SCR16(p, SCR_QS); bf16_t* SC = SCR16(p, SCR_W);
    const int srow = tid >> 3, sc8 = tid & 7;
    const unsigned soff = (unsigned)(srow * 128 + ((sc8 ^ ((srow >> 1) & 7)) << 4));
    constexpr int NBAT = (NCHR - 1) / 8;
    for (int unit = blockIdx.x; unit < NB * 16; unit += gridDim.x) {
        const int v = 16 * (wid & 3) + fr;
        const bf16_t* pa = A + ((size_t)unit * LP) * 64 + tid * 8;
        const bf16_t* pq = Qs + ((size_t)unit * NCHR) * 4096 + tid * 8;
        f32x4 X[4];
#pragma unroll
        for (int kb = 0; kb < 4; ++kb) X[kb] = (f32x4){0.f, 0.f, 0.f, 0.f};
        u32x4 ra[8], rq[8];
#pragma unroll
        for (int j = 0; j < 8; ++j) { ra[j] = *(const u32x4*)(pa + (size_t)j * 4096); rq[j] = *(const u32x4*)(pq + (size_t)j * 4096); }
#pragma unroll
        for (int j = 0; j < 8; ++j) { *(u32x4*)(lds + j * 8192 + soff) = ra[j]; *(u32x4*)(lds + 65536 + j * 8192 + soff) = rq[j]; }
#pragma unroll
        for (int j = 0; j < 8; ++j) { ra[j] = *(const u32x4*)(pa + (size_t)(8 + j) * 4096); rq[j] = *(const u32x4*)(pq + (size_t)(8 + j) * 4096); }
        __syncthreads();
        for (int bt = 0; bt < NBAT; ++bt) {
            if (wid < 4) {
                const int sw = (fr >> 1) & 7;
                bf16x8 fa[4][2], fb[4][2]; u32x4 qa[2], qb[2];
#define SB_LOAD(F, Q, S8) do { const unsigned char* pimg_ = lds + (S8) * 8192; const unsigned char* qimg_ = lds + 65536 + (S8) * 8192; \
                    _Pragma("unroll") for (int kb = 0; kb < 4; ++kb) _Pragma("unroll") for (int ks = 0; ks < 2; ++ks) F[kb][ks] = *(const bf16x8*)(pimg_ + (16 * kb + fr) * 128 + (((4 * ks + g) ^ sw) << 4)); \
                    Q[0] = *(const u32x4*)(qimg_ + v * 128 + (((2 * g) ^ sw) << 4)); Q[1] = *(const u32x4*)(qimg_ + v * 128 + (((2 * g + 1) ^ sw) << 4)); } while (0)
#define SB_STEP(F, Q, S8) do { const size_t ch = (size_t)unit * NCHR + bt * 8 + (S8); \
                    _Pragma("unroll") for (int kb = 0; kb < 4; ++kb) st_bf4(SC + ch * 4096 + v * 64 + 16 * kb + 4 * g, X[kb]); \
                    bf16x8 xp[2]; \
                    _Pragma("unroll") for (int ks = 0; ks < 2; ++ks) { u32x4 w; w.x = cvt_pk_bf16(X[2 * ks][0], X[2 * ks][1]); w.y = cvt_pk_bf16(X[2 * ks][2], X[2 * ks][3]); \
                        w.z = cvt_pk_bf16(X[2 * ks + 1][0], X[2 * ks + 1][1]); w.w = cvt_pk_bf16(X[2 * ks + 1][2], X[2 * ks + 1][3]); xp[ks] = __builtin_bit_cast(bf16x8, w); } \
                    const unsigned qw[8] = {Q[0].x, Q[0].y, Q[0].z, Q[0].w, Q[1].x, Q[1].y, Q[1].z, Q[1].w}; \
                    _Pragma("unroll") for (int kb = 0; kb < 4; ++kb) { f32x4 acc = (f32x4){bflo(qw[2 * kb]), bfhi(qw[2 * kb]), bflo(qw[2 * kb + 1]), bfhi(qw[2 * kb + 1])}; \
                        _Pragma("unroll") for (int ks = 0; ks < 2; ++ks) acc = __builtin_amdgcn_mfma_f32_16x16x32_bf16(F[kb][ks], xp[ks], acc, 0, 0, 0); \
                        X[kb] = acc; } } while (0)
                SB_LOAD(fa, qa, 0);
#pragma unroll
                for (int s2 = 0; s2 < 8; s2 += 2) {
                    SB_LOAD(fb, qb, s2 + 1);
                    SB_STEP(fa, qa, s2);
                    if (s2 + 2 < 8) SB_LOAD(fa, qa, s2 + 2);
                    SB_STEP(fb, qb, s2 + 1);
                }
#undef SB_LOAD
#undef SB_STEP
            }
            __syncthreads();
            if (bt + 1 < NBAT) {
#pragma unroll
                for (int j = 0; j < 8; ++j) { *(u32x4*)(lds + j * 8192 + soff) = ra[j]; *(u32x4*)(lds + 65536 + j * 8192 + soff) = rq[j]; }
                if (bt + 2 < NBAT) {
#pragma unroll
                    for (int j = 0; j < 8; ++j) { ra[j] = *(const u32x4*)(pa + (size_t)((bt + 2) * 8 + j) * 4096); rq[j] = *(const u32x4*)(pq + (size_t)((bt + 2) * 8 + j) * 4096); }
                }
            }
            __syncthreads();
        }
        if (wid < 4) {
#pragma unroll
            for (int kb = 0; kb < 4; ++kb) st_bf4(SC + ((size_t)unit * NCHR + NCHR - 1) * 4096 + v * 64 + 16 * kb + 4 * g, X[kb]);
        }
    }
}

DI void phase_scanC(PP p, unsigned char* lds, int l) {
    const int tid = tid_(), lane = tid & 63, wid = tid >> 6, fr = lane & 15, g = lane >> 4, mb = wid >> 1, nh = wid & 1;
    float* Yl = (float*)(lds + 16384);
    const bf16_t* R = SCR16(p, SCR_R); const bf16_t* Kp = SCR16(p, SCR_K); const bf16_t* V = l == 0 ? VFIRST(p) : SCR16(p, SCR_V);
    const bf16_t* G = SCR16(p, SCR_G); const bf16_t* SC = SCR16(p, SCR_W); const float* bonus = (const float*)(p->ws + OFF_SCR + SCR_LO1); bf16_t* Z = SCR16(p, SCR_Z);
    const int srow = tid >> 3, sc8 = tid & 7;
    const unsigned so = (unsigned)(srow * 128 + ((sc8 ^ ((srow >> 1) & 7)) << 4));
    const int NU = NB * 16 * NCHR;
    int unit = blockIdx.x;
    u32x4 rp, sc;
    if (unit < NU) {
        const int c = unit % NCHR, bh = unit / NCHR; const size_t base = ((size_t)bh * LP + 64 * c) * 64;
        rp = *(const u32x4*)(R + base + (size_t)srow * 64 + sc8 * 8); sc = *(const u32x4*)(SC + (size_t)unit * 4096 + srow * 64 + sc8 * 8);
    }
    for (; unit < NU; unit += gridDim.x) {
        const int c = unit % NCHR, bh = unit / NCHR, h = bh & 15;
        const size_t base = ((size_t)bh * LP + 64 * c) * 64;
        const int hc = l * D_ + h * 64 + lane;
        const float c_lg = p->in[I_LNXG][hc], c_lb = p->in[I_LNXB][hc];
        *(u32x4*)(lds + so) = rp; *(u32x4*)(lds + 8192 + so) = sc;
        const int row = 16 * mb + fr;
        u32x2 y0[2];
#pragma unroll
        for (int nbi = 0; nbi < 2; ++nbi) y0[nbi] = *(const u32x2*)(Kp + base + (size_t)row * 64 + 16 * (2 * nh + nbi) + 4 * g);
        float ev[8], eg[8], eb[8];
#pragma unroll
        for (int j = 0; j < 8; ++j) { const int t = 8 * wid + j; const size_t e = base + (size_t)t * 64 + lane; ev[j] = bf2f(V[e]); eg[j] = bf2f(G[e]); eb[j] = bonus[(size_t)bh * LP + 64 * c + t]; }
        {
            const int un = unit + gridDim.x;
            if (un < NU) { const int cn = un % NCHR, bhn = un / NCHR; const size_t bn = ((size_t)bhn * LP + 64 * cn) * 64;
                rp = *(const u32x4*)(R + bn + (size_t)srow * 64 + sc8 * 8); sc = *(const u32x4*)(SC + (size_t)un * 4096 + srow * 64 + sc8 * 8); }
        }
        __syncthreads();
        f32x4 acc[2]; ZACC(acc);
        mm64(lds, lds + 8192, mb, nh, fr, g, acc);
#pragma unroll
        for (int nbi = 0; nbi < 2; ++nbi) {
            const int c0 = 16 * (2 * nh + nbi) + 4 * g;
            float* d = Yl + row * 65 + c0;
            d[0] = acc[nbi][0] + bflo(y0[nbi].x); d[1] = acc[nbi][1] + bfhi(y0[nbi].x); d[2] = acc[nbi][2] + bflo(y0[nbi].y); d[3] = acc[nbi][3] + bfhi(y0[nbi].y);
        }
        __syncthreads();
#pragma unroll
        for (int j = 0; j < 8; ++j) {
            const int t = 8 * wid + j;
            const float y = Yl[t * 65 + lane];
            const float mean = wave_sum(y) * (1.0f / 64.0f);
            const float dlt = y - mean;
            const float var = wave_sum(dlt * dlt) * (1.0f / 64.0f);
            const float yn = dlt * rsqrtf(var + 64e-5f) * c_lg + c_lb;
            Z[base + (size_t)t * 64 + lane] = f2bf((yn + eb[j] * ev[j]) * eg[j]);
        }
        __syncthreads();
    }
}

DI void phase_outproj_old(PP p, unsigned char* lds, bool hm) {
    EpiResid e; e.out = p->out; e.ws = p->ws;
    for (int u = blockIdx.x; u < MT * 4; u += gridDim.x) {
        const int mt = u >> 2, nt = u & 3;
        e.m0 = mt * 128; e.n0 = nt * 256;
        APlain a;
        if (hm) { const int b = mt * 128 >= LP ? 1 : 0, t0 = mt * 128 - b * LP; a.base = SCR16(p, SCR_Z) + ((size_t)(b * 16) * LP + t0) * 64; a.ld = 64; }
        else { a.base = SCR16(p, SCR_Z) + (size_t)(mt * 128) * D_; a.ld = D_; }
        gemm_tile<128, 256, 64, 64, true>(lds, a, WL_OUT(p) + (size_t)(nt * 256) * D_, D_, D_, e, hm ? (size_t)LP * 64 : (size_t)64);
    }
}

template <bool COMBINE>
DI void phase_ln(PP p, const float* gam, const float* bet, bool final_out) {
    const int tid0 = tid_(); const int lane = tid0 & 63, wid = tid0 >> 6;
    bf16_t* h16 = H16(p);
    const int* tok_slot = (const int*)(p->ws + OFF_TAB) + 2 * NSLOT;
    const bf16_t* Y = SCR16(p, SCR_Y);
    const int c0 = lane * 16;
    f32x4 g4[4], b4[4];
#pragma unroll
    for (int i = 0; i < 4; ++i) { g4[i] = *(const f32x4*)(gam + c0 + 4 * i); b4[i] = *(const f32x4*)(bet + c0 + 4 * i); }
    for (int n = blockIdx.x * 8 + wid; n < NTOK; n += gridDim.x * 8) {
        const int b = n >= LSEQ ? 1 : 0, t = n - b * LSEQ, prow = b * LP + t;
        f32x4 x[4];
        {
            const bf16_t* src = h16 + (size_t)prow * D_;
            const u32x4 w0 = *(const u32x4*)(src + c0), w1 = *(const u32x4*)(src + c0 + 8);
            x[0] = (f32x4){bflo(w0.x), bfhi(w0.x), bflo(w0.y), bfhi(w0.y)}; x[1] = (f32x4){bflo(w0.z), bfhi(w0.z), bflo(w0.w), bfhi(w0.w)};
            x[2] = (f32x4){bflo(w1.x), bfhi(w1.x), bflo(w1.y), bfhi(w1.y)}; x[3] = (f32x4){bflo(w1.z), bfhi(w1.z), bflo(w1.w), bfhi(w1.w)};
        }
        if (!COMBINE) {
            const bf16_t* src = SCR16(p, SCR_R) + (size_t)prow * D_;
            const u32x4 w0 = *(const u32x4*)(src + c0), w1 = *(const u32x4*)(src + c0 + 8);
#pragma unroll
            for (int i = 0; i < 4; ++i) x[i] = x[i] * DN_ALPHA;
            x[0][0] += bflo(w0.x); x[0][1] += bfhi(w0.x); x[0][2] += bflo(w0.y); x[0][3] += bfhi(w0.y);
            x[1][0] += bflo(w0.z); x[1][1] += bfhi(w0.z); x[1][2] += bflo(w0.w); x[1][3] += bfhi(w0.w);
            x[2][0] += bflo(w1.x); x[2][1] += bfhi(w1.x); x[2][2] += bflo(w1.y); x[2][3] += bfhi(w1.y);
            x[3][0] += bflo(w1.z); x[3][1] += bfhi(w1.z); x[3][2] += bflo(w1.w); x[3][3] += bfhi(w1.w);
        }
        if (COMBINE) {
#pragma unroll
            for (int i = 0; i < 4; ++i) x[i] = x[i] * DN_ALPHA;
            {
                const bf16_t* src = SCR16(p, SCR_YSH) + (size_t)prow * D_;
                const u32x4 w0 = *(const u32x4*)(src + c0), w1 = *(const u32x4*)(src + c0 + 8);
                x[0][0] += bflo(w0.x); x[0][1] += bfhi(w0.x); x[0][2] += bflo(w0.y); x[0][3] += bfhi(w0.y);
                x[1][0] += bflo(w0.z); x[1][1] += bfhi(w0.z); x[1][2] += bflo(w0.w); x[1][3] += bfhi(w0.w);
                x[2][0] += bflo(w1.x); x[2][1] += bfhi(w1.x); x[2][2] += bflo(w1.y); x[2][3] += bfhi(w1.y);
                x[3][0] += bflo(w1.z); x[3][1] += bfhi(w1.z); x[3][2] += bflo(w1.w); x[3][3] += bfhi(w1.w);
            }
            f32x4 ys[4];
#pragma unroll
            for (int i = 0; i < 4; ++i) ys[i] = (f32x4){0.f, 0.f, 0.f, 0.f};
#pragma unroll
            for (int k = 0; k < 8; ++k) {
                const u32x4 w = *(const u32x4*)((const unsigned char*)Y + (size_t)tok_slot[n * 8 + k] * D_ + c0);
                const unsigned ww[4] = {w.x, w.y, w.z, w.w};
#pragma unroll
                for (int i = 0; i < 4; ++i) {
                    const f32x2 lo = __builtin_amdgcn_cvt_pk_f32_fp8((int)ww[i], false), hi = __builtin_amdgcn_cvt_pk_f32_fp8((int)ww[i], true);
                    ys[i][0] += lo.x; ys[i][1] += lo.y; ys[i][2] += hi.x; ys[i][3] += hi.y;
                }
            }
#pragma unroll
            for (int i = 0; i < 4; ++i) x[i] = x[i] + ys[i] * 0.0625f;
        }
        float s = 0.f;
#pragma unroll
        for (int i = 0; i < 4; ++i) s += (x[i][0] + x[i][1]) + (x[i][2] + x[i][3]);
        const float mean = wave_sum(s) * (1.0f / 1024.0f);
        float qv = 0.f;
#pragma unroll
        for (int i = 0; i < 4; ++i) { const f32x4 d = x[i] - mean; qv += (d[0] * d[0] + d[1] * d[1]) + (d[2] * d[2] + d[3] * d[3]); }
        const float rstd = rsqrtf(wave_sum(qv) * (1.0f / 1024.0f) + LN_EPS);
        u32x4 o0, o1;
#pragma unroll
        for (int i = 0; i < 4; ++i) x[i] = (x[i] - mean) * rstd * g4[i] + b4[i];
        if (final_out) {
            if (t >= NMETA) { float* orow = p->out + ((size_t)b * SEQ + (t - NMETA)) * D_ + c0;
#pragma unroll
                for (int i = 0; i < 4; ++i) *(f32x4*)(orow + 4 * i) = x[i]; }
            continue;
        }
        o0.x = cvt_pk_bf16(x[0][0], x[0][1]); o0.y = cvt_pk_bf16(x[0][2], x[0][3]); o0.z = cvt_pk_bf16(x[1][0], x[1][1]); o0.w = cvt_pk_bf16(x[1][2], x[1][3]);
        o1.x = cvt_pk_bf16(x[2][0], x[2][1]); o1.y = cvt_pk_bf16(x[2][2], x[2][3]); o1.z = cvt_pk_bf16(x[3][0], x[3][1]); o1.w = cvt_pk_bf16(x[3][2], x[3][3]);
        *(u32x4*)(h16 + (size_t)prow * D_ + c0) = o0; *(u32x4*)(h16 + (size_t)prow * D_ + c0 + 8) = o1;
        {
            u32x4 o8; o8.x = (unsigned)pk4_fp8(x[0]); o8.y = (unsigned)pk4_fp8(x[1]); o8.z = (unsigned)pk4_fp8(x[2]); o8.w = (unsigned)pk4_fp8(x[3]);
            *(u32x4*)(H8BUF(p) + (size_t)prow * D_ + c0) = o8;
        }
    }
}

DI void phase_qkv_old(PP p, unsigned char* lds, int l) {
    const int nq = MT * 4, nk = l == 2 ? MT * 4 : 0, nv = nk;
    for (int u = blockIdx.x; u < nq + nk + nv; u += gridDim.x) {
        if (u < nq + nk) {
            const bool isq = u < nq; const int r = isq ? u : u - nq, mt = r >> 2, nt = r & 3;
            EpiQK e; e.m0 = mt * 128; e.n0 = nt * 256; e.dst = isq ? SCR16(p, 0) : KBUF(p); e.scale = isq ? 0.125f * 1.4426950408889634f : 1.0f;
            APlain a; a.base = H16(p) + (size_t)(mt * 128) * D_; a.ld = D_;
            const bf16_t* B = isq ? WL_WQ(p) + (size_t)(nt * 256) * D_ : WL_BIG(p) + (size_t)(nt * 256) * D_;
            gemm_tile<128, 256, 64, 64, true>(lds, a, B, D_, D_, e);
        } else {
            const int r = u - nq - nk, mt = r >> 2, nt = r & 3;
            EpiVt e; e.m0 = mt * 128; e.n0 = nt * 256; e.dst = VTBUF(p);
            APlain a; a.base = H16(p) + (size_t)(mt * 128) * D_; a.ld = D_;
            gemm_tile<128, 256, 64, 64, false>(lds, a, WL_BIG(p) + (size_t)(1024 + nt * 256) * D_, D_, D_, e);
        }
    }
}

DI int crow32(int i, int h) { return (i & 3) + 8 * (i >> 2) + 4 * h; }

DI void phase_attn(PP p, unsigned char* lds, int j, int rep = 0) {
    const int tid = tid_(), lane = tid & 63, wid = tid >> 6, cmap = wid >> 2, rg = wid & 3, ql = lane & 31, hh = lane >> 5;
    const float lam_init = j == 0 ? (float)(0.8 - 0.6 * 0.5488116360940264) : (float)(0.8 - 0.6 * 0.4065696597405991);
    float d1 = 0.f, d2 = 0.f;
    for (int i = 0; i < 64; ++i) { d1 += p->in[I_LQ1][j * 64 + i] * p->in[I_LK1][j * 64 + i]; d2 += p->in[I_LQ2][j * 64 + i] * p->in[I_LK2][j * 64 + i]; }
    const float lam = __expf(d1) - __expf(d2) + lam_init;
    const float post = 1.0f - lam_init;
    const bf16_t* Q = SCR16(p, 0); const bf16_t* Kb = KBUF(p); const bf16_t* Vt = VTBUF(p); bf16_t* Z = SCR16(p, SCR_Z);
    const float* subg = p->in[I_SUBG] + j * 128;
    unsigned* ctr = CTRL(p) + CT_ATTNQ + 64 * (j + 2 * rep);
    constexpr int STG = 32768;
    unsigned* s_u = (unsigned*)(lds + 2 * STG);
    constexpr int NQB = LP / 128;
    const int total = NB * 8 * NQB;
    const int krow = tid >> 3, kc8 = tid & 7;
    const unsigned koff = krow * 128 + ((kc8 ^ ((krow >> 1) & 7)) << 4);
    for (;;) {
        if (tid == 0) *s_u = atomicAdd(ctr, 1u);
        __syncthreads();
        const int u = (int)*s_u;
        __syncthreads();
        if (u >= total) break;
        const int qb = NQB - 1 - u / 16, bh = u & 15, b = bh >> 3, head = bh & 7;
        const int q0 = qb * 128 + rg * 32;
        bf16x8 qf[4];
        {
            const bf16_t* qp = Q + (((size_t)(b * 16 + head * 2 + cmap)) * LP + q0 + ql) * 64 + 8 * hh;
#pragma unroll
            for (int s = 0; s < 4; ++s) qf[s] = *(const bf16x8*)(qp + 16 * s);
        }
        const bf16_t* k0p = Kb + (((size_t)(b * 16 + head * 2 + 0)) * LP) * 64 + krow * 64 + kc8 * 8;
        const bf16_t* k1p = Kb + (((size_t)(b * 16 + head * 2 + 1)) * LP) * 64 + krow * 64 + kc8 * 8;
        const bf16_t* vp0 = Vt + ((size_t)(b * 1024 + head * 128 + krow)) * LP + kc8 * 8;
        const bf16_t* vp1 = vp0 + (size_t)64 * LP;
        const int ntile = 2 * qb + 2;
        f32x16 O[4];
#pragma unroll
        for (int i = 0; i < 4; ++i)
#pragma unroll
            for (int r = 0; r < 16; ++r) O[i][r] = 0.f;
        float m_run = -1e30f, l_run = 0.f;
        u32x4 rk0, rk1, rv0, rv1;
        rk0 = *(const u32x4*)(k0p); rk1 = *(const u32x4*)(k1p); rv0 = *(const u32x4*)(vp0); rv1 = *(const u32x4*)(vp1);
        auto stage_write = [&](unsigned char* st) {
            *(u32x4*)(st + koff) = rk0; *(u32x4*)(st + 8192 + koff) = rk1;
            {
                const int r0 = krow, r1 = krow + 64;
                const int s0 = (r0 >> 1) & 15, s1 = (r1 >> 1) & 15;
                unsigned char* vb = st + 16384;
                *(u32x2*)(vb + r0 * 128 + (((2 * kc8) ^ s0) << 3)) = (u32x2){rv0.x, rv0.y};
                *(u32x2*)(vb + r0 * 128 + (((2 * kc8 + 1) ^ s0) << 3)) = (u32x2){rv0.z, rv0.w};
                *(u32x2*)(vb + r1 * 128 + (((2 * kc8) ^ s1) << 3)) = (u32x2){rv1.x, rv1.y};
                *(u32x2*)(vb + r1 * 128 + (((2 * kc8 + 1) ^ s1) << 3)) = (u32x2){rv1.z, rv1.w};
            }
        };
        stage_write(lds);
        __syncthreads();
        for (int kt = 0; kt < ntile; ++kt) {
            const unsigned char* cur = lds + (kt & 1) * STG;
            const bool more = kt + 1 < ntile;
            if (more) {
                const size_t ko = (size_t)(kt + 1) * 64 * 64, vo = (size_t)(kt + 1) * 64;
                rk0 = *(const u32x4*)(k0p + ko); rk1 = *(const u32x4*)(k1p + ko); rv0 = *(const u32x4*)(vp0 + vo); rv1 = *(const u32x4*)(vp1 + vo);
            }
            const int key0 = kt * 64;
            if (key0 <= q0 + 31) {
                const unsigned char* kst = cur + cmap * 8192;
                f32x16 sc[2];
#pragma unroll
                for (int kb = 0; kb < 2; ++kb) {
#pragma unroll
                    for (int r = 0; r < 16; ++r) sc[kb][r] = 0.f;
                    const int row = kb * 32 + ql;
#pragma unroll
                    for (int s = 0; s < 4; ++s) {
                        const bf16x8 kf = *(const bf16x8*)(kst + row * 128 + (((2 * s + hh) ^ ((row >> 1) & 7)) << 4));
                        sc[kb] = __builtin_amdgcn_mfma_f32_32x32x16_bf16(kf, qf[s], sc[kb], 0, 0, 0);
                    }
                }
                if (key0 + 63 > q0) {
                    const int qq = q0 + ql;
#pragma unroll
                    for (int kb = 0; kb < 2; ++kb)
#pragma unroll
                        for (int r = 0; r < 16; ++r) { const int key = key0 + kb * 32 + crow32(r, hh); sc[kb][r] = key > qq ? -INFINITY : sc[kb][r]; }
                }
                float mx = sc[0][0];
#pragma unroll
                for (int kb = 0; kb < 2; ++kb)
#pragma unroll
                    for (int r = 0; r < 16; ++r) mx = fmaxf(mx, sc[kb][r]);
                mx = fmaxf(mx, __shfl_xor(mx, 32));
                const float m_new = fmaxf(m_run, mx);
                const float alpha = __builtin_amdgcn_exp2f(m_run - m_new);
                m_run = m_new;
                float ps = 0.f;
#pragma unroll
                for (int kb = 0; kb < 2; ++kb)
#pragma unroll
                    for (int r = 0; r < 16; ++r) { const float e = __builtin_amdgcn_exp2f(sc[kb][r] - m_new); sc[kb][r] = e; ps += e; }
                l_run = l_run * alpha + ps;
#pragma unroll
                for (int i = 0; i < 4; ++i)
#pragma unroll
                    for (int r = 0; r < 16; ++r) O[i][r] *= alpha;
                const unsigned char* vst = cur + 16384;
#pragma unroll
                for (int s = 0; s < 4; ++s) {
                    const int kb = s >> 1, r0 = 8 * (s & 1);
                    u32x4 pw;
                    pw.x = cvt_pk_bf16(sc[kb][r0 + 0], sc[kb][r0 + 1]); pw.y = cvt_pk_bf16(sc[kb][r0 + 2], sc[kb][r0 + 3]);
                    pw.z = cvt_pk_bf16(sc[kb][r0 + 4], sc[kb][r0 + 5]); pw.w = cvt_pk_bf16(sc[kb][r0 + 6], sc[kb][r0 + 7]);
                    const bf16x8 pf = __builtin_bit_cast(bf16x8, pw);
#pragma unroll
                    for (int dvb = 0; dvb < 4; ++dvb) {
                        const int row = dvb * 32 + ql, sw = (row >> 1) & 15;
                        const u32x2 lo = *(const u32x2*)(vst + row * 128 + (((4 * s + hh) ^ sw) << 3));
                        const u32x2 hi = *(const u32x2*)(vst + row * 128 + (((4 * s + 2 + hh) ^ sw) << 3));
                        const bf16x8 vf = __builtin_bit_cast(bf16x8, (u32x4){lo.x, lo.y, hi.x, hi.y});
                        O[dvb] = __builtin_amdgcn_mfma_f32_32x32x16_bf16(vf, pf, O[dvb], 0, 0, 0);
                    }
                }
            }
            if (more) stage_write(lds + ((kt + 1) & 1) * STG);
            __syncthreads();
        }
        const float l_tot = l_run + __shfl_xor(l_run, 32);
        const float inv = 1.0f / l_tot;
        float* xb = (float*)lds + rg * 4096;
        if (cmap == 1) {
            const float sc1 = lam * inv;
#pragma unroll
            for (int i = 0; i < 4; ++i)
#pragma unroll
                for (int r = 0; r < 16; ++r) xb[(i * 16 + r) * 64 + lane] = O[i][r] * sc1;
        }
        __syncthreads();
        if (cmap == 0) {
            float ss = 0.f;
#pragma unroll
            for (int i = 0; i < 4; ++i)
#pragma unroll
                for (int r = 0; r < 16; ++r) { const float o = O[i][r] * inv - xb[(i * 16 + r) * 64 + lane]; O[i][r] = o; ss += o * o; }
            ss += __shfl_xor(ss, 32);
            const float rn = rsqrtf(ss * (1.0f / 128.0f) + 1e-5f) * post;
            bf16_t* zp = Z + ((size_t)(b * LP + q0 + ql)) * D_ + head * 128;
#pragma unroll
            for (int i = 0; i < 4; ++i)
#pragma unroll
                for (int g = 0; g < 4; ++g) {
                    const int dv = i * 32 + 8 * g + 4 * hh;
                    const f32x4 sg = *(const f32x4*)(subg + dv);
                    f32x4 o; o[0] = O[i][4 * g + 0] * rn * sg[0]; o[1] = O[i][4 * g + 1] * rn * sg[1]; o[2] = O[i][4 * g + 2] * rn * sg[2]; o[3] = O[i][4 * g + 3] * rn * sg[3];
                    st_bf4(zp + dv, o);
                }
        }
        __syncthreads();
    }
}


DI void attn_qk(f32x16 (&sc)[2], const unsigned char* kst, const bf16x8 (&qf)[4], float m_run, int ql, int hh) {
#pragma unroll
    for (int kb = 0; kb < 2; ++kb) {
        const int row = kb * 32 + ql, sw = (row >> 1) & 7;
        f32x16 z;
#pragma unroll
        for (int r = 0; r < 16; ++r) z[r] = 0.f;
        sc[kb] = __builtin_amdgcn_mfma_f32_32x32x16_bf16(*(const bf16x8*)(kst + row * 128 + (((0 + hh) ^ sw) << 4)), qf[0], z, 0, 0, 0);
#pragma unroll
        for (int s = 1; s < 4; ++s)
            sc[kb] = __builtin_amdgcn_mfma_f32_32x32x16_bf16(*(const bf16x8*)(kst + row * 128 + (((2 * s + hh) ^ sw) << 4)), qf[s], sc[kb], 0, 0, 0);
    }
    if (__any(m_run != 0.f)) {
#pragma unroll
        for (int kb = 0; kb < 2; ++kb)
#pragma unroll
            for (int r = 0; r < 16; ++r) sc[kb][r] -= m_run;
    }
}
DI void attn_sm(f32x16 (&sc)[2], bf16x8 (&pf)[4], f32x16 (&O)[4], float& m_run, float& l_run, int key0, int qq, bool diag, int hh) {
    if (diag) {
#pragma unroll
        for (int kb = 0; kb < 2; ++kb)
#pragma unroll
            for (int r = 0; r < 16; ++r) { const int key = key0 + kb * 32 + crow32(r, hh); sc[kb][r] = key > qq ? -INFINITY : sc[kb][r]; }
    }
    float mx = fmaxf(fmaxf(sc[0][0], sc[0][1]), sc[0][2]);
#pragma unroll
    for (int r = 3; r < 15; r += 2) mx = fmaxf(fmaxf(mx, sc[0][r]), sc[0][r + 1]);
    mx = fmaxf(mx, sc[0][15]);
#pragma unroll
    for (int r = 0; r < 16; r += 2) mx = fmaxf(fmaxf(mx, sc[1][r]), sc[1][r + 1]);
    mx = fmaxf(mx, __shfl_xor(mx, 32));
    if (__any(mx > 8.0f)) {
        const float delta = mx > 8.0f ? mx : 0.f;
        const float alpha = __builtin_amdgcn_exp2f(-delta);
        m_run += delta; l_run *= alpha;
#pragma unroll
        for (int i = 0; i < 4; ++i)
#pragma unroll
            for (int r = 0; r < 16; ++r) O[i][r] *= alpha;
#pragma unroll
        for (int kb = 0; kb < 2; ++kb)
#pragma unroll
            for (int r = 0; r < 16; ++r) sc[kb][r] -= delta;
    }
    float ps0 = 0.f, ps1 = 0.f;
#pragma unroll
    for (int r = 0; r < 16; ++r) { const float e0 = __builtin_amdgcn_exp2f(sc[0][r]), e1 = __builtin_amdgcn_exp2f(sc[1][r]); sc[0][r] = e0; sc[1][r] = e1; ps0 += e0; ps1 += e1; }
    l_run += ps0 + ps1;
#pragma unroll
    for (int s = 0; s < 4; ++s) {
        const int kb = s >> 1, r0 = 8 * (s & 1);
        u32x4 pw;
        pw.x = cvt_pk_bf16(sc[kb][r0 + 0], sc[kb][r0 + 1]); pw.y = cvt_pk_bf16(sc[kb][r0 + 2], sc[kb][r0 + 3]);
        pw.z = cvt_pk_bf16(sc[kb][r0 + 4], sc[kb][r0 + 5]); pw.w = cvt_pk_bf16(sc[kb][r0 + 6], sc[kb][r0 + 7]);
        pf[s] = __builtin_bit_cast(bf16x8, pw);
    }
}
constexpr int VT_BLK = 4112;
DI void attn_pv(f32x16 (&O)[4], const bf16x8 (&pf)[4], const unsigned char* vst, int ql, int hh) {
    __builtin_amdgcn_s_setprio(1);
    const int sw = (ql >> 1) & 7;
#pragma unroll
    for (int s = 0; s < 4; ++s) {
#pragma unroll
        for (int dvb = 0; dvb < 4; ++dvb) {
            const bf16x8 vf = *(const bf16x8*)(vst + dvb * VT_BLK + ql * 128 + (((2 * s + hh) ^ sw) << 4));
            O[dvb] = __builtin_amdgcn_mfma_f32_32x32x16_bf16(vf, pf[s], O[dvb], 0, 0, 0);
        }
    }
    __builtin_amdgcn_s_setprio(0);
}

DI void phase_attn3(PP p, unsigned char* lds, int j) {
    const int tid = tid_(), lane = tid & 63, wid = __builtin_amdgcn_readfirstlane(tid >> 6), cmap = wid >> 2, rg = wid & 3, ql = lane & 31, hh = lane >> 5;
    const bool skew = cmap == 1;
    const float lam_init = j == 0 ? (float)(0.8 - 0.6 * 0.5488116360940264) : (float)(0.8 - 0.6 * 0.4065696597405991);
    float d1 = 0.f, d2 = 0.f;
    for (int i = 0; i < 64; ++i) { d1 += p->in[I_LQ1][j * 64 + i] * p->in[I_LK1][j * 64 + i]; d2 += p->in[I_LQ2][j * 64 + i] * p->in[I_LK2][j * 64 + i]; }
    const float lam = __builtin_bit_cast(float, __builtin_amdgcn_readfirstlane(__builtin_bit_cast(int, __expf(d1) - __expf(d2) + lam_init)));
    const float post = 1.0f - lam_init;
    const bf16_t* Q = SCR16(p, 0); const bf16_t* Kb = KBUF(p); const bf16_t* Vt = VTBUF(p); bf16_t* Z = SCR16(p, SCR_Z);
    const float* subg = p->in[I_SUBG] + j * 128;
    unsigned* ctr = CTRL(p) + CT_ATTNQ + 64 * j;
    constexpr int STG = 32896;
    unsigned* s_u = (unsigned*)(lds + 3 * STG);
    constexpr int NQB = LP / 128;
    const int total = NB * 8 * NQB;
    const int krow = tid >> 3, kc8 = tid & 7;
    const unsigned koff = krow * 128 + ((kc8 ^ ((krow >> 1) & 7)) << 4);
    for (;;) {
        if (tid == 0) *s_u = atomicAdd(ctr, 1u);
        __syncthreads();
        const int u = (int)*s_u;
        __syncthreads();
        if (u >= total) break;
        const int qb = NQB - 1 - u / 16, bh = u & 15, b = bh >> 3, head = bh & 7;
        const int q0 = qb * 128 + rg * 32, qq = q0 + ql;
        bf16x8 qf[4];
        {
            const bf16_t* qp = Q + (((size_t)(b * 16 + head * 2 + cmap)) * LP + q0 + ql) * 64 + 8 * hh;
#pragma unroll
            for (int s = 0; s < 4; ++s) qf[s] = *(const bf16x8*)(qp + 16 * s);
        }
        const bf16_t* kbase0 = Kb + (((size_t)(b * 16 + head * 2 + 0)) * LP) * 64;
        const bf16_t* kbase1 = Kb + (((size_t)(b * 16 + head * 2 + 1)) * LP) * 64;
        const bf16_t* vbase = Vt + ((size_t)(b * 1024 + head * 128)) * LP;
        const int ntile = 2 * qb + 2;
        const int nw = ((q0 + 31) >> 6) + 1;
        f32x16 O[4];
#pragma unroll
        for (int i = 0; i < 4; ++i)
#pragma unroll
            for (int r = 0; r < 16; ++r) O[i][r] = 0.f;
        float m_run = 0.f, l_run = 0.f;
        f32x16 sc[2];
        bf16x8 pf[4];
#pragma unroll
        for (int s = 0; s < 4; ++s) pf[s] = (bf16x8){0, 0, 0, 0, 0, 0, 0, 0};
        const int dpos = lane & 7, drow = lane >> 3;
        auto stage_dma = [&](unsigned char* stg, int kt) {
            {
                const int row = wid * 8 + drow, c = dpos ^ ((row >> 1) & 7);
                const size_t so = (size_t)kt * 64 * 64 + row * 64 + c * 8;
                __builtin_amdgcn_global_load_lds((const unsigned*)(kbase0 + so), (LAS unsigned*)(stg + wid * 1024), 16, 0, 0);
                __builtin_amdgcn_global_load_lds((const unsigned*)(kbase1 + so), (LAS unsigned*)(stg + 8192 + wid * 1024), 16, 0, 0);
            }
#pragma unroll
            for (int i = 0; i < 2; ++i) {
                const int q = wid * 2 + i, r = 8 * q + drow, c = dpos ^ (((r & 31) >> 1) & 7);
                __builtin_amdgcn_global_load_lds((const unsigned*)(vbase + (size_t)r * LP + (size_t)kt * 64 + c * 8),
                                                 (LAS unsigned*)(stg + 16384 + (q >> 2) * VT_BLK + (q & 3) * 1024), 16, 0, 0);
            }
        };
        stage_dma(lds, 0);
        __syncthreads();
        int slot = 0, pslot = 2;
        for (int kt = 0; kt < ntile; ++kt) {
            const bool more = kt + 1 < ntile;
            const int nslot = slot == 2 ? 0 : slot + 1;
            if (more) stage_dma(lds + nslot * STG, kt + 1);
            const unsigned char* cur = lds + slot * STG;
            if (skew && kt >= 1 && kt - 1 < nw) attn_pv(O, pf, lds + pslot * STG + 16384, ql, hh);
            if (kt < nw) {
                attn_qk(sc, cur + cmap * 8192, qf, m_run, ql, hh);
                attn_sm(sc, pf, O, m_run, l_run, kt * 64, qq, kt * 64 + 63 > q0, hh);
                if (!skew) attn_pv(O, pf, cur + 16384, ql, hh);
            }
            __syncthreads();
            pslot = slot; slot = nslot;
        }
        if (skew && ntile - 1 < nw) attn_pv(O, pf, lds + pslot * STG + 16384, ql, hh);
        __syncthreads();
        const float l_tot = l_run + __shfl_xor(l_run, 32);
        const float inv = 1.0f / l_tot;
        float* xb = (float*)lds + rg * 4096;
        if (cmap == 1) {
            const float sc1 = lam * inv;
#pragma unroll
            for (int i = 0; i < 4; ++i)
#pragma unroll
                for (int r = 0; r < 16; ++r) xb[(i * 16 + r) * 64 + lane] = O[i][r] * sc1;
        }
        __syncthreads();
        if (cmap == 0) {
            float ss = 0.f;
#pragma unroll
            for (int i = 0; i < 4; ++i)
#pragma unroll
                for (int r = 0; r < 16; ++r) { const float o = O[i][r] * inv - xb[(i * 16 + r) * 64 + lane]; O[i][r] = o; ss += o * o; }
            ss += __shfl_xor(ss, 32);
            const float rn = rsqrtf(ss * (1.0f / 128.0f) + 1e-5f) * post;
            const float* subg_l = subg; asm volatile("" : "+s"(subg_l));
            bf16_t* zp = Z + ((size_t)(b * LP + q0 + ql)) * D_ + head * 128;
#pragma unroll
            for (int i = 0; i < 4; ++i)
#pragma unroll
                for (int g = 0; g < 4; ++g) {
                    const int dv = i * 32 + 8 * g + 4 * hh;
                    const f32x4 sg = *(const f32x4*)(subg_l + dv);
                    f32x4 o; o[0] = O[i][4 * g + 0] * rn * sg[0]; o[1] = O[i][4 * g + 1] * rn * sg[1]; o[2] = O[i][4 * g + 2] * rn * sg[2]; o[3] = O[i][4 * g + 3] * rn * sg[3];
                    st_bf4(zp + dv, o);
                }
        }
        __syncthreads();
    }
}

DI void attn_kload(bf16x8 (&kf)[2][4], const unsigned char* kst, int ql, int hh) {
#pragma unroll
    for (int kb = 0; kb < 2; ++kb) {
        const int row = kb * 32 + ql, sw = (row >> 1) & 7;
#pragma unroll
        for (int s = 0; s < 4; ++s) kf[kb][s] = *(const bf16x8*)(kst + row * 128 + (((2 * s + hh) ^ sw) << 4));
    }
}
DI void attn_qk_pre(f32x16 (&sc)[2], const bf16x8 (&kf)[2][4], const bf16x8 (&qf)[4], float m_run) {
#pragma unroll
    for (int kb = 0; kb < 2; ++kb) {
        f32x16 z;
#pragma unroll
        for (int r = 0; r < 16; ++r) z[r] = 0.f;
        sc[kb] = __builtin_amdgcn_mfma_f32_32x32x16_bf16(kf[kb][0], qf[0], z, 0, 0, 0);
#pragma unroll
        for (int s = 1; s < 4; ++s) sc[kb] = __builtin_amdgcn_mfma_f32_32x32x16_bf16(kf[kb][s], qf[s], sc[kb], 0, 0, 0);
    }
    if (__any(m_run != 0.f)) {
#pragma unroll
        for (int kb = 0; kb < 2; ++kb)
#pragma unroll
            for (int r = 0; r < 16; ++r) sc[kb][r] -= m_run;
    }
}
DI void attn_vload0(bf16x8 (&v0)[4], const unsigned char* vst, int ql, int hh) {
    const int sw = (ql >> 1) & 7;
#pragma unroll
    for (int dvb = 0; dvb < 4; ++dvb) v0[dvb] = *(const bf16x8*)(vst + dvb * VT_BLK + ql * 128 + (((0 + hh) ^ sw) << 4));
}
DI void attn_pv_pre(f32x16 (&O)[4], const bf16x8 (&pf)[4], const bf16x8 (&v0)[4], const unsigned char* vst, int ql, int hh) {
    __builtin_amdgcn_s_setprio(1);
    const int sw = (ql >> 1) & 7;
#pragma unroll
    for (int dvb = 0; dvb < 4; ++dvb) O[dvb] = __builtin_amdgcn_mfma_f32_32x32x16_bf16(v0[dvb], pf[0], O[dvb], 0, 0, 0);
#pragma unroll
    for (int s = 1; s < 4; ++s) {
#pragma unroll
        for (int dvb = 0; dvb < 4; ++dvb) {
            const bf16x8 vf = *(const bf16x8*)(vst + dvb * VT_BLK + ql * 128 + (((2 * s + hh) ^ sw) << 4));
            O[dvb] = __builtin_amdgcn_mfma_f32_32x32x16_bf16(vf, pf[s], O[dvb], 0, 0, 0);
        }
    }
    __builtin_amdgcn_s_setprio(0);
}

template <bool SKEW>
DI void attn6_body(PP p, unsigned char* lds, int j) {
    const int tid = tid_(), lane = tid & 63, wid = __builtin_amdgcn_readfirstlane(tid >> 6), cmap = wid >> 2, rg = wid & 3, ql = lane & 31, hh = lane >> 5;
    constexpr bool skew = SKEW;
    const float lam_init = j == 0 ? (float)(0.8 - 0.6 * 0.5488116360940264) : (float)(0.8 - 0.6 * 0.4065696597405991);
    float d1 = 0.f, d2 = 0.f;
    for (int i = 0; i < 64; ++i) { d1 += p->in[I_LQ1][j * 64 + i] * p->in[I_LK1][j * 64 + i]; d2 += p->in[I_LQ2][j * 64 + i] * p->in[I_LK2][j * 64 + i]; }
    const float lam = __builtin_bit_cast(float, __builtin_amdgcn_readfirstlane(__builtin_bit_cast(int, __expf(d1) - __expf(d2) + lam_init)));
    const float post = 1.0f - lam_init;
    const bf16_t* Q = SCR16(p, 0); const bf16_t* Kb = KBUF(p); const bf16_t* Vt = VTBUF(p); bf16_t* Z = SCR16(p, SCR_Z);
    const float* subg = p->in[I_SUBG] + j * 128;
    unsigned* ctr = CTRL(p) + CT_ATTNQ + 64 * j;
    constexpr int STG = 32896;
    unsigned* s_u = (unsigned*)(lds + 4 * STG);
    constexpr int NQB = LP / 128;
    const int total = NB * 8 * NQB;
    const int krow = tid >> 3, kc8 = tid & 7;
    const unsigned koff = krow * 128 + ((kc8 ^ ((krow >> 1) & 7)) << 4);
    for (;;) {
        if (tid == 0) *s_u = atomicAdd(ctr, 1u);
        __syncthreads();
        const int u = (int)*s_u;
        __syncthreads();
        if (u >= total) break;
        const int qb = NQB - 1 - u / 16, bh = u & 15, b = bh >> 3, head = bh & 7;
        const int q0 = qb * 128 + rg * 32, qq = q0 + ql;
        bf16x8 qf[4];
        {
            const bf16_t* qp = Q + (((size_t)(b * 16 + head * 2 + cmap)) * LP + q0 + ql) * 64 + 8 * hh;
#pragma unroll
            for (int s = 0; s < 4; ++s) qf[s] = *(const bf16x8*)(qp + 16 * s);
        }
        const bf16_t* kbase0 = Kb + (((size_t)(b * 16 + head * 2 + 0)) * LP) * 64;
        const bf16_t* kbase1 = Kb + (((size_t)(b * 16 + head * 2 + 1)) * LP) * 64;
        const bf16_t* vbase = Vt + ((size_t)(b * 1024 + head * 128)) * LP;
        const int ntile = 2 * qb + 2;
        const int nw = ((q0 + 31) >> 6) + 1;
        f32x16 O[4];
#pragma unroll
        for (int i = 0; i < 4; ++i)
#pragma unroll
            for (int r = 0; r < 16; ++r) O[i][r] = 0.f;
        float m_run = 0.f, l_run = 0.f;
        f32x16 sc[2];
        bf16x8 pf[4];
#pragma unroll
        for (int s = 0; s < 4; ++s) pf[s] = (bf16x8){0, 0, 0, 0, 0, 0, 0, 0};
        const int dpos = lane & 7, drow = lane >> 3;
        auto stage_dma = [&](unsigned char* stg, int kt) {
            {
                const int row = wid * 8 + drow, c = dpos ^ ((row >> 1) & 7);
                const size_t so = (size_t)kt * 64 * 64 + row * 64 + c * 8;
                __builtin_amdgcn_global_load_lds((const unsigned*)(kbase0 + so), (LAS unsigned*)(stg + wid * 1024), 16, 0, 0);
                __builtin_amdgcn_global_load_lds((const unsigned*)(kbase1 + so), (LAS unsigned*)(stg + 8192 + wid * 1024), 16, 0, 0);
            }
#pragma unroll
            for (int i = 0; i < 2; ++i) {
                const int q = wid * 2 + i, r = 8 * q + drow, c = dpos ^ (((r & 31) >> 1) & 7);
                __builtin_amdgcn_global_load_lds((const unsigned*)(vbase + (size_t)r * LP + (size_t)kt * 64 + c * 8),
                                                 (LAS unsigned*)(stg + 16384 + (q >> 2) * VT_BLK + (q & 3) * 1024), 16, 0, 0);
            }
        };
        stage_dma(lds, 0);
        stage_dma(lds + STG, 1);
        __syncthreads();
        bf16x8 kf[2][4], v0[4];
        if (!skew) attn_kload(kf, lds + cmap * 8192, ql, hh);
        for (int kt = 0; kt < ntile; ++kt) {
            if (kt + 2 < ntile) stage_dma(lds + ((kt + 2) & 3) * STG, kt + 2);
            const unsigned char* cur = lds + (kt & 3) * STG;
            if (!skew) {
                if (kt < nw) {
                    attn_qk_pre(sc, kf, qf, m_run);
                    attn_sm(sc, pf, O, m_run, l_run, kt * 64, qq, kt * 64 + 63 > q0, hh);
                    attn_pv(O, pf, cur + 16384, ql, hh);
                    if (kt + 1 < nw) attn_kload(kf, lds + ((kt + 1) & 3) * STG + cmap * 8192, ql, hh);
                }
            } else {
                if (kt >= 1 && kt - 1 < nw) attn_pv_pre(O, pf, v0, lds + ((kt - 1) & 3) * STG + 16384, ql, hh);
                if (kt < nw) {
                    attn_qk(sc, cur + cmap * 8192, qf, m_run, ql, hh);
                    attn_sm(sc, pf, O, m_run, l_run, kt * 64, qq, kt * 64 + 63 > q0, hh);
                    attn_vload0(v0, cur + 16384, ql, hh);
                }
            }
            __syncthreads();
        }
        if (skew && ntile - 1 < nw) attn_pv_pre(O, pf, v0, lds + ((ntile - 1) & 3) * STG + 16384, ql, hh);
        __syncthreads();
        const float l_tot = l_run + __shfl_xor(l_run, 32);
        const float inv = 1.0f / l_tot;
        float* xb = (float*)lds + rg * 4096;
        if (cmap == 1) {
            const float sc1 = lam * inv;
#pragma unroll
            for (int i = 0; i < 4; ++i)
#pragma unroll
                for (int r = 0; r < 16; ++r) xb[(i * 16 + r) * 64 + lane] = O[i][r] * sc1;
        }
        __syncthreads();
        if (cmap == 0) {
            float ss = 0.f;
#pragma unroll
            for (int i = 0; i < 4; ++i)
#pragma unroll
                for (int r = 0; r < 16; ++r) { const float o = O[i][r] * inv - xb[(i * 16 + r) * 64 + lane]; O[i][r] = o; ss += o * o; }
            ss += __shfl_xor(ss, 32);
            const float rn = rsqrtf(ss * (1.0f / 128.0f) + 1e-5f) * post;
            const float* subg_l = subg; asm volatile("" : "+s"(subg_l));
            bf16_t* zp = Z + ((size_t)(b * LP + q0 + ql)) * D_ + head * 128;
#pragma unroll
            for (int i = 0; i < 4; ++i)
#pragma unroll
                for (int g = 0; g < 4; ++g) {
                    const int dv = i * 32 + 8 * g + 4 * hh;
                    const f32x4 sg = *(const f32x4*)(subg_l + dv);
                    f32x4 o; o[0] = O[i][4 * g + 0] * rn * sg[0]; o[1] = O[i][4 * g + 1] * rn * sg[1]; o[2] = O[i][4 * g + 2] * rn * sg[2]; o[3] = O[i][4 * g + 3] * rn * sg[3];
                    st_bf4(zp + dv, o);
                }
        }
        __syncthreads();
    }
}

DI void phase_attn6(PP p, unsigned char* lds, int j) {
    if (__builtin_amdgcn_readfirstlane(threadIdx.x >> 8) == 0) attn6_body<false>(p, lds, j); else attn6_body<true>(p, lds, j);
}

typedef int i32x8 __attribute__((ext_vector_type(8)));
constexpr int STG9 = 16384;
#define MFMA_F8S(a, b, c, sa, sb) __builtin_amdgcn_mfma_scale_f32_32x32x64_f8f6f4(a, b, c, 0, 0, 0, sa, 0, sb)
DI i32x8 attn9_frag(const unsigned char* img, int blk, int ql, int hh) {
    const int f = (ql >> 2) & 3;
    const unsigned olo = (unsigned)(ql * 64 + (((2 * hh) ^ f) << 4)), ohi = (unsigned)(ql * 64 + (((2 * hh + 1) ^ f) << 4));
    const unsigned char* base = img + blk * 2048;
    const u32x4 lo = *(const u32x4*)(base + olo), hi = *(const u32x4*)(base + ohi);
    return (i32x8){(int)lo.x, (int)lo.y, (int)lo.z, (int)lo.w, (int)hi.x, (int)hi.y, (int)hi.z, (int)hi.w};
}
DI void attn9_qk(f32x16 (&sc)[2], const i32x8 (&kf)[2], const i32x8& qf, const f32x16& zc) {
    sc[0] = MFMA_F8S(kf[0], qf, zc, 0x7F7F7F7F, 0x7C7C7C7C);
    sc[1] = MFMA_F8S(kf[1], qf, zc, 0x7F7F7F7F, 0x7C7C7C7C);
}
DI void attn9_move(f32x16 (&sc)[2], f32x16 (&O)[4], f32x16& zc, float& m_run, float& l_run, bool all) {
    float mx = fmaxf(fmaxf(sc[0][0], sc[0][1]), sc[0][2]);
#pragma unroll
    for (int r = 3; r < 15; r += 2) mx = fmaxf(fmaxf(mx, sc[0][r]), sc[0][r + 1]);
    mx = fmaxf(mx, sc[0][15]);
#pragma unroll
    for (int r = 0; r < 16; r += 2) mx = fmaxf(fmaxf(mx, sc[1][r]), sc[1][r + 1]);
    mx = fmaxf(mx, __shfl_xor(mx, 32));
    const float delta = (all || mx > 8.0f) ? mx - 4.0f : 0.f;
    const float alpha = __builtin_amdgcn_exp2f(-delta);
    m_run += delta; l_run *= alpha;
#pragma unroll
    for (int i = 0; i < 4; ++i)
#pragma unroll
        for (int r = 0; r < 16; ++r) O[i][r] *= alpha;
#pragma unroll
    for (int kb = 0; kb < 2; ++kb)
#pragma unroll
        for (int r = 0; r < 16; ++r) sc[kb][r] -= delta;
    const float zi = 4.0f - m_run;
#pragma unroll
    for (int r = 0; r < 16; ++r) zc[r] = zi;
}
DI void attn9_sm(f32x16 (&sc)[2], i32x8& pf, f32x16 (&O)[4], f32x16& zc, float& m_run, float& l_run, int key0, int qq, bool diag, bool first, int hh) {
    if (diag) {
        float ninf = -INFINITY; asm volatile("" : "+s"(ninf));
#pragma unroll
        for (int kb = 0; kb < 2; ++kb)
#pragma unroll
            for (int r = 0; r < 16; ++r) { const int key = key0 + kb * 32 + crow32(r, hh); sc[kb][r] = key > qq ? ninf : sc[kb][r]; }
    }
    if (first) attn9_move(sc, O, zc, m_run, l_run, true);
    float ps0 = 0.f, ps1 = 0.f;
    float onef = 1.0f; asm volatile("" : "+s"(onef));
#pragma unroll
    for (int r = 0; r < 16; ++r) { const float e0 = __builtin_amdgcn_exp2f(sc[0][r]), e1 = __builtin_amdgcn_exp2f(sc[1][r]); sc[0][r] = e0; sc[1][r] = e1; ps0 += e0; ps1 = __builtin_fmaf(e1, onef, ps1); }
    float ps = ps0 + ps1;
    if (__any(ps > 448.0f)) {
#pragma unroll
        for (int kb = 0; kb < 2; ++kb)
#pragma unroll
            for (int r = 0; r < 16; ++r) sc[kb][r] = __builtin_amdgcn_logf(sc[kb][r]);
        attn9_move(sc, O, zc, m_run, l_run, false);
        ps0 = 0.f; ps1 = 0.f;
#pragma unroll
        for (int r = 0; r < 16; ++r) { const float e0 = __builtin_amdgcn_exp2f(sc[0][r]), e1 = __builtin_amdgcn_exp2f(sc[1][r]); sc[0][r] = e0; sc[1][r] = e1; ps0 += e0; ps1 += e1; }
        ps = ps0 + ps1;
    }
    l_run += ps;
#pragma unroll
    for (int w = 0; w < 8; ++w) {
        const int kb = w >> 2, r0 = 4 * (w & 3);
        pf[w] = __builtin_amdgcn_cvt_pk_fp8_f32(sc[kb][r0 + 2], sc[kb][r0 + 3], __builtin_amdgcn_cvt_pk_fp8_f32(sc[kb][r0 + 0], sc[kb][r0 + 1], pf[w], false), true);
    }
}
DI void attn9_pv(f32x16 (&O)[4], const i32x8& pf, const unsigned char* vst, int ql, int hh) {
    __builtin_amdgcn_s_setprio(1);
#pragma unroll
    for (int dvb = 0; dvb < 4; ++dvb) { const i32x8 vf = attn9_frag(vst, dvb, ql, hh); O[dvb] = MFMA_F8S(vf, pf, O[dvb], 0x7F7F7F7F, 0x7F7F7F7F); }
    __builtin_amdgcn_s_setprio(0);
}
DI void attn9_pv_pre(f32x16 (&O)[4], const i32x8& pf, const i32x8 (&v0)[2], const unsigned char* vst, int ql, int hh) {
    __builtin_amdgcn_s_setprio(1);
    O[0] = MFMA_F8S(v0[0], pf, O[0], 0x7F7F7F7F, 0x7F7F7F7F); O[1] = MFMA_F8S(v0[1], pf, O[1], 0x7F7F7F7F, 0x7F7F7F7F);
#pragma unroll
    for (int dvb = 2; dvb < 4; ++dvb) { const i32x8 vf = attn9_frag(vst, dvb, ql, hh); O[dvb] = MFMA_F8S(vf, pf, O[dvb], 0x7F7F7F7F, 0x7F7F7F7F); }
    __builtin_amdgcn_s_setprio(0);
}

template <bool SKEW>
DI void attn9_body(PP p, unsigned char* lds, int j) {
    const int tid = tid_(), lane = tid & 63, wid = __builtin_amdgcn_readfirstlane(tid >> 6), cmap = wid >> 2, rg = wid & 3, ql = lane & 31, hh = lane >> 5;
    constexpr bool skew = SKEW;
    const float lam_init = j == 0 ? (float)(0.8 - 0.6 * 0.5488116360940264) : (float)(0.8 - 0.6 * 0.4065696597405991);
    float d1 = 0.f, d2 = 0.f;
    for (int i = 0; i < 64; ++i) { d1 += p->in[I_LQ1][j * 64 + i] * p->in[I_LK1][j * 64 + i]; d2 += p->in[I_LQ2][j * 64 + i] * p->in[I_LK2][j * 64 + i]; }
    const float lam = __builtin_bit_cast(float, __builtin_amdgcn_readfirstlane(__builtin_bit_cast(int, __expf(d1) - __expf(d2) + lam_init)));
    const float post = 1.0f - lam_init;
    const unsigned char* Q8 = (const unsigned char*)SCR16(p, 0); const unsigned char* K8 = (const unsigned char*)KBUF(p); const unsigned char* Vt8 = (const unsigned char*)VTBUF(p);
    bf16_t* Z = SCR16(p, SCR_Z);
    const float* subg = p->in[I_SUBG] + j * 128;
    unsigned* ctr = CTRL(p) + CT_ATTNQ + 64 * j;
    unsigned* s_u = (unsigned*)(lds + 65536);
    constexpr int NQB = LP / 128;
    const int total = NB * 8 * NQB;
    for (;;) {
        if (tid == 0) *s_u = atomicAdd(ctr, 1u);
        __syncthreads();
        const int u = __builtin_amdgcn_readfirstlane((int)*s_u);
        __syncthreads();
        if (u >= total) break;
        const int qb = NQB - 1 - u / 16, bh = u & 15, b = bh >> 3, head = bh & 7;
        const int q0 = qb * 128 + rg * 32, qq = q0 + ql;
        i32x8 qf;
        {
            const unsigned char* qp = Q8 + (((size_t)(b * 16 + head * 2 + cmap)) * LP + q0 + ql) * 64 + 32 * hh;
            const u32x4 lo = *(const u32x4*)qp, hi = *(const u32x4*)(qp + 16);
            qf = (i32x8){(int)lo.x, (int)lo.y, (int)lo.z, (int)lo.w, (int)hi.x, (int)hi.y, (int)hi.z, (int)hi.w};
        }
        const unsigned char* kbase = K8 + (((size_t)(b * 16 + head * 2 + cmap)) * LP) * 64;
        const unsigned char* vbase = Vt8 + ((size_t)(b * 1024 + head * 128)) * LP;
        const int ntile = 2 * qb + 2;
        const int nw = ((q0 + 31) >> 6) + 1;
        f32x16 O[4];
#pragma unroll
        for (int i = 0; i < 4; ++i)
#pragma unroll
            for (int r = 0; r < 16; ++r) O[i][r] = 0.f;
        float m_run = 0.f, l_run = 0.f;
        f32x16 sc[2], zc;
#pragma unroll
        for (int r = 0; r < 16; ++r) zc[r] = 4.0f;
        i32x8 pf = (i32x8){0, 0, 0, 0, 0, 0, 0, 0};
        const int krow_ = rg * 16 + (lane >> 2), vrow_ = wid * 16 + (lane >> 2);
        unsigned kofs = (unsigned)(krow_ * 64 + (((lane & 3) ^ ((krow_ >> 2) & 3)) << 4)); unsigned vofs = (unsigned)(vrow_ * LP + (((lane & 3) ^ ((vrow_ >> 2) & 3)) << 4));
        auto stage_dma = [&](unsigned char* stg, int kt) {
            {
                asm volatile("" : "+v"(kofs));
                __builtin_amdgcn_global_load_lds((const unsigned*)(kbase + (size_t)kt * 4096 + kofs), (LAS unsigned*)(stg + cmap * 4096 + rg * 1024), 16, 0, 0);
            }
            {
                asm volatile("" : "+v"(vofs));
                __builtin_amdgcn_global_load_lds((const unsigned*)(vbase + (size_t)kt * 64 + vofs), (LAS unsigned*)(stg + 8192 + wid * 1024), 16, 0, 0);
            }
        };
        stage_dma(lds, 0);
        stage_dma(lds + STG9, 1);
        __syncthreads();
        i32x8 kf[2], v0[2];
        if (!skew) { kf[0] = attn9_frag(lds + cmap * 4096, 0, ql, hh); kf[1] = attn9_frag(lds + cmap * 4096, 1, ql, hh); }
        for (int kt = 0; kt < ntile; ++kt) {
            if (kt + 2 < ntile) stage_dma(lds + ((kt + 2) & 3) * STG9, kt + 2);
            const unsigned char* cur = lds + (kt & 3) * STG9;
            if (!skew) {
                if (kt < nw) {
                    attn9_qk(sc, kf, qf, zc);
                    attn9_sm(sc, pf, O, zc, m_run, l_run, kt * 64, qq, kt * 64 + 63 > q0, kt == 0, hh);
                    attn9_pv(O, pf, cur + 8192, ql, hh);
                    if (kt + 1 < nw) { const unsigned char* nk = lds + ((kt + 1) & 3) * STG9 + cmap * 4096; kf[0] = attn9_frag(nk, 0, ql, hh); kf[1] = attn9_frag(nk, 1, ql, hh); }
                }
            } else {
                if (kt >= 1 && kt - 1 < nw) attn9_pv_pre(O, pf, v0, lds + ((kt - 1) & 3) * STG9 + 8192, ql, hh);
                if (kt < nw) {
                    kf[0] = attn9_frag(cur + cmap * 4096, 0, ql, hh); kf[1] = attn9_frag(cur + cmap * 4096, 1, ql, hh);
                    attn9_qk(sc, kf, qf, zc);
                    attn9_sm(sc, pf, O, zc, m_run, l_run, kt * 64, qq, kt * 64 + 63 > q0, kt == 0, hh);
                    v0[0] = attn9_frag(cur + 8192, 0, ql, hh); v0[1] = attn9_frag(cur + 8192, 1, ql, hh);
                }
            }
            __syncthreads();
        }
        if (skew && ntile - 1 < nw) attn9_pv_pre(O, pf, v0, lds + ((ntile - 1) & 3) * STG9 + 8192, ql, hh);
        __syncthreads();
        const float l_tot = l_run + __shfl_xor(l_run, 32);
        const float inv = 1.0f / l_tot;
        float* xb = (float*)lds + rg * 4096;
        if (cmap == 1) {
            const float sc1 = lam * inv;
#pragma unroll
            for (int i = 0; i < 4; ++i)
#pragma unroll
                for (int r = 0; r < 16; ++r) xb[(i * 16 + r) * 64 + lane] = O[i][r] * sc1;
        }
        __syncthreads();
        if (cmap == 0) {
            float ss = 0.f;
#pragma unroll
            for (int i = 0; i < 4; ++i)
#pragma unroll
                for (int r = 0; r < 16; ++r) { const float o = O[i][r] * inv - xb[(i * 16 + r) * 64 + lane]; O[i][r] = o; ss += o * o; }
            ss += __shfl_xor(ss, 32);
            const float rn = rsqrtf(ss * (1.0f / 128.0f) + 1e-5f) * post;
            const float* subg_l = subg; asm volatile("" : "+s"(subg_l));
            bf16_t* zp = Z + ((size_t)(b * LP + q0 + ql)) * D_ + head * 128;
#pragma unroll
            for (int i = 0; i < 4; ++i)
#pragma unroll
                for (int g = 0; g < 4; ++g) {
                    const int dv = i * 32 + 8 * g + 4 * hh;
                    const f32x4 sg = *(const f32x4*)(subg_l + dv);
                    f32x4 o; o[0] = O[i][4 * g + 0] * rn * sg[0]; o[1] = O[i][4 * g + 1] * rn * sg[1]; o[2] = O[i][4 * g + 2] * rn * sg[2]; o[3] = O[i][4 * g + 3] * rn * sg[3];
                    st_bf4(zp + dv, o);
                }
        }
        __syncthreads();
    }
}
DI void phase_attn8(PP p, unsigned char* lds, int j) {
    if (__builtin_amdgcn_readfirstlane(threadIdx.x >> 8) == 0) attn9_body<false>(p, lds, j); else attn9_body<true>(p, lds, j);
}

DI int* TAB_IDX(PP p) { return (int*)(p->ws + OFF_TAB); }
DI float* TAB_GATE(PP p) { return (float*)(p->ws + OFF_TAB) + NSLOT; }
DI int* TAB_TOKSLOT(PP p) { return (int*)(p->ws + OFF_TAB) + 2 * NSLOT; }
DI int* TAB_SLOTTOK(PP p) { return (int*)(p->ws + OFF_TAB) + 3 * NSLOT; }
DI float* TAB_SLOTGATE(PP p) { return (float*)(p->ws + OFF_TAB) + 4 * NSLOT; }
DI int* TAB_TILES(PP p) { return (int*)(p->ws + OFF_TAB) + 5 * NSLOT; }


DI void router_gemm(unsigned char* lds, const bf16_t* __restrict__ A, const bf16_t* __restrict__ Bt, float* lg) {
    const int tid = tid_(), lane = tid & 63, wid = tid >> 6, fr = lane & 15, fq = lane >> 4, sw = (fr >> 1) & 7;
    u32x4 ra[8], rb[4];
    unsigned oa[8], ob[4]; const bf16_t* pa[8]; const bf16_t* pb[4];
#pragma unroll
    for (int i = 0; i < 8; ++i) { const int id = tid + NTHR * i, j = id >> 10, row = (id & 1023) >> 3, c = id & 7; pa[i] = A + (size_t)row * D_ + j * 64 + c * 8; oa[i] = (unsigned)(j * 16384 + row * 128 + ((c ^ ((row >> 1) & 7)) << 4)); }
#pragma unroll
    for (int i = 0; i < 4; ++i) { const int id = tid + NTHR * i, j = id >> 9, row = (id & 511) >> 3, c = id & 7; pb[i] = Bt + (size_t)row * D_ + j * 64 + c * 8; ob[i] = (unsigned)(65536 + j * 8192 + row * 128 + ((c ^ ((row >> 1) & 7)) << 4)); }
    f32x4 acc[4];
#pragma unroll
    for (int ni = 0; ni < 4; ++ni) acc[ni] = (f32x4){0.f, 0.f, 0.f, 0.f};
#pragma unroll
    for (int i = 0; i < 8; ++i) ra[i] = *(const u32x4*)pa[i];
#pragma unroll
    for (int i = 0; i < 4; ++i) rb[i] = *(const u32x4*)pb[i];
#pragma unroll
    for (int i = 0; i < 8; ++i) *(u32x4*)(lds + oa[i]) = ra[i];
#pragma unroll
    for (int i = 0; i < 4; ++i) *(u32x4*)(lds + ob[i]) = rb[i];
    __syncthreads();
    for (int ck = 0; ck < 4; ++ck) {
        if (ck < 3) {
#pragma unroll
            for (int i = 0; i < 8; ++i) ra[i] = *(const u32x4*)(pa[i] + (ck + 1) * 256);
#pragma unroll
            for (int i = 0; i < 4; ++i) rb[i] = *(const u32x4*)(pb[i] + (ck + 1) * 256);
        }
#pragma unroll
        for (int j = 0; j < 4; ++j)
#pragma unroll
            for (int ks = 0; ks < 2; ++ks) {
                const int ch = ((ks * 4 + fq) ^ sw) << 4;
                const bf16x8 af = *(const bf16x8*)(lds + j * 16384 + (wid * 16 + fr) * 128 + ch);
#pragma unroll
                for (int ni = 0; ni < 4; ++ni) {
                    const bf16x8 bfr = *(const bf16x8*)(lds + 65536 + j * 8192 + (ni * 16 + fr) * 128 + ch);
                    acc[ni] = __builtin_amdgcn_mfma_f32_16x16x32_bf16(bfr, af, acc[ni], 0, 0, 0);
                }
            }
        __syncthreads();
        if (ck < 3) {
#pragma unroll
            for (int i = 0; i < 8; ++i) *(u32x4*)(lds + oa[i]) = ra[i];
#pragma unroll
            for (int i = 0; i < 4; ++i) *(u32x4*)(lds + ob[i]) = rb[i];
            __syncthreads();
        }
    }
#pragma unroll
    for (int ni = 0; ni < 4; ++ni) { float* d = lg + (wid * 16 + fr) * 65 + ni * 16 + 4 * fq; d[0] = acc[ni][0]; d[1] = acc[ni][1]; d[2] = acc[ni][2]; d[3] = acc[ni][3]; }
}

DI void router_gemm144(unsigned char* lds, const bf16_t* __restrict__ A, const bf16_t* __restrict__ Bt, float* lg) {
    const int tid = tid_(), lane = tid & 63, wid = __builtin_amdgcn_readfirstlane(tid >> 6), fr = lane & 15, fq = lane >> 4, sw = (fr >> 1) & 7;
    u32x4 ra[9], rb[4];
    unsigned oa[9], ob[4]; const bf16_t* pa[9]; const bf16_t* pb[4];
#pragma unroll
    for (int i = 0; i < 9; ++i) { const int id = tid + NTHR * i, j = id / 1152, rem = id - j * 1152, row = rem >> 3, c = rem & 7; pa[i] = A + (size_t)row * D_ + j * 64 + c * 8; oa[i] = (unsigned)(j * 18432 + row * 128 + ((c ^ ((row >> 1) & 7)) << 4)); }
#pragma unroll
    for (int i = 0; i < 4; ++i) { const int id = tid + NTHR * i, j = id >> 9, row = (id & 511) >> 3, c = id & 7; pb[i] = Bt + (size_t)row * D_ + j * 64 + c * 8; ob[i] = (unsigned)(73728 + j * 8192 + row * 128 + ((c ^ ((row >> 1) & 7)) << 4)); }
    f32x4 acc[4], acc9 = (f32x4){0.f, 0.f, 0.f, 0.f};
#pragma unroll
    for (int ni = 0; ni < 4; ++ni) acc[ni] = (f32x4){0.f, 0.f, 0.f, 0.f};
#pragma unroll
    for (int i = 0; i < 9; ++i) ra[i] = *(const u32x4*)pa[i];
#pragma unroll
    for (int i = 0; i < 4; ++i) rb[i] = *(const u32x4*)pb[i];
#pragma unroll
    for (int i = 0; i < 9; ++i) *(u32x4*)(lds + oa[i]) = ra[i];
#pragma unroll
    for (int i = 0; i < 4; ++i) *(u32x4*)(lds + ob[i]) = rb[i];
    __syncthreads();
    for (int ck = 0; ck < 4; ++ck) {
        if (ck < 3) {
#pragma unroll
            for (int i = 0; i < 9; ++i) ra[i] = *(const u32x4*)(pa[i] + (ck + 1) * 256);
#pragma unroll
            for (int i = 0; i < 4; ++i) rb[i] = *(const u32x4*)(pb[i] + (ck + 1) * 256);
        }
#pragma unroll
        for (int j = 0; j < 4; ++j)
#pragma unroll
            for (int ks = 0; ks < 2; ++ks) {
                const int ch = ((ks * 4 + fq) ^ sw) << 4;
                const bf16x8 af = *(const bf16x8*)(lds + j * 18432 + (wid * 16 + fr) * 128 + ch);
#pragma unroll
                for (int ni = 0; ni < 4; ++ni) {
                    const bf16x8 bfr = *(const bf16x8*)(lds + 73728 + j * 8192 + (ni * 16 + fr) * 128 + ch);
                    acc[ni] = __builtin_amdgcn_mfma_f32_16x16x32_bf16(bfr, af, acc[ni], 0, 0, 0);
                }
                if (wid < 4) {
                    const bf16x8 af9 = *(const bf16x8*)(lds + j * 18432 + (128 + fr) * 128 + ch);
                    const bf16x8 bf9 = *(const bf16x8*)(lds + 73728 + j * 8192 + (wid * 16 + fr) * 128 + ch);
                    acc9 = __builtin_amdgcn_mfma_f32_16x16x32_bf16(bf9, af9, acc9, 0, 0, 0);
                }
            }
        __syncthreads();
        if (ck < 3) {
#pragma unroll
            for (int i = 0; i < 9; ++i) *(u32x4*)(lds + oa[i]) = ra[i];
#pragma unroll
            for (int i = 0; i < 4; ++i) *(u32x4*)(lds + ob[i]) = rb[i];
            __syncthreads();
        }
    }
#pragma unroll
    for (int ni = 0; ni < 4; ++ni) { float* d = lg + (wid * 16 + fr) * 65 + ni * 16 + 4 * fq; d[0] = acc[ni][0]; d[1] = acc[ni][1]; d[2] = acc[ni][2]; d[3] = acc[ni][3]; }
    if (wid < 4) { float* d = lg + (128 + fr) * 65 + wid * 16 + 4 * fq; d[0] = acc9[0]; d[1] = acc9[1]; d[2] = acc9[2]; d[3] = acc9[3]; }
}


DI void phase_router(PP p, unsigned char* lds, int l) {
    float* lg = (float*)(lds + 106496);
    unsigned* hist = (unsigned*)(lds + 106496 + 144 * 65 * 4);
    const int tid = tid_(), lane = tid & 63, wid = tid >> 6;
    if (tid < 64) hist[tid] = 0u;
    __syncthreads();
    const float bias = p->in[I_RTB][l * NE + lane];
    int* idx = TAB_IDX(p); float* gt = TAB_GATE(p);
    constexpr int TPB = (LSEQ + 143) / 144;
    for (int mt = blockIdx.x; mt < NB * TPB; mt += gridDim.x) {
        const int b = mt / TPB, t0 = (mt - b * TPB) * 144;
        router_gemm144(lds, H16(p) + (size_t)(b * LP + t0) * D_, WS_RT(p), lg);
        __syncthreads();
        for (int rr = 0; rr < 18; ++rr) {
            const int r = wid * 18 + rr, t = t0 + r;
            if (t >= LSEQ) continue;
            const int n = b * LSEQ + t;
            const float s = sigmoidf_(lg[r * 65 + lane]);
            const float sel = s + bias;
            const float m1 = red8_max(sel);
            const unsigned long long eq = __ballot(sel == m1);
            const unsigned gb = (unsigned)(eq >> ((lane >> 3) * 8)) & 0xffu;
            const int first = __builtin_ctz(gb | 0x100u);
            const float sel2 = (lane & 7) == first ? -INFINITY : sel;
            const float gs = m1 + red8_max(sel2);
            int rank = 0;
#pragma unroll
            for (int g = 0; g < 8; ++g) { const float o = rdlane(gs, g * 8); rank += (o > gs || (o == gs && g < (lane >> 3))) ? 1 : 0; }
            float cur = rank < 4 ? sel : -INFINITY;
            float wsum = 0.f, my_s = 0.f; int my_i = 0;
#pragma unroll
            for (int k = 0; k < 8; ++k) {
                const float m = wave_max(cur);
                const unsigned long long bal = __ballot(cur == m);
                const int win = __builtin_ctzll(bal | (1ull << 63));
                const float swv = rdlane(s, win);
                wsum += swv;
                if (lane == k) { my_i = win; my_s = swv; }
                if (lane == win) cur = -INFINITY;
            }
            if (lane < 8) {
                idx[n * 8 + lane] = my_i; gt[n * 8 + lane] = my_s / wsum * 2.5f;
                atomicAdd(hist + my_i, 1u);
            }
        }
        __syncthreads();
    }
    __syncthreads();
    if (tid < 64 && hist[tid]) atomicAdd(CTRL(p) + CT_CNT + 64 * l + tid, (unsigned)hist[tid]);
}

DI void phase_scatter(PP p, unsigned char* lds, int l) {
    unsigned* cnt = (unsigned*)lds; unsigned* lh = cnt + 64; unsigned* lbase = lh + 64; unsigned* lcur = lbase + 64; unsigned* start = lcur + 64;
    const int tid = tid_();
    unsigned* gc = CTRL(p) + CT_CNT + 64 * l; unsigned* gcur = CTRL(p) + CT_CUR + 64 * l;
    if (tid < 64) { cnt[tid] = __hip_atomic_load(gc + tid, __ATOMIC_RELAXED, __HIP_MEMORY_SCOPE_AGENT); lh[tid] = 0u; lcur[tid] = 0u; }
    __syncthreads();
    if (tid < 64) { unsigned s = 0; for (int e = 0; e < tid; ++e) s += cnt[e]; start[tid] = s; }
    const int per = (NTOK + gridDim.x - 1) / gridDim.x;
    const int n0 = blockIdx.x * per, n1 = n0 + per < NTOK ? n0 + per : NTOK;
    const int* idx = TAB_IDX(p); const float* gt = TAB_GATE(p);
    int* tok_slot = TAB_TOKSLOT(p); int* slot_tok = TAB_SLOTTOK(p); float* slot_gate = TAB_SLOTGATE(p);
    __syncthreads();
    for (int i = n0 * 8 + tid; i < n1 * 8; i += NTHR) atomicAdd(lh + idx[i], 1u);
    __syncthreads();
    if (tid < 64) lbase[tid] = start[tid] + (lh[tid] ? atomicAdd(gcur + tid, (unsigned)lh[tid]) : 0u);
    __syncthreads();
    for (int i = n0 * 8 + tid; i < n1 * 8; i += NTHR) {
        const int e = idx[i], n = i >> 3;
        const unsigned pos = lbase[e] + atomicAdd(lcur + e, 1u);
        const int b = n >= LSEQ ? 1 : 0, t = n - b * LSEQ;
        slot_tok[pos] = b * LP + t; slot_gate[pos] = gt[i]; tok_slot[i] = (int)pos;
    }
    if (blockIdx.x == 0 && tid < 64) {
        unsigned tb = 0; for (int e = 0; e < tid; ++e) tb += (cnt[e] + 255) >> 8;
        const unsigned nt = (cnt[tid] + 255) >> 8;
        int* tiles = TAB_TILES(p);
        for (unsigned i = 0; i < nt; ++i) { int* tp = tiles + (tb + i) * 4; tp[0] = tid; tp[1] = (int)(start[tid] + 256 * i); const int rem = (int)cnt[tid] - 256 * (int)i; tp[2] = rem < 256 ? rem : 256; tp[3] = 0; }
        if (tid == 63) CTRL(p)[CT_NT + l] = tb + nt;
    }
}


constexpr int MT8 = 128;
DI bf16_t* r1_dst(bf16_t* r, bf16_t* v, bf16_t* lo1, int n4) {
    bf16_t* d = r + (size_t)n4 * (SZ_ACT16 / 2); if (n4 == 2) d = v; if (n4 >= 3) d = lo1; return d; }
DI bool xcd_order(int i, int nN, int& mt, int& nt) {
    const int G = gridDim.x, b = blockIdx.x;
    if ((G & 7) == 0) {
        const int x = b & 7, per = G >> 3, li = i * per + (b >> 3), ml = li / nN;
        if (ml >= MT8 / 8) return false;
        mt = ml * 8 + x; nt = li - ml * nN; return true;
    }
    const long L = (long)i * G + b; if (L >= (long)MT8 * nN) return false;
    mt = (int)(L / nN); nt = (int)(L - (long)mt * nN); return true;
}
struct EpiR1Q { bf16_t* r; bf16_t* v; bf16_t* lo1;
    DI void apply(const f32x4 (&acc)[2][2][4][2], const g8::Unit& u, int wr, int wc, int fr, int fq) const {
        const int n4 = u.n0 >> 10, col = u.n0 + 64 * wc + 16 * fq;
        bf16_t* dst = r1_dst(r, v, lo1, n4);
        if (n4 >= 3 && col >= 3456) return;
        const int c = col - 3072;
        const int act = n4 < 3 ? 0 : (c < 64 ? 1 : ((c >= 128 && c < 288) ? 2 : (((c >= 288 && c < 320) || c >= 352) ? 3 : 0)));
#pragma unroll
        for (int ai = 0; ai < 2; ++ai)
#pragma unroll
            for (int m = 0; m < 4; ++m) {
                const int prow = u.m0 + 128 * ai + 64 * wr + 16 * m + fr;
                bf16_t* d = n4 < 3 ? dst + hm_off(prow, col & 1023) : dst + (size_t)prow * LO1_W + c;
#pragma unroll
                for (int bj = 0; bj < 2; ++bj) {
                    f32x4 v0 = acc[ai][bj][m][0], v1 = acc[ai][bj][m][1];
                    if (act == 1) {
#pragma unroll
                        for (int i = 0; i < 4; ++i) { v0[i] = tanhf_(v0[i]); v1[i] = tanhf_(v1[i]); }
                    } else if (act == 2) {
#pragma unroll
                        for (int i = 0; i < 4; ++i) { v0[i] = sigmoidf_(v0[i]); v1[i] = sigmoidf_(v1[i]); }
                    } else if (act == 3) { v0 = (f32x4){0.f, 0.f, 0.f, 0.f}; v1 = v0; }
                    u32x4 w; w.x = cvt_pk_bf16(v0[0], v0[1]); w.y = cvt_pk_bf16(v0[2], v0[3]); w.z = cvt_pk_bf16(v1[0], v1[1]); w.w = cvt_pk_bf16(v1[2], v1[3]);
                    *(u32x4*)(d + 8 * bj) = w;
                }
            }
    } };
struct SchedR1 { const char* ab; const bf16_t* bt; int tid;
    DI bool next(int i, g8::Unit& u) const {
        int mt, nt; if (!xcd_order(i, 14, mt, nt)) return false;
        u.m0 = mt * 256; u.n0 = nt * 256; u.ab = ab + (size_t)u.m0 * D_; u.bb = (const char*)bt + (size_t)(nt * 256) * 2048;
        u.ao[0] = 0; u.ao[1] = 0; u.ag[0] = 0; u.ag[1] = 0; u.x0 = 0; u.x1 = 0; u.x2 = 0; return true; } };
DI void phase_r1(PP p, unsigned char* lds, int l) {
    EpiR1Q eq; eq.r = SCR16(p, SCR_R); eq.v = l == 0 ? VFIRST(p) : SCR16(p, SCR_V); eq.lo1 = SCR16(p, SCR_LO1);
    SchedR1 sc; sc.ab = (const char*)(H8BUF(p) - D_); sc.bt = WL_BIG(p); sc.tid = tid_();
    g8::gemm8<true, 0, EpiR1Q, SchedR1, true, true, 0x7F7F7F7F, 0x7A7A7A7A>(lds, 1024, 128, D_, sc, eq);
    EpiR1 e;
    for (int u = blockIdx.x; u < 2 * 56; u += gridDim.x) {
        const int ms = u / 56, nt = u - ms * 56;
        e.m0 = MT8 * 256 + ms * 128; e.n0 = nt * 64; const int n4 = nt >> 2;
        e.kind = n4 < 12 ? 0 : 1; e.dst = r1_dst(eq.r, eq.v, eq.lo1, n4 >> 2);
        APlain a; a.base = (const bf16_t*)(H8BUF(p) + (size_t)e.m0 * D_ - D_); a.ld = D_ / 2;
        gemm_tile<128, 64, 16, 64, true, true, 0x7F7F7F7F, 0x7A7A7A7A>(lds, a, (const bf16_t*)((const unsigned char*)WL_BIG(p) + (size_t)(nt * 64) * 2048), 1024, 1024, e);
    }
}

struct EpiMixQ { bf16_t* mix;
    DI void apply(const f32x4 (&acc)[2][2][4][2], const g8::Unit& u, int wr, int wc, int fr, int fq) const {
        bf16_t* dst = mix + (size_t)u.m0 * D_ + u.n0 + 64 * wc + 16 * fq;
#pragma unroll
        for (int ai = 0; ai < 2; ++ai)
#pragma unroll
            for (int m = 0; m < 4; ++m) {
                const int r = 128 * ai + 64 * wr + 16 * m + fr;
#pragma unroll
                for (int bj = 0; bj < 2; ++bj) {
                    const f32x4 v0 = acc[ai][bj][m][0], v1 = acc[ai][bj][m][1];
                    u32x4 w; w.x = cvt_pk_bf16(v0[0], v0[1]); w.y = cvt_pk_bf16(v0[2], v0[3]); w.z = cvt_pk_bf16(v1[0], v1[1]); w.w = cvt_pk_bf16(v1[2], v1[3]);
                    *(u32x4*)(dst + (size_t)r * D_ + 8 * bj) = w;
                }
            }
    } };
struct SchedOut { const char* ab; const bf16_t* bt; int tid; bool hm;
    DI bool next(int i, g8::Unit& u) const {
        int mt, nt; if (!xcd_order(i, 4, mt, nt)) return false;
        u.m0 = mt * 256; u.n0 = nt * 256; u.ab = ab; u.bb = (const char*)(bt + (size_t)(nt * 256) * D_);
#pragma unroll
        for (int j = 0; j < 2; ++j) { int R, C; g8::piece_rc(tid, j, R, C);
#pragma unroll
            for (int h = 0; h < 2; ++h) {
                const int prow = u.m0 + 128 * h + R; unsigned o;
                if (hm) { const int b = prow >= LP ? 1 : 0, t = prow - b * LP; o = (unsigned)((((b * 16) * LP + t) * 64 + C) * 2); }
                else o = (unsigned)((prow * D_ + C) * 2);
                if (h) u.ag[j] = o; else u.ao[j] = o;
            } }
        u.x0 = 0; u.x1 = 0; u.x2 = 0; return true; } };
DI void phase_outproj(PP p, unsigned char* lds, bool hm) {
    EpiMixQ eq; eq.mix = SCR16(p, SCR_R);
    SchedOut sc; sc.ab = (const char*)SCR16(p, SCR_Z); sc.bt = WL_OUT(p); sc.hm = hm; sc.tid = tid_();
    g8::gemm8<true, true, EpiMixQ, SchedOut, true>(lds, D_, hm ? (size_t)LP * 128 : (size_t)128, 0, sc, eq);
    EpiMix e; e.dst = SCR16(p, SCR_R);
    for (int u = blockIdx.x; u < 2 * 16; u += gridDim.x) {
        const int ms = u >> 4, nt = u & 15;
        e.m0 = MT8 * 256 + ms * 128; e.n0 = nt * 64;
        APlain a;
        if (hm) { const int b = e.m0 >= LP ? 1 : 0, t0 = e.m0 - b * LP; a.base = SCR16(p, SCR_Z) + ((size_t)(b * 16) * LP + t0) * 64; a.ld = 64; }
        else { a.base = SCR16(p, SCR_Z) + (size_t)e.m0 * D_; a.ld = D_; }
        gemm_tile<128, 64, 16, 64, true>(lds, a, WL_OUT(p) + (size_t)(nt * 64) * D_, D_, D_, e, hm ? (size_t)LP * 64 : (size_t)64);
    }
}

struct EpiQKQ { bf16_t* q; bf16_t* k;
    DI void apply(const f32x4 (&acc)[2][2][4][2], const g8::Unit& u, int wr, int wc, int fr, int fq) const {
        unsigned char* dst = (unsigned char*)(u.x0 ? k : q); const float scale = u.x0 ? 1.0f : 1.4426950408889634f;
        const int col = u.n0 + 64 * wc + 16 * fq;
#pragma unroll
        for (int ai = 0; ai < 2; ++ai)
#pragma unroll
            for (int m = 0; m < 4; ++m) {
                const int prow = u.m0 + 128 * ai + 64 * wr + 16 * m + fr;
                const int b = prow >= LP ? 1 : 0, t = prow - b * LP;
                unsigned char* d = dst + (((size_t)(b * 16 + (col >> 6))) * LP + t) * 64 + (col & 63);
                const f32x4 a0 = acc[ai][0][m][0] * scale, a1 = acc[ai][0][m][1] * scale, b0 = acc[ai][1][m][0] * scale, b1 = acc[ai][1][m][1] * scale;
                u32x4 w;
                w.x = (unsigned)__builtin_amdgcn_cvt_pk_fp8_f32(a0[2], a0[3], __builtin_amdgcn_cvt_pk_fp8_f32(a0[0], a0[1], 0, false), true);
                w.y = (unsigned)__builtin_amdgcn_cvt_pk_fp8_f32(a1[2], a1[3], __builtin_amdgcn_cvt_pk_fp8_f32(a1[0], a1[1], 0, false), true);
                w.z = (unsigned)__builtin_amdgcn_cvt_pk_fp8_f32(b0[2], b0[3], __builtin_amdgcn_cvt_pk_fp8_f32(b0[0], b0[1], 0, false), true);
                w.w = (unsigned)__builtin_amdgcn_cvt_pk_fp8_f32(b1[2], b1[3], __builtin_amdgcn_cvt_pk_fp8_f32(b1[0], b1[1], 0, false), true);
                *(u32x4*)d = w;
            }
    } };
struct EpiVtQ { bf16_t* vt;
    DI void apply(const f32x4 (&acc)[2][2][4][2], const g8::Unit& u, int wr, int wc, int fr, int fq) const {
        EpiVt8 e; e.m0 = u.m0; e.n0 = u.n0; e.dst = (unsigned char*)vt; g8::quad_epi(e, acc, wr, wc, fr, fq); } };
struct SchedQKV { const char* ab; const bf16_t* wq; const bf16_t* wkv; int tid; int nwhich; bool vpart;
    DI bool next(int i, g8::Unit& u) const {
        int mt, nn; if (!xcd_order(i, 4 * nwhich, mt, nn)) return false;
        const int which = nn >> 2, nt = nn & 3;
        u.m0 = mt * 256; u.n0 = nt * 256; u.ab = ab + (size_t)u.m0 * D_; u.x0 = which;
        const bf16_t* bt = vpart ? wkv + (size_t)(1024 + nt * 256) * (D_ / 2) : (which ? wkv + (size_t)(nt * 256) * (D_ / 2) : wq + (size_t)(nt * 256) * (D_ / 2));
        u.bb = (const char*)bt; u.ao[0] = 0; u.ao[1] = 0; u.ag[0] = 0; u.ag[1] = 0;
        u.x1 = 0; u.x2 = 0; return true; } };
DI void phase_qkv(PP p, unsigned char* lds, int l) {
    SchedQKV sc; sc.ab = (const char*)H8BUF(p); sc.wq = WL_WQ(p); sc.wkv = WL_BIG(p); sc.tid = tid_();
    { EpiQKQ eq; eq.q = SCR16(p, 0); eq.k = KBUF(p); sc.nwhich = l == 2 ? 2 : 1; sc.vpart = false; g8::gemm8<true, 0, EpiQKQ, SchedQKV, true, true, 0x7F7F7F7F, 0x7A7A7A7A>(lds, D_ / 2, 128, D_, sc, eq); }
    if (l == 2) { EpiVtQ ev; ev.vt = VTBUF(p); sc.nwhich = 1; sc.vpart = true; g8::gemm8<false, 0, EpiVtQ, SchedQKV, false, true, 0x7F7F7F7F, 0x7A7A7A7A>(lds, D_ / 2, 128, D_, sc, ev); }
    const int nsu = l == 2 ? 3 * 32 : 32;
    for (int u = blockIdx.x; u < nsu; u += gridDim.x) {
        const int which = u >> 5, r = u & 31, ms = r >> 4, nt = r & 15;
        const int m0 = MT8 * 256 + ms * 128;
        APlain a; a.base = (const bf16_t*)(H8BUF(p) + (size_t)m0 * D_); a.ld = D_ / 2;
        if (which < 2) {
            EpiQK8 e; e.m0 = m0; e.n0 = nt * 64; e.dst = (unsigned char*)(which ? KBUF(p) : SCR16(p, 0)); e.scale = which ? 1.0f : 1.4426950408889634f;
            gemm_tile<128, 64, 16, 64, true, true, 0x7F7F7F7F, 0x7A7A7A7A>(lds, a, (which ? WL_BIG(p) : WL_WQ(p)) + (size_t)(nt * 64) * (D_ / 2), D_ / 2, D_ / 2, e);
        } else {
            EpiVt8 e; e.m0 = m0; e.n0 = nt * 64; e.dst = (unsigned char*)VTBUF(p);
            gemm_tile<128, 64, 16, 64, false, true, 0x7F7F7F7F, 0x7A7A7A7A>(lds, a, WL_BIG(p) + (size_t)(1024 + nt * 64) * (D_ / 2), D_ / 2, D_ / 2, e);
        }
    }
}

struct EpiM1Q { unsigned char* h; unsigned char* hs; const float* gate;
    DI void apply(const f32x4 (&acc)[2][2][4][2], const g8::Unit& u, int wr, int wc, int fr, int fq) const {
        EpiM1 e; e.n0 = u.n0; e.row0 = u.x0; e.nrows = u.x1; e.dst = u.x2 ? hs : h; e.gate = u.x2 ? nullptr : gate; g8::quad_epi(e, acc, wr, wc, fr, fq); } };
constexpr int MTS = NP / 256;
struct SchedM1 { const char* ab; const unsigned char* wm; const unsigned char* wsh; const int* tiles; const int* slot_tok; int T; int tid_unused;
    DI bool next(int i, g8::Unit& u) const {
        int tid = (int)threadIdx.x; asm volatile("" : "+v"(tid));
        int tile, half;
        if ((gridDim.x & 7) == 0) { const int li = i * (int)(gridDim.x >> 3) + (int)(blockIdx.x >> 3); tile = 8 * (li >> 1) + (int)(blockIdx.x & 7); half = li & 1; if (tile >= T + MTS) return false; }
        else { const long L = (long)i * gridDim.x + blockIdx.x; if (L >= (long)(T + MTS) * 2) return false; tile = (int)L >> 1; half = (int)L & 1; }
        u.ab = ab; u.n0 = half * 256; u.m0 = 0;
        if (tile < T) {
            const int ex = __builtin_amdgcn_readfirstlane(tiles[tile * 4]), s0 = __builtin_amdgcn_readfirstlane(tiles[tile * 4 + 1]), nr = __builtin_amdgcn_readfirstlane(tiles[tile * 4 + 2]);
            u.x0 = s0; u.x1 = nr; u.x2 = 0; u.bb = (const char*)(wm + ((size_t)ex * 512 + half * 256) * D_);
#pragma unroll
            for (int j = 0; j < 2; ++j) { int R, C; g8::piece_rc(tid, j, R, C);
                int r0 = R < nr ? R : nr - 1, r1 = 128 + R < nr ? 128 + R : nr - 1;
                u.ao[j] = (unsigned)slot_tok[s0 + r0] | ((unsigned)slot_tok[s0 + r1] << 16); u.ag[j] = 0; (void)C; }
        } else {
            const int mt = tile - T;
            u.x0 = mt * 256; u.x1 = 256; u.x2 = 1; u.bb = (const char*)(wsh + (size_t)(half * 256) * D_);
#pragma unroll
            for (int j = 0; j < 2; ++j) { int R, C; g8::piece_rc(tid, j, R, C);
                u.ao[j] = (unsigned)(mt * 256 + R) | ((unsigned)(mt * 256 + 128 + R) << 16); u.ag[j] = 0; (void)C; }
        }
        return true; } };
DI void phase_m1(PP p, unsigned char* lds, int l) {
    EpiM1Q eq; eq.h = (unsigned char*)SCR16(p, SCR_H); eq.hs = (unsigned char*)SCR16(p, SCR_HS); eq.gate = TAB_SLOTGATE(p);
    SchedM1 sc; sc.ab = (const char*)H8BUF(p); sc.wm = (const unsigned char*)WM_GU(p); sc.wsh = (const unsigned char*)WS_GU(p); sc.tiles = TAB_TILES(p); sc.slot_tok = TAB_SLOTTOK(p); sc.T = (int)CTRL(p)[CT_NT + l]; sc.tid_unused = 0;
    g8::gemm8<true, 2, EpiM1Q, SchedM1, false, true, 0x7F7F7F7F, 0x7A7A7A7A>(lds, D_ / 2, 128, 0, sc, eq);
}

struct EpiM2Q { unsigned char* y8; bf16_t* ysh;
    DI void apply(const f32x4 (&acc)[2][2][4][2], const g8::Unit& u, int wr, int wc, int fr, int fq) const {
        const int colb = u.n0 + 64 * wc + 16 * fq;
#pragma unroll
        for (int ai = 0; ai < 2; ++ai)
#pragma unroll
            for (int m = 0; m < 4; ++m) {
                const int r = 128 * ai + 64 * wr + 16 * m + fr;
                if (r < u.x1) {
                    const f32x4 a0 = acc[ai][0][m][0], a1 = acc[ai][0][m][1], b0 = acc[ai][1][m][0], b1 = acc[ai][1][m][1];
                    if (u.x2) {
                        bf16_t* d = ysh + (size_t)(u.x0 + r) * D_ + colb;
                        u32x4 w; w.x = cvt_pk_bf16(a0[0], a0[1]); w.y = cvt_pk_bf16(a0[2], a0[3]); w.z = cvt_pk_bf16(a1[0], a1[1]); w.w = cvt_pk_bf16(a1[2], a1[3]);
                        *(u32x4*)d = w;
                        w.x = cvt_pk_bf16(b0[0], b0[1]); w.y = cvt_pk_bf16(b0[2], b0[3]); w.z = cvt_pk_bf16(b1[0], b1[1]); w.w = cvt_pk_bf16(b1[2], b1[3]);
                        *(u32x4*)(d + 8) = w;
                    } else {
                        u32x4 w;
                        w.x = (unsigned)__builtin_amdgcn_cvt_pk_fp8_f32(a0[2] * 16.f, a0[3] * 16.f, __builtin_amdgcn_cvt_pk_fp8_f32(a0[0] * 16.f, a0[1] * 16.f, 0, false), true);
                        w.y = (unsigned)__builtin_amdgcn_cvt_pk_fp8_f32(a1[2] * 16.f, a1[3] * 16.f, __builtin_amdgcn_cvt_pk_fp8_f32(a1[0] * 16.f, a1[1] * 16.f, 0, false), true);
                        w.z = (unsigned)__builtin_amdgcn_cvt_pk_fp8_f32(b0[2] * 16.f, b0[3] * 16.f, __builtin_amdgcn_cvt_pk_fp8_f32(b0[0] * 16.f, b0[1] * 16.f, 0, false), true);
                        w.w = (unsigned)__builtin_amdgcn_cvt_pk_fp8_f32(b1[2] * 16.f, b1[3] * 16.f, __builtin_amdgcn_cvt_pk_fp8_f32(b1[0] * 16.f, b1[1] * 16.f, 0, false), true);
                        *(u32x4*)(y8 + (size_t)(u.x0 + r) * D_ + colb) = w;
                    }
                }
            }
    } };
struct SchedM2 { const char* ah; const char* ahs; const unsigned char* wm; const unsigned char* wsh; const int* tiles; int T; int tid;
    DI bool next(int i, g8::Unit& u) const {
        int tile, nq;
        if ((gridDim.x & 7) == 0) { const int li = i * (int)(gridDim.x >> 3) + (int)(blockIdx.x >> 3); tile = 8 * (li >> 2) + (int)(blockIdx.x & 7); nq = li & 3; if (tile >= T + MTS) return false; }
        else { const long L = (long)i * gridDim.x + blockIdx.x; if (L >= (long)(T + MTS) * 4) return false; tile = (int)L >> 2; nq = (int)L & 3; }
        u.n0 = nq * 256; u.m0 = 0;
        if (tile < T) {
            const int ex = __builtin_amdgcn_readfirstlane(tiles[tile * 4]), s0 = __builtin_amdgcn_readfirstlane(tiles[tile * 4 + 1]), nr = __builtin_amdgcn_readfirstlane(tiles[tile * 4 + 2]);
            u.x0 = s0; u.x1 = nr; u.x2 = 0; u.bb = (const char*)(wm + ((size_t)ex * 1024 + nq * 256) * FF);
            u.ab = ah + (size_t)s0 * FF;
        } else {
            const int mt = tile - T;
            u.ab = ahs + (size_t)(mt * 256) * FF; u.x0 = mt * 256; u.x1 = 256; u.x2 = 1; u.bb = (const char*)(wsh + (size_t)(nq * 256) * FF);
        }
        u.ao[0] = 0; u.ao[1] = 0; u.ag[0] = 0; u.ag[1] = 0; return true; } };
DI void phase_m2(PP p, unsigned char* lds, int l) {
    EpiM2Q eq; eq.y8 = (unsigned char*)SCR16(p, SCR_Y); eq.ysh = SCR16(p, SCR_YSH);
    SchedM2 sc; sc.ah = (const char*)SCR16(p, SCR_H); sc.ahs = (const char*)SCR16(p, SCR_HS); sc.wm = (const unsigned char*)WM_DN(p); sc.wsh = (const unsigned char*)WS_DN(p); sc.tiles = TAB_TILES(p); sc.T = (int)CTRL(p)[CT_NT + l]; sc.tid = tid_();
    g8::gemm8<true, false, EpiM2Q, SchedM2, true, true, 0x7C7C7C7C, 0x7A7A7A7A>(lds, FF / 2, 128, FF, sc, eq);
}

__global__ void __launch_bounds__(NTHR, 2) mega(Params p) {
    extern __shared__ __attribute__((aligned(16))) unsigned char lds[];
    LAS unsigned* xbw = (LAS unsigned*)(lds + LDS_BAR);
    if (threadIdx.x == 0) { xbw[0] = 0u; xbw[1] = 0u; xbw[2] = 0u; xbw[3] = 0u; }
    __syncthreads();
    (void)xcd_barrier_post(CTRL(P_()), (volatile LAS unsigned*)xbw);
#define bar mkbar(P_(), lds)
#ifndef AMP_MASK
#define AMP_MASK 0
#endif
#define PH(id, ...) do { const unsigned long long t0_ = (AMP_MASK >> (id)) & 1 ? wall_clock64() : 0ull; __VA_ARGS__; xcd_barrier(bar); \
    if ((AMP_MASK >> (id)) & 1) { const unsigned long long d_ = wall_clock64() - t0_; while (wall_clock64() - t0_ < 2 * d_) __builtin_amdgcn_s_sleep(8); } } while (0)
    PH(0, phase_init(P_()); phase_weights(P_(), lds, 0, 0, 0));
    for (int l = 0; l < 4; ++l) {
        if (l < 2) {
            PH(1, phase_r1(P_(), lds, l));
            PH(2, phase_r2(P_(), lds, l));
            PH(3, phase_scanA(P_(), lds, l));
            PH(4, phase_scanB(P_(), lds, l); phase_weights_moe(P_(), lds, l, NB * 16));
            PH(5, phase_scanC(P_(), lds, l));
        } else {
            PH(6, phase_qkv(P_(), lds, l));
            PH(7, phase_attn8(P_(), lds, l - 2));
        }
        PH(8, phase_outproj(P_(), lds, l < 2));
        PH(9, phase_ln<false>(P_(), P_()->in[I_LNMG] + l * D_, P_()->in[I_LNMB] + l * D_, false));
        PH(10, phase_router(P_(), lds, l));
        PH(11, phase_scatter(P_(), lds, l));
        PH(12, phase_m1(P_(), lds, l));
        PH(13, phase_m2(P_(), lds, l));
        PH(14, phase_ln<true>(P_(), P_()->in[I_LNFG] + l * D_, P_()->in[I_LNFB] + l * D_, l == 3); if (l < 3) { phase_weights(P_(), lds, l + 1, 0, 0); if (l + 1 >= 2) phase_weights_moe(P_(), lds, l + 1, 0); });
    }
}

extern "C" void kernel_launch(void* const* d_in, const int* in_sizes, int n_in, void* d_out, int out_size, void* d_ws, size_t ws_size, hipStream_t stream) {
    constexpr size_t kDynLds = LDS_BAR + 256;
    static int grid = 0;
    if (!grid) {
        int dev = 0, cus = 0, per_cu = 0;
        hipGetDevice(&dev);
        hipDeviceGetAttribute(&cus, hipDeviceAttributeMultiprocessorCount, dev);
        hipFuncSetAttribute((const void*)mega, hipFuncAttributeMaxDynamicSharedMemorySize, (int)kDynLds);
        hipOccupancyMaxActiveBlocksPerMultiprocessor(&per_cu, mega, NTHR, kDynLds);
        grid = cus * (per_cu < 1 ? per_cu : 1);
        if (grid <= 0) grid = 0;
    }
    if (n_in < 41 || ws_size < WS_NEED || grid <= 0) { fprintf(stderr, "kernel_launch: bad config (n_in %d ws %zu need %zu grid %d)\n", n_in, ws_size, (size_t)WS_NEED, grid); return; }
    hipMemsetAsync(d_ws, 0, 65536, stream);
    Params p; memset(&p, 0, sizeof(p));
    for (int i = 0; i < 41; ++i) p.in[i] = (const float*)d_in[i];
    p.out = (float*)d_out; p.ws = (unsigned char*)d_ws;
    hipLaunchKernelGGL(mega, dim3(grid), dim3(NTHR), kDynLds, stream, p);
}
#ifdef PHASE_TEST
#define PK(name, body) __global__ void __launch_bounds__(NTHR, 2) name(Params pv, int l) { extern __shared__ __attribute__((aligned(16))) unsigned char lds[]; PP p = P_(); body; }
PK(t_init, phase_init(p))
PK(t_weights, phase_weights(p, lds, l, 0, 0); phase_weights_moe(p, lds, l, 32))
PK(t_r1, phase_r1(p, lds, l))
PK(t_r2, phase_r2(p, lds, l))
PK(t_scanA, phase_scanA(p, lds, l))
PK(t_scanB, phase_scanB(p, lds, l))
PK(t_scanC, phase_scanC(p, lds, l))
PK(t_outproj, phase_outproj(p, lds, l < 2))
PK(t_ln0, phase_ln<false>(p, p->in[I_LNMG], p->in[I_LNMB], false))
PK(t_ln1, phase_ln<true>(p, p->in[I_LNMG], p->in[I_LNMB], l == 3))
PK(t_qkv, phase_qkv(p, lds, l))
PK(t_attn, phase_attn8(p, lds, l))
PK(t_router, phase_router(p, lds, l))
PK(t_scatter, phase_scatter(p, lds, l))
PK(t_m1, phase_m1(p, lds, l))
PK(t_m2, phase_m2(p, lds, l))
#endif
```

```cpp
#include <hip/hip_runtime.h>
#include <stdint.h>
#include <stdio.h>
#include <string.h>

#define DI __device__ __forceinline__
typedef unsigned short bf16_t;
typedef short bf16x8 __attribute__((ext_vector_type(8)));
typedef short s16x4 __attribute__((ext_vector_type(4)));
typedef float f32x2 __attribute__((ext_vector_type(2)));
typedef float f32x4 __attribute__((ext_vector_type(4)));
typedef float f32x16 __attribute__((ext_vector_type(16)));
typedef unsigned u32x4 __attribute__((ext_vector_type(4)));
typedef unsigned u32x2 __attribute__((ext_vector_type(2)));

constexpr int D_ = 1024, NB = 2, SEQ = 16384, NMETA = 16, LSEQ = SEQ + NMETA, LP = 16512, NP = NB * LP, NTOK = NB * LSEQ;
constexpr int NE = 64, TOPK = 8, FF = 256, NSLOT = NTOK * TOPK;
constexpr int NTHR = 512;
constexpr int LDS_BAR = 145408;
constexpr int NCHR = 257;
constexpr int MT = NP / 128;
constexpr float DN_ALPHA = 1.6817928305074290f;
constexpr float LN_EPS = 1e-5f;
constexpr int WBIG_ROWS = 3584, LO1_W = 384;

constexpr size_t AL(size_t x) { return (x + 255) & ~(size_t)255; }
constexpr size_t OFF_CTRL = 0;
constexpr size_t OFF_META32 = 65536;
constexpr size_t OFF_H16 = OFF_META32 + (size_t)NB * NMETA * D_ * 4;
constexpr size_t SZ_ACT16 = (size_t)NP * D_ * 2;
constexpr size_t OFF_KV = AL(OFF_H16 + SZ_ACT16 + 2048);
constexpr size_t OFF_WL = AL(OFF_KV + 2 * SZ_ACT16);
constexpr size_t SZ_WL = (size_t)WBIG_ROWS * 2048 * 2 + (size_t)1024 * LO1_W * 2 + (size_t)1024 * 1024 * 2;
constexpr size_t OFF_WSH = AL(OFF_WL + SZ_WL);
constexpr size_t SZ_WSH = (size_t)512 * 1024 * 2 + (size_t)1024 * 256 * 2 + (size_t)64 * 1024 * 2;
constexpr size_t OFF_WMOE = AL(OFF_WSH + SZ_WSH);
constexpr size_t SZ_WMOE = (size_t)NE * (512 * 1024 + 1024 * 256) * 2;
constexpr size_t OFF_TAB = AL(OFF_WMOE + SZ_WMOE);
constexpr size_t SZ_TAB = (size_t)NSLOT * 4 * 5 + 65536;
constexpr size_t OFF_SCR = AL(OFF_TAB + SZ_TAB);
constexpr size_t SCR_R = 0, SCR_K = SZ_ACT16, SCR_V = 2 * SZ_ACT16, SCR_G = 3 * SZ_ACT16, SCR_A = 4 * SZ_ACT16, SCR_Z = 5 * SZ_ACT16;
constexpr size_t SCR_W = 6 * SZ_ACT16;
constexpr size_t SCR_LO1 = SCR_W + 2 * SZ_ACT16;
constexpr size_t SCR_QS = SCR_LO1 + (size_t)NP * LO1_W * 2;
constexpr size_t SZ_SCR_RW = SCR_QS + SZ_ACT16;
constexpr size_t SCR_H = 0;
constexpr size_t SCR_HS = AL((size_t)NSLOT * 256 * 2);
constexpr size_t SCR_Y = AL(SCR_HS + (size_t)NP * 256 * 2);
constexpr size_t SCR_YSH = AL(SCR_Y + (size_t)NSLOT * 1024);
constexpr size_t SZ_SCR_MOE = SCR_Y + (size_t)NSLOT * 1024 * 2;
constexpr size_t SZ_SCR = SZ_SCR_MOE > SZ_SCR_RW ? SZ_SCR_MOE : SZ_SCR_RW;
constexpr size_t WS_NEED = OFF_SCR + SZ_SCR + 4096;

constexpr int CT_ATTNQ = 4096;
constexpr int CT_CNT = 4352;
constexpr int CT_CUR = 4608;
constexpr int CT_NT = 4864;

struct Params {
    const float* in[41];
    float* out;
    unsigned char* ws;
};
typedef const __attribute__((address_space(4))) Params* PP;
DI PP P_() { PP q = (PP)__builtin_amdgcn_kernarg_segment_ptr(); asm volatile("" : "+s"(q)); return q; }
enum { I_X = 0, I_META, I_LNMG, I_LNMB, I_LNFG, I_LNFB, I_MU, I_WRKV, I_W0, I_WL1, I_WL2, I_A0, I_AL1, I_AL2, I_GL1, I_GL2, I_KK, I_KA, I_RK, I_LNXG, I_LNXB, I_WOUT,
       I_V0, I_VL1, I_VL2, I_KVW, I_WQ, I_LQ1, I_LK1, I_LQ2, I_LK2, I_SUBG, I_DAWO, I_RTW, I_RTB, I_MG, I_MU_, I_MD, I_SG, I_SU, I_SD };

#define XB_TMO      128
#define XB_XCNT(j)  (256  + 64 * (j))
#define XB_XSUB(j)  (1280 + 64 * (j))
#define XB_XGEN(j)  (2304 + 64 * (j))
#define XB_TOP      3328
#define XB_TOPGEN   3392
#define XCD_BAR_WORDS 3456
#define XB_SPIN_CAP (1u << 22)
#define LAS __attribute__((address_space(3)))

__device__ __forceinline__ unsigned xb_ld(unsigned* p)              { return __hip_atomic_load(p, __ATOMIC_RELAXED, __HIP_MEMORY_SCOPE_AGENT); }
__device__ __forceinline__ unsigned xb_add(unsigned* p, unsigned v) { return __hip_atomic_fetch_add(p, v, __ATOMIC_RELAXED, __HIP_MEMORY_SCOPE_AGENT); }
__device__ __forceinline__ unsigned xb_xcc_id() { return (unsigned)__builtin_amdgcn_s_getreg((3 << 11) | 20) & 0xFu; }
#define XB_SPIN(cond, bar) do { unsigned _sp = 0; while (cond) { __builtin_amdgcn_s_sleep(1); \
    if ((++_sp & 255u) == 0u) { if (xb_ld(&(bar)[XB_TMO])) break; if (_sp > XB_SPIN_CAP) { atomicAdd(&(bar)[XB_TMO], 1u); break; } } } } while (0)

struct XcdBarrier { unsigned* bar; unsigned x; volatile LAS unsigned* st; };

__device__ __forceinline__ XcdBarrier xcd_barrier_post(unsigned* bar, volatile LAS unsigned* st) {
    XcdBarrier b; b.bar = bar; b.x = xb_xcc_id(); b.st = st;
    if (threadIdx.x == 0) (void)xb_add(&bar[XB_XCNT(b.x)], 1u);
    return b;
}
__device__ __forceinline__ void xcd_barrier_complete(unsigned* bar, unsigned x, unsigned& nloc, unsigned& nx) {
    const unsigned G = gridDim.x * gridDim.y * gridDim.z;
    unsigned sum, cnt, mine, sp = 0u;
    for (;;) {
        sum = 0u; cnt = 0u; mine = 0u;
#pragma unroll
        for (unsigned j = 0; j < 16; ++j) { const unsigned c = xb_ld(&bar[XB_XCNT(j)]); sum += c; cnt += (c > 0u) ? 1u : 0u; mine = (j == x) ? c : mine; }
        if (sum == G) break;
        __builtin_amdgcn_s_sleep(1);
        if ((++sp & 255u) == 0u) { if (xb_ld(&bar[XB_TMO])) break; if (sp > XB_SPIN_CAP) { atomicAdd(&bar[XB_TMO], 1u); break; } }
    }
    nloc = mine > 0u ? mine : 1u; nx = cnt > 0u ? cnt : 1u;
}
__device__ __forceinline__ void xcd_barrier(const XcdBarrier& b) {
    asm volatile("s_waitcnt vmcnt(0)" ::: "memory");
    __syncthreads();
    if (threadIdx.x == 0) {
        unsigned* bar = b.bar;
        __builtin_amdgcn_s_waitcnt(0);
        unsigned nloc = b.st[0], nx = b.st[1];
        if (nloc == 0u) { xcd_barrier_complete(bar, b.x, nloc, nx); b.st[0] = nloc; b.st[1] = nx; }
        const unsigned old = xb_add(&bar[XB_XSUB(b.x)], 1u);
        const unsigned gen = old / nloc;
        if (old + 1u == (gen + 1u) * nloc) {
            __builtin_amdgcn_fence(__ATOMIC_RELEASE, "agent");
            asm volatile("s_waitcnt vmcnt(0)" ::: "memory");
            const unsigned og = xb_add(&bar[XB_TOP], 1u);
            const unsigned tg = og / nx;
            if (og + 1u == (tg + 1u) * nx) xb_add(&bar[XB_TOPGEN], 1u);
            else XB_SPIN(xb_ld(&bar[XB_TOPGEN]) == tg, bar);
            __builtin_amdgcn_fence(__ATOMIC_ACQUIRE, "agent");
            xb_add(&bar[XB_XGEN(b.x)], 1u);
            asm volatile("s_waitcnt vmcnt(0)" ::: "memory");
        } else {
            XB_SPIN(xb_ld(&bar[XB_XGEN(b.x)]) == gen, bar);
            __builtin_amdgcn_fence(__ATOMIC_ACQUIRE, "agent");
            asm volatile("s_waitcnt vmcnt(0)" ::: "memory");
        }
    }
    __syncthreads();
}

struct Params;
DI int tid_() { int t = threadIdx.x; asm volatile("" : "+v"(t)); return t; }
DI int lane_now() { int l; asm volatile("v_mbcnt_lo_u32_b32 %0, -1, 0\n\tv_mbcnt_hi_u32_b32 %0, -1, %0" : "=v"(l)); return l; }
typedef __bf16 bf16v2 __attribute__((ext_vector_type(2)));
DI unsigned cvt_pk_bf16(float lo, float hi) { f32x2 v = {lo, hi}; bf16v2 b = __builtin_convertvector(v, bf16v2); return __builtin_bit_cast(unsigned, b); }
DI float bf2f(bf16_t x) { return __uint_as_float((unsigned)x << 16); }
DI float bflo(unsigned w) { return __uint_as_float(w << 16); }
DI float bfhi(unsigned w) { return __uint_as_float(w & 0xffff0000u); }
DI bf16_t f2bf(float x) { return (bf16_t)(cvt_pk_bf16(x, 0.f) & 0xffffu); }
DI float sigmoidf_(float x) { return 1.0f / (1.0f + __expf(-x)); }
DI float tanhf_(float x) { const float t = __expf(-2.0f * fabsf(x)); const float r = (1.0f - t) / (1.0f + t); return x < 0.f ? -r : r; }
template <int CTRL> DI float dpp_f(float v) { return __builtin_bit_cast(float, __builtin_amdgcn_update_dpp(0, __builtin_bit_cast(int, v), CTRL, 0xF, 0xF, true)); }
DI float rdlane(float v, int l) { return __builtin_bit_cast(float, __builtin_amdgcn_readlane(__builtin_bit_cast(int, v), l)); }
DI float red8_sum(float v) { v += dpp_f<0xB1>(v); v += dpp_f<0x4E>(v); v += dpp_f<0x141>(v); return v; }
DI float red16_sum(float v) { v = red8_sum(v); v += dpp_f<0x140>(v); return v; }
template <int CTRL, int RM> DI float dpp_rm(float v) { return __builtin_bit_cast(float, __builtin_amdgcn_update_dpp(0, __builtin_bit_cast(int, v), CTRL, RM, 0xF, false)); }
DI float wave_sum(float v) { v = red16_sum(v); v += dpp_rm<0x142, 0xA>(v); v += dpp_rm<0x143, 0xC>(v); return rdlane(v, 63); }
DI float red8_max(float v) { v = fmaxf(v, dpp_f<0xB1>(v)); v = fmaxf(v, dpp_f<0x4E>(v)); v = fmaxf(v, dpp_f<0x141>(v)); return v; }
DI float wave_max(float v) { v = red8_max(v); v = fmaxf(v, dpp_f<0x140>(v)); return fmaxf(fmaxf(rdlane(v, 0), rdlane(v, 16)), fmaxf(rdlane(v, 32), rdlane(v, 48))); }

DI bf16_t* H16(PP p) { return (bf16_t*)(p->ws + OFF_H16 + 2048); }
DI float* h32row_(float* out, unsigned char* ws, int prow) {
    const int b = prow >= LP ? 1 : 0, t = prow - b * LP;
    return t < NMETA ? (float*)(ws + OFF_META32) + (size_t)(b * NMETA + t) * D_ : out + ((size_t)b * SEQ + (t - NMETA)) * D_;
}
DI float* h32row(PP p, int prow) { return h32row_(p->out, p->ws, prow); }
DI unsigned* CTRL(PP p) { return (unsigned*)(p->ws + OFF_CTRL); }
DI XcdBarrier mkbar(PP p, unsigned char* lds) { XcdBarrier b; b.bar = CTRL(p); b.x = xb_xcc_id(); b.st = (volatile LAS unsigned*)(lds + LDS_BAR); return b; }

DI int pk4_fp8(f32x4 a) { return __builtin_amdgcn_cvt_pk_fp8_f32(a[2], a[3], __builtin_amdgcn_cvt_pk_fp8_f32(a[0], a[1], 0, false), true); }
DI unsigned char* H8BUF(PP p) { return p->ws + OFF_KV + SZ_ACT16 + SZ_ACT16 / 2; }
DI void phase_init(PP p) {
    bf16_t* h16 = H16(p);
    const float* x = p->in[I_X]; const float* meta = p->in[I_META];
    const int tid0 = tid_(); const int half = tid0 >> 8, t4 = (tid0 & 255) * 4;
    for (int rp = blockIdx.x; rp < NTOK / 2; rp += gridDim.x) {
        const int n = rp * 2 + half; const int b = n >= LSEQ ? 1 : 0, t = n - b * LSEQ; const int prow = b * LP + t;
        const float* src = t < NMETA ? meta + t * D_ + t4 : x + ((size_t)b * SEQ + (t - NMETA)) * D_ + t4;
        const f32x4 v = *(const f32x4*)src;
        u32x2 w; w.x = cvt_pk_bf16(v[0], v[1]); w.y = cvt_pk_bf16(v[2], v[3]);
        *(u32x2*)(h16 + (size_t)prow * D_ + t4) = w;
        *(int*)(H8BUF(p) + (size_t)prow * D_ + t4) = pk4_fp8(v);
    }
    for (int zr = blockIdx.x; zr < 225; zr += gridDim.x) {
        const long prow = zr == 224 ? -1 : (long)(zr / 112) * LP + LSEQ + (zr % 112);
        *(unsigned*)(h16 + prow * D_ + tid0 * 2) = 0u;
        if (tid0 < 256) *(unsigned*)(H8BUF(p) + prow * D_ + tid0 * 4) = 0u;
    }
}

struct Job { const float* src; int Kvalid, Kpad, N, ldsrc; bf16_t* dst; int ld_dst, kofs, rowmode, rowbase; const float* scale; int scalemode; };

DI void cvt_mat(float* T, int& tctr, const Job& jb, int wk, int G) {
    if (jb.N == 0) return;
    const int tk = jb.Kpad >> 6, tn = (jb.N + 63) >> 6, nt = tk * tn;
    int first = (wk - (tctr % G) + G) % G;
    const int tid = tid_();
    for (int i = first; i < nt; i += G) {
        const int k0 = (i / tn) << 6, n0 = (i % tn) << 6;
        {
            const int kk = tid >> 4, n4 = (tid & 15) * 4;
#pragma unroll
            for (int ps = 0; ps < 2; ++ps) {
                const int k = k0 + kk + 32 * ps, n = n0 + n4;
                f32x4 v = (f32x4){0.f, 0.f, 0.f, 0.f};
                if (k < jb.Kvalid && n < jb.N) {
                    v = *(const f32x4*)(jb.src + (size_t)k * jb.ldsrc + n);
                    float s = 1.0f;
                    if ((jb.scalemode & 3) == 1) s = jb.scale[k]; else if ((jb.scalemode & 3) == 2) s = 1.0f - jb.scale[k];
                    v = v * s;
                }
                float* tp = T + (kk + 32 * ps) * 65 + n4;
                tp[0] = v[0]; tp[1] = v[1]; tp[2] = v[2]; tp[3] = v[3];
            }
        }
        __syncthreads();
        {
            const int n = tid >> 3, k8 = (tid & 7) * 8;
            if (n0 + n < jb.N) {
                const int ng = n0 + n;
                const int row = jb.rowmode == 0 ? jb.rowbase + ng : jb.rowbase + 32 * (ng >> 4) + (ng & 15);
                const float* tp = T + k8 * 65 + n;
                if (jb.scalemode & 8) {
                    u32x2 w8;
                    w8.x = (unsigned)__builtin_amdgcn_cvt_pk_fp8_f32(tp[130] * 32.f, tp[195] * 32.f, __builtin_amdgcn_cvt_pk_fp8_f32(tp[0] * 32.f, tp[65] * 32.f, 0, false), true);
                    w8.y = (unsigned)__builtin_amdgcn_cvt_pk_fp8_f32(tp[390] * 32.f, tp[455] * 32.f, __builtin_amdgcn_cvt_pk_fp8_f32(tp[260] * 32.f, tp[325] * 32.f, 0, false), true);
                    *(u32x2*)((unsigned char*)jb.dst + (size_t)row * jb.ld_dst + jb.kofs + k0 + k8) = w8;
                } else {
                u32x4 w;
                w.x = cvt_pk_bf16(tp[0], tp[65]); w.y = cvt_pk_bf16(tp[130], tp[195]); w.z = cvt_pk_bf16(tp[260], tp[325]); w.w = cvt_pk_bf16(tp[390], tp[455]);
                *(u32x4*)(jb.dst + (size_t)row * jb.ld_dst + jb.kofs + k0 + k8) = w;
                }
            }
        }
        __syncthreads();
    }
    tctr += nt;
}

DI bf16_t* WL_BIG(PP p) { return (bf16_t*)(p->ws + OFF_WL); }
DI bf16_t* WL_LORA2(PP p) { return (bf16_t*)(p->ws + OFF_WL + (size_t)WBIG_ROWS * 2048 * 2); }
DI bf16_t* WL_OUT(PP p) { return (bf16_t*)(p->ws + OFF_WL + (size_t)WBIG_ROWS * 2048 * 2 + (size_t)1024 * LO1_W * 2); }
DI bf16_t* WL_WQ(PP p) { return (bf16_t*)(p->ws + OFF_WL + (size_t)2048 * 1024 * 2); }
DI bf16_t* WS_GU(PP p) { return (bf16_t*)(p->ws + OFF_WSH); }
DI bf16_t* WS_DN(PP p) { return (bf16_t*)(p->ws + OFF_WSH + (size_t)512 * 1024 * 2); }
DI bf16_t* WS_RT(PP p) { return (bf16_t*)(p->ws + OFF_WSH + (size_t)512 * 1024 * 2 + (size_t)1024 * 256 * 2); }
DI bf16_t* WM_GU(PP p) { return (bf16_t*)(p->ws + OFF_WMOE); }
DI bf16_t* WM_DN(PP p) { return (bf16_t*)(p->ws + OFF_WMOE + (size_t)NE * 512 * 1024 * 2); }

DI Job mkjob(const float* src, int Kv, int Kp, int N, int ldsrc, bf16_t* dst, int ld_dst, int kofs, int rowmode, int rowbase, const float* scale, int scalemode) {
    Job j; j.src = src; j.Kvalid = Kv; j.Kpad = Kp; j.N = N; j.ldsrc = ldsrc; j.dst = dst; j.ld_dst = ld_dst; j.kofs = kofs; j.rowmode = rowmode; j.rowbase = rowbase; j.scale = scale; j.scalemode = scalemode; return j;
}

DI Job get_job(PP p, int l, int j) {
    Job z = mkjob(nullptr, 0, 0, 0, 0, nullptr, 0, 0, 0, 0, nullptr, 0);
    if (j < 19) {
        if (l < 2) {
            const float* mu = p->in[I_MU] + (size_t)l * 6 * D_;
            bf16_t* big = WL_BIG(p); bf16_t* lo2 = WL_LORA2(p);
            if (j < 6) { const int s = j >> 1, part = j & 1; return mkjob(p->in[I_WRKV] + (size_t)(l * 3 + s) * D_ * D_, 1024, 1024, 1024, 1024, big, 2048, part * 1024, 0, s * 1024, mu + s * D_, (1 + part) | 8); }
            if (j < 8) { const int part = j & 1; return mkjob(p->in[I_WL1] + (size_t)l * D_ * 64, 1024, 1024, 64, 64, big, 2048, part * 1024, 0, 3072, mu + 3 * D_, (1 + part) | 8); }
            if (j < 10) { const int part = j & 1; return mkjob(p->in[I_AL1] + (size_t)l * D_ * 64, 1024, 1024, 64, 64, big, 2048, part * 1024, 0, 3136, mu + 4 * D_, (1 + part) | 8); }
            if (j < 12) { const int part = j & 1; return mkjob(p->in[I_GL1] + (size_t)l * D_ * 160, 1024, 1024, 160, 160, big, 2048, part * 1024, 0, 3200, mu + 5 * D_, (1 + part) | 8); }
            if (j < 14) { if (l != 1) return z; const int part = j & 1; return mkjob(p->in[I_VL1], 1024, 1024, 32, 32, big, 2048, part * 1024, 0, 3392, mu + 2 * D_, (1 + part) | 8); }
            if (j == 14) return mkjob(p->in[I_WL2] + (size_t)l * 64 * D_, 64, 64, 1024, 1024, lo2, 64, 0, 0, 0, nullptr, 0);
            if (j == 15) return mkjob(p->in[I_AL2] + (size_t)l * 64 * D_, 64, 64, 1024, 1024, lo2 + 1024 * 64, 64, 0, 0, 0, nullptr, 0);
            if (j == 16) return mkjob(p->in[I_GL2] + (size_t)l * 160 * D_, 160, 192, 1024, 1024, lo2 + 2 * 1024 * 64, 192, 0, 0, 0, nullptr, 0);
            if (j == 17) { if (l != 1) return z; return mkjob(p->in[I_VL2], 32, 64, 1024, 1024, lo2 + 2 * 1024 * 64 + 1024 * 192, 64, 0, 0, 0, nullptr, 0); }
            return mkjob(p->in[I_WOUT] + (size_t)l * D_ * D_, 1024, 1024, 1024, 1024, WL_OUT(p), 1024, 0, 0, 0, nullptr, 0);
        } else {
            const int a = l - 2;
            if (j == 0) { if (l != 2) return z; return mkjob(p->in[I_KVW], 1024, 1024, 2048, 2048, WL_BIG(p), 1024, 0, 0, 0, nullptr, 8); }
            if (j == 1) return mkjob(p->in[I_WQ] + (size_t)a * D_ * D_, 1024, 1024, 1024, 1024, WL_WQ(p), 1024, 0, 0, 0, nullptr, 8);
            if (j == 2) return mkjob(p->in[I_DAWO] + (size_t)a * D_ * D_, 1024, 1024, 1024, 1024, WL_OUT(p), 1024, 0, 0, 0, nullptr, 0);
            return z;
        }
    }
    j -= 19;
    if (j == 0) return mkjob(p->in[I_SG] + (size_t)l * D_ * FF, 1024, 1024, 256, 256, WS_GU(p), 1024, 0, 1, 0, nullptr, 8);
    if (j == 1) return mkjob(p->in[I_SU] + (size_t)l * D_ * FF, 1024, 1024, 256, 256, WS_GU(p), 1024, 0, 1, 16, nullptr, 8);
    if (j == 2) return mkjob(p->in[I_SD] + (size_t)l * FF * D_, 256, 256, 1024, 1024, WS_DN(p), 256, 0, 0, 0, nullptr, 8);
    if (j == 3) return mkjob(p->in[I_RTW] + (size_t)l * D_ * NE, 1024, 1024, 64, 64, WS_RT(p), 1024, 0, 0, 0, nullptr, 0);
    j -= 4;
    const int e = j / 3, w = j - e * 3;
    if (w == 0) return mkjob(p->in[I_MG] + ((size_t)l * NE + e) * D_ * FF, 1024, 1024, 256, 256, WM_GU(p) + (size_t)e * 512 * 1024, 1024, 0, 1, 0, nullptr, 0);
    if (w == 1) return mkjob(p->in[I_MU_] + ((size_t)l * NE + e) * D_ * FF, 1024, 1024, 256, 256, WM_GU(p) + (size_t)e * 512 * 1024, 1024, 0, 1, 16, nullptr, 0);
    return mkjob(p->in[I_MD] + ((size_t)l * NE + e) * FF * D_, 256, 256, 1024, 1024, WM_DN(p) + (size_t)e * 1024 * 256, 256, 0, 0, 0, nullptr, 0);
}

DI void phase_weights(PP p, unsigned char* lds, int l, int part, int wg0) {
    if ((int)blockIdx.x < wg0) return;
    float* T = (float*)lds;
    int tctr = 0;
    const int j0 = part == 0 ? 0 : 23, j1 = part == 0 ? 23 : 23 + NE * 3;
    for (int j = j0; j < j1; ++j) { const Job jb = get_job(p, l, j); cvt_mat(T, tctr, jb, (int)blockIdx.x - wg0, (int)gridDim.x - wg0); }
}


template <int W>
DI void cvt_moe_stream(unsigned char* lds, const float* src, unsigned char* dst, int wk, int G, int tid) {
    const int kp = tid >> 4, n4 = (tid & 15) * 4, wn = tid >> 3, wk8 = (tid & 7) * 8;
    constexpr int NTL = NE * 64;
    constexpr int LD = W < 2 ? FF : D_, TSH = W < 2 ? 2 : 4, TMK = W < 2 ? 3 : 15;
    f32x4 a0, a1, b0, b1;
#define CVT_LD(X0, X1, Q) do { const int e_ = (Q) >> 6, tile_ = (Q) & 63, k0_ = (tile_ >> TSH) << 6, n0_ = (tile_ & TMK) << 6; \
        const float* sp_ = src + (size_t)e_ * D_ * FF + (size_t)(k0_ + 2 * kp) * LD + n0_ + n4; X0 = *(const f32x4*)sp_; X1 = *(const f32x4*)(sp_ + LD); } while (0)
    int q = wk;
    if (q < NTL) CVT_LD(a0, a1, q);
    if (q + G < NTL) CVT_LD(b0, b1, q + G);
    int buf = 0;
    for (; q < NTL; q += G) {
        unsigned char* T = lds + buf * 4608;
#pragma unroll
        for (int i = 0; i < 4; ++i) *(unsigned short*)(T + (n4 + i) * 72 + kp * 2) = (unsigned short)__builtin_amdgcn_cvt_pk_fp8_f32(a0[i] * 32.f, a1[i] * 32.f, 0, false);
        a0 = b0; a1 = b1;
        if (q + 2 * G < NTL) CVT_LD(b0, b1, q + 2 * G);
        __syncthreads();
        {
            const int e = q >> 6, tile = q & 63, k0 = (tile >> TSH) << 6, ng = ((tile & TMK) << 6) + wn;
            const u32x2 v = *(const u32x2*)(T + wn * 72 + wk8);
            if (W < 2) *(u32x2*)(dst + ((size_t)e * 512 + 32 * (ng >> 4) + (ng & 15) + 16 * W) * D_ + k0 + wk8) = v;
            else *(u32x2*)(dst + ((size_t)e * 1024 + ng) * FF + k0 + wk8) = v;
        }
        buf ^= 1;
    }
#undef CVT_LD
    __syncthreads();
}
DI void phase_weights_moe(PP p, unsigned char* lds, int l, int wg0) {
    if ((int)blockIdx.x < wg0) return;
    const int wk = (int)blockIdx.x - wg0, G = (int)gridDim.x - wg0, tid = tid_();
    cvt_moe_stream<0>(lds, p->in[I_MG] + (size_t)l * NE * D_ * FF, (unsigned char*)WM_GU(p), wk, G, tid);
    cvt_moe_stream<1>(lds, p->in[I_MU_] + (size_t)l * NE * D_ * FF, (unsigned char*)WM_GU(p), wk, G, tid);
    cvt_moe_stream<2>(lds, p->in[I_MD] + (size_t)l * NE * FF * D_, (unsigned char*)WM_DN(p), wk, G, tid);
}

typedef int i32x8t __attribute__((ext_vector_type(8)));
DI i32x8t cat16t(bf16x8 a, bf16x8 b) { const u32x4 x = __builtin_bit_cast(u32x4, a), y = __builtin_bit_cast(u32x4, b); return (i32x8t){(int)x.x, (int)x.y, (int)x.z, (int)x.w, (int)y.x, (int)y.y, (int)y.z, (int)y.w}; }
template <int BM, int BN, int WTM, int WTN, bool TRANS, bool FP8 = false, int SA = 0x7F7F7F7F, int SB = 0x7F7F7F7F, class AP, class EPI>
DI void gemm_tile(unsigned char* lds, const AP& aptr, const bf16_t* __restrict__ Bt, size_t ldb, int K, const EPI& epi, size_t akstride = 64) {
    constexpr int WN_ = BN / WTN, MI = WTM / 16, NI = WTN / 16;
    static_assert((BM / WTM) * WN_ == 8, "8 waves");
    constexpr int CA = BM * 8 / NTHR, CB = BN * 8 / NTHR;
    static_assert(CA >= 1 && CB >= 1, "tile too small");
    constexpr int ABYTES = BM * 128, STAGE = (BM + BN) * 128;
    const int tid = tid_(), lane = tid & 63, wid = tid >> 6, wm = wid / WN_, wn = wid % WN_;
    const bf16_t* ap[CA]; const bf16_t* bp[CB]; unsigned aoff[CA], boff[CB];
#pragma unroll
    for (int i = 0; i < CA; ++i) { const int id = tid + NTHR * i, row = id >> 3, c = id & 7; ap[i] = aptr(row) + c * 8; aoff[i] = row * 128 + ((c ^ ((row >> 1) & 7)) << 4); }
#pragma unroll
    for (int i = 0; i < CB; ++i) { const int id = tid + NTHR * i, row = id >> 3, c = id & 7; bp[i] = Bt + (size_t)row * ldb + c * 8; boff[i] = ABYTES + row * 128 + ((c ^ ((row >> 1) & 7)) << 4); }
    u32x4 ra[CA], rb[CB];
    f32x4 acc[MI][NI];
#pragma unroll
    for (int mi = 0; mi < MI; ++mi)
#pragma unroll
        for (int ni = 0; ni < NI; ++ni) acc[mi][ni] = (f32x4){0.f, 0.f, 0.f, 0.f};
    asm volatile("" : "+s"(K));
    const int nk = K >> 6;
#pragma unroll
    for (int i = 0; i < CA; ++i) ra[i] = *(const u32x4*)(ap[i]);
#pragma unroll
    for (int i = 0; i < CB; ++i) rb[i] = *(const u32x4*)(bp[i]);
#pragma unroll
    for (int i = 0; i < CA; ++i) *(u32x4*)(lds + aoff[i]) = ra[i];
#pragma unroll
    for (int i = 0; i < CB; ++i) *(u32x4*)(lds + boff[i]) = rb[i];
    __syncthreads();
    const int fr = lane & 15, fq = lane >> 4, sw = (fr >> 1) & 7;
    for (int kt = 0; kt < nk; ++kt) {
        const unsigned char* cur = lds + (kt & 1) * STAGE;
        unsigned char* nxt = lds + ((kt + 1) & 1) * STAGE;
        const bool more = kt + 1 < nk;
        if (more) {
#pragma unroll
            for (int i = 0; i < CA; ++i) ra[i] = *(const u32x4*)(ap[i] + (size_t)(kt + 1) * akstride);
#pragma unroll
            for (int i = 0; i < CB; ++i) rb[i] = *(const u32x4*)(bp[i] + (kt + 1) * 64);
        }
        if (FP8) {
            bf16x8 af[MI][2], bfr[NI][2];
#pragma unroll
            for (int ks = 0; ks < 2; ++ks) {
                const int ch = ((ks * 4 + fq) ^ sw) << 4;
#pragma unroll
                for (int mi = 0; mi < MI; ++mi) af[mi][ks] = *(const bf16x8*)(cur + (wm * WTM + mi * 16 + fr) * 128 + ch);
#pragma unroll
                for (int ni = 0; ni < NI; ++ni) bfr[ni][ks] = *(const bf16x8*)(cur + ABYTES + (wn * WTN + ni * 16 + fr) * 128 + ch);
            }
#pragma unroll
            for (int mi = 0; mi < MI; ++mi)
#pragma unroll
                for (int ni = 0; ni < NI; ++ni)
                    acc[mi][ni] = TRANS ? __builtin_amdgcn_mfma_scale_f32_16x16x128_f8f6f4(cat16t(bfr[ni][0], bfr[ni][1]), cat16t(af[mi][0], af[mi][1]), acc[mi][ni], 0, 0, 0, SB, 0, SA)
                                        : __builtin_amdgcn_mfma_scale_f32_16x16x128_f8f6f4(cat16t(af[mi][0], af[mi][1]), cat16t(bfr[ni][0], bfr[ni][1]), acc[mi][ni], 0, 0, 0, SA, 0, SB);
        } else {
#pragma unroll
        for (int ks = 0; ks < 2; ++ks) {
            bf16x8 af[MI], bfr[NI];
            const int ch = ((ks * 4 + fq) ^ sw) << 4;
#pragma unroll
            for (int mi = 0; mi < MI; ++mi) af[mi] = *(const bf16x8*)(cur + (wm * WTM + mi * 16 + fr) * 128 + ch);
#pragma unroll
            for (int ni = 0; ni < NI; ++ni) bfr[ni] = *(const bf16x8*)(cur + ABYTES + (wn * WTN + ni * 16 + fr) * 128 + ch);
#pragma unroll
            for (int mi = 0; mi < MI; ++mi)
#pragma unroll
                for (int ni = 0; ni < NI; ++ni)
                    acc[mi][ni] = TRANS ? __builtin_amdgcn_mfma_f32_16x16x32_bf16(bfr[ni], af[mi], acc[mi][ni], 0, 0, 0)
                                        : __builtin_amdgcn_mfma_f32_16x16x32_bf16(af[mi], bfr[ni], acc[mi][ni], 0, 0, 0);
        }
        }
        if (more) {
#pragma unroll
            for (int i = 0; i < CA; ++i) *(u32x4*)(nxt + aoff[i]) = ra[i];
#pragma unroll
            for (int i = 0; i < CB; ++i) *(u32x4*)(nxt + boff[i]) = rb[i];
        }
        __syncthreads();
    }
    epi.template run<MI, NI>(acc, wm * WTM, wn * WTN, fr, fq);
}

struct APlain { const bf16_t* base; size_t ld; DI const bf16_t* operator()(int r) const { return base + (size_t)r * ld; } };
struct AClamp { const bf16_t* base; int last; DI const bf16_t* operator()(int r) const { return base + (size_t)(r < last ? r : last) * FF; } };
struct AGather { const bf16_t* base; const int* rows; int nrows; DI const bf16_t* operator()(int r) const { const int rr = r < nrows ? r : nrows - 1; return base + (size_t)rows[rr] * D_; } };

DI size_t hm_off(int prow, int col) { const int b = prow >= LP ? 1 : 0, t = prow - b * LP; return ((size_t)((b * 16 + (col >> 6)) * LP + t)) * 64 + (col & 63); }
DI void st_bf4(bf16_t* dst, f32x4 v) { u32x2 w; w.x = cvt_pk_bf16(v[0], v[1]); w.y = cvt_pk_bf16(v[2], v[3]); *(u32x2*)dst = w; }

struct EpiR1 {
    bf16_t* dst; int kind; int m0, n0;
    template <int MI, int NI> DI void run(const f32x4 (&acc)[MI][NI], int rb, int cb, int fr, int fq) const {
#pragma unroll
        for (int ni = 0; ni < NI; ++ni) {
            const int col = n0 + cb + ni * 16 + 4 * fq;
            if (col >= 3456) continue;
#pragma unroll
            for (int mi = 0; mi < MI; ++mi) {
                const size_t row = (size_t)(m0 + rb + mi * 16 + fr);
                f32x4 a = acc[mi][ni];
                if (kind == 0) {
                    st_bf4(dst + hm_off((int)row, col & 1023), a);
                } else {
                    const int c = col - 3072;
                    if (c < 64) { a[0] = tanhf_(a[0]); a[1] = tanhf_(a[1]); a[2] = tanhf_(a[2]); a[3] = tanhf_(a[3]); }
                    else if (c >= 128 && c < 288) { a[0] = sigmoidf_(a[0]); a[1] = sigmoidf_(a[1]); a[2] = sigmoidf_(a[2]); a[3] = sigmoidf_(a[3]); }
                    else if ((c >= 288 && c < 320) || c >= 352) a = (f32x4){0.f, 0.f, 0.f, 0.f};
                    st_bf4(dst + row * LO1_W + c, a);
                }
            }
        }
    }
};
struct EpiLora2 {
    int mode; float* wdec; bf16_t* dst; const bf16_t* vfirst; const float* bias; int m0, n0;
    template <int MI, int NI> DI void run(const f32x4 (&acc)[MI][NI], int rb, int cb, int fr, int fq) const {
#pragma unroll
        for (int ni = 0; ni < NI; ++ni) {
            const int col = n0 + cb + ni * 16 + 4 * fq;
            f32x4 bv = (f32x4){0.f, 0.f, 0.f, 0.f};
            if (mode != 2) bv = *(const f32x4*)(bias + col);
#pragma unroll
            for (int mi = 0; mi < MI; ++mi) {
                const size_t off = hm_off(m0 + rb + mi * 16 + fr, col);
                f32x4 a = acc[mi][ni] + bv;
                if (mode == 0) {
#pragma unroll
                    for (int i = 0; i < 4; ++i) a[i] = -0.6065306597126334f * sigmoidf_(a[i]);
                    *(f32x4*)(wdec + off) = a;
                } else if (mode == 1) {
#pragma unroll
                    for (int i = 0; i < 4; ++i) a[i] = sigmoidf_(a[i]);
                    st_bf4(dst + off, a);
                } else if (mode == 2) {
                    st_bf4(dst + off, a);
                } else {
                    const u32x2 vv = *(const u32x2*)(dst + off), vf = *(const u32x2*)(vfirst + off);
                    const float v0 = bflo(vv.x), v1 = bfhi(vv.x), v2 = bflo(vv.y), v3 = bfhi(vv.y);
                    const float f0 = bflo(vf.x), f1 = bfhi(vf.x), f2 = bflo(vf.y), f3 = bfhi(vf.y);
                    f32x4 o;
                    o[0] = v0 + (f0 - v0) * sigmoidf_(a[0]); o[1] = v1 + (f1 - v1) * sigmoidf_(a[1]); o[2] = v2 + (f2 - v2) * sigmoidf_(a[2]); o[3] = v3 + (f3 - v3) * sigmoidf_(a[3]);
                    st_bf4(dst + off, o);
                }
            }
        }
    }
};
struct EpiResid {
    float* out; unsigned char* ws; int m0, n0;
    template <int MI, int NI> DI void run(const f32x4 (&acc)[MI][NI], int rb, int cb, int fr, int fq) const {
#pragma unroll
        for (int mi = 0; mi < MI; ++mi) {
            const int prow = m0 + rb + mi * 16 + fr;
            const int t = prow >= LP ? prow - LP : prow;
            if (t >= LSEQ) continue;
            float* hr = h32row_(out, ws, prow);
#pragma unroll
            for (int ni = 0; ni < NI; ++ni) {
                const int col = n0 + cb + ni * 16 + 4 * fq;
                f32x4 h = *(const f32x4*)(hr + col);
                *(f32x4*)(hr + col) = h * DN_ALPHA + acc[mi][ni];
            }
        }
    }
};
struct EpiMix {
    bf16_t* dst; int m0, n0;
    template <int MI, int NI> DI void run(const f32x4 (&acc)[MI][NI], int rb, int cb, int fr, int fq) const {
#pragma unroll
        for (int mi = 0; mi < MI; ++mi)
#pragma unroll
            for (int ni = 0; ni < NI; ++ni) st_bf4(dst + (size_t)(m0 + rb + mi * 16 + fr) * D_ + n0 + cb + ni * 16 + 4 * fq, acc[mi][ni]);
    }
};
struct EpiQK {
    bf16_t* dst; float scale; int m0, n0;
    template <int MI, int NI> DI void run(const f32x4 (&acc)[MI][NI], int rb, int cb, int fr, int fq) const {
#pragma unroll
        for (int mi = 0; mi < MI; ++mi) {
            const int prow = m0 + rb + mi * 16 + fr;
            const int b = prow >= LP ? 1 : 0, t = prow - b * LP;
#pragma unroll
            for (int ni = 0; ni < NI; ++ni) {
                const int col = n0 + cb + ni * 16 + 4 * fq;
                const int hc = col >> 6, dd = col & 63;
                st_bf4(dst + (((size_t)(b * 16 + hc)) * LP + t) * 64 + dd, acc[mi][ni] * scale);
            }
        }
    }
};
struct EpiQK8 {
    unsigned char* dst; float scale; int m0, n0;
    template <int MI, int NI> DI void run(const f32x4 (&acc)[MI][NI], int rb, int cb, int fr, int fq) const {
#pragma unroll
        for (int mi = 0; mi < MI; ++mi) {
            const int prow = m0 + rb + mi * 16 + fr;
            const int b = prow >= LP ? 1 : 0, t = prow - b * LP;
#pragma unroll
            for (int ni = 0; ni < NI; ++ni) {
                const int col = n0 + cb + ni * 16 + 4 * fq;
                const int hc = col >> 6, dd = col & 63;
                const f32x4 a = acc[mi][ni] * scale;
                *(int*)(dst + (((size_t)(b * 16 + hc)) * LP + t) * 64 + dd) = __builtin_amdgcn_cvt_pk_fp8_f32(a[2], a[3], __builtin_amdgcn_cvt_pk_fp8_f32(a[0], a[1], 0, false), true);
            }
        }
    }
};
struct EpiVt {
    bf16_t* dst; int m0, n0;
    template <int MI, int NI> DI void run(const f32x4 (&acc)[MI][NI], int rb, int cb, int fr, int fq) const {
#pragma unroll
        for (int mi = 0; mi < MI; ++mi) {
            const int prow = m0 + rb + mi * 16 + 4 * fq;
            const int b = prow >= LP ? 1 : 0, t = prow - b * LP;
#pragma unroll
            for (int ni = 0; ni < NI; ++ni) {
                const int col = n0 + cb + ni * 16 + fr;
                const int tp = (t & ~12) | ((t & 4) << 1) | ((t & 8) >> 1);
                st_bf4(dst + ((size_t)(b * 1024 + col)) * LP + tp, acc[mi][ni]);
            }
        }
    }
};
struct EpiVt8 {
    unsigned char* dst; int m0, n0;
    template <int MI, int NI> DI void run(const f32x4 (&acc)[MI][NI], int rb, int cb, int fr, int fq) const {
#pragma unroll
        for (int mi = 0; mi < MI; ++mi) {
            const int prow = m0 + rb + mi * 16 + 4 * fq;
            const int b = prow >= LP ? 1 : 0, t = prow - b * LP;
            const int pos = (t & ~63) | ((t & 4) << 3) | ((t & 32) >> 1) | ((t >> 1) & 12);
#pragma unroll
            for (int ni = 0; ni < NI; ++ni) {
                const int col = n0 + cb + ni * 16 + fr;
                const f32x4 a = acc[mi][ni];
                const int w = __builtin_amdgcn_cvt_pk_fp8_f32(a[2], a[3], __builtin_amdgcn_cvt_pk_fp8_f32(a[0], a[1], 0, false), true);
                *(int*)(dst + ((size_t)(b * 1024 + col)) * LP + pos) = w;
            }
        }
    }
};
struct EpiM1 {
    unsigned char* dst; const float* gate; int row0, nrows, n0;
    template <int MI, int NI> DI void run(const f32x4 (&acc)[MI][NI], int rb, int cb, int fr, int fq) const {
#pragma unroll
        for (int mi = 0; mi < MI; ++mi) {
            const int r = rb + mi * 16 + fr;
            if (r >= nrows) continue;
            const float gw = gate ? gate[row0 + r] : 1.0f;
#pragma unroll
            for (int ni = 0; ni < NI; ni += 2) {
                const int hc = ((n0 + cb + ni * 16) >> 1) + 4 * fq;
                const f32x4 g = acc[mi][ni], u = acc[mi][ni + 1];
                f32x4 o;
#pragma unroll
                for (int i = 0; i < 4; ++i) o[i] = g[i] * sigmoidf_(g[i]) * u[i] * gw * 8.0f;
                *(int*)(dst + (size_t)(row0 + r) * FF + hc) = pk4_fp8(o);
            }
        }
    }
};
struct EpiM2 {
    bf16_t* dst; int row0, nrows, n0;
    template <int MI, int NI> DI void run(const f32x4 (&acc)[MI][NI], int rb, int cb, int fr, int fq) const {
#pragma unroll
        for (int mi = 0; mi < MI; ++mi) {
            const int r = rb + mi * 16 + fr;
            if (r >= nrows) continue;
#pragma unroll
            for (int ni = 0; ni < NI; ++ni) st_bf4(dst + (size_t)(row0 + r) * D_ + n0 + cb + ni * 16 + 4 * fq, acc[mi][ni]);
        }
    }
};
struct EpiLds {
    float* dst;
    template <int MI, int NI> DI void run(const f32x4 (&acc)[MI][NI], int rb, int cb, int fr, int fq) const {
#pragma unroll
        for (int mi = 0; mi < MI; ++mi)
#pragma unroll
            for (int ni = 0; ni < NI; ++ni) {
                float* d = dst + (rb + mi * 16 + fr) * 65 + cb + ni * 16 + 4 * fq;
                d[0] = acc[mi][ni][0]; d[1] = acc[mi][ni][1]; d[2] = acc[mi][ni][2]; d[3] = acc[mi][ni][3];
            }
    }
};


namespace g8 {
constexpr int BM = 256, BK = 64, HALF = 128, HTB = HALF * BK * 2, STAGE_BYTES = 8 * HTB;
DI int lds_byte(int r, int c) { const int st = (r >> 4) * 2 + (c >> 5), rr = r & 15, cc = c & 31, ob = rr * 64 + cc * 2; return st * 1024 + (ob ^ (((ob >> 9) & 1) << 5)); }
DI void stage_rc(int b, int& R, int& C) { const int st = b / 1024, sb = b % 1024, swz = sb ^ (((sb >> 9) & 1) << 5); R = (st >> 1) * 16 + swz / 64; C = (st & 1) * 32 + (swz % 64) / 2; }
struct Unit { const char* ab; unsigned ao[2]; unsigned ag[2]; const char* bb; int m0, n0, x0, x1, x2; };

DI int perm32(int rho) { const int n = rho >> 4, i = rho & 15; return 8 * (i >> 2) + 4 * n + (i & 3); }
typedef int i32x8g __attribute__((ext_vector_type(8)));
typedef short s16x16g __attribute__((ext_vector_type(16)));
DI i32x8g cat16(bf16x8 a, bf16x8 b) { const u32x4 x = __builtin_bit_cast(u32x4, a), y = __builtin_bit_cast(u32x4, b); return (i32x8g){(int)x.x, (int)x.y, (int)x.z, (int)x.w, (int)y.x, (int)y.y, (int)y.z, (int)y.w}; }
template <bool TRANS, int GATHER, class Epi, class Sched, bool PERM = false, bool FP8 = false, int SA = 0x7F7F7F7F, int SB = 0x7F7F7F7F>
DI void gemm8(unsigned char* lds_, int K, size_t akstep, unsigned lda_bytes, const Sched& S, const Epi& E) {
    LAS unsigned char* lds = (LAS unsigned char*)lds_;
    const int tid = tid_(), wid = __builtin_amdgcn_readfirstlane(tid >> 6), lane = tid & 63, wr = wid >> 2, wc = wid & 3, fr = lane & 15, fq = lane >> 4;
    asm volatile("" : "+s"(K));
    const int nt = K / BK;
    unsigned voffB[2], voffA[2];
    { int R, C; stage_rc(tid * 16, R, C); const int Rb = PERM ? (64 * (R >> 5) + 16 * ((R & 15) >> 2) + 4 * ((R & 31) >> 4) + (R & 3)) : R;
      voffB[0] = (unsigned)(Rb * K + C) * 2u; voffA[0] = (unsigned)R * lda_bytes + (unsigned)C * 2u; voffB[1] = voffB[0]; voffA[1] = voffA[0]; }
    const size_t dB1 = (size_t)(PERM ? 128 : 64) * K * 2, dA1 = (size_t)64 * lda_bytes;
    const size_t hsA = (size_t)128 * lda_bytes;
    const size_t kstep = (size_t)(BK * 2);
    const size_t hstep = PERM ? (size_t)8 * K * 2 : (size_t)HALF * K * 2;
    const unsigned ldsw = (unsigned)wid * 1024u;
    const int aoff = lds_byte(wr * 64 + fr, fq * 8), boff = lds_byte(wc * 32 + fr, fq * 8);
#define G8_SA(b, h) (((b) * 2 + (h)) * HTB)
#define G8_SB(b, h) ((4 + (b) * 2 + (h)) * HTB)
#define G8_STAGEB(bufoff, gbase) do { _Pragma("unroll") for (int _i = 0; _i < 2; ++_i) { unsigned _vo = voffB[_i]; asm volatile("" : "+v"(_vo)); \
        __builtin_amdgcn_global_load_lds((const unsigned*)((const char*)(gbase) + _i * dB1 + _vo), (LAS unsigned*)(lds + (bufoff) + ldsw + _i * 8192), 16, 0, 0); } } while (0)
#define G8_STAGEA(bufoff, U, h, kofs) do { _Pragma("unroll") for (int _i = 0; _i < 2; ++_i) { unsigned _vo = GATHER == 2 ? ((((h) ? (U).ao[_i] >> 16 : (U).ao[_i] & 0xFFFFu) << 10) + voffA[_i]) : GATHER ? ((h) ? (U).ag[_i] : (U).ao[_i]) : voffA[_i]; asm volatile("" : "+v"(_vo)); \
        const char* _b = (U).ab + (GATHER ? (size_t)0 : (h) * hsA + _i * dA1) + (size_t)(kofs); \
        __builtin_amdgcn_global_load_lds((const unsigned*)(_b + _vo), (LAS unsigned*)(lds + (bufoff) + ldsw + _i * 8192), 16, 0, 0); } } while (0)
#define G8_STAGEA2(bufoff, h, kofs) do { _Pragma("unroll") for (int _i = 0; _i < 2; ++_i) { \
        const char* _b = (last ? nxt.ab : cur.ab) + (GATHER ? (size_t)0 : (h) * hsA + _i * dA1) + (size_t)(kofs); \
        unsigned _vo = GATHER == 2 ? ((((h) ? (last ? nxt.ao[_i] : cur.ao[_i]) >> 16 : (last ? nxt.ao[_i] : cur.ao[_i]) & 0xFFFFu) << 10) + voffA[_i]) \
                     : GATHER ? ((h) ? (last ? nxt.ag[_i] : cur.ag[_i]) : (last ? nxt.ao[_i] : cur.ao[_i])) : voffA[_i]; asm volatile("" : "+v"(_vo)); \
        __builtin_amdgcn_global_load_lds((const unsigned*)(_b + _vo), (LAS unsigned*)(lds + (bufoff) + ldsw + _i * 8192), 16, 0, 0); } } while (0)
#define G8_LDA(dst, b, h) do { _Pragma("unroll") for (int m = 0; m < (FP8 ? 2 : 4); ++m) _Pragma("unroll") for (int k = 0; k < 2; ++k) dst[m][k] = *(const LAS bf16x8*)(lds + G8_SA(b, h) + aoff + m * 2048 + k * 1024); } while (0)
#define G8_LDB(dst, b, h) do { _Pragma("unroll") for (int n = 0; n < 2; ++n) _Pragma("unroll") for (int k = 0; k < 2; ++k) dst[n][k] = *(const LAS bf16x8*)(lds + G8_SB(b, h) + boff + n * 2048 + k * 1024); } while (0)
#define G8_MMA(ai, bj, At, Bt) do { __builtin_amdgcn_s_setprio(1); _Pragma("unroll") for (int m = 0; m < 4; ++m) _Pragma("unroll") for (int n = 0; n < 2; ++n) _Pragma("unroll") for (int k = 0; k < 2; ++k) \
        acc[ai][bj][m][n] = TRANS ? __builtin_amdgcn_mfma_f32_16x16x32_bf16(Bt[n][k], At[m][k], acc[ai][bj][m][n], 0, 0, 0) \
                                  : __builtin_amdgcn_mfma_f32_16x16x32_bf16(At[m][k], Bt[n][k], acc[ai][bj][m][n], 0, 0, 0); __builtin_amdgcn_s_setprio(0); } while (0)
#define G8_LDA_HI(dst, b, h) do { _Pragma("unroll") for (int m = 0; m < 2; ++m) _Pragma("unroll") for (int k = 0; k < 2; ++k) dst[m][k] = *(const LAS bf16x8*)(lds + G8_SA(b, h) + aoff + (m + 2) * 2048 + k * 1024); } while (0)
#define G8_MMA8(ai, bj, mh, At, Bt) do { _Pragma("unroll") for (int m = 0; m < 2; ++m) _Pragma("unroll") for (int n = 0; n < 2; ++n) \
        acc[ai][bj][2 * (mh) + m][n] = TRANS ? __builtin_amdgcn_mfma_scale_f32_16x16x128_f8f6f4(cat16(Bt[n][0], Bt[n][1]), cat16(At[m][0], At[m][1]), acc[ai][bj][2 * (mh) + m][n], 0, 0, 0, SB, 0, SA) \
                                             : __builtin_amdgcn_mfma_scale_f32_16x16x128_f8f6f4(cat16(At[m][0], At[m][1]), cat16(Bt[n][0], Bt[n][1]), acc[ai][bj][2 * (mh) + m][n], 0, 0, 0, SA, 0, SB); } while (0)
#define G8_MMAS(ai, b, h) do { if (FP8) { __builtin_amdgcn_s_setprio(1); G8_MMA8(ai, 0, 0, At, B0); G8_MMA8(ai, 1, 0, At, B1); __builtin_amdgcn_s_setprio(0); G8_SCHED; G8_LDA_HI(At, b, h); G8_SCHED; \
        __builtin_amdgcn_s_setprio(1); G8_MMA8(ai, 0, 1, At, B0); G8_MMA8(ai, 1, 1, At, B1); __builtin_amdgcn_s_setprio(0); } else { G8_MMA(ai, 0, At, B0); G8_MMA(ai, 1, At, B1); } } while (0)
#define G8_WAIT_V(n) asm volatile("s_waitcnt vmcnt(" #n ")" ::: "memory")
#define G8_WAIT_L(n) asm volatile("s_waitcnt lgkmcnt(" #n ")" ::: "memory")
#define G8_BAR __builtin_amdgcn_s_barrier()
#define G8_SCHED __builtin_amdgcn_sched_barrier(0)
    Unit cur, nxt; int ui = 0;
    if (!S.next(0, cur)) return;
#define G8_UNIF(U) do { (U).m0 = __builtin_amdgcn_readfirstlane((U).m0); (U).n0 = __builtin_amdgcn_readfirstlane((U).n0); (U).x0 = __builtin_amdgcn_readfirstlane((U).x0); \
        (U).x1 = __builtin_amdgcn_readfirstlane((U).x1); (U).x2 = __builtin_amdgcn_readfirstlane((U).x2); } while (0)
    G8_UNIF(cur);
    f32x4 acc[2][2][4][2];
#pragma unroll
    for (int a = 0; a < 2; ++a)
#pragma unroll
        for (int b = 0; b < 2; ++b)
#pragma unroll
            for (int m = 0; m < 4; ++m)
#pragma unroll
                for (int n = 0; n < 2; ++n) acc[a][b][m][n] = (f32x4){0.f, 0.f, 0.f, 0.f};
    bf16x8 At[4][2], B0[2][2], B1[2][2];
    const char* cB = cur.bb;
    G8_STAGEB(G8_SB(0, 0), cB); G8_STAGEB(G8_SB(0, 1), cB + hstep); G8_STAGEA(G8_SA(0, 0), cur, 0, 0); G8_STAGEA(G8_SA(0, 1), cur, 1, 0);
    if (wr == 1) G8_BAR;
    G8_WAIT_V(2); G8_BAR;
    G8_STAGEB(G8_SB(1, 0), cB + kstep); G8_STAGEA(G8_SA(1, 0), cur, 0, akstep); G8_STAGEB(G8_SB(1, 1), cB + hstep + kstep);
    G8_WAIT_V(6); G8_BAR;
    for (;;) {
        const bool has_next = S.next(ui + 1, nxt);
        if (!has_next) nxt = cur;
        G8_UNIF(nxt);
        const char* nB = nxt.bb;
        for (int t = 0; t < nt; t += 2) {
            const bool last = (t == nt - 2);
            const size_t ka1 = (size_t)(t + 1) * akstep;
            const size_t ka2 = last ? (size_t)0 : (size_t)(t + 2) * akstep, ka3 = ka2 + akstep;
            const char* b2 = last ? nB : cB + (size_t)(t + 2) * kstep; const char* b3 = b2 + kstep;
            G8_LDB(B0, 0, 0); G8_LDB(B1, 0, 1); G8_SCHED; G8_LDA(At, 0, 0); G8_STAGEA(G8_SA(1, 1), cur, 1, ka1);
            G8_WAIT_V(8); G8_WAIT_L(0); G8_BAR; G8_MMAS(0, 0, 0); G8_BAR; G8_SCHED;
            G8_LDA(At, 0, 1); G8_STAGEB(G8_SB(0, 0), b2); G8_STAGEB(G8_SB(0, 1), b2 + hstep); G8_STAGEA2(G8_SA(0, 0), 0, ka2);
            G8_WAIT_V(8); G8_WAIT_L(0); G8_BAR; G8_MMAS(1, 0, 1); G8_BAR; G8_SCHED;
            G8_LDB(B0, 1, 0); G8_LDB(B1, 1, 1); G8_SCHED; G8_LDA(At, 1, 0); G8_STAGEA2(G8_SA(0, 1), 1, ka2);
            G8_WAIT_V(8); G8_WAIT_L(0); G8_BAR; G8_MMAS(0, 1, 0); G8_BAR; G8_SCHED;
            G8_LDA(At, 1, 1); G8_STAGEB(G8_SB(1, 0), b3); G8_STAGEB(G8_SB(1, 1), b3 + hstep); G8_STAGEA2(G8_SA(1, 0), 0, ka3);
            G8_WAIT_V(8); G8_WAIT_L(0); G8_BAR; G8_MMAS(1, 1, 1); G8_BAR; G8_SCHED;
        }
        if (wr == 0) G8_BAR;
        { const int ln = lane_now(); E.apply(acc, cur, wr, wc, ln & 15, ln >> 4); }
        if (!has_next) break;
#pragma unroll
        for (int a = 0; a < 2; ++a)
#pragma unroll
            for (int b = 0; b < 2; ++b)
#pragma unroll
                for (int m = 0; m < 4; ++m)
#pragma unroll
                    for (int n = 0; n < 2; ++n) acc[a][b][m][n] = (f32x4){0.f, 0.f, 0.f, 0.f};
        cur = nxt; cB = nB; ++ui;
        if (wr == 1) G8_BAR;
    }
    G8_WAIT_V(0);
    G8_BAR;
#undef G8_UNIF
#undef G8_SA
#undef G8_SB
#undef G8_STAGEA
#undef G8_STAGEA2
#undef G8_STAGEB
#undef G8_LDA
#undef G8_LDB
#undef G8_MMA
#undef G8_MMA8
#undef G8_MMAS
#undef G8_LDA_HI
#undef G8_WAIT_V
#undef G8_WAIT_L
#undef G8_BAR
#undef G8_SCHED
}
DI void piece_rc(int tid, int i, int& R, int& C) { stage_rc(tid * 16 + i * 8192, R, C); }
template <class EP> DI void quad_epi(const EP& e, const f32x4 (&acc)[2][2][4][2], int wr, int wc, int fr, int fq) {
#pragma unroll
    for (int ai = 0; ai < 2; ++ai)
#pragma unroll
        for (int bj = 0; bj < 2; ++bj) { e.template run<4, 2>(acc[ai][bj], 128 * ai + 64 * wr, 128 * bj + 32 * wc, fr, fq); __builtin_amdgcn_sched_barrier(0); }
}
}

DI bf16_t* SCR16(PP p, size_t off) { return (bf16_t*)(p->ws + OFF_SCR + off); }
DI bf16_t* VFIRST(PP p) { return (bf16_t*)(p->ws + OFF_KV); }
DI bf16_t* KBUF(PP p) { return (bf16_t*)(p->ws + OFF_KV); }
DI bf16_t* VTBUF(PP p) { return (bf16_t*)(p->ws + OFF_KV + SZ_ACT16); }

DI void phase_r1_old(PP p, unsigned char* lds, int l) {
    constexpr int NT = WBIG_ROWS / 256;
    EpiR1 e;
    for (int u = blockIdx.x; u < MT * NT; u += gridDim.x) {
        const int mt = u / NT, nt = u - mt * NT;
        e.m0 = mt * 128; e.n0 = nt * 256;
        if (nt < 4) { e.kind = 0; e.dst = SCR16(p, SCR_R); } else if (nt < 8) { e.kind = 0; e.dst = SCR16(p, SCR_K); }
        else if (nt < 12) { e.kind = 0; e.dst = l == 0 ? VFIRST(p) : SCR16(p, SCR_V); } else { e.kind = 1; e.dst = SCR16(p, SCR_LO1); }
        APlain a; a.base = H16(p) + (size_t)(mt * 128) * D_ - D_; a.ld = D_;
        gemm_tile<128, 256, 64, 64, true>(lds, a, WL_BIG(p) + (size_t)(nt * 256) * 2048, 2048, 2048, e);
    }
}
DI void phase_r2(PP p, unsigned char* lds, int l) {
    const int ng = l == 1 ? 4 : 3;
    for (int u = blockIdx.x; u < ng * MT * 4; u += gridDim.x) {
        const int g = u / (MT * 4), r = u - g * (MT * 4), mt = r >> 2, nt = r & 3;
        EpiLora2 e; e.mode = g; e.m0 = mt * 128; e.n0 = nt * 256; e.wdec = (float*)(p->ws + OFF_SCR + SCR_W); e.vfirst = VFIRST(p); e.bias = nullptr; e.dst = nullptr;
        APlain a; a.ld = LO1_W; const bf16_t* lo1 = SCR16(p, SCR_LO1) + (size_t)(mt * 128) * LO1_W;
        const bf16_t* lo2 = WL_LORA2(p);
        if (g == 0) { e.bias = p->in[I_W0] + l * D_; a.base = lo1; gemm_tile<128, 256, 64, 64, true>(lds, a, lo2 + (size_t)(nt * 256) * 64, 64, 64, e); }
        else if (g == 1) { e.bias = p->in[I_A0] + l * D_; e.dst = SCR16(p, SCR_A); a.base = lo1 + 64; gemm_tile<128, 256, 64, 64, true>(lds, a, lo2 + 1024 * 64 + (size_t)(nt * 256) * 64, 64, 64, e); }
        else if (g == 2) { e.dst = SCR16(p, SCR_G); a.base = lo1 + 128; gemm_tile<128, 256, 64, 64, true>(lds, a, lo2 + 2 * 1024 * 64 + (size_t)(nt * 256) * 192, 192, 192, e); }
        else { e.bias = p->in[I_V0]; e.dst = SCR16(p, SCR_V); a.base = lo1 + 320; gemm_tile<128, 256, 64, 64, true>(lds, a, lo2 + 2 * 1024 * 64 + 1024 * 192 + (size_t)(nt * 256) * 64, 64, 64, e); }
    }
}

DI unsigned img_off(int row, int col) { return (unsigned)(row * 128 + ((((col >> 3) ^ ((row >> 1) & 7)) << 4) | ((col & 7) << 1))); }
DI void mm64(const unsigned char* Aimg, const unsigned char* Bimg, int mb, int nh, int fr, int g, f32x4 (&acc)[2]) {
#pragma unroll
    for (int ks = 0; ks < 2; ++ks) {
        const int ch = ((ks * 4 + g) ^ ((fr >> 1) & 7)) << 4;
        const bf16x8 a = *(const bf16x8*)(Aimg + (16 * mb + fr) * 128 + ch);
#pragma unroll
        for (int nbi = 0; nbi < 2; ++nbi) {
            const bf16x8 b = *(const bf16x8*)(Bimg + (16 * (2 * nh + nbi) + fr) * 128 + ch);
            acc[nbi] = __builtin_amdgcn_mfma_f32_16x16x32_bf16(b, a, acc[nbi], 0, 0, 0);
        }
    }
}
DI void st_img4(unsigned char* img, int row, int col4, f32x4 v) { u32x2 w; w.x = cvt_pk_bf16(v[0], v[1]); w.y = cvt_pk_bf16(v[2], v[3]); *(u32x2*)(img + img_off(row, col4)) = w; }
DI void st_img4T(unsigned char* img, int row, int col4, f32x4 v) {
    const unsigned w0 = cvt_pk_bf16(v[0], v[1]), w1 = cvt_pk_bf16(v[2], v[3]);
    *(bf16_t*)(img + img_off(col4 + 0, row)) = (bf16_t)(w0 & 0xffffu); *(bf16_t*)(img + img_off(col4 + 1, row)) = (bf16_t)(w0 >> 16);
    *(bf16_t*)(img + img_off(col4 + 2, row)) = (bf16_t)(w1 & 0xffffu); *(bf16_t*)(img + img_off(col4 + 3, row)) = (bf16_t)(w1 >> 16);
}
DI f32x4 ld_img4(const unsigned char* img, int row, int col4) { const u32x2 w = *(const u32x2*)(img + img_off(row, col4)); return (f32x4){bflo(w.x), bfhi(w.x), bflo(w.y), bfhi(w.y)}; }
#define ZACC(a) do { a[0] = (f32x4){0.f, 0.f, 0.f, 0.f}; a[1] = (f32x4){0.f, 0.f, 0.f, 0.f}; } while (0)

DI float ldso_bf(const bf16_t* base, unsigned bo) { return bf2f(*(const bf16_t*)((const char*)base + bo)); }
DI float ldso_f(const float* base, unsigned bo) { return *(const float*)((const char*)base + bo); }
DI void stso_bf4(bf16_t* base, unsigned bo, f32x4 v) { u32x2 w; w.x = cvt_pk_bf16(v[0], v[1]); w.y = cvt_pk_bf16(v[2], v[3]); *(u32x2*)((char*)base + bo) = w; }
DI void phase_scanA(PP p, unsigned char* lds, int l) {
    const int tid = tid_(), lane = tid & 63, wid = tid >> 6, fr = lane & 15, g = lane >> 4, mb = wid >> 1, nh = wid & 1;
    float* seg = (float*)(lds + 16 * 8192); float* gC = seg + 512;
#define SL(i) (lds + (i) * 8192)
    bf16_t* R = SCR16(p, SCR_R); bf16_t* Kp = SCR16(p, SCR_K); const bf16_t* V = l == 0 ? VFIRST(p) : SCR16(p, SCR_V); bf16_t* A = SCR16(p, SCR_A);
    const float* LW = (const float*)(p->ws + OFF_SCR + SCR_W); float* bonus = (float*)(p->ws + OFF_SCR + SCR_LO1); bf16_t* Qs = SCR16(p, SCR_QS);
    const int NU = NB * 16 * NCHR;
    f32x4 kLT[2], kLE[2], kEQ[2];
#pragma unroll
    for (int nbi = 0; nbi < 2; ++nbi)
#pragma unroll
        for (int i = 0; i < 4; ++i) { const int cc = 16 * (2 * nh + nbi) + 4 * g + i, rr = 16 * mb + fr;
            float a0 = cc < rr ? 1.f : 0.f, a1 = cc <= rr ? 1.f : 0.f, a3 = cc == rr ? 1.f : 0.f;
            asm volatile("" : "+v"(a0), "+v"(a1), "+v"(a3));
            kLT[nbi][i] = a0; kLE[nbi][i] = a1; kEQ[nbi][i] = a3; }
    float pr_[8], pk_[8], pv_[8], pa_[8], pl_[8];
    if ((int)blockIdx.x < NU) {
        const int c = blockIdx.x % NCHR, bh = blockIdx.x / NCHR; const size_t base = ((size_t)bh * LP + 64 * c) * 64;
#pragma unroll
        for (int j = 0; j < 8; ++j) { unsigned lb = (unsigned)((8 * wid * 64 + lane) * 2); asm volatile("" : "+v"(lb));
            pr_[j] = ldso_bf(R + base + j * 64, lb); pk_[j] = ldso_bf(Kp + base + j * 64, lb); pv_[j] = ldso_bf(V + base + j * 64, lb); pa_[j] = ldso_bf(A + base + j * 64, lb); pl_[j] = ldso_f(LW + base + j * 64, lb * 2); }
    }
    for (int unit = blockIdx.x; unit < NU; unit += gridDim.x) {
        const int c = unit % NCHR, bh = unit / NCHR, h = bh & 15;
        const size_t base = ((size_t)bh * LP + 64 * c) * 64;
        const int hc = l * D_ + h * 64 + lane;
        const float c_kk = p->in[I_KK][hc], c_ka = p->in[I_KA][hc], c_rk = p->in[I_RK][hc];
        float vr[8], vk2[8], vv[8], vas[8], vbs[8], lwv[8], cum[8];
        float run = 0.f;
#pragma unroll
        for (int j = 0; j < 8; ++j) {
            const int t = 8 * wid + j;
            const float r = pr_[j], k = pk_[j], v = pv_[j], a = pa_[j], lw = pl_[j];
            const float kkr = k * c_kk; const float n2 = wave_sum(kkr * kkr);
            const float kk = kkr / fmaxf(sqrtf(n2), 1e-12f);
            const float k2 = k * (1.0f + (a - 1.0f) * c_ka);
            const float bon = wave_sum(r * k2 * c_rk);
            if (lane == 0) bonus[(size_t)bh * LP + 64 * c + t] = bon;
            run += lw; cum[j] = run; lwv[j] = lw; vr[j] = r; vk2[j] = k2; vv[j] = v; vas[j] = -kk; vbs[j] = kk * a;
        }
        seg[wid * 64 + lane] = run;
        __syncthreads();
        float off = 0.f, tot = 0.f;
#pragma unroll
        for (int w2 = 0; w2 < 8; ++w2) { const float sg = seg[w2 * 64 + lane]; off += w2 < wid ? sg : 0.f; tot += sg; }
        if (wid == 0) gC[lane] = __expf(tot);
        {
            float tA[8], tB[8], tK[8];
#pragma unroll
            for (int j = 0; j < 8; ++j) {
                const int t = 8 * wid + j;
                const float cu = cum[j] + off, cp = cu - lwv[j];
                const float ea = __expf(cp), er = __expf(cu), ei = __expf(-cu), eh = __expf(tot - cu);
                const float At = vas[j] * ea, Rt = vr[j] * er, Bt = vbs[j] * ei, Kt = vk2[j] * ei;
                const unsigned o = img_off(t, lane);
                *(bf16_t*)(SL(5) + o) = f2bf(At); *(bf16_t*)(SL(0) + o) = f2bf(Rt); *(bf16_t*)(SL(6) + o) = f2bf(Bt); *(bf16_t*)(SL(7) + o) = f2bf(Kt);
                tA[j] = At; tB[j] = vbs[j] * eh; tK[j] = vk2[j] * eh;
            }
            const unsigned ot = (unsigned)(lane * 128 + ((wid ^ ((lane >> 1) & 7)) << 4));
            u32x4 w;
            w.x = cvt_pk_bf16(tA[0], tA[1]); w.y = cvt_pk_bf16(tA[2], tA[3]); w.z = cvt_pk_bf16(tA[4], tA[5]); w.w = cvt_pk_bf16(tA[6], tA[7]); *(u32x4*)(SL(1) + ot) = w;
            w.x = cvt_pk_bf16(vv[0], vv[1]); w.y = cvt_pk_bf16(vv[2], vv[3]); w.z = cvt_pk_bf16(vv[4], vv[5]); w.w = cvt_pk_bf16(vv[6], vv[7]); *(u32x4*)(SL(2) + ot) = w;
            w.x = cvt_pk_bf16(tB[0], tB[1]); w.y = cvt_pk_bf16(tB[2], tB[3]); w.z = cvt_pk_bf16(tB[4], tB[5]); w.w = cvt_pk_bf16(tB[6], tB[7]); *(u32x4*)(SL(3) + ot) = w;
            w.x = cvt_pk_bf16(tK[0], tK[1]); w.y = cvt_pk_bf16(tK[2], tK[3]); w.z = cvt_pk_bf16(tK[4], tK[5]); w.w = cvt_pk_bf16(tK[6], tK[7]); *(u32x4*)(SL(4) + ot) = w;
        }
        __syncthreads();
        {
            const int un = unit + gridDim.x;
            if (un < NU) {
                const int cn = un % NCHR, bhn = un / NCHR; const size_t bn = ((size_t)bhn * LP + 64 * cn) * 64;
#pragma unroll
                for (int j = 0; j < 8; ++j) { unsigned lb = (unsigned)((8 * wid * 64 + lane) * 2); asm volatile("" : "+v"(lb));
                    pr_[j] = ldso_bf(R + bn + j * 64, lb); pk_[j] = ldso_bf(Kp + bn + j * 64, lb); pv_[j] = ldso_bf(V + bn + j * 64, lb); pa_[j] = ldso_bf(A + bn + j * 64, lb); pl_[j] = ldso_f(LW + bn + j * 64, lb * 2); }
            }
        }
        f32x4 acc[2];
        const int row = 16 * mb + fr;
        ZACC(acc); mm64(SL(5), SL(6), mb, nh, fr, g, acc);
#pragma unroll
        for (int nbi = 0; nbi < 2; ++nbi) { const int c0 = 16 * (2 * nh + nbi) + 4 * g; f32x4 m = acc[nbi] * kLT[nbi];
            st_img4(SL(8), row, c0, m);
            st_img4T(SL(9), row, c0, m);
            m = m + kEQ[nbi];
            st_img4(SL(13), row, c0, m); }
        ZACC(acc); mm64(SL(5), SL(7), mb, nh, fr, g, acc);
#pragma unroll
        for (int nbi = 0; nbi < 2; ++nbi) { const int c0 = 16 * (2 * nh + nbi) + 4 * g; st_img4(SL(10), row, c0, acc[nbi] * kLT[nbi]); }
        ZACC(acc); mm64(SL(0), SL(6), mb, nh, fr, g, acc);
#pragma unroll
        for (int nbi = 0; nbi < 2; ++nbi) { const int c0 = 16 * (2 * nh + nbi) + 4 * g; st_img4(SL(11), row, c0, acc[nbi] * kLE[nbi]); }
        ZACC(acc); mm64(SL(0), SL(7), mb, nh, fr, g, acc);
#pragma unroll
        for (int nbi = 0; nbi < 2; ++nbi) { const int c0 = 16 * (2 * nh + nbi) + 4 * g; st_img4(SL(12), row, c0, acc[nbi] * kLE[nbi]); }
        __syncthreads();
#define MMST(dst, Ai, Bi) do { ZACC(acc); mm64(SL(Ai), SL(Bi), mb, nh, fr, g, acc); st_img4(SL(dst), row, 16 * (2 * nh) + 4 * g, acc[0]); st_img4(SL(dst), row, 16 * (2 * nh + 1) + 4 * g, acc[1]); } while (0)
#define MMST2(dst, dstT, Ai, Bi) do { ZACC(acc); mm64(SL(Ai), SL(Bi), mb, nh, fr, g, acc); \
        st_img4(SL(dst), row, 16 * (2 * nh) + 4 * g, acc[0]); st_img4(SL(dst), row, 16 * (2 * nh + 1) + 4 * g, acc[1]); \
        st_img4T(SL(dstT), row, 16 * (2 * nh) + 4 * g, acc[0]); st_img4T(SL(dstT), row, 16 * (2 * nh + 1) + 4 * g, acc[1]); } while (0)
#define MMUPD(dst, Ti, Bi) do { ZACC(acc); mm64(SL(Ti), SL(Bi), mb, nh, fr, g, acc); \
        st_img4(SL(dst), row, 16 * (2 * nh) + 4 * g, acc[0] + ld_img4(SL(Ti), row, 16 * (2 * nh) + 4 * g)); \
        st_img4(SL(dst), row, 16 * (2 * nh + 1) + 4 * g, acc[1] + ld_img4(SL(Ti), row, 16 * (2 * nh + 1) + 4 * g)); } while (0)
        MMST(7, 2, 10); MMST2(14, 15, 8, 9);
        __syncthreads();
        MMST2(5, 6, 14, 15); MMUPD(8, 13, 15);
        __syncthreads();
        MMST2(14, 15, 5, 6); MMUPD(9, 8, 6);
        __syncthreads();
        MMST2(5, 6, 14, 15); MMUPD(8, 9, 15);
        __syncthreads();
        MMST(15, 6, 5); MMUPD(9, 8, 6);
        __syncthreads();
        MMUPD(8, 9, 15);
        __syncthreads();
        MMST(5, 1, 8); MMST(6, 7, 8);
        __syncthreads();
        ZACC(acc); mm64(SL(11), SL(5), mb, nh, fr, g, acc);
#pragma unroll
        for (int nbi = 0; nbi < 2; ++nbi) { const int c0 = 16 * (2 * nh + nbi) + 4 * g; unsigned bo = (unsigned)((row * 64 + c0) * 2); asm volatile("" : "+v"(bo)); stso_bf4(R + base, bo, acc[nbi] + ld_img4(SL(0), row, c0)); }
        ZACC(acc); mm64(SL(11), SL(6), mb, nh, fr, g, acc); mm64(SL(12), SL(2), mb, nh, fr, g, acc);
#pragma unroll
        for (int nbi = 0; nbi < 2; ++nbi) { const int c0 = 16 * (2 * nh + nbi) + 4 * g; unsigned bo = (unsigned)((row * 64 + c0) * 2); asm volatile("" : "+v"(bo)); stso_bf4(Kp + base, bo, acc[nbi]); }
        ZACC(acc); mm64(SL(3), SL(5), mb, nh, fr, g, acc);
#pragma unroll
        for (int nbi = 0; nbi < 2; ++nbi) { const int c0 = 16 * (2 * nh + nbi) + 4 * g; f32x4 m = acc[nbi] + kEQ[nbi] * gC[row];
            const int cp = (c0 & 32) + 8 * ((c0 >> 2) & 3) + 4 * ((c0 >> 4) & 1);
            unsigned bo = (unsigned)((row * 64 + cp) * 2); asm volatile("" : "+v"(bo)); stso_bf4(A + base, bo, m); }
        ZACC(acc); mm64(SL(6), SL(3), mb, nh, fr, g, acc); mm64(SL(2), SL(4), mb, nh, fr, g, acc);
#pragma unroll
        for (int nbi = 0; nbi < 2; ++nbi) { const int c0 = 16 * (2 * nh + nbi) + 4 * g; unsigned bo = (unsigned)((row * 64 + 16 * ((c0 >> 2) & 3) + 4 * (c0 >> 4)) * 2); asm volatile("" : "+v"(bo)); stso_bf4(Qs + (size_t)unit * 4096, bo, acc[nbi]); }
        __syncthreads();
    }
#undef SL
}

DI void phase_scanB(PP p, unsigned char* lds, int l) {
    const int tid = tid_(), lane = tid & 63, wid = tid >> 6, fr = lane & 15, g = lane >> 4;
    const bf16_t* A = SCR16(p, SCR_A); const bf16_t* Qs = SCR16(p, SCR_QS); bf16_t* SC = SCR16(p, SCR_W);
    const int srow = tid >> 3, sc8 = tid & 7;
    const unsigned soff = (unsigned)(srow * 128 + ((sc8 ^ ((srow >> 1) & 7)) << 4));
    constexpr int NBAT = (NCHR - 1) / 8;
    for (int unit = blockIdx.x; unit < NB * 16; unit += gridDim.x) {
        const int v = 16 * (wid & 3) + fr;
        const bf16_t* pa = A + ((size_t)unit * LP) * 64 + tid * 8;
        const bf16_t* pq = Qs + ((size_t)unit * NCHR) * 4096 + tid * 8;
        f32x4 X[4];
#pragma unroll
        for (int kb = 0; kb < 4; ++kb) X[kb] = (f32x4){0.f, 0.f, 0.f, 0.f};
        u32x4 ra[8], rq[8];
#pragma unroll
        for (int j = 0; j < 8; ++j) { ra[j] = *(const u32x4*)(pa + (size_t)j * 4096); rq[j] = *(const u32x4*)(pq + (size_t)j * 4096); }
#pragma unroll
        for (int j = 0; j < 8; ++j) { *(u32x4*)(lds + j * 8192 + soff) = ra[j]; *(u32x4*)(lds + 65536 + j * 8192 + soff) = rq[j]; }
#pragma unroll
        for (int j = 0; j < 8; ++j) { ra[j] = *(const u32x4*)(pa + (size_t)(8 + j) * 4096); rq[j] = *(const u32x4*)(pq + (size_t)(8 + j) * 4096); }
        __syncthreads();
        for (int bt = 0; bt < NBAT; ++bt) {
            if (wid < 4) {
                const int sw = (fr >> 1) & 7;
                bf16x8 fa[4][2], fb[4][2]; u32x4 qa[2], qb[2];
#define SB_LOAD(F, Q, S8) do { const unsigned char* pimg_ = lds + (S8) * 8192; const unsigned char* qimg_ = lds + 65536 + (S8) * 8192; \
                    _Pragma("unroll") for (int kb = 0; kb < 4; ++kb) _Pragma("unroll") for (int ks = 0; ks < 2; ++ks) F[kb][ks] = *(const bf16x8*)(pimg_ + (16 * kb + fr) * 128 + (((4 * ks + g) ^ sw) << 4)); \
                    Q[0] = *(const u32x4*)(qimg_ + v * 128 + (((2 * g) ^ sw) << 4)); Q[1] = *(const u32x4*)(qimg_ + v * 128 + (((2 * g + 1) ^ sw) << 4)); } while (0)
#define SB_STEP(F, Q, S8) do { const size_t ch = (size_t)unit * NCHR + bt * 8 + (S8); \
                    _Pragma("unroll") for (int kb = 0; kb < 4; ++kb) st_bf4(SC + ch * 4096 + v * 64 + 16 * kb + 4 * g, X[kb]); \
                    bf16x8 xp[2]; \
                    _Pragma("unroll") for (int ks = 0; ks < 2; ++ks) { u32x4 w; w.x = cvt_pk_bf16(X[2 * ks][0], X[2 * ks][1]); w.y = cvt_pk_bf16(X[2 * ks][2], X[2 * ks][3]); \
                        w.z = cvt_pk_bf16(X[2 * ks + 1][0], X[2 * ks + 1][1]); w.w = cvt_pk_bf16(X[2 * ks + 1][2], X[2 * ks + 1][3]); xp[ks] = __builtin_bit_cast(bf16x8, w); } \
                    const unsigned qw[8] = {Q[0].x, Q[0].y, Q[0].z, Q[0].w, Q[1].x, Q[1].y, Q[1].z, Q[1].w}; \
                    _Pragma("unroll") for (int kb = 0; kb < 4; ++kb) { f32x4 acc = (f32x4){bflo(qw[2 * kb]), bfhi(qw[2 * kb]), bflo(qw[2 * kb + 1]), bfhi(qw[2 * kb + 1])}; \
                        _Pragma("unroll") for (int ks = 0; ks < 2; ++ks) acc = __builtin_amdgcn_mfma_f32_16x16x32_bf16(F[kb][ks], xp[ks], acc, 0, 0, 0); \
                        X[kb] = acc; } } while (0)
                SB_LOAD(fa, qa, 0);
#pragma unroll
                for (int s2 = 0; s2 < 8; s2 += 2) {
                    SB_LOAD(fb, qb, s2 + 1);
                    SB_STEP(fa, qa, s2);
                    if (s2 + 2 < 8) SB_LOAD(fa, qa, s2 + 2);
                    SB_STEP(fb, qb, s2 + 1);
                }
#undef SB_LOAD
#undef SB_STEP
            }
            __syncthreads();
            if (bt + 1 < NBAT) {
#pragma unroll
                for (int j = 0; j < 8; ++j) { *(u32x4*)(lds + j * 8192 + soff) = ra[j]; *(u32x4*)(lds + 65536 + j * 8192 + soff) = rq[j]; }
                if (bt + 2 < NBAT) {
#pragma unroll
                    for (int j = 0; j < 8; ++j) { ra[j] = *(const u32x4*)(pa + (size_t)((bt + 2) * 8 + j) * 4096); rq[j] = *(const u32x4*)(pq + (size_t)((bt + 2) * 8 + j) * 4096); }
                }
            }
            __syncthreads();
        }
        if (wid < 4) {
#pragma unroll
            for (int kb = 0; kb < 4; ++kb) st_bf4(SC + ((size_t)unit * NCHR + NCHR - 1) * 4096 + v * 64 + 16 * kb + 4 * g, X[kb]);
        }
    }
}

DI void phase_scanC(PP p, unsigned char* lds, int l) {
    const int tid = tid_(), lane = tid & 63, wid = tid >> 6, fr = lane & 15, g = lane >> 4, mb = wid >> 1, nh = wid & 1;
    float* Yl = (float*)(lds + 16384);
    const bf16_t* R = SCR16(p, SCR_R); const bf16_t* Kp = SCR16(p, SCR_K); const bf16_t* V = l == 0 ? VFIRST(p) : SCR16(p, SCR_V);
    const bf16_t* G = SCR16(p, SCR_G); const bf16_t* SC = SCR16(p, SCR_W); const float* bonus = (const float*)(p->ws + OFF_SCR + SCR_LO1); bf16_t* Z = SCR16(p, SCR_Z);
    const int srow = tid >> 3, sc8 = tid & 7;
    const unsigned so = (unsigned)(srow * 128 + ((sc8 ^ ((srow >> 1) & 7)) << 4));
    const int NU = NB * 16 * NCHR;
    int unit = blockIdx.x;
    u32x4 rp, sc;
    if (unit < NU) {
        const int c = unit % NCHR, bh = unit / NCHR; const size_t base = ((size_t)bh * LP + 64 * c) * 64;
        rp = *(const u32x4*)(R + base + (size_t)srow * 64 + sc8 * 8); sc = *(const u32x4*)(SC + (size_t)unit * 4096 + srow * 64 + sc8 * 8);
    }
    for (; unit < NU; unit += gridDim.x) {
        const int c = unit % NCHR, bh = unit / NCHR, h = bh & 15;
        const size_t base = ((size_t)bh * LP + 64 * c) * 64;
        const int hc = l * D_ + h * 64 + lane;
        const float c_lg = p->in[I_LNXG][hc], c_lb = p->in[I_LNXB][hc];
        *(u32x4*)(lds + so) = rp; *(u32x4*)(lds + 8192 + so) = sc;
        const int row = 16 * mb + fr;
        u32x2 y0[2];
#pragma unroll
        for (int nbi = 0; nbi < 2; ++nbi) y0[nbi] = *(const u32x2*)(Kp + base + (size_t)row * 64 + 16 * (2 * nh + nbi) + 4 * g);
        float ev[8], eg[8], eb[8];
#pragma unroll
        for (int j = 0; j < 8; ++j) { const int t = 8 * wid + j; const size_t e = base + (size_t)t * 64 + lane; ev[j] = bf2f(V[e]); eg[j] = bf2f(G[e]); eb[j] = bonus[(size_t)bh * LP + 64 * c + t]; }
        {
            const int un = unit + gridDim.x;
            if (un < NU) { const int cn = un % NCHR, bhn = un / NCHR; const size_t bn = ((size_t)bhn * LP + 64 * cn) * 64;
                rp = *(const u32x4*)(R + bn + (size_t)srow * 64 + sc8 * 8); sc = *(const u32x4*)(SC + (size_t)un * 4096 + srow * 64 + sc8 * 8); }
        }
        __syncthreads();
        f32x4 acc[2]; ZACC(acc);
        mm64(lds, lds + 8192, mb, nh, fr, g, acc);
#pragma unroll
        for (int nbi = 0; nbi < 2; ++nbi) {
            const int c0 = 16 * (2 * nh + nbi) + 4 * g;
            float* d = Yl + row * 65 + c0;
            d[0] = acc[nbi][0] + bflo(y0[nbi].x); d[1] = acc[nbi][1] + bfhi(y0[nbi].x); d[2] = acc[nbi][2] + bflo(y0[nbi].y); d[3] = acc[nbi][3] + bfhi(y0[nbi].y);
        }
        __syncthreads();
#pragma unroll
        for (int j = 0; j < 8; ++j) {
            const int t = 8 * wid + j;
            const float y = Yl[t * 65 + lane];
            const float mean = wave_sum(y) * (1.0f / 64.0f);
            const float dlt = y - mean;
            const float var = wave_sum(dlt * dlt) * (1.0f / 64.0f);
            const float yn = dlt * rsqrtf(var + 64e-5f) * c_lg + c_lb;
            Z[base + (size_t)t * 64 + lane] = f2bf((yn + eb[j] * ev[j]) * eg[j]);
        }
        __syncthreads();
    }
}

DI void phase_outproj_old(PP p, unsigned char* lds, bool hm) {
    EpiResid e; e.out = p->out; e.ws = p->ws;
    for (int u = blockIdx.x; u < MT * 4; u += gridDim.x) {
        const int mt = u >> 2, nt = u & 3;
        e.m0 = mt * 128; e.n0 = nt * 256;
        APlain a;
        if (hm) { const int b = mt * 128 >= LP ? 1 : 0, t0 = mt * 128 - b * LP; a.base = SCR16(p, SCR_Z) + ((size_t)(b * 16) * LP + t0) * 64; a.ld = 64; }
        else { a.base = SCR16(p, SCR_Z) + (size_t)(mt * 128) * D_; a.ld = D_; }
        gemm_tile<128, 256, 64, 64, true>(lds, a, WL_OUT(p) + (size_t)(nt * 256) * D_, D_, D_, e, hm ? (size_t)LP * 64 : (size_t)64);
    }
}

template <bool COMBINE>
DI void phase_ln(PP p, const float* gam, const float* bet, bool final_out) {
    const int tid0 = tid_(); const int lane = tid0 & 63, wid = tid0 >> 6;
    bf16_t* h16 = H16(p);
    const int* tok_slot = (const int*)(p->ws + OFF_TAB) + 2 * NSLOT;
    const bf16_t* Y = SCR16(p, SCR_Y);
    const int c0 = lane * 16;
    f32x4 g4[4], b4[4];
#pragma unroll
    for (int i = 0; i < 4; ++i) { g4[i] = *(const f32x4*)(gam + c0 + 4 * i); b4[i] = *(const f32x4*)(bet + c0 + 4 * i); }
    for (int n = blockIdx.x * 8 + wid; n < NTOK; n += gridDim.x * 8) {
        const int b = n >= LSEQ ? 1 : 0, t = n - b * LSEQ, prow = b * LP + t;
        f32x4 x[4];
        {
            const bf16_t* src = h16 + (size_t)prow * D_;
            const u32x4 w0 = *(const u32x4*)(src + c0), w1 = *(const u32x4*)(src + c0 + 8);
            x[0] = (f32x4){bflo(w0.x), bfhi(w0.x), bflo(w0.y), bfhi(w0.y)}; x[1] = (f32x4){bflo(w0.z), bfhi(w0.z), bflo(w0.w), bfhi(w0.w)};
            x[2] = (f32x4){bflo(w1.x), bfhi(w1.x), bflo(w1.y), bfhi(w1.y)}; x[3] = (f32x4){bflo(w1.z), bfhi(w1.z), bflo(w1.w), bfhi(w1.w)};
        }
        if (!COMBINE) {
            const bf16_t* src = SCR16(p, SCR_R) + (size_t)prow * D_;
            const u32x4 w0 = *(const u32x4*)(src + c0), w1 = *(const u32x4*)(src + c0 + 8);
#pragma unroll
            for (int i = 0; i < 4; ++i) x[i] = x[i] * DN_ALPHA;
            x[0][0] += bflo(w0.x); x[0][1] += bfhi(w0.x); x[0][2] += bflo(w0.y); x[0][3] += bfhi(w0.y);
            x[1][0] += bflo(w0.z); x[1][1] += bfhi(w0.z); x[1][2] += bflo(w0.w); x[1][3] += bfhi(w0.w);
            x[2][0] += bflo(w1.x); x[2][1] += bfhi(w1.x); x[2][2] += bflo(w1.y); x[2][3] += bfhi(w1.y);
            x[3][0] += bflo(w1.z); x[3][1] += bfhi(w1.z); x[3][2] += bflo(w1.w); x[3][3] += bfhi(w1.w);
        }
        if (COMBINE) {
#pragma unroll
            for (int i = 0; i < 4; ++i) x[i] = x[i] * DN_ALPHA;
            {
                const bf16_t* src = SCR16(p, SCR_YSH) + (size_t)prow * D_;
                const u32x4 w0 = *(const u32x4*)(src + c0), w1 = *(const u32x4*)(src + c0 + 8);
                x[0][0] += bflo(w0.x); x[0][1] += bfhi(w0.x); x[0][2] += bflo(w0.y); x[0][3] += bfhi(w0.y);
                x[1][0] += bflo(w0.z); x[1][1] += bfhi(w0.z); x[1][2] += bflo(w0.w); x[1][3] += bfhi(w0.w);
                x[2][0] += bflo(w1.x); x[2][1] += bfhi(w1.x); x[2][2] += bflo(w1.y); x[2][3] += bfhi(w1.y);
                x[3][0] += bflo(w1.z); x[3][1] += bfhi(w1.z); x[3][2] += bflo(w1.w); x[3][3] += bfhi(w1.w);
            }
            f32x4 ys[4];
#pragma unroll
            for (int i = 0; i < 4; ++i) ys[i] = (f32x4){0.f, 0.f, 0.f, 0.f};
#pragma unroll
            for (int k = 0; k < 8; ++k) {
                const u32x4 w = *(const u32x4*)((const unsigned char*)Y + (size_t)tok_slot[n * 8 + k] * D_ + c0);
                const unsigned ww[4] = {w.x, w.y, w.z, w.w};
#pragma unroll
                for (int i = 0; i < 4; ++i) {
                    const f32x2 lo = __builtin_amdgcn_cvt_pk_f32_fp8((int)ww[i], false), hi = __builtin_amdgcn_cvt_pk_f32_fp8((int)ww[i], true);
                    ys[i][0] += lo.x; ys[i][1] += lo.y; ys[i][2] += hi.x; ys[i][3] += hi.y;
                }
            }
#pragma unroll
            for (int i = 0; i < 4; ++i) x[i] = x[i] + ys[i] * 0.0625f;
        }
        float s = 0.f;
#pragma unroll
        for (int i = 0; i < 4; ++i) s += (x[i][0] + x[i][1]) + (x[i][2] + x[i][3]);
        const float mean = wave_sum(s) * (1.0f / 1024.0f);
        float qv = 0.f;
#pragma unroll
        for (int i = 0; i < 4; ++i) { const f32x4 d = x[i] - mean; qv += (d[0] * d[0] + d[1] * d[1]) + (d[2] * d[2] + d[3] * d[3]); }
        const float rstd = rsqrtf(wave_sum(qv) * (1.0f / 1024.0f) + LN_EPS);
        u32x4 o0, o1;
#pragma unroll
        for (int i = 0; i < 4; ++i) x[i] = (x[i] - mean) * rstd * g4[i] + b4[i];
        if (final_out) {
            if (t >= NMETA) { float* orow = p->out + ((size_t)b * SEQ + (t - NMETA)) * D_ + c0;
#pragma unroll
                for (int i = 0; i < 4; ++i) *(f32x4*)(orow + 4 * i) = x[i]; }
            continue;
        }
        o0.x = cvt_pk_bf16(x[0][0], x[0][1]); o0.y = cvt_pk_bf16(x[0][2], x[0][3]); o0.z = cvt_pk_bf16(x[1][0], x[1][1]); o0.w = cvt_pk_bf16(x[1][2], x[1][3]);
        o1.x = cvt_pk_bf16(x[2][0], x[2][1]); o1.y = cvt_pk_bf16(x[2][2], x[2][3]); o1.z = cvt_pk_bf16(x[3][0], x[3][1]); o1.w = cvt_pk_bf16(x[3][2], x[3][3]);
        *(u32x4*)(h16 + (size_t)prow * D_ + c0) = o0; *(u32x4*)(h16 + (size_t)prow * D_ + c0 + 8) = o1;
        {
            u32x4 o8; o8.x = (unsigned)pk4_fp8(x[0]); o8.y = (unsigned)pk4_fp8(x[1]); o8.z = (unsigned)pk4_fp8(x[2]); o8.w = (unsigned)pk4_fp8(x[3]);
            *(u32x4*)(H8BUF(p) + (size_t)prow * D_ + c0) = o8;
        }
    }
}

DI void phase_qkv_old(PP p, unsigned char* lds, int l) {
    const int nq = MT * 4, nk = l == 2 ? MT * 4 : 0, nv = nk;
    for (int u = blockIdx.x; u < nq + nk + nv; u += gridDim.x) {
        if (u < nq + nk) {
            const bool isq = u < nq; const int r = isq ? u : u - nq, mt = r >> 2, nt = r & 3;
            EpiQK e; e.m0 = mt * 128; e.n0 = nt * 256; e.dst = isq ? SCR16(p, 0) : KBUF(p); e.scale = isq ? 0.125f * 1.4426950408889634f : 1.0f;
            APlain a; a.base = H16(p) + (size_t)(mt * 128) * D_; a.ld = D_;
            const bf16_t* B = isq ? WL_WQ(p) + (size_t)(nt * 256) * D_ : WL_BIG(p) + (size_t)(nt * 256) * D_;
            gemm_tile<128, 256, 64, 64, true>(lds, a, B, D_, D_, e);
        } else {
            const int r = u - nq - nk, mt = r >> 2, nt = r & 3;
            EpiVt e; e.m0 = mt * 128; e.n0 = nt * 256; e.dst = VTBUF(p);
            APlain a; a.base = H16(p) + (size_t)(mt * 128) * D_; a.ld = D_;
            gemm_tile<128, 256, 64, 64, false>(lds, a, WL_BIG(p) + (size_t)(1024 + nt * 256) * D_, D_, D_, e);
        }
    }
}

DI int crow32(int i, int h) { return (i & 3) + 8 * (i >> 2) + 4 * h; }

DI void phase_attn(PP p, unsigned char* lds, int j, int rep = 0) {
    const int tid = tid_(), lane = tid & 63, wid = tid >> 6, cmap = wid >> 2, rg = wid & 3, ql = lane & 31, hh = lane >> 5;
    const float lam_init = j == 0 ? (float)(0.8 - 0.6 * 0.5488116360940264) : (float)(0.8 - 0.6 * 0.4065696597405991);
    float d1 = 0.f, d2 = 0.f;
    for (int i = 0; i < 64; ++i) { d1 += p->in[I_LQ1][j * 64 + i] * p->in[I_LK1][j * 64 + i]; d2 += p->in[I_LQ2][j * 64 + i] * p->in[I_LK2][j * 64 + i]; }
    const float lam = __expf(d1) - __expf(d2) + lam_init;
    const float post = 1.0f - lam_init;
    const bf16_t* Q = SCR16(p, 0); const bf16_t* Kb = KBUF(p); const bf16_t* Vt = VTBUF(p); bf16_t* Z = SCR16(p, SCR_Z);
    const float* subg = p->in[I_SUBG] + j * 128;
    unsigned* ctr = CTRL(p) + CT_ATTNQ + 64 * (j + 2 * rep);
    constexpr int STG = 32768;
    unsigned* s_u = (unsigned*)(lds + 2 * STG);
    constexpr int NQB = LP / 128;
    const int total = NB * 8 * NQB;
    const int krow = tid >> 3, kc8 = tid & 7;
    const unsigned koff = krow * 128 + ((kc8 ^ ((krow >> 1) & 7)) << 4);
    for (;;) {
        if (tid == 0) *s_u = atomicAdd(ctr, 1u);
        __syncthreads();
        const int u = (int)*s_u;
        __syncthreads();
        if (u >= total) break;
        const int qb = NQB - 1 - u / 16, bh = u & 15, b = bh >> 3, head = bh & 7;
        const int q0 = qb * 128 + rg * 32;
        bf16x8 qf[4];
        {
            const bf16_t* qp = Q + (((size_t)(b * 16 + head * 2 + cmap)) * LP + q0 + ql) * 64 + 8 * hh;
#pragma unroll
            for (int s = 0; s < 4; ++s) qf[s] = *(const bf16x8*)(qp + 16 * s);
        }
        const bf16_t* k0p = Kb + (((size_t)(b * 16 + head * 2 + 0)) * LP) * 64 + krow * 64 + kc8 * 8;
        const bf16_t* k1p = Kb + (((size_t)(b * 16 + head * 2 + 1)) * LP) * 64 + krow * 64 + kc8 * 8;
        const bf16_t* vp0 = Vt + ((size_t)(b * 1024 + head * 128 + krow)) * LP + kc8 * 8;
        const bf16_t* vp1 = vp0 + (size_t)64 * LP;
        const int ntile = 2 * qb + 2;
        f32x16 O[4];
#pragma unroll
        for (int i = 0; i < 4; ++i)
#pragma unroll
            for (int r = 0; r < 16; ++r) O[i][r] = 0.f;
        float m_run = -1e30f, l_run = 0.f;
        u32x4 rk0, rk1, rv0, rv1;
        rk0 = *(const u32x4*)(k0p); rk1 = *(const u32x4*)(k1p); rv0 = *(const u32x4*)(vp0); rv1 = *(const u32x4*)(vp1);
        auto stage_write = [&](unsigned char* st) {
            *(u32x4*)(st + koff) = rk0; *(u32x4*)(st + 8192 + koff) = rk1;
            {
                const int r0 = krow, r1 = krow + 64;
                const int s0 = (r0 >> 1) & 15, s1 = (r1 >> 1) & 15;
                unsigned char* vb = st + 16384;
                *(u32x2*)(vb + r0 * 128 + (((2 * kc8) ^ s0) << 3)) = (u32x2){rv0.x, rv0.y};
                *(u32x2*)(vb + r0 * 128 + (((2 * kc8 + 1) ^ s0) << 3)) = (u32x2){rv0.z, rv0.w};
                *(u32x2*)(vb + r1 * 128 + (((2 * kc8) ^ s1) << 3)) = (u32x2){rv1.x, rv1.y};
                *(u32x2*)(vb + r1 * 128 + (((2 * kc8 + 1) ^ s1) << 3)) = (u32x2){rv1.z, rv1.w};
            }
        };
        stage_write(lds);
        __syncthreads();
        for (int kt = 0; kt < ntile; ++kt) {
            const unsigned char* cur = lds + (kt & 1) * STG;
            const bool more = kt + 1 < ntile;
            if (more) {
                const size_t ko = (size_t)(kt + 1) * 64 * 64, vo = (size_t)(kt + 1) * 64;
                rk0 = *(const u32x4*)(k0p + ko); rk1 = *(const u32x4*)(k1p + ko); rv0 = *(const u32x4*)(vp0 + vo); rv1 = *(const u32x4*)(vp1 + vo);
            }
            const int key0 = kt * 64;
            if (key0 <= q0 + 31) {
                const unsigned char* kst = cur + cmap * 8192;
                f32x16 sc[2];
#pragma unroll
                for (int kb = 0; kb < 2; ++kb) {
#pragma unroll
                    for (int r = 0; r < 16; ++r) sc[kb][r] = 0.f;
                    const int row = kb * 32 + ql;
#pragma unroll
                    for (int s = 0; s < 4; ++s) {
                        const bf16x8 kf = *(const bf16x8*)(kst + row * 128 + (((2 * s + hh) ^ ((row >> 1) & 7)) << 4));
                        sc[kb] = __builtin_amdgcn_mfma_f32_32x32x16_bf16(kf, qf[s], sc[kb], 0, 0, 0);
                    }
                }
                if (key0 + 63 > q0) {
                    const int qq = q0 + ql;
#pragma unroll
                    for (int kb = 0; kb < 2; ++kb)
#pragma unroll
                        for (int r = 0; r < 16; ++r) { const int key = key0 + kb * 32 + crow32(r, hh); sc[kb][r] = key > qq ? -INFINITY : sc[kb][r]; }
                }
                float mx = sc[0][0];
#pragma unroll
                for (int kb = 0; kb < 2; ++kb)
#pragma unroll
                    for (int r = 0; r < 16; ++r) mx = fmaxf(mx, sc[kb][r]);
                mx = fmaxf(mx, __shfl_xor(mx, 32));
                const float m_new = fmaxf(m_run, mx);
                const float alpha = __builtin_amdgcn_exp2f(m_run - m_new);
                m_run = m_new;
                float ps = 0.f;
#pragma unroll
                for (int kb = 0; kb < 2; ++kb)
#pragma unroll
                    for (int r = 0; r < 16; ++r) { const float e = __builtin_amdgcn_exp2f(sc[kb][r] - m_new); sc[kb][r] = e; ps += e; }
                l_run = l_run * alpha + ps;
#pragma unroll
                for (int i = 0; i < 4; ++i)
#pragma unroll
                    for (int r = 0; r < 16; ++r) O[i][r] *= alpha;
                const unsigned char* vst = cur + 16384;
#pragma unroll
                for (int s = 0; s < 4; ++s) {
                    const int kb = s >> 1, r0 = 8 * (s & 1);
                    u32x4 pw;
                    pw.x = cvt_pk_bf16(sc[kb][r0 + 0], sc[kb][r0 + 1]); pw.y = cvt_pk_bf16(sc[kb][r0 + 2], sc[kb][r0 + 3]);
                    pw.z = cvt_pk_bf16(sc[kb][r0 + 4], sc[kb][r0 + 5]); pw.w = cvt_pk_bf16(sc[kb][r0 + 6], sc[kb][r0 + 7]);
                    const bf16x8 pf = __builtin_bit_cast(bf16x8, pw);
#pragma unroll
                    for (int dvb = 0; dvb < 4; ++dvb) {
                        const int row = dvb * 32 + ql, sw = (row >> 1) & 15;
                        const u32x2 lo = *(const u32x2*)(vst + row * 128 + (((4 * s + hh) ^ sw) << 3));
                        const u32x2 hi = *(const u32x2*)(vst + row * 128 + (((4 * s + 2 + hh) ^ sw) << 3));
                        const bf16x8 vf = __builtin_bit_cast(bf16x8, (u32x4){lo.x, lo.y, hi.x, hi.y});
                        O[dvb] = __builtin_amdgcn_mfma_f32_32x32x16_bf16(vf, pf, O[dvb], 0, 0, 0);
                    }
                }
            }
            if (more) stage_write(lds + ((kt + 1) & 1) * STG);
            __syncthreads();
        }
        const float l_tot = l_run + __shfl_xor(l_run, 32);
        const float inv = 1.0f / l_tot;
        float* xb = (float*)lds + rg * 4096;
        if (cmap == 1) {
            const float sc1 = lam * inv;
#pragma unroll
            for (int i = 0; i < 4; ++i)
#pragma unroll
                for (int r = 0; r < 16; ++r) xb[(i * 16 + r) * 64 + lane] = O[i][r] * sc1;
        }
        __syncthreads();
        if (cmap == 0) {
            float ss = 0.f;
#pragma unroll
            for (int i = 0; i < 4; ++i)
#pragma unroll
                for (int r = 0; r < 16; ++r) { const float o = O[i][r] * inv - xb[(i * 16 + r) * 64 + lane]; O[i][r] = o; ss += o * o; }
            ss += __shfl_xor(ss, 32);
            const float rn = rsqrtf(ss * (1.0f / 128.0f) + 1e-5f) * post;
            bf16_t* zp = Z + ((size_t)(b * LP + q0 + ql)) * D_ + head * 128;
#pragma unroll
            for (int i = 0; i < 4; ++i)
#pragma unroll
                for (int g = 0; g < 4; ++g) {
                    const int dv = i * 32 + 8 * g + 4 * hh;
                    const f32x4 sg = *(const f32x4*)(subg + dv);
                    f32x4 o; o[0] = O[i][4 * g + 0] * rn * sg[0]; o[1] = O[i][4 * g + 1] * rn * sg[1]; o[2] = O[i][4 * g + 2] * rn * sg[2]; o[3] = O[i][4 * g + 3] * rn * sg[3];
                    st_bf4(zp + dv, o);
                }
        }
        __syncthreads();
    }
}


DI void attn_qk(f32x16 (&sc)[2], const unsigned char* kst, const bf16x8 (&qf)[4], float m_run, int ql, int hh) {
#pragma unroll
    for (int kb = 0; kb < 2; ++kb) {
        const int row = kb * 32 + ql, sw = (row >> 1) & 7;
        f32x16 z;
#pragma unroll
        for (int r = 0; r < 16; ++r) z[r] = 0.f;
        sc[kb] = __builtin_amdgcn_mfma_f32_32x32x16_bf16(*(const bf16x8*)(kst + row * 128 + (((0 + hh) ^ sw) << 4)), qf[0], z, 0, 0, 0);
#pragma unroll
        for (int s = 1; s < 4; ++s)
            sc[kb] = __builtin_amdgcn_mfma_f32_32x32x16_bf16(*(const bf16x8*)(kst + row * 128 + (((2 * s + hh) ^ sw) << 4)), qf[s], sc[kb], 0, 0, 0);
    }
    if (__any(m_run != 0.f)) {
#pragma unroll
        for (int kb = 0; kb < 2; ++kb)
#pragma unroll
            for (int r = 0; r < 16; ++r) sc[kb][r] -= m_run;
    }
}
DI void attn_sm(f32x16 (&sc)[2], bf16x8 (&pf)[4], f32x16 (&O)[4], float& m_run, float& l_run, int key0, int qq, bool diag, int hh) {
    if (diag) {
#pragma unroll
        for (int kb = 0; kb < 2; ++kb)
#pragma unroll
            for (int r = 0; r < 16; ++r) { const int key = key0 + kb * 32 + crow32(r, hh); sc[kb][r] = key > qq ? -INFINITY : sc[kb][r]; }
    }
    float mx = fmaxf(fmaxf(sc[0][0], sc[0][1]), sc[0][2]);
#pragma unroll
    for (int r = 3; r < 15; r += 2) mx = fmaxf(fmaxf(mx, sc[0][r]), sc[0][r + 1]);
    mx = fmaxf(mx, sc[0][15]);
#pragma unroll
    for (int r = 0; r < 16; r += 2) mx = fmaxf(fmaxf(mx, sc[1][r]), sc[1][r + 1]);
    mx = fmaxf(mx, __shfl_xor(mx, 32));
    if (__any(mx > 8.0f)) {
        const float delta = mx > 8.0f ? mx : 0.f;
        const float alpha = __builtin_amdgcn_exp2f(-delta);
        m_run += delta; l_run *= alpha;
#pragma unroll
        for (int i = 0; i < 4; ++i)
#pragma unroll
            for (int r = 0; r < 16; ++r) O[i][r] *= alpha;
#pragma unroll
        for (int kb = 0; kb < 2; ++kb)
#pragma unroll
            for (int r = 0; r < 16; ++r) sc[kb][r] -= delta;
    }
    float ps0 = 0.f, ps1 = 0.f;
#pragma unroll
    for (int r = 0; r < 16; ++r) { const float e0 = __builtin_amdgcn_exp2f(sc[0][r]), e1 = __builtin_amdgcn_exp2f(sc[1][r]); sc[0][r] = e0; sc[1][r] = e1; ps0 += e0; ps1 += e1; }
    l_run += ps0 + ps1;
#pragma unroll
    for (int s = 0; s < 4; ++s) {
        const int kb = s >> 1, r0 = 8 * (s & 1);
        u32x4 pw;
        pw.x = cvt_pk_bf16(sc[kb][r0 + 0], sc[kb][r0 + 1]); pw.y = cvt_pk_bf16(sc[kb][r0 + 2], sc[kb][r0 + 3]);
        pw.z = cvt_pk_bf16(sc[kb][r0 + 4], sc[kb][r0 + 5]); pw.w = cvt_pk_bf16(sc[kb][r0 + 6], sc[kb][r0 + 7]);
        pf[s] = __builtin_bit_cast(bf16x8, pw);
    }
}
constexpr int VT_BLK = 4112;
DI void attn_pv(f32x16 (&O)[4], const bf16x8 (&pf)[4], const unsigned char* vst, int ql, int hh) {
    __builtin_amdgcn_s_setprio(1);
    const int sw = (ql >> 1) & 7;
#pragma unroll
    for (int s = 0; s < 4; ++s) {
#pragma unroll
        for (int dvb = 0; dvb < 4; ++dvb) {
            const bf16x8 vf = *(const bf16x8*)(vst + dvb * VT_BLK + ql * 128 + (((2 * s + hh) ^ sw) << 4));
            O[dvb] = __builtin_amdgcn_mfma_f32_32x32x16_bf16(vf, pf[s], O[dvb], 0, 0, 0);
        }
    }
    __builtin_amdgcn_s_setprio(0);
}

DI void phase_attn3(PP p, unsigned char* lds, int j) {
    const int tid = tid_(), lane = tid & 63, wid = __builtin_amdgcn_readfirstlane(tid >> 6), cmap = wid >> 2, rg = wid & 3, ql = lane & 31, hh = lane >> 5;
    const bool skew = cmap == 1;
    const float lam_init = j == 0 ? (float)(0.8 - 0.6 * 0.5488116360940264) : (float)(0.8 - 0.6 * 0.4065696597405991);
    float d1 = 0.f, d2 = 0.f;
    for (int i = 0; i < 64; ++i) { d1 += p->in[I_LQ1][j * 64 + i] * p->in[I_LK1][j * 64 + i]; d2 += p->in[I_LQ2][j * 64 + i] * p->in[I_LK2][j * 64 + i]; }
    const float lam = __builtin_bit_cast(float, __builtin_amdgcn_readfirstlane(__builtin_bit_cast(int, __expf(d1) - __expf(d2) + lam_init)));
    const float post = 1.0f - lam_init;
    const bf16_t* Q = SCR16(p, 0); const bf16_t* Kb = KBUF(p); const bf16_t* Vt = VTBUF(p); bf16_t* Z = SCR16(p, SCR_Z);
    const float* subg = p->in[I_SUBG] + j * 128;
    unsigned* ctr = CTRL(p) + CT_ATTNQ + 64 * j;
    constexpr int STG = 32896;
    unsigned* s_u = (unsigned*)(lds + 3 * STG);
    constexpr int NQB = LP / 128;
    const int total = NB * 8 * NQB;
    const int krow = tid >> 3, kc8 = tid & 7;
    const unsigned koff = krow * 128 + ((kc8 ^ ((krow >> 1) & 7)) << 4);
    for (;;) {
        if (tid == 0) *s_u = atomicAdd(ctr, 1u);
        __syncthreads();
        const int u = (int)*s_u;
        __syncthreads();
        if (u >= total) break;
        const int qb = NQB - 1 - u / 16, bh = u & 15, b = bh >> 3, head = bh & 7;
        const int q0 = qb * 128 + rg * 32, qq = q0 + ql;
        bf16x8 qf[4];
        {
            const bf16_t* qp = Q + (((size_t)(b * 16 + head * 2 + cmap)) * LP + q0 + ql) * 64 + 8 * hh;
#pragma unroll
            for (int s = 0; s < 4; ++s) qf[s] = *(const bf16x8*)(qp + 16 * s);
        }
        const bf16_t* kbase0 = Kb + (((size_t)(b * 16 + head * 2 + 0)) * LP) * 64;
        const bf16_t* kbase1 = Kb + (((size_t)(b * 16 + head * 2 + 1)) * LP) * 64;
        const bf16_t* vbase = Vt + ((size_t)(b * 1024 + head * 128)) * LP;
        const int ntile = 2 * qb + 2;
        const int nw = ((q0 + 31) >> 6) + 1;
        f32x16 O[4];
#pragma unroll
        for (int i = 0; i < 4; ++i)
#pragma unroll
            for (int r = 0; r < 16; ++r) O[i][r] = 0.f;
        float m_run = 0.f, l_run = 0.f;
        f32x16 sc[2];
        bf16x8 pf[4];
#pragma unroll
        for (int s = 0; s < 4; ++s) pf[s] = (bf16x8){0, 0, 0, 0, 0, 0, 0, 0};
        const int dpos = lane & 7, drow = lane >> 3;
        auto stage_dma = [&](unsigned char* stg, int kt) {
            {
                const int row = wid * 8 + drow, c = dpos ^ ((row >> 1) & 7);
                const size_t so = (size_t)kt * 64 * 64 + row * 64 + c * 8;
                __builtin_amdgcn_global_load_lds((const unsigned*)(kbase0 + so), (LAS unsigned*)(stg + wid * 1024), 16, 0, 0);
                __builtin_amdgcn_global_load_lds((const unsigned*)(kbase1 + so), (LAS unsigned*)(stg + 8192 + wid * 1024), 16, 0, 0);
            }
#pragma unroll
            for (int i = 0; i < 2; ++i) {
                const int q = wid * 2 + i, r = 8 * q + drow, c = dpos ^ (((r & 31) >> 1) & 7);
                __builtin_amdgcn_global_load_lds((const unsigned*)(vbase + (size_t)r * LP + (size_t)kt * 64 + c * 8),
                                                 (LAS unsigned*)(stg + 16384 + (q >> 2) * VT_BLK + (q & 3) * 1024), 16, 0, 0);
            }
        };
        stage_dma(lds, 0);
        __syncthreads();
        int slot = 0, pslot = 2;
        for (int kt = 0; kt < ntile; ++kt) {
            const bool more = kt + 1 < ntile;
            const int nslot = slot == 2 ? 0 : slot + 1;
            if (more) stage_dma(lds + nslot * STG, kt + 1);
            const unsigned char* cur = lds + slot * STG;
            if (skew && kt >= 1 && kt - 1 < nw) attn_pv(O, pf, lds + pslot * STG + 16384, ql, hh);
            if (kt < nw) {
                attn_qk(sc, cur + cmap * 8192, qf, m_run, ql, hh);
                attn_sm(sc, pf, O, m_run, l_run, kt * 64, qq, kt * 64 + 63 > q0, hh);
                if (!skew) attn_pv(O, pf, cur + 16384, ql, hh);
            }
            __syncthreads();
            pslot = slot; slot = nslot;
        }
        if (skew && ntile - 1 < nw) attn_pv(O, pf, lds + pslot * STG + 16384, ql, hh);
        __syncthreads();
        const float l_tot = l_run + __shfl_xor(l_run, 32);
        const float inv = 1.0f / l_tot;
        float* xb = (float*)lds + rg * 4096;
        if (cmap == 1) {
            const float sc1 = lam * inv;
#pragma unroll
            for (int i = 0; i < 4; ++i)
#pragma unroll
                for (int r = 0; r < 16; ++r) xb[(i * 16 + r) * 64 + lane] = O[i][r] * sc1;
        }
        __syncthreads();
        if (cmap == 0) {
            float ss = 0.f;
#pragma unroll
            for (int i = 0; i < 4; ++i)
#pragma unroll
                for (int r = 0; r < 16; ++r) { const float o = O[i][r] * inv - xb[(i * 16 + r) * 64 + lane]; O[i][r] = o; ss += o * o; }
            ss += __shfl_xor(ss, 32);
            const float rn = rsqrtf(ss * (1.0f / 128.0f) + 1e-5f) * post;
            const float* subg_l = subg; asm volatile("" : "+s"(subg_l));
            bf16_t* zp = Z + ((size_t)(b * LP + q0 + ql)) * D_ + head * 128;
#pragma unroll
            for (int i = 0; i < 4; ++i)
#pragma unroll
                for (int g = 0; g < 4; ++g) {
                    const int dv = i * 32 + 8 * g + 4 * hh;
                    const f32x4 sg = *(const f32x4*)(subg_l + dv);
                    f32x4 o; o[0] = O[i][4 * g + 0] * rn * sg[0]; o[1] = O[i][4 * g + 1] * rn * sg[1]; o[2] = O[i][4 * g + 2] * rn * sg[2]; o[3] = O[i][4 * g + 3] * rn * sg[3];
                    st_bf4(zp + dv, o);
                }
        }
        __syncthreads();
    }
}

DI void attn_kload(bf16x8 (&kf)[2][4], const unsigned char* kst, int ql, int hh) {
#pragma unroll
    for (int kb = 0; kb < 2; ++kb) {
        const int row = kb * 32 + ql, sw = (row >> 1) & 7;
#pragma unroll
        for (int s = 0; s < 4; ++s) kf[kb][s] = *(const bf16x8*)(kst + row * 128 + (((2 * s + hh) ^ sw) << 4));
    }
}
DI void attn_qk_pre(f32x16 (&sc)[2], const bf16x8 (&kf)[2][4], const bf16x8 (&qf)[4], float m_run) {
#pragma unroll
    for (int kb = 0; kb < 2; ++kb) {
        f32x16 z;
#pragma unroll
        for (int r = 0; r < 16; ++r) z[r] = 0.f;
        sc[kb] = __builtin_amdgcn_mfma_f32_32x32x16_bf16(kf[kb][0], qf[0], z, 0, 0, 0);
#pragma unroll
        for (int s = 1; s < 4; ++s) sc[kb] = __builtin_amdgcn_mfma_f32_32x32x16_bf16(kf[kb][s], qf[s], sc[kb], 0, 0, 0);
    }
    if (__any(m_run != 0.f)) {
#pragma unroll
        for (int kb = 0; kb < 2; ++kb)
#pragma unroll
            for (int r = 0; r < 16; ++r) sc[kb][r] -= m_run;
    }
}
DI void attn_vload0(bf16x8 (&v0)[4], const unsigned char* vst, int ql, int hh) {
    const int sw = (ql >> 1) & 7;
#pragma unroll
    for (int dvb = 0; dvb < 4; ++dvb) v0[dvb] = *(const bf16x8*)(vst + dvb * VT_BLK + ql * 128 + (((0 + hh) ^ sw) << 4));
}
DI void attn_pv_pre(f32x16 (&O)[4], const bf16x8 (&pf)[4], const bf16x8 (&v0)[4], const unsigned char* vst, int ql, int hh) {
    __builtin_amdgcn_s_setprio(1);
    const int sw = (ql >> 1) & 7;
#pragma unroll
    for (int dvb = 0; dvb < 4; ++dvb) O[dvb] = __builtin_amdgcn_mfma_f32_32x32x16_bf16(v0[dvb], pf[0], O[dvb], 0, 0, 0);
#pragma unroll
    for (int s = 1; s < 4; ++s) {
#pragma unroll
        for (int dvb = 0; dvb < 4; ++dvb) {
            const bf16x8 vf = *(const bf16x8*)(vst + dvb * VT_BLK + ql * 128 + (((2 * s + hh) ^ sw) << 4));
            O[dvb] = __builtin_amdgcn_mfma_f32_32x32x16_bf16(vf, pf[s], O[dvb], 0, 0, 0);
        }
    }
    __builtin_amdgcn_s_setprio(0);
}

template <bool SKEW>
DI void attn6_body(PP p, unsigned char* lds, int j) {
    const int tid = tid_(), lane = tid & 63, wid = __builtin_amdgcn_readfirstlane(tid >> 6), cmap = wid >> 2, rg = wid & 3, ql = lane & 31, hh = lane >> 5;
    constexpr bool skew = SKEW;
    const float lam_init = j == 0 ? (float)(0.8 - 0.6 * 0.5488116360940264) : (float)(0.8 - 0.6 * 0.4065696597405991);
    float d1 = 0.f, d2 = 0.f;
    for (int i = 0; i < 64; ++i) { d1 += p->in[I_LQ1][j * 64 + i] * p->in[I_LK1][j * 64 + i]; d2 += p->in[I_LQ2][j * 64 + i] * p->in[I_LK2][j * 64 + i]; }
    const float lam = __builtin_bit_cast(float, __builtin_amdgcn_readfirstlane(__builtin_bit_cast(int, __expf(d1) - __expf(d2) + lam_init)));
    const float post = 1.0f - lam_init;
    const bf16_t* Q = SCR16(p, 0); const bf16_t* Kb = KBUF(p); const bf16_t* Vt = VTBUF(p); bf16_t* Z = SCR16(p, SCR_Z);
    const float* subg = p->in[I_SUBG] + j * 128;
    unsigned* ctr = CTRL(p) + CT_ATTNQ + 64 * j;
    constexpr int STG = 32896;
    unsigned* s_u = (unsigned*)(lds + 4 * STG);
    constexpr int NQB = LP / 128;
    const int total = NB * 8 * NQB;
    const int krow = tid >> 3, kc8 = tid & 7;
    const unsigned koff = krow * 128 + ((kc8 ^ ((krow >> 1) & 7)) << 4);
    for (;;) {
        if (tid == 0) *s_u = atomicAdd(ctr, 1u);
        __syncthreads();
        const int u = (int)*s_u;
        __syncthreads();
        if (u >= total) break;
        const int qb = NQB - 1 - u / 16, bh = u & 15, b = bh >> 3, head = bh & 7;
        const int q0 = qb * 128 + rg * 32, qq = q0 + ql;
        bf16x8 qf[4];
        {
            const bf16_t* qp = Q + (((size_t)(b * 16 + head * 2 + cmap)) * LP + q0 + ql) * 64 + 8 * hh;
#pragma unroll
            for (int s = 0; s < 4; ++s) qf[s] = *(const bf16x8*)(qp + 16 * s);
        }
        const bf16_t* kbase0 = Kb + (((size_t)(b * 16 + head * 2 + 0)) * LP) * 64;
        const bf16_t* kbase1 = Kb + (((size_t)(b * 16 + head * 2 + 1)) * LP) * 64;
        const bf16_t* vbase = Vt + ((size_t)(b * 1024 + head * 128)) * LP;
        const int ntile = 2 * qb + 2;
        const int nw = ((q0 + 31) >> 6) + 1;
        f32x16 O[4];
#pragma unroll
        for (int i = 0; i < 4; ++i)
#pragma unroll
            for (int r = 0; r < 16; ++r) O[i][r] = 0.f;
        float m_run = 0.f, l_run = 0.f;
        f32x16 sc[2];
        bf16x8 pf[4];
#pragma unroll
        for (int s = 0; s < 4; ++s) pf[s] = (bf16x8){0, 0, 0, 0, 0, 0, 0, 0};
        const int dpos = lane & 7, drow = lane >> 3;
        auto stage_dma = [&](unsigned char* stg, int kt) {
            {
                const int row = wid * 8 + drow, c = dpos ^ ((row >> 1) & 7);
                const size_t so = (size_t)kt * 64 * 64 + row * 64 + c * 8;
                __builtin_amdgcn_global_load_lds((const unsigned*)(kbase0 + so), (LAS unsigned*)(stg + wid * 1024), 16, 0, 0);
                __builtin_amdgcn_global_load_lds((const unsigned*)(kbase1 + so), (LAS unsigned*)(stg + 8192 + wid * 1024), 16, 0, 0);
            }
#pragma unroll
            for (int i = 0; i < 2; ++i) {
                const int q = wid * 2 + i, r = 8 * q + drow, c = dpos ^ (((r & 31) >> 1) & 7);
                __builtin_amdgcn_global_load_lds((const unsigned*)(vbase + (size_t)r * LP + (size_t)kt * 64 + c * 8),
                                                 (LAS unsigned*)(stg + 16384 + (q >> 2) * VT_BLK + (q & 3) * 1024), 16, 0, 0);
            }
        };
        stage_dma(lds, 0);
        stage_dma(lds + STG, 1);
        __syncthreads();
        bf16x8 kf[2][4], v0[4];
        if (!skew) attn_kload(kf, lds + cmap * 8192, ql, hh);
        for (int kt = 0; kt < ntile; ++kt) {
            if (kt + 2 < ntile) stage_dma(lds + ((kt + 2) & 3) * STG, kt + 2);
            const unsigned char* cur = lds + (kt & 3) * STG;
            if (!skew) {
                if (kt < nw) {
                    attn_qk_pre(sc, kf, qf, m_run);
                    attn_sm(sc, pf, O, m_run, l_run, kt * 64, qq, kt * 64 + 63 > q0, hh);
                    attn_pv(O, pf, cur + 16384, ql, hh);
                    if (kt + 1 < nw) attn_kload(kf, lds + ((kt + 1) & 3) * STG + cmap * 8192, ql, hh);
                }
            } else {
                if (kt >= 1 && kt - 1 < nw) attn_pv_pre(O, pf, v0, lds + ((kt - 1) & 3) * STG + 16384, ql, hh);
                if (kt < nw) {
                    attn_qk(sc, cur + cmap * 8192, qf, m_run, ql, hh);
                    attn_sm(sc, pf, O, m_run, l_run, kt * 64, qq, kt * 64 + 63 > q0, hh);
                    attn_vload0(v0, cur + 16384, ql, hh);
                }
            }
            __syncthreads();
        }
        if (skew && ntile - 1 < nw) attn_pv_pre(O, pf, v0, lds + ((ntile - 1) & 3) * STG + 16384, ql, hh);
        __syncthreads();
        const float l_tot = l_run + __shfl_xor(l_run, 32);
        const float inv = 1.0f / l_tot;
        float* xb = (float*)lds + rg * 4096;
        if (cmap == 1) {
            const float sc1 = lam * inv;
#pragma unroll
            for (int i = 0; i < 4; ++i)
#pragma unroll
                for (int r = 0; r < 16; ++r) xb[(i * 16 + r) * 64 + lane] = O[i][r] * sc1;
        }
        __syncthreads();
        if (cmap == 0) {
            float ss = 0.f;
#pragma unroll
            for (int i = 0; i < 4; ++i)
#pragma unroll
                for (int r = 0; r < 16; ++r) { const float o = O[i][r] * inv - xb[(i * 16 + r) * 64 + lane]; O[i][r] = o; ss += o * o; }
            ss += __shfl_xor(ss, 32);
            const float rn = rsqrtf(ss * (1.0f / 128.0f) + 1e-5f) * post;
            const float* subg_l = subg; asm volatile("" : "+s"(subg_l));
            bf16_t* zp = Z + ((size_t)(b * LP + q0 + ql)) * D_ + head * 128;
#pragma unroll
            for (int i = 0; i < 4; ++i)
#pragma unroll
                for (int g = 0; g < 4; ++g) {
                    const int dv = i * 32 + 8 * g + 4 * hh;
                    const f32x4 sg = *(const f32x4*)(subg_l + dv);
                    f32x4 o; o[0] = O[i][4 * g + 0] * rn * sg[0]; o[1] = O[i][4 * g + 1] * rn * sg[1]; o[2] = O[i][4 * g + 2] * rn * sg[2]; o[3] = O[i][4 * g + 3] * rn * sg[3];
                    st_bf4(zp + dv, o);
                }
        }
        __syncthreads();
    }
}

DI void phase_attn6(PP p, unsigned char* lds, int j) {
    if (__builtin_amdgcn_readfirstlane(threadIdx.x >> 8) == 0) attn6_body<false>(p, lds, j); else attn6_body<true>(p, lds, j);
}

typedef int i32x8 __attribute__((ext_vector_type(8)));
constexpr int STG9 = 16384;
#define MFMA_F8S(a, b, c, sa, sb) __builtin_amdgcn_mfma_scale_f32_32x32x64_f8f6f4(a, b, c, 0, 0, 0, sa, 0, sb)
DI i32x8 attn9_frag(const unsigned char* img, int blk, int ql, int hh) {
    const int f = (ql >> 2) & 3;
    const unsigned olo = (unsigned)(ql * 64 + (((2 * hh) ^ f) << 4)), ohi = (unsigned)(ql * 64 + (((2 * hh + 1) ^ f) << 4));
    const unsigned char* base = img + blk * 2048;
    const u32x4 lo = *(const u32x4*)(base + olo), hi = *(const u32x4*)(base + ohi);
    return (i32x8){(int)lo.x, (int)lo.y, (int)lo.z, (int)lo.w, (int)hi.x, (int)hi.y, (int)hi.z, (int)hi.w};
}
DI void attn9_qk(f32x16 (&sc)[2], const i32x8 (&kf)[2], const i32x8& qf, const f32x16& zc) {
    sc[0] = MFMA_F8S(kf[0], qf, zc, 0x7F7F7F7F, 0x7C7C7C7C);
    sc[1] = MFMA_F8S(kf[1], qf, zc, 0x7F7F7F7F, 0x7C7C7C7C);
}
DI void attn9_move(f32x16 (&sc)[2], f32x16 (&O)[4], f32x16& zc, float& m_run, float& l_run, bool all) {
    float mx = fmaxf(fmaxf(sc[0][0], sc[0][1]), sc[0][2]);
#pragma unroll
    for (int r = 3; r < 15; r += 2) mx = fmaxf(fmaxf(mx, sc[0][r]), sc[0][r + 1]);
    mx = fmaxf(mx, sc[0][15]);
#pragma unroll
    for (int r = 0; r < 16; r += 2) mx = fmaxf(fmaxf(mx, sc[1][r]), sc[1][r + 1]);
    mx = fmaxf(mx, __shfl_xor(mx, 32));
    const float delta = (all || mx > 8.0f) ? mx - 4.0f : 0.f;
    const float alpha = __builtin_amdgcn_exp2f(-delta);
    m_run += delta; l_run *= alpha;
#pragma unroll
    for (int i = 0; i < 4; ++i)
#pragma unroll
        for (int r = 0; r < 16; ++r) O[i][r] *= alpha;
#pragma unroll
    for (int kb = 0; kb < 2; ++kb)
#pragma unroll
        for (int r = 0; r < 16; ++r) sc[kb][r] -= delta;
    const float zi = 4.0f - m_run;
#pragma unroll
    for (int r = 0; r < 16; ++r) zc[r] = zi;
}
DI void attn9_sm(f32x16 (&sc)[2], i32x8& pf, f32x16 (&O)[4], f32x16& zc, float& m_run, float& l_run, int key0, int qq, bool diag, bool first, int hh) {
    if (diag) {
        float ninf = -INFINITY; asm volatile("" : "+s"(ninf));
#pragma unroll
        for (int kb = 0; kb < 2; ++kb)
#pragma unroll
            for (int r = 0; r < 16; ++r) { const int key = key0 + kb * 32 + crow32(r, hh); sc[kb][r] = key > qq ? ninf : sc[kb][r]; }
    }
    if (first) attn9_move(sc, O, zc, m_run, l_run, true);
    float ps0 = 0.f, ps1 = 0.f;
    float onef = 1.0f; asm volatile("" : "+s"(onef));
#pragma unroll
    for (int r = 0; r < 16; ++r) { const float e0 = __builtin_amdgcn_exp2f(sc[0][r]), e1 = __builtin_amdgcn_exp2f(sc[1][r]); sc[0][r] = e0; sc[1][r] = e1; ps0 += e0; ps1 = __builtin_fmaf(e1, onef, ps1); }
    float ps = ps0 + ps1;
    if (__any(ps > 448.0f)) {
#pragma unroll
        for (int kb = 0; kb < 2; ++kb)
#pragma unroll
            for (int r = 0; r < 16; ++r) sc[kb][r] = __builtin_amdgcn_logf(sc[kb][r]);
        attn9_move(sc, O, zc, m_run, l_run, false);
        ps0 = 0.f; ps1 = 0.f;
#pragma unroll
        for (int r = 0; r < 16; ++r) { const float e0 = __builtin_amdgcn_exp2f(sc[0][r]), e1 = __builtin_amdgcn_exp2f(sc[1][r]); sc[0][r] = e0; sc[1][r] = e1; ps0 += e0; ps1 += e1; }
        ps = ps0 + ps1;
    }
    l_run += ps;
#pragma unroll
    for (int w = 0; w < 8; ++w) {
        const int kb = w >> 2, r0 = 4 * (w & 3);
        pf[w] = __builtin_amdgcn_cvt_pk_fp8_f32(sc[kb][r0 + 2], sc[kb][r0 + 3], __builtin_amdgcn_cvt_pk_fp8_f32(sc[kb][r0 + 0], sc[kb][r0 + 1], pf[w], false), true);
    }
}
DI void attn9_pv(f32x16 (&O)[4], const i32x8& pf, const unsigned char* vst, int ql, int hh) {
    __builtin_amdgcn_s_setprio(1);
#pragma unroll
    for (int dvb = 0; dvb < 4; ++dvb) { const i32x8 vf = attn9_frag(vst, dvb, ql, hh); O[dvb] = MFMA_F8S(vf, pf, O[dvb], 0x7F7F7F7F, 0x7F7F7F7F); }
    __builtin_amdgcn_s_setprio(0);
}
DI void attn9_pv_pre(f32x16 (&O)[4], const i32x8& pf, const i32x8 (&v0)[2], const unsigned char* vst, int ql, int hh) {
    __builtin_amdgcn_s_setprio(1);
    O[0] = MFMA_F8S(v0[0], pf, O[0], 0x7F7F7F7F, 0x7F7F7F7F); O[1] = MFMA_F8S(v0[1], pf, O[1], 0x7F7F7F7F, 0x7F7F7F7F);
#pragma unroll
    for (int dvb = 2; dvb < 4; ++dvb) { const i32x8 vf = attn9_frag(vst, dvb, ql, hh); O[dvb] = MFMA_F8S(vf, pf, O[dvb], 0x7F7F7F7F, 0x7F7F7F7F); }
    __builtin_amdgcn_s_setprio(0);
}

template <bool SKEW>
DI void attn9_body(PP p, unsigned char* lds, int j) {
    const int tid = tid_(), lane = tid & 63, wid = __builtin_amdgcn_readfirstlane(tid >> 6), cmap = wid >> 2, rg = wid & 3, ql = lane & 31, hh = lane >> 5;
    constexpr bool skew = SKEW;
    const float lam_init = j == 0 ? (float)(0.8 - 0.6 * 0.5488116360940264) : (float)(0.8 - 0.6 * 0.4065696597405991);
    float d1 = 0.f, d2 = 0.f;
    for (int i = 0; i < 64; ++i) { d1 += p->in[I_LQ1][j * 64 + i] * p->in[I_LK1][j * 64 + i]; d2 += p->in[I_LQ2][j * 64 + i] * p->in[I_LK2][j * 64 + i]; }
    const float lam = __builtin_bit_cast(float, __builtin_amdgcn_readfirstlane(__builtin_bit_cast(int, __expf(d1) - __expf(d2) + lam_init)));
    const float post = 1.0f - lam_init;
    const unsigned char* Q8 = (const unsigned char*)SCR16(p, 0); const unsigned char* K8 = (const unsigned char*)KBUF(p); const unsigned char* Vt8 = (const unsigned char*)VTBUF(p);
    bf16_t* Z = SCR16(p, SCR_Z);
    const float* subg = p->in[I_SUBG] + j * 128;
    unsigned* ctr = CTRL(p) + CT_ATTNQ + 64 * j;
    unsigned* s_u = (unsigned*)(lds + 65536);
    constexpr int NQB = LP / 128;
    const int total = NB * 8 * NQB;
    for (;;) {
        if (tid == 0) *s_u = atomicAdd(ctr, 1u);
        __syncthreads();
        const int u = __builtin_amdgcn_readfirstlane((int)*s_u);
        __syncthreads();
        if (u >= total) break;
        const int qb = NQB - 1 - u / 16, bh = u & 15, b = bh >> 3, head = bh & 7;
        const int q0 = qb * 128 + rg * 32, qq = q0 + ql;
        i32x8 qf;
        {
            const unsigned char* qp = Q8 + (((size_t)(b * 16 + head * 2 + cmap)) * LP + q0 + ql) * 64 + 32 * hh;
            const u32x4 lo = *(const u32x4*)qp, hi = *(const u32x4*)(qp + 16);
            qf = (i32x8){(int)lo.x, (int)lo.y, (int)lo.z, (int)lo.w, (int)hi.x, (int)hi.y, (int)hi.z, (int)hi.w};
        }
        const unsigned char* kbase = K8 + (((size_t)(b * 16 + head * 2 + cmap)) * LP) * 64;
        const unsigned char* vbase = Vt8 + ((size_t)(b * 1024 + head * 128)) * LP;
        const int ntile = 2 * qb + 2;
        const int nw = ((q0 + 31) >> 6) + 1;
        f32x16 O[4];
#pragma unroll
        for (int i = 0; i < 4; ++i)
#pragma unroll
            for (int r = 0; r < 16; ++r) O[i][r] = 0.f;
        float m_run = 0.f, l_run = 0.f;
        f32x16 sc[2], zc;
#pragma unroll
        for (int r = 0; r < 16; ++r) zc[r] = 4.0f;
        i32x8 pf = (i32x8){0, 0, 0, 0, 0, 0, 0, 0};
        const int krow_ = rg * 16 + (lane >> 2), vrow_ = wid * 16 + (lane >> 2);
        unsigned kofs = (unsigned)(krow_ * 64 + (((lane & 3) ^ ((krow_ >> 2) & 3)) << 4)); unsigned vofs = (unsigned)(vrow_ * LP + (((lane & 3) ^ ((vrow_ >> 2) & 3)) << 4));
        auto stage_dma = [&](unsigned char* stg, int kt) {
            {
                asm volatile("" : "+v"(kofs));
                __builtin_amdgcn_global_load_lds((const unsigned*)(kbase + (size_t)kt * 4096 + kofs), (LAS unsigned*)(stg + cmap * 4096 + rg * 1024), 16, 0, 0);
            }
            {
                asm volatile("" : "+v"(vofs));
                __builtin_amdgcn_global_load_lds((const unsigned*)(vbase + (size_t)kt * 64 + vofs), (LAS unsigned*)(stg + 8192 + wid * 1024), 16, 0, 0);
            }
        };
        stage_dma(lds, 0);
        stage_dma(lds + STG9, 1);
        __syncthreads();
        i32x8 kf[2], v0[2];
        if (!skew) { kf[0] = attn9_frag(lds + cmap * 4096, 0, ql, hh); kf[1] = attn9_frag(lds + cmap * 4096, 1, ql, hh); }
        for (int kt = 0; kt < ntile; ++kt) {
            if (kt + 2 < ntile) stage_dma(lds + ((kt + 2) & 3) * STG9, kt + 2);
            const unsigned char* cur = lds + (kt & 3) * STG9;
            if (!skew) {
                if (kt < nw) {
                    attn9_qk(sc, kf, qf, zc);
                    attn9_sm(sc, pf, O, zc, m_run, l_run, kt * 64, qq, kt * 64 + 63 > q0, kt == 0, hh);
                    attn9_pv(O, pf, cur + 8192, ql, hh);
                    if (kt + 1 < nw) { const unsigned char* nk = lds + ((kt + 1) & 3) * STG9 + cmap * 4096; kf[0] = attn9_frag(nk, 0, ql, hh); kf[1] = attn9_frag(nk, 1, ql, hh); }
                }
            } else {
                if (kt >= 1 && kt - 1 < nw) attn9_pv_pre(O, pf, v0, lds + ((kt - 1) & 3) * STG9 + 8192, ql, hh);
                if (kt < nw) {
                    kf[0] = attn9_frag(cur + cmap * 4096, 0, ql, hh); kf[1] = attn9_frag(cur + cmap * 4096, 1, ql, hh);
                    attn9_qk(sc, kf, qf, zc);
                    attn9_sm(sc, pf, O, zc, m_run, l_run, kt * 64, qq, kt * 64 + 63 > q0, kt == 0, hh);
                    v0[0] = attn9_frag(cur + 8192, 0, ql, hh); v0[1] = attn9_frag(cur + 8192, 1, ql, hh);
                }
            }
            __syncthreads();
        }
        if (skew && ntile - 1 < nw) attn9_pv_pre(O, pf, v0, lds + ((ntile - 1) & 3) * STG9 + 8192, ql, hh);
        __syncthreads();
        const float l_tot = l_run + __shfl_xor(l_run, 32);
        const float inv = 1.0f / l_tot;
        float* xb = (float*)lds + rg * 4096;
        if (cmap == 1) {
            const float sc1 = lam * inv;
#pragma unroll
            for (int i = 0; i < 4; ++i)
#pragma unroll
                for (int r = 0; r < 16; ++r) xb[(i * 16 + r) * 64 + lane] = O[i][r] * sc1;
        }
        __syncthreads();
        if (cmap == 0) {
            float ss = 0.f;
#pragma unroll
            for (int i = 0; i < 4; ++i)
#pragma unroll
                for (int r = 0; r < 16; ++r) { const float o = O[i][r] * inv - xb[(i * 16 + r) * 64 + lane]; O[i][r] = o; ss += o * o; }
            ss += __shfl_xor(ss, 32);
            const float rn = rsqrtf(ss * (1.0f / 128.0f) + 1e-5f) * post;
            const float* subg_l = subg; asm volatile("" : "+s"(subg_l));
            bf16_t* zp = Z + ((size_t)(b * LP + q0 + ql)) * D_ + head * 128;
#pragma unroll
            for (int i = 0; i < 4; ++i)
#pragma unroll
                for (int g = 0; g < 4; ++g) {
                    const int dv = i * 32 + 8 * g + 4 * hh;
                    const f32x4 sg = *(const f32x4*)(subg_l + dv);
                    f32x4 o; o[0] = O[i][4 * g + 0] * rn * sg[0]; o[1] = O[i][4 * g + 1] * rn * sg[1]; o[2] = O[i][4 * g + 2] * rn * sg[2]; o[3] = O[i][4 * g + 3] * rn * sg[3];
                    st_bf4(zp + dv, o);
                }
        }
        __syncthreads();
    }
}
DI void phase_attn8(PP p, unsigned char* lds, int j) {
    if (__builtin_amdgcn_readfirstlane(threadIdx.x >> 8) == 0) attn9_body<false>(p, lds, j); else attn9_body<true>(p, lds, j);
}

DI int* TAB_IDX(PP p) { return (int*)(p->ws + OFF_TAB); }
DI float* TAB_GATE(PP p) { return (float*)(p->ws + OFF_TAB) + NSLOT; }
DI int* TAB_TOKSLOT(PP p) { return (int*)(p->ws + OFF_TAB) + 2 * NSLOT; }
DI int* TAB_SLOTTOK(PP p) { return (int*)(p->ws + OFF_TAB) + 3 * NSLOT; }
DI float* TAB_SLOTGATE(PP p) { return (float*)(p->ws + OFF_TAB) + 4 * NSLOT; }
DI int* TAB_TILES(PP p) { return (int*)(p->ws + OFF_TAB) + 5 * NSLOT; }


DI void router_gemm(unsigned char* lds, const bf16_t* __restrict__ A, const bf16_t* __restrict__ Bt, float* lg) {
    const int tid = tid_(), lane = tid & 63, wid = tid >> 6, fr = lane & 15, fq = lane >> 4, sw = (fr >> 1) & 7;
    u32x4 ra[8], rb[4];
    unsigned oa[8], ob[4]; const bf16_t* pa[8]; const bf16_t* pb[4];
#pragma unroll
    for (int i = 0; i < 8; ++i) { const int id = tid + NTHR * i, j = id >> 10, row = (id & 1023) >> 3, c = id & 7; pa[i] = A + (size_t)row * D_ + j * 64 + c * 8; oa[i] = (unsigned)(j * 16384 + row * 128 + ((c ^ ((row >> 1) & 7)) << 4)); }
#pragma unroll
    for (int i = 0; i < 4; ++i) { const int id = tid + NTHR * i, j = id >> 9, row = (id & 511) >> 3, c = id & 7; pb[i] = Bt + (size_t)row * D_ + j * 64 + c * 8; ob[i] = (unsigned)(65536 + j * 8192 + row * 128 + ((c ^ ((row >> 1) & 7)) << 4)); }
    f32x4 acc[4];
#pragma unroll
    for (int ni = 0; ni < 4; ++ni) acc[ni] = (f32x4){0.f, 0.f, 0.f, 0.f};
#pragma unroll
    for (int i = 0; i < 8; ++i) ra[i] = *(const u32x4*)pa[i];
#pragma unroll
    for (int i = 0; i < 4; ++i) rb[i] = *(const u32x4*)pb[i];
#pragma unroll
    for (int i = 0; i < 8; ++i) *(u32x4*)(lds + oa[i]) = ra[i];
#pragma unroll
    for (int i = 0; i < 4; ++i) *(u32x4*)(lds + ob[i]) = rb[i];
    __syncthreads();
    for (int ck = 0; ck < 4; ++ck) {
        if (ck < 3) {
#pragma unroll
            for (int i = 0; i < 8; ++i) ra[i] = *(const u32x4*)(pa[i] + (ck + 1) * 256);
#pragma unroll
            for (int i = 0; i < 4; ++i) rb[i] = *(const u32x4*)(pb[i] + (ck + 1) * 256);
        }
#pragma unroll
        for (int j = 0; j < 4; ++j)
#pragma unroll
            for (int ks = 0; ks < 2; ++ks) {
                const int ch = ((ks * 4 + fq) ^ sw) << 4;
                const bf16x8 af = *(const bf16x8*)(lds + j * 16384 + (wid * 16 + fr) * 128 + ch);
#pragma unroll
                for (int ni = 0; ni < 4; ++ni) {
                    const bf16x8 bfr = *(const bf16x8*)(lds + 65536 + j * 8192 + (ni * 16 + fr) * 128 + ch);
                    acc[ni] = __builtin_amdgcn_mfma_f32_16x16x32_bf16(bfr, af, acc[ni], 0, 0, 0);
                }
            }
        __syncthreads();
        if (ck < 3) {
#pragma unroll
            for (int i = 0; i < 8; ++i) *(u32x4*)(lds + oa[i]) = ra[i];
#pragma unroll
            for (int i = 0; i < 4; ++i) *(u32x4*)(lds + ob[i]) = rb[i];
            __syncthreads();
        }
    }
#pragma unroll
    for (int ni = 0; ni < 4; ++ni) { float* d = lg + (wid * 16 + fr) * 65 + ni * 16 + 4 * fq; d[0] = acc[ni][0]; d[1] = acc[ni][1]; d[2] = acc[ni][2]; d[3] = acc[ni][3]; }
}

DI void router_gemm144(unsigned char* lds, const bf16_t* __restrict__ A, const bf16_t* __restrict__ Bt, float* lg) {
    const int tid = tid_(), lane = tid & 63, wid = __builtin_amdgcn_readfirstlane(tid >> 6), fr = lane & 15, fq = lane >> 4, sw = (fr >> 1) & 7;
    u32x4 ra[9], rb[4];
    unsigned oa[9], ob[4]; const bf16_t* pa[9]; const bf16_t* pb[4];
#pragma unroll
    for (int i = 0; i < 9; ++i) { const int id = tid + NTHR * i, j = id / 1152, rem = id - j * 1152, row = rem >> 3, c = rem & 7; pa[i] = A + (size_t)row * D_ + j * 64 + c * 8; oa[i] = (unsigned)(j * 18432 + row * 128 + ((c ^ ((row >> 1) & 7)) << 4)); }
#pragma unroll
    for (int i = 0; i < 4; ++i) { const int id = tid + NTHR * i, j = id >> 9, row = (id & 511) >> 3, c = id & 7; pb[i] = Bt + (size_t)row * D_ + j * 64 + c * 8; ob[i] = (unsigned)(73728 + j * 8192 + row * 128 + ((c ^ ((row >> 1) & 7)) << 4)); }
    f32x4 acc[4], acc9 = (f32x4){0.f, 0.f, 0.f, 0.f};
#pragma unroll
    for (int ni = 0; ni < 4; ++ni) acc[ni] = (f32x4){0.f, 0.f, 0.f, 0.f};
#pragma unroll
    for (int i = 0; i < 9; ++i) ra[i] = *(const u32x4*)pa[i];
#pragma unroll
    for (int i = 0; i < 4; ++i) rb[i] = *(const u32x4*)pb[i];
#pragma unroll
    for (int i = 0; i < 9; ++i) *(u32x4*)(lds + oa[i]) = ra[i];
#pragma unroll
    for (int i = 0; i < 4; ++i) *(u32x4*)(lds + ob[i]) = rb[i];
    __syncthreads();
    for (int ck = 0; ck < 4; ++ck) {
        if (ck < 3) {
#pragma unroll
            for (int i = 0; i < 9; ++i) ra[i] = *(const u32x4*)(pa[i] + (ck + 1) * 256);
#pragma unroll
            for (int i = 0; i < 4; ++i) rb[i] = *(const u32x4*)(pb[i] + (ck + 1) * 256);
        }
#pragma unroll
        for (int j = 0; j < 4; ++j)
#pragma unroll
            for (int ks = 0; ks < 2; ++ks) {
                const int ch = ((ks * 4 + fq) ^ sw) << 4;
                const bf16x8 af = *(const bf16x8*)(lds + j * 18432 + (wid * 16 + fr) * 128 + ch);
#pragma unroll
                for (int ni = 0; ni < 4; ++ni) {
                    const bf16x8 bfr = *(const bf16x8*)(lds + 73728 + j * 8192 + (ni * 16 + fr) * 128 + ch);
                    acc[ni] = __builtin_amdgcn_mfma_f32_16x16x32_bf16(bfr, af, acc[ni], 0, 0, 0);
                }
                if (wid < 4) {
                    const bf16x8 af9 = *(const bf16x8*)(lds + j * 18432 + (128 + fr) * 128 + ch);
                    const bf16x8 bf9 = *(const bf16x8*)(lds + 73728 + j * 8192 + (wid * 16 + fr) * 128 + ch);
                    acc9 = __builtin_amdgcn_mfma_f32_16x16x32_bf16(bf9, af9, acc9, 0, 0, 0);
                }
            }
        __syncthreads();
        if (ck < 3) {
#pragma unroll
            for (int i = 0; i < 9; ++i) *(u32x4*)(lds + oa[i]) = ra[i];
#pragma unroll
            for (int i = 0; i < 4; ++i) *(u32x4*)(lds + ob[i]) = rb[i];
            __syncthreads();
        }
    }
#pragma unroll
    for (int ni = 0; ni < 4; ++ni) { float* d = lg + (wid * 16 + fr) * 65 + ni * 16 + 4 * fq; d[0] = acc[ni][0]; d[1] = acc[ni][1]; d[2] = acc[ni][2]; d[3] = acc[ni][3]; }
    if (wid < 4) { float* d = lg + (128 + fr) * 65 + wid * 16 + 4 * fq; d[0] = acc9[0]; d[1] = acc9[1]; d[2] = acc9[2]; d[3] = acc9[3]; }
}


DI void phase_router(PP p, unsigned char* lds, int l) {
    float* lg = (float*)(lds + 106496);
    unsigned* hist = (unsigned*)(lds + 106496 + 144 * 65 * 4);
    const int tid = tid_(), lane = tid & 63, wid = tid >> 6;
    if (tid < 64) hist[tid] = 0u;
    __syncthreads();
    const float bias = p->in[I_RTB][l * NE + lane];
    int* idx = TAB_IDX(p); float* gt = TAB_GATE(p);
    constexpr int TPB = (LSEQ + 143) / 144;
    for (int mt = blockIdx.x; mt < NB * TPB; mt += gridDim.x) {
        const int b = mt / TPB, t0 = (mt - b * TPB) * 144;
        router_gemm144(lds, H16(p) + (size_t)(b * LP + t0) * D_, WS_RT(p), lg);
        __syncthreads();
        for (int rr = 0; rr < 18; ++rr) {
            const int r = wid * 18 + rr, t = t0 + r;
            if (t >= LSEQ) continue;
            const int n = b * LSEQ + t;
            const float s = sigmoidf_(lg[r * 65 + lane]);
            const float sel = s + bias;
            const float m1 = red8_max(sel);
            const unsigned long long eq = __ballot(sel == m1);
            const unsigned gb = (unsigned)(eq >> ((lane >> 3) * 8)) & 0xffu;
            const int first = __builtin_ctz(gb | 0x100u);
            const float sel2 = (lane & 7) == first ? -INFINITY : sel;
            const float gs = m1 + red8_max(sel2);
            int rank = 0;
#pragma unroll
            for (int g = 0; g < 8; ++g) { const float o = rdlane(gs, g * 8); rank += (o > gs || (o == gs && g < (lane >> 3))) ? 1 : 0; }
            float cur = rank < 4 ? sel : -INFINITY;
            float wsum = 0.f, my_s = 0.f; int my_i = 0;
#pragma unroll
            for (int k = 0; k < 8; ++k) {
                const float m = wave_max(cur);
                const unsigned long long bal = __ballot(cur == m);
                const int win = __builtin_ctzll(bal | (1ull << 63));
                const float swv = rdlane(s, win);
                wsum += swv;
                if (lane == k) { my_i = win; my_s = swv; }
                if (lane == win) cur = -INFINITY;
            }
            if (lane < 8) {
                idx[n * 8 + lane] = my_i; gt[n * 8 + lane] = my_s / wsum * 2.5f;
                atomicAdd(hist + my_i, 1u);
            }
        }
        __syncthreads();
    }
    __syncthreads();
    if (tid < 64 && hist[tid]) atomicAdd(CTRL(p) + CT_CNT + 64 * l + tid, (unsigned)hist[tid]);
}

DI void phase_scatter(PP p, unsigned char* lds, int l) {
    unsigned* cnt = (unsigned*)lds; unsigned* lh = cnt + 64; unsigned* lbase = lh + 64; unsigned* lcur = lbase + 64; unsigned* start = lcur + 64;
    const int tid = tid_();
    unsigned* gc = CTRL(p) + CT_CNT + 64 * l; unsigned* gcur = CTRL(p) + CT_CUR + 64 * l;
    if (tid < 64) { cnt[tid] = __hip_atomic_load(gc + tid, __ATOMIC_RELAXED, __HIP_MEMORY_SCOPE_AGENT); lh[tid] = 0u; lcur[tid] = 0u; }
    __syncthreads();
    if (tid < 64) { unsigned s = 0; for (int e = 0; e < tid; ++e) s += cnt[e]; start[tid] = s; }
    const int per = (NTOK + gridDim.x - 1) / gridDim.x;
    const int n0 = blockIdx.x * per, n1 = n0 + per < NTOK ? n0 + per : NTOK;
    const int* idx = TAB_IDX(p); const float* gt = TAB_GATE(p);
    int* tok_slot = TAB_TOKSLOT(p); int* slot_tok = TAB_SLOTTOK(p); float* slot_gate = TAB_SLOTGATE(p);
    __syncthreads();
    for (int i = n0 * 8 + tid; i < n1 * 8; i += NTHR) atomicAdd(lh + idx[i], 1u);
    __syncthreads();
    if (tid < 64) lbase[tid] = start[tid] + (lh[tid] ? atomicAdd(gcur + tid, (unsigned)lh[tid]) : 0u);
    __syncthreads();
    for (int i = n0 * 8 + tid; i < n1 * 8; i += NTHR) {
        const int e = idx[i], n = i >> 3;
        const unsigned pos = lbase[e] + atomicAdd(lcur + e, 1u);
        const int b = n >= LSEQ ? 1 : 0, t = n - b * LSEQ;
        slot_tok[pos] = b * LP + t; slot_gate[pos] = gt[i]; tok_slot[i] = (int)pos;
    }
    if (blockIdx.x == 0 && tid < 64) {
        unsigned tb = 0; for (int e = 0; e < tid; ++e) tb += (cnt[e] + 255) >> 8;
        const unsigned nt = (cnt[tid] + 255) >> 8;
        int* tiles = TAB_TILES(p);
        for (unsigned i = 0; i < nt; ++i) { int* tp = tiles + (tb + i) * 4; tp[0] = tid; tp[1] = (int)(start[tid] + 256 * i); const int rem = (int)cnt[tid] - 256 * (int)i; tp[2] = rem < 256 ? rem : 256; tp[3] = 0; }
        if (tid == 63) CTRL(p)[CT_NT + l] = tb + nt;
    }
}


constexpr int MT8 = 128;
DI bf16_t* r1_dst(bf16_t* r, bf16_t* v, bf16_t* lo1, int n4) {
    bf16_t* d = r + (size_t)n4 * (SZ_ACT16 / 2); if (n4 == 2) d = v; if (n4 >= 3) d = lo1; return d; }
DI bool xcd_order(int i, int nN, int& mt, int& nt) {
    const int G = gridDim.x, b = blockIdx.x;
    if ((G & 7) == 0) {
        const int x = b & 7, per = G >> 3, li = i * per + (b >> 3), ml = li / nN;
        if (ml >= MT8 / 8) return false;
        mt = ml * 8 + x; nt = li - ml * nN; return true;
    }
    const long L = (long)i * G + b; if (L >= (long)MT8 * nN) return false;
    mt = (int)(L / nN); nt = (int)(L - (long)mt * nN); return true;
}
struct EpiR1Q { bf16_t* r; bf16_t* v; bf16_t* lo1;
    DI void apply(const f32x4 (&acc)[2][2][4][2], const g8::Unit& u, int wr, int wc, int fr, int fq) const {
        const int n4 = u.n0 >> 10, col = u.n0 + 64 * wc + 16 * fq;
        bf16_t* dst = r1_dst(r, v, lo1, n4);
        if (n4 >= 3 && col >= 3456) return;
        const int c = col - 3072;
        const int act = n4 < 3 ? 0 : (c < 64 ? 1 : ((c >= 128 && c < 288) ? 2 : (((c >= 288 && c < 320) || c >= 352) ? 3 : 0)));
#pragma unroll
        for (int ai = 0; ai < 2; ++ai)
#pragma unroll
            for (int m = 0; m < 4; ++m) {
                const int prow = u.m0 + 128 * ai + 64 * wr + 16 * m + fr;
                bf16_t* d = n4 < 3 ? dst + hm_off(prow, col & 1023) : dst + (size_t)prow * LO1_W + c;
#pragma unroll
                for (int bj = 0; bj < 2; ++bj) {
                    f32x4 v0 = acc[ai][bj][m][0], v1 = acc[ai][bj][m][1];
                    if (act == 1) {
#pragma unroll
                        for (int i = 0; i < 4; ++i) { v0[i] = tanhf_(v0[i]); v1[i] = tanhf_(v1[i]); }
                    } else if (act == 2) {
#pragma unroll
                        for (int i = 0; i < 4; ++i) { v0[i] = sigmoidf_(v0[i]); v1[i] = sigmoidf_(v1[i]); }
                    } else if (act == 3) { v0 = (f32x4){0.f, 0.f, 0.f, 0.f}; v1 = v0; }
                    u32x4 w; w.x = cvt_pk_bf16(v0[0], v0[1]); w.y = cvt_pk_bf16(v0[2], v0[3]); w.z = cvt_pk_bf16(v1[0], v1[1]); w.w = cvt_pk_bf16(v1[2], v1[3]);
                    *(u32x4*)(d + 8 * bj) = w;
                }
            }
    } };
struct SchedR1 { const char* ab; const bf16_t* bt; int tid;
    DI bool next(int i, g8::Unit& u) const {
        int mt, nt; if (!xcd_order(i, 14, mt, nt)) return false;
        u.m0 = mt * 256; u.n0 = nt * 256; u.ab = ab + (size_t)u.m0 * D_; u.bb = (const char*)bt + (size_t)(nt * 256) * 2048;
        u.ao[0] = 0; u.ao[1] = 0; u.ag[0] = 0; u.ag[1] = 0; u.x0 = 0; u.x1 = 0; u.x2 = 0; return true; } };
DI void phase_r1(PP p, unsigned char* lds, int l) {
    EpiR1Q eq; eq.r = SCR16(p, SCR_R); eq.v = l == 0 ? VFIRST(p) : SCR16(p, SCR_V); eq.lo1 = SCR16(p, SCR_LO1);
    SchedR1 sc; sc.ab = (const char*)(H8BUF(p) - D_); sc.bt = WL_BIG(p); sc.tid = tid_();
    g8::gemm8<true, 0, EpiR1Q, SchedR1, true, true, 0x7F7F7F7F, 0x7A7A7A7A>(lds, 1024, 128, D_, sc, eq);
    EpiR1 e;
    for (int u = blockIdx.x; u < 2 * 56; u += gridDim.x) {
        const int ms = u / 56, nt = u - ms * 56;
        e.m0 = MT8 * 256 + ms * 128; e.n0 = nt * 64; const int n4 = nt >> 2;
        e.kind = n4 < 12 ? 0 : 1; e.dst = r1_dst(eq.r, eq.v, eq.lo1, n4 >> 2);
        APlain a; a.base = (const bf16_t*)(H8BUF(p) + (size_t)e.m0 * D_ - D_); a.ld = D_ / 2;
        gemm_tile<128, 64, 16, 64, true, true, 0x7F7F7F7F, 0x7A7A7A7A>(lds, a, (const bf16_t*)((const unsigned char*)WL_BIG(p) + (size_t)(nt * 64) * 2048), 1024, 1024, e);
    }
}

struct EpiMixQ { bf16_t* mix;
    DI void apply(const f32x4 (&acc)[2][2][4][2], const g8::Unit& u, int wr, int wc, int fr, int fq) const {
        bf16_t* dst = mix + (size_t)u.m0 * D_ + u.n0 + 64 * wc + 16 * fq;
#pragma unroll
        for (int ai = 0; ai < 2; ++ai)
#pragma unroll
            for (int m = 0; m < 4; ++m) {
                const int r = 128 * ai + 64 * wr + 16 * m + fr;
#pragma unroll
                for (int bj = 0; bj < 2; ++bj) {
                    const f32x4 v0 = acc[ai][bj][m][0], v1 = acc[ai][bj][m][1];
                    u32x4 w; w.x = cvt_pk_bf16(v0[0], v0[1]); w.y = cvt_pk_bf16(v0[2], v0[3]); w.z = cvt_pk_bf16(v1[0], v1[1]); w.w = cvt_pk_bf16(v1[2], v1[3]);
                    *(u32x4*)(dst + (size_t)r * D_ + 8 * bj) = w;
                }
            }
    } };
struct SchedOut { const char* ab; const bf16_t* bt; int tid; bool hm;
    DI bool next(int i, g8::Unit& u) const {
        int mt, nt; if (!xcd_order(i, 4, mt, nt)) return false;
        u.m0 = mt * 256; u.n0 = nt * 256; u.ab = ab; u.bb = (const char*)(bt + (size_t)(nt * 256) * D_);
#pragma unroll
        for (int j = 0; j < 2; ++j) { int R, C; g8::piece_rc(tid, j, R, C);
#pragma unroll
            for (int h = 0; h < 2; ++h) {
                const int prow = u.m0 + 128 * h + R; unsigned o;
                if (hm) { const int b = prow >= LP ? 1 : 0, t = prow - b * LP; o = (unsigned)((((b * 16) * LP + t) * 64 + C) * 2); }
                else o = (unsigned)((prow * D_ + C) * 2);
                if (h) u.ag[j] = o; else u.ao[j] = o;
            } }
        u.x0 = 0; u.x1 = 0; u.x2 = 0; return true; } };
DI void phase_outproj(PP p, unsigned char* lds, bool hm) {
    EpiMixQ eq; eq.mix = SCR16(p, SCR_R);
    SchedOut sc; sc.ab = (const char*)SCR16(p, SCR_Z); sc.bt = WL_OUT(p); sc.hm = hm; sc.tid = tid_();
    g8::gemm8<true, true, EpiMixQ, SchedOut, true>(lds, D_, hm ? (size_t)LP * 128 : (size_t)128, 0, sc, eq);
    EpiMix e; e.dst = SCR16(p, SCR_R);
    for (int u = blockIdx.x; u < 2 * 16; u += gridDim.x) {
        const int ms = u >> 4, nt = u & 15;
        e.m0 = MT8 * 256 + ms * 128; e.n0 = nt * 64;
        APlain a;
        if (hm) { const int b = e.m0 >= LP ? 1 : 0, t0 = e.m0 - b * LP; a.base = SCR16(p, SCR_Z) + ((size_t)(b * 16) * LP + t0) * 64; a.ld = 64; }
        else { a.base = SCR16(p, SCR_Z) + (size_t)e.m0 * D_; a.ld = D_; }
        gemm_tile<128, 64, 16, 64, true>(lds, a, WL_OUT(p) + (size_t)(nt * 64) * D_, D_, D_, e, hm ? (size_t)LP * 64 : (size_t)64);
    }
}

struct EpiQKQ { bf16_t* q; bf16_t* k;
    DI void apply(const f32x4 (&acc)[2][2][4][2], const g8::Unit& u, int wr, int wc, int fr, int fq) const {
        unsigned char* dst = (unsigned char*)(u.x0 ? k : q); const float scale = u.x0 ? 1.0f : 1.4426950408889634f;
        const int col = u.n0 + 64 * wc + 16 * fq;
#pragma unroll
        for (int ai = 0; ai < 2; ++ai)
#pragma unroll
            for (int m = 0; m < 4; ++m) {
                const int prow = u.m0 + 128 * ai + 64 * wr + 16 * m + fr;
                const int b = prow >= LP ? 1 : 0, t = prow - b * LP;
                unsigned char* d = dst + (((size_t)(b * 16 + (col >> 6))) * LP + t) * 64 + (col & 63);
                const f32x4 a0 = acc[ai][0][m][0] * scale, a1 = acc[ai][0][m][1] * scale, b0 = acc[ai][1][m][0] * scale, b1 = acc[ai][1][m][1] * scale;
                u32x4 w;
                w.x = (unsigned)__builtin_amdgcn_cvt_pk_fp8_f32(a0[2], a0[3], __builtin_amdgcn_cvt_pk_fp8_f32(a0[0], a0[1], 0, false), true);
                w.y = (unsigned)__builtin_amdgcn_cvt_pk_fp8_f32(a1[2], a1[3], __builtin_amdgcn_cvt_pk_fp8_f32(a1[0], a1[1], 0, false), true);
                w.z = (unsigned)__builtin_amdgcn_cvt_pk_fp8_f32(b0[2], b0[3], __builtin_amdgcn_cvt_pk_fp8_f32(b0[0], b0[1], 0, false), true);
                w.w = (unsigned)__builtin_amdgcn_cvt_pk_fp8_f32(b1[2], b1[3], __builtin_amdgcn_cvt_pk_fp8_f32(b1[0], b1[1], 0, false), true);
                *(u32x4*)d = w;
            }
    } };
struct EpiVtQ { bf16_t* vt;
    DI void apply(const f32x4 (&acc)[2][2][4][2], const g8::Unit& u, int wr, int wc, int fr, int fq) const {
        EpiVt8 e; e.m0 = u.m0; e.n0 = u.n0; e.dst = (unsigned char*)vt; g8::quad_epi(e, acc, wr, wc, fr, fq); } };
struct SchedQKV { const char* ab; const bf16_t* wq; const bf16_t* wkv; int tid; int nwhich; bool vpart;
    DI bool next(int i, g8::Unit& u) const {
        int mt, nn; if (!xcd_order(i, 4 * nwhich, mt, nn)) return false;
        const int which = nn >> 2, nt = nn & 3;
        u.m0 = mt * 256; u.n0 = nt * 256; u.ab = ab + (size_t)u.m0 * D_; u.x0 = which;
        const bf16_t* bt = vpart ? wkv + (size_t)(1024 + nt * 256) * (D_ / 2) : (which ? wkv + (size_t)(nt * 256) * (D_ / 2) : wq + (size_t)(nt * 256) * (D_ / 2));
        u.bb = (const char*)bt; u.ao[0] = 0; u.ao[1] = 0; u.ag[0] = 0; u.ag[1] = 0;
        u.x1 = 0; u.x2 = 0; return true; } };
DI void phase_qkv(PP p, unsigned char* lds, int l) {
    SchedQKV sc; sc.ab = (const char*)H8BUF(p); sc.wq = WL_WQ(p); sc.wkv = WL_BIG(p); sc.tid = tid_();
    { EpiQKQ eq; eq.q = SCR16(p, 0); eq.k = KBUF(p); sc.nwhich = l == 2 ? 2 : 1; sc.vpart = false; g8::gemm8<true, 0, EpiQKQ, SchedQKV, true, true, 0x7F7F7F7F, 0x7A7A7A7A>(lds, D_ / 2, 128, D_, sc, eq); }
    if (l == 2) { EpiVtQ ev; ev.vt = VTBUF(p); sc.nwhich = 1; sc.vpart = true; g8::gemm8<false, 0, EpiVtQ, SchedQKV, false, true, 0x7F7F7F7F, 0x7A7A7A7A>(lds, D_ / 2, 128, D_, sc, ev); }
    const int nsu = l == 2 ? 3 * 32 : 32;
    for (int u = blockIdx.x; u < nsu; u += gridDim.x) {
        const int which = u >> 5, r = u & 31, ms = r >> 4, nt = r & 15;
        const int m0 = MT8 * 256 + ms * 128;
        APlain a; a.base = (const bf16_t*)(H8BUF(p) + (size_t)m0 * D_); a.ld = D_ / 2;
        if (which < 2) {
            EpiQK8 e; e.m0 = m0; e.n0 = nt * 64; e.dst = (unsigned char*)(which ? KBUF(p) : SCR16(p, 0)); e.scale = which ? 1.0f : 1.4426950408889634f;
            gemm_tile<128, 64, 16, 64, true, true, 0x7F7F7F7F, 0x7A7A7A7A>(lds, a, (which ? WL_BIG(p) : WL_WQ(p)) + (size_t)(nt * 64) * (D_ / 2), D_ / 2, D_ / 2, e);
        } else {
            EpiVt8 e; e.m0 = m0; e.n0 = nt * 64; e.dst = (unsigned char*)VTBUF(p);
            gemm_tile<128, 64, 16, 64, false, true, 0x7F7F7F7F, 0x7A7A7A7A>(lds, a, WL_BIG(p) + (size_t)(1024 + nt * 64) * (D_ / 2), D_ / 2, D_ / 2, e);
        }
    }
}

struct EpiM1Q { unsigned char* h; unsigned char* hs; const float* gate;
    DI void apply(const f32x4 (&acc)[2][2][4][2], const g8::Unit& u, int wr, int wc, int fr, int fq) const {
        EpiM1 e; e.n0 = u.n0; e.row0 = u.x0; e.nrows = u.x1; e.dst = u.x2 ? hs : h; e.gate = u.x2 ? nullptr : gate; g8::quad_epi(e, acc, wr, wc, fr, fq); } };
constexpr int MTS = NP / 256;
struct SchedM1 { const char* ab; const unsigned char* wm; const unsigned char* wsh; const int* tiles; const int* slot_tok; int T; int tid_unused;
    DI bool next(int i, g8::Unit& u) const {
        int tid = (int)threadIdx.x; asm volatile("" : "+v"(tid));
        int tile, half;
        if ((gridDim.x & 7) == 0) { const int li = i * (int)(gridDim.x >> 3) + (int)(blockIdx.x >> 3); tile = 8 * (li >> 1) + (int)(blockIdx.x & 7); half = li & 1; if (tile >= T + MTS) return false; }
        else { const long L = (long)i * gridDim.x + blockIdx.x; if (L >= (long)(T + MTS) * 2) return false; tile = (int)L >> 1; half = (int)L & 1; }
        u.ab = ab; u.n0 = half * 256; u.m0 = 0;
        if (tile < T) {
            const int ex = __builtin_amdgcn_readfirstlane(tiles[tile * 4]), s0 = __builtin_amdgcn_readfirstlane(tiles[tile * 4 + 1]), nr = __builtin_amdgcn_readfirstlane(tiles[tile * 4 + 2]);
            u.x0 = s0; u.x1 = nr; u.x2 = 0; u.bb = (const char*)(wm + ((size_t)ex * 512 + half * 256) * D_);
#pragma unroll
            for (int j = 0; j < 2; ++j) { int R, C; g8::piece_rc(tid, j, R, C);
                int r0 = R < nr ? R : nr - 1, r1 = 128 + R < nr ? 128 + R : nr - 1;
                u.ao[j] = (unsigned)slot_tok[s0 + r0] | ((unsigned)slot_tok[s0 + r1] << 16); u.ag[j] = 0; (void)C; }
        } else {
            const int mt = tile - T;
            u.x0 = mt * 256; u.x1 = 256; u.x2 = 1; u.bb = (const char*)(wsh + (size_t)(half * 256) * D_);
#pragma unroll
            for (int j = 0; j < 2; ++j) { int R, C; g8::piece_rc(tid, j, R, C);
                u.ao[j] = (unsigned)(mt * 256 + R) | ((unsigned)(mt * 256 + 128 + R) << 16); u.ag[j] = 0; (void)C; }
        }
        return true; } };
DI void phase_m1(PP p, unsigned char* lds, int l) {
    EpiM1Q eq; eq.h = (unsigned char*)SCR16(p, SCR_H); eq.hs = (unsigned char*)SCR16(p, SCR_HS); eq.gate = TAB_SLOTGATE(p);
    SchedM1 sc; sc.ab = (const char*)H8BUF(p); sc.wm = (const unsigned char*)WM_GU(p); sc.wsh = (const unsigned char*)WS_GU(p); sc.tiles = TAB_TILES(p); sc.slot_tok = TAB_SLOTTOK(p); sc.T = (int)CTRL(p)[CT_NT + l]; sc.tid_unused = 0;
    g8::gemm8<true, 2, EpiM1Q, SchedM1, false, true, 0x7F7F7F7F, 0x7A7A7A7A>(lds, D_ / 2, 128, 0, sc, eq);
}

struct EpiM2Q { unsigned char* y8; bf16_t* ysh;
    DI void apply(const f32x4 (&acc)[2][2][4][2], const g8::Unit& u, int wr, int wc, int fr, int fq) const {
        const int colb = u.n0 + 64 * wc + 16 * fq;
#pragma unroll
        for (int ai = 0; ai < 2; ++ai)
#pragma unroll
            for (int m = 0; m < 4; ++m) {
                const int r = 128 * ai + 64 * wr + 16 * m + fr;
                if (r < u.x1) {
                    const f32x4 a0 = acc[ai][0][m][0], a1 = acc[ai][0][m][1], b0 = acc[ai][1][m][0], b1 = acc[ai][1][m][1];
                    if (u.x2) {
                        bf16_t* d = ysh + (size_t)(u.x0 + r) * D_ + colb;
                        u32x4 w; w.x = cvt_pk_bf16(a0[0], a0[1]); w.y = cvt_pk_bf16(a0[2], a0[3]); w.z = cvt_pk_bf16(a1[0], a1[1]); w.w = cvt_pk_bf16(a1[2], a1[3]);
                        *(u32x4*)d = w;
                        w.x = cvt_pk_bf16(b0[0], b0[1]); w.y = cvt_pk_bf16(b0[2], b0[3]); w.z = cvt_pk_bf16(b1[0], b1[1]); w.w = cvt_pk_bf16(b1[2], b1[3]);
                        *(u32x4*)(d + 8) = w;
                    } else {
                        u32x4 w;
                        w.x = (unsigned)__builtin_amdgcn_cvt_pk_fp8_f32(a0[2] * 16.f, a0[3] * 16.f, __builtin_amdgcn_cvt_pk_fp8_f32(a0[0] * 16.f, a0[1] * 16.f, 0, false), true);
                        w.y = (unsigned)__builtin_amdgcn_cvt_pk_fp8_f32(a1[2] * 16.f, a1[3] * 16.f, __builtin_amdgcn_cvt_pk_fp8_f32(a1[0] * 16.f, a1[1] * 16.f, 0, false), true);
                        w.z = (unsigned)__builtin_amdgcn_cvt_pk_fp8_f32(b0[2] * 16.f, b0[3] * 16.f, __builtin_amdgcn_cvt_pk_fp8_f32(b0[0] * 16.f, b0[1] * 16.f, 0, false), true);
                        w.w = (unsigned)__builtin_amdgcn_cvt_pk_fp8_f32(b1[2] * 16.f, b1[3] * 16.f, __builtin_amdgcn_cvt_pk_fp8_f32(b1[0] * 16.f, b1[1] * 16.f, 0, false), true);
                        *(u32x4*)(y8 + (size_t)(u.x0 + r) * D_ + colb) = w;
                    }
                }
            }
    } };
struct SchedM2 { const char* ah; const char* ahs; const unsigned char* wm; const unsigned char* wsh; const int* tiles; int T; int tid;
    DI bool next(int i, g8::Unit& u) const {
        int tile, nq;
        if ((gridDim.x & 7) == 0) { const int li = i * (int)(gridDim.x >> 3) + (int)(blockIdx.x >> 3); tile = 8 * (li >> 2) + (int)(blockIdx.x & 7); nq = li & 3; if (tile >= T + MTS) return false; }
        else { const long L = (long)i * gridDim.x + blockIdx.x; if (L >= (long)(T + MTS) * 4) return false; tile = (int)L >> 2; nq = (int)L & 3; }
        u.n0 = nq * 256; u.m0 = 0;
        if (tile < T) {
            const int ex = __builtin_amdgcn_readfirstlane(tiles[tile * 4]), s0 = __builtin_amdgcn_readfirstlane(tiles[tile * 4 + 1]), nr = __builtin_amdgcn_readfirstlane(tiles[tile * 4 + 2]);
            u.x0 = s0; u.x1 = nr; u.x2 = 0; u.bb = (const char*)(wm + ((size_t)ex * 1024 + nq * 256) * FF);
            u.ab = ah + (size_t)s0 * FF;
        } else {
            const int mt = tile - T;
            u.ab = ahs + (size_t)(mt * 256) * FF; u.x0 = mt * 256; u.x1 = 256; u.x2 = 1; u.bb = (const char*)(wsh + (size_t)(nq * 256) * FF);
        }
        u.ao[0] = 0; u.ao[1] = 0; u.ag[0] = 0; u.ag[1] = 0; return true; } };
DI void phase_m2(PP p, unsigned char* lds, int l) {
    EpiM2Q eq; eq.y8 = (unsigned char*)SCR16(p, SCR_Y); eq.ysh = SCR16(p, SCR_YSH);
    SchedM2 sc; sc.ah = (const char*)SCR16(p, SCR_H); sc.ahs = (const char*)SCR16(p, SCR_HS); sc.wm = (const unsigned char*)WM_DN(p); sc.wsh = (const unsigned char*)WS_DN(p); sc.tiles = TAB_TILES(p); sc.T = (int)CTRL(p)[CT_NT + l]; sc.tid = tid_();
    g8::gemm8<true, false, EpiM2Q, SchedM2, true, true, 0x7C7C7C7C, 0x7A7A7A7A>(lds, FF / 2, 128, FF, sc, eq);
}

__global__ void __launch_bounds__(NTHR, 2) mega(Params p) {
    extern __shared__ __attribute__((aligned(16))) unsigned char lds[];
    LAS unsigned* xbw = (LAS unsigned*)(lds + LDS_BAR);
    if (threadIdx.x == 0) { xbw[0] = 0u; xbw[1] = 0u; xbw[2] = 0u; xbw[3] = 0u; }
    __syncthreads();
    (void)xcd_barrier_post(CTRL(P_()), (volatile LAS unsigned*)xbw);
#define bar mkbar(P_(), lds)
#ifndef AMP_MASK
#define AMP_MASK 0
#endif
#define PH(id, ...) do { const unsigned long long t0_ = (AMP_MASK >> (id)) & 1 ? wall_clock64() : 0ull; __VA_ARGS__; xcd_barrier(bar); \
    if ((AMP_MASK >> (id)) & 1) { const unsigned long long d_ = wall_clock64() - t0_; while (wall_clock64() - t0_ < 2 * d_) __builtin_amdgcn_s_sleep(8); } } while (0)
    PH(0, phase_init(P_()); phase_weights(P_(), lds, 0, 0, 0));
    for (int l = 0; l < 4; ++l) {
        if (l < 2) {
            PH(1, phase_r1(P_(), lds, l));
            PH(2, phase_r2(P_(), lds, l));
            PH(3, phase_scanA(P_(), lds, l));
            PH(4, phase_scanB(P_(), lds, l); phase_weights_moe(P_(), lds, l, NB * 16));
            PH(5, phase_scanC(P_(), lds, l));
        } else {
            PH(6, phase_qkv(P_(), lds, l));
            PH(7, phase_attn8(P_(), lds, l - 2));
        }
        PH(8, phase_outproj(P_(), lds, l < 2));
        PH(9, phase_ln<false>(P_(), P_()->in[I_LNMG] + l * D_, P_()->in[I_LNMB] + l * D_, false));
        PH(10, phase_router(P_(), lds, l));
        PH(11, phase_scatter(P_(), lds, l));
        PH(12, phase_m1(P_(), lds, l));
        PH(13, phase_m2(P_(), lds, l));
        PH(14, phase_ln<true>(P_(), P_()->in[I_LNFG] + l * D_, P_()->in[I_LNFB] + l * D_, l == 3); if (l < 3) { phase_weights(P_(), lds, l + 1, 0, 0); if (l + 1 >= 2) phase_weights_moe(P_(), lds, l + 1, 0); });
    }
}

extern "C" void kernel_launch(void* const* d_in, const int* in_sizes, int n_in, void* d_out, int out_size, void* d_ws, size_t ws_size, hipStream_t stream) {
    constexpr size_t kDynLds = LDS_BAR + 256;
    static int grid = 0;
    if (!grid) {
        int dev = 0, cus = 0, per_cu = 0;
        hipGetDevice(&dev);
        hipDeviceGetAttribute(&cus, hipDeviceAttributeMultiprocessorCount, dev);
        hipFuncSetAttribute((const void*)mega, hipFuncAttributeMaxDynamicSharedMemorySize, (int)kDynLds);
        hipOccupancyMaxActiveBlocksPerMultiprocessor(&per_cu, mega, NTHR, kDynLds);
        grid = cus * (per_cu < 1 ? per_cu : 1);
        if (grid <= 0) grid = 0;
    }
    if (n_in < 41 || ws_size < WS_NEED || grid <= 0) { fprintf(stderr, "kernel_launch: bad config (n_in %d ws %zu need %zu grid %d)\n", n_in, ws_size, (size_t)WS_NEED, grid); return; }
    hipMemsetAsync(d_ws, 0, 65536, stream);
    Params p; memset(&p, 0, sizeof(p));
    for (int i = 0; i < 41; ++i) p.in[i] = (const float*)d_in[i];
    p.out = (float*)d_out; p.ws = (unsigned char*)d_ws;
    hipLaunchKernelGGL(mega, dim3(grid), dim3(NTHR), kDynLds, stream, p);
}
#ifdef PHASE_TEST
#define PK(name, body) __global__ void __launch_bounds__(NTHR, 2) name(Params pv, int l) { extern __shared__ __attribute__((aligned(16))) unsigned char lds[]; PP p = P_(); body; }
PK(t_init, phase_init(p))
PK(t_weights, phase_weights(p, lds, l, 0, 0); phase_weights_moe(p, lds, l, 32))
PK(t_r1, phase_r1(p, lds, l))
PK(t_r2, phase_r2(p, lds, l))
PK(t_scanA, phase_scanA(p, lds, l))
PK(t_scanB, phase_scanB(p, lds, l))
PK(t_scanC, phase_scanC(p, lds, l))
PK(t_outproj, phase_outproj(p, lds, l < 2))
PK(t_ln0, phase_ln<false>(p, p->in[I_LNMG], p->in[I_LNMB], false))
PK(t_ln1, phase_ln<true>(p, p->in[I_LNMG], p->in[I_LNMB], l == 3))
PK(t_qkv, phase_qkv(p, lds, l))
PK(t_attn, phase_attn8(p, lds, l))
PK(t_router, phase_router(p, lds, l))
PK(t_scatter, phase_scatter(p, lds, l))
PK(t_m1, phase_m1(p, lds, l))
PK(t_m2, phase_m2(p, lds, l))
#endif
```
